# Optimizing an MI355X kernel written in HIP

```python
import math
import jax, jax.numpy as jnp
from jax import lax
import numpy as np

D_MODEL = 1024
BATCH = 4
SEQ = 8192
DEPTH = 4

GRID_W = 64
CTX_LEN = 256
HEAD_DIM = 64
NA_HEADS = 6
NA_W = NA_HEADS * HEAD_DIM
NA_ROWS = 8
NA_COLS = 16
NA_QBLK = 16
NA_KBLK = 32
S5_GROUP_CH = 16
S5_CH = 256
S5_GROUPS = S5_CH // S5_GROUP_CH
S5_STATE = 64
S5_DT_MIN = 1e-3
S5_DT_MAX = 1e-1
S5_EIG_MAX = -1e-4
SW_HEADS = 6
SW_KV_HEADS = 2
SW_W = SW_HEADS * HEAD_DIM
SW_KV_W = SW_KV_HEADS * HEAD_DIM
SW_WINDOW = 128
SW_BLK = 128
ROPE_BASE = 10000.0
MIX_W = NA_W + S5_CH + SW_W
IN_COLS = 3 * NA_W + S5_CH + SW_W + 2 * SW_KV_W
PROJ_SPLITS = (NA_W, 2 * NA_W, 3 * NA_W, 3 * NA_W + S5_CH, 3 * NA_W + S5_CH + SW_W, 3 * NA_W + S5_CH + SW_W + SW_KV_W)
N_EXPERTS = 32
TOP_K = 4
EXPERT_FF = D_MODEL
MOE_BLK = 256
SWIGLU_LIMIT = 7.0
SWIGLU_ALPHA = 1.702
RMS_EPS = 1e-6
NEG_INF = -1e30

kernel_name = 'hybrid_na_s5_swa_moe_dit'


def _rmsnorm(x, g):
    x32 = x.astype(jnp.float32)
    y = x32 * lax.rsqrt(jnp.mean(x32 * x32, axis=-1, keepdims=True) + RMS_EPS)
    return (y * g.astype(jnp.float32)).astype(x.dtype)


def _modulate(h, shift, scale):
    return h * (1.0 + scale) + shift


def _heads(t):
    return t.reshape(t.shape[:-1] + (t.shape[-1] // HEAD_DIM, HEAD_DIM))


def _axial_rope(length, dim):
    t = jnp.arange(length)
    row = (t // GRID_W).astype(jnp.float32)
    col = (t % GRID_W).astype(jnp.float32)
    nf = dim // 4
    inv = ROPE_BASE ** (-jnp.arange(nf, dtype=jnp.float32) / nf)
    ar = row[:, None] * inv
    ac = col[:, None] * inv
    ang = jnp.concatenate([ar, ar, ac, ac], axis=-1)[:, None, :]
    return jnp.cos(ang), jnp.sin(ang)


def _apply_rope(x, cos, sin):
    xs = x.reshape(x.shape[:-1] + (2, 2, x.shape[-1] // 4))
    rot = jnp.stack([-xs[..., 1, :], xs[..., 0, :]], axis=-2).reshape(x.shape)
    return (x * cos + rot * sin).astype(x.dtype)


def _na_col_tables():
    n_qb = GRID_W // NA_QBLK
    kc0 = np.clip(np.arange(n_qb) * NA_QBLK - NA_COLS // 2, 0, GRID_W - NA_KBLK)
    qcol = np.arange(n_qb)[:, None] * NA_QBLK + np.arange(NA_QBLK)[None, :]
    kcol = kc0[:, None] + np.arange(NA_KBLK)[None, :]
    ws = np.clip(qcol - NA_COLS // 2, 0, GRID_W - NA_COLS)
    valid = (kcol[:, None, :] >= ws[:, :, None]) & (kcol[:, None, :] < ws[:, :, None] + NA_COLS)
    dc = np.clip(kcol[:, None, :] - qcol[:, :, None] + NA_COLS - 1, 0, 2 * NA_COLS - 2)
    return kc0, valid, dc


def _neighbourhood_attention(q, k, v, qc, kc, vc, rpb, with_ctx):
    bsz, seq, nh, hd = q.shape
    ctx_len = kc.shape[1]
    rows = seq // GRID_W
    kr = min(NA_ROWS, rows)
    scale = hd ** -0.5
    kc0, valid, dc = _na_col_tables()
    n_qb = kc0.shape[0]
    nk = kr * NA_KBLK
    mask = np.broadcast_to(valid[:, :, None, :], (n_qb, NA_QBLK, kr, NA_KBLK)).reshape(n_qb, NA_QBLK, nk)
    rpb_c = rpb[:, :, dc]
    kg = k.reshape(bsz, rows, GRID_W, nh, hd)
    vg = v.reshape(bsz, rows, GRID_W, nh, hd)
    qg = jnp.moveaxis(q.reshape(bsz, rows, GRID_W, nh, hd), 1, 0)

    def row_block(args):
        q_r, r = args
        rs = jnp.clip(r - kr // 2, 0, rows - kr)
        k_win = lax.dynamic_slice_in_dim(kg, rs, kr, axis=1)
        v_win = lax.dynamic_slice_in_dim(vg, rs, kr, axis=1)
        kb = jnp.stack([k_win[:, :, int(s):int(s) + NA_KBLK] for s in kc0], axis=1).reshape(bsz, n_qb, nk, nh, hd)
        vb = jnp.stack([v_win[:, :, int(s):int(s) + NA_KBLK] for s in kc0], axis=1).reshape(bsz, n_qb, nk, nh, hd)
        qb = q_r.reshape(bsz, n_qb, NA_QBLK, nh, hd)
        dr_idx = rs + jnp.arange(kr) - r + NA_ROWS - 1
        bias = jnp.take(rpb_c, dr_idx, axis=1)
        bias = bias.transpose(0, 2, 3, 1, 4).reshape(nh, n_qb, NA_QBLK, nk).astype(jnp.float32)
        s_nb = jnp.einsum('bjqhd,bjkhd->bhjqk', qb, kb).astype(jnp.float32) * scale + bias
        s_nb = jnp.where(mask, s_nb, NEG_INF)
        s_cx = jnp.einsum('bjqhd,bchd->bhjqc', qb, kc).astype(jnp.float32) * scale
        p = jax.nn.softmax(jnp.concatenate([s_nb, s_cx], axis=-1), axis=-1).astype(q.dtype)
        o = (jnp.einsum('bhjqk,bjkhd->bjqhd', p[..., :nk], vb)
             + jnp.einsum('bhjqc,bchd->bjqhd', p[..., nk:], vc))
        return o.reshape(bsz, GRID_W, nh, hd)

    o = lax.map(row_block, (qg, jnp.arange(rows)))
    o = jnp.moveaxis(o, 0, 1).reshape(bsz, seq, nh * hd)
    oc = None
    if with_ctx:
        sc = jnp.einsum('bqhd,bkhd->bhqk', qc, kc).astype(jnp.float32) * scale
        pc = jax.nn.softmax(sc, axis=-1).astype(q.dtype)
        oc = jnp.einsum('bhqk,bkhd->bqhd', pc, vc).reshape(bsz, ctx_len, nh * hd)
    return o, oc


def _window_gqa(q, k, v, qc, kc, vc, sinks, with_ctx):
    bsz, seq, n_q, hd = q.shape
    n_kv = k.shape[2]
    grp = n_q // n_kv
    ctx_len = kc.shape[1]
    nb = seq // SW_BLK
    scale = hd ** -0.5
    sink_logit = sinks.astype(jnp.float32).reshape(n_kv, grp, 1, 1)
    qb = q.reshape(bsz, nb, SW_BLK, n_kv, grp, hd)

    def band(t):
        tp = jnp.pad(t, ((0, 0), (SW_BLK, SW_BLK), (0, 0), (0, 0))).reshape(bsz, nb + 2, SW_BLK, n_kv, hd)
        return jnp.concatenate([tp[:, :-2], tp[:, 1:-1], tp[:, 2:]], axis=2)

    kb, vb = band(k), band(v)
    qpos = np.arange(nb)[:, None] * SW_BLK + np.arange(SW_BLK)[None, :]
    kpos = (np.arange(nb)[:, None] - 1) * SW_BLK + np.arange(3 * SW_BLK)[None, :]
    valid = ((np.abs(qpos[:, :, None] - kpos[:, None, :]) <= SW_WINDOW)
             & (kpos[:, None, :] >= 0) & (kpos[:, None, :] < seq))
    s_loc = jnp.einsum('bnqhgd,bnkhd->bnhgqk', qb, kb).astype(jnp.float32) * scale
    s_loc = jnp.where(valid[:, None, None], s_loc, NEG_INF)
    s_ctx = jnp.einsum('bnqhgd,bchd->bnhgqc', qb, kc).astype(jnp.float32) * scale
    s_sink = jnp.broadcast_to(sink_logit, s_ctx.shape[:-1] + (1,))
    p = jax.nn.softmax(jnp.concatenate([s_loc, s_ctx, s_sink], axis=-1), axis=-1).astype(q.dtype)
    nk = 3 * SW_BLK
    o = (jnp.einsum('bnhgqk,bnkhd->bnqhgd', p[..., :nk], vb)
         + jnp.einsum('bnhgqc,bchd->bnqhgd', p[..., nk:nk + ctx_len], vc))
    o = o.reshape(bsz, seq, n_q * hd)
    oc = None
    if with_ctx:
        qcb = qc.reshape(bsz, ctx_len, n_kv, grp, hd)
        sc = jnp.einsum('bqhgd,bkhd->bhgqk', qcb, kc).astype(jnp.float32) * scale
        sc_sink = jnp.broadcast_to(sink_logit, sc.shape[:-1] + (1,))
        pc = jax.nn.softmax(jnp.concatenate([sc, sc_sink], axis=-1), axis=-1).astype(q.dtype)
        oc = jnp.einsum('bhgqk,bkhd->bqhgd', pc[..., :ctx_len], vc).reshape(bsz, ctx_len, n_q * hd)
    return o, oc


def _ssm_drive(u, b_bar):
    return lax.complex(jnp.einsum('blgh,gph->blgp', u, jnp.real(b_bar)),
                       jnp.einsum('blgh,gph->blgp', u, jnp.imag(b_bar)))


def _ssm_readout(xs, c_re, c_im):
    return (jnp.einsum('blgp,ghp->blgh', jnp.real(xs), c_re.astype(jnp.float32))
            - jnp.einsum('blgp,ghp->blgh', jnp.imag(xs), c_im.astype(jnp.float32)))


def _diag_scan(lam_bar, drive):
    a = jnp.broadcast_to(lam_bar, drive.shape)

    def combine(e1, e2):
        a1, b1 = e1
        a2, b2 = e2
        return a1 * a2, a2 * b1 + b2

    _, xs = lax.associative_scan(combine, (a, drive), axis=1)
    return xs


def _s5_mixer(u, uc, a_re, a_im, log_step, b_re, b_im, c_re, c_im, d_skip, w_glu, b_glu, with_ctx):
    f32 = jnp.float32
    bsz, seq, _ = u.shape
    ctx_len = uc.shape[1]
    u32 = u.astype(f32).reshape(bsz, seq, S5_GROUPS, S5_GROUP_CH)
    uc32 = uc.astype(f32).reshape(bsz, ctx_len, S5_GROUPS, S5_GROUP_CH)
    lam = lax.complex(jnp.minimum(a_re.astype(f32), S5_EIG_MAX), a_im.astype(f32))
    step = jnp.exp(log_step.astype(f32))[..., None]
    lam_bar = jnp.exp(lam * step)
    b_bar = ((lam_bar - 1.0) / lam)[..., None] * lax.complex(b_re.astype(f32), b_im.astype(f32))
    d32 = d_skip.astype(f32).reshape(S5_GROUPS, S5_GROUP_CH)
    y = d32 * u32
    yc = d32 * uc32
    for direction in range(2):
        rev = direction == 1
        seq_u = jnp.flip(u32, axis=1) if rev else u32
        seq_c = jnp.flip(uc32, axis=1) if rev else uc32
        xc = _diag_scan(lam_bar[direction], _ssm_drive(seq_c, b_bar[direction]))
        drive = _ssm_drive(seq_u, b_bar[direction])
        drive = drive.at[:, 0].add(lam_bar[direction] * xc[:, -1])
        xs = _diag_scan(lam_bar[direction], drive)
        out = _ssm_readout(xs, c_re[direction], c_im[direction])
        y = y + (jnp.flip(out, axis=1) if rev else out)
        if with_ctx:
            outc = _ssm_readout(xc, c_re[direction], c_im[direction])
            yc = yc + (jnp.flip(outc, axis=1) if rev else outc)

    def glu(t):
        g = jax.nn.gelu(t.reshape(t.shape[:2] + (S5_CH,)))
        return (g * jax.nn.sigmoid(g @ w_glu.astype(f32) + b_glu.astype(f32))).astype(u.dtype)

    return glu(y), (glu(yc) if with_ctx else None)


def _clamped_swiglu(gu):
    gate, up = jnp.split(gu, 2, axis=-1)
    gate = jnp.minimum(gate, SWIGLU_LIMIT)
    up = jnp.clip(up, -SWIGLU_LIMIT, SWIGLU_LIMIT)
    return gate * jax.nn.sigmoid(SWIGLU_ALPHA * gate) * (up + 1.0)


def _moe_ffn(h, w_router, b_router, w_gate_up, b_gate_up, w_down, b_down):
    f32 = jnp.float32
    n_tok, dim = h.shape
    logits = (h @ w_router + b_router).astype(f32)
    top_val, top_idx = lax.top_k(logits, TOP_K)
    top_w = jax.nn.softmax(top_val, axis=-1)
    n_assign = n_tok * TOP_K
    e_flat = top_idx.reshape(n_assign)
    order = jnp.argsort(e_flat)
    e_sorted = e_flat[order]
    tok_sorted = (order // TOP_K).astype(jnp.int32)
    w_sorted = top_w.reshape(n_assign)[order]
    counts = jnp.bincount(e_flat, length=N_EXPERTS)
    padded = (counts + MOE_BLK - 1) // MOE_BLK * MOE_BLK
    ends = jnp.cumsum(padded)
    pstarts = ends - padded
    starts = jnp.cumsum(counts) - counts
    dest = pstarts[e_sorted] + jnp.arange(n_assign) - starts[e_sorted]
    n_blocks = -(-(n_assign + N_EXPERTS * (MOE_BLK - 1)) // MOE_BLK)
    n_rows = n_blocks * MOE_BLK
    tok_buf = jnp.zeros((n_rows,), jnp.int32).at[dest].set(tok_sorted)
    w_buf = jnp.zeros((n_rows,), f32).at[dest].set(w_sorted)
    blk_exp = jnp.minimum(jnp.searchsorted(ends, jnp.arange(n_blocks) * MOE_BLK, side='right'), N_EXPERTS - 1)

    def expert_block(args):
        tok, e = args
        gu = h[tok] @ w_gate_up[e] + b_gate_up[e]
        return _clamped_swiglu(gu) @ w_down[e] + b_down[e]

    y = lax.map(expert_block, (tok_buf.reshape(n_blocks, MOE_BLK), blk_exp))
    y = y.reshape(n_rows, dim).astype(f32) * w_buf[:, None]
    return jnp.zeros((n_tok, dim), f32).at[tok_buf].add(y).astype(h.dtype)


def setup_inputs(seed: int = 0) -> dict:
    key = jax.random.key(seed)
    ks = iter(jax.random.split(key, 40))
    f32 = jnp.float32

    def nrm(shape, s):
        return jax.random.normal(next(ks), shape, f32) * s

    d = D_MODEL
    x = nrm((BATCH, SEQ, d), 1.0)
    c = nrm((BATCH, d), 1.0)
    ctx = nrm((BATCH, CTX_LEN, d), 1.0)
    c_ctx = nrm((d,), 1.0)
    w_mod = nrm((DEPTH, d, 6 * d), 0.5 * d ** -0.5)
    b_mod = nrm((DEPTH, 6 * d), 0.02)
    g_mix = 1.0 + nrm((DEPTH, d), 0.05)
    w_in = nrm((DEPTH, d, IN_COLS), d ** -0.5)
    w_out = nrm((DEPTH, MIX_W, d), MIX_W ** -0.5)
    na_rpb = nrm((DEPTH, NA_HEADS, 2 * NA_ROWS - 1, 2 * NA_COLS - 1), 0.1)
    s5_a_re = -0.5 + nrm((DEPTH, 2, S5_GROUPS, S5_STATE), 0.01)
    s5_a_im = jnp.pi * jnp.arange(S5_STATE, dtype=f32) + nrm((DEPTH, 2, S5_GROUPS, S5_STATE), 0.01)
    s5_log_step = jax.random.uniform(next(ks), (DEPTH, 2, S5_GROUPS), f32, math.log(S5_DT_MIN), math.log(S5_DT_MAX))
    s5_b_re = nrm((DEPTH, 2, S5_GROUPS, S5_STATE, S5_GROUP_CH), (2 * S5_GROUP_CH) ** -0.5)
    s5_b_im = nrm((DEPTH, 2, S5_GROUPS, S5_STATE, S5_GROUP_CH), (2 * S5_GROUP_CH) ** -0.5)
    s5_c_re = nrm((DEPTH, 2, S5_GROUPS, S5_GROUP_CH, S5_STATE), S5_STATE ** -0.5)
    s5_c_im = nrm((DEPTH, 2, S5_GROUPS, S5_GROUP_CH, S5_STATE), S5_STATE ** -0.5)
    s5_d = nrm((DEPTH, S5_CH), 1.0)
    s5_w_glu = nrm((DEPTH, S5_CH, S5_CH), S5_CH ** -0.5)
    s5_b_glu = nrm((DEPTH, S5_CH), 0.01)
    sw_sinks = nrm((DEPTH, SW_HEADS), 0.5)
    g_ffn = 1.0 + nrm((DEPTH, d), 0.05)
    w_router = nrm((DEPTH, d, N_EXPERTS), d ** -0.5)
    b_router = nrm((DEPTH, N_EXPERTS), 0.01)
    w_gate_up = nrm((DEPTH, N_EXPERTS, d, 2 * EXPERT_FF), d ** -0.5)
    b_gate_up = nrm((DEPTH, N_EXPERTS, 2 * EXPERT_FF), 0.01)
    w_down = nrm((DEPTH, N_EXPERTS, EXPERT_FF, d), EXPERT_FF ** -0.5)
    b_down = nrm((DEPTH, N_EXPERTS, d), 0.01)
    g_final = 1.0 + nrm((d,), 0.05)
    return {'x': x, 'c': c, 'ctx': ctx, 'c_ctx': c_ctx, 'w_mod': w_mod, 'b_mod': b_mod,
            'g_mix': g_mix, 'w_in': w_in, 'w_out': w_out, 'na_rpb': na_rpb,
            's5_a_re': s5_a_re, 's5_a_im': s5_a_im, 's5_log_step': s5_log_step,
            's5_b_re': s5_b_re, 's5_b_im': s5_b_im, 's5_c_re': s5_c_re, 's5_c_im': s5_c_im,
            's5_d': s5_d, 's5_w_glu': s5_w_glu, 's5_b_glu': s5_b_glu, 'sw_sinks': sw_sinks,
            'g_ffn': g_ffn, 'w_router': w_router, 'b_router': b_router,
            'w_gate_up': w_gate_up, 'b_gate_up': b_gate_up, 'w_down': w_down, 'b_down': b_down,
            'g_final': g_final}


def reference(x, c, ctx, c_ctx, w_mod, b_mod, g_mix, w_in, w_out, na_rpb,
              s5_a_re, s5_a_im, s5_log_step, s5_b_re, s5_b_im, s5_c_re, s5_c_im,
              s5_d, s5_w_glu, s5_b_glu, sw_sinks, g_ffn, w_router, b_router,
              w_gate_up, b_gate_up, w_down, b_down, g_final):
    bsz, seq, dim = x.shape
    ctx_len = ctx.shape[1]
    cos, sin = _axial_rope(seq, HEAD_DIM)
    cond = jax.nn.silu(c)
    cond_ctx = jax.nn.silu(c_ctx)
    for l in range(DEPTH):
        with_ctx = l < DEPTH - 1
        mod = (cond @ w_mod[l] + b_mod[l]).reshape(bsz, 6, 1, dim)
        mod_c = (cond_ctx @ w_mod[l] + b_mod[l]).reshape(6, dim)
        h = _modulate(_rmsnorm(x, g_mix[l]), mod[:, 0], mod[:, 1])
        hc = _modulate(_rmsnorm(ctx, g_mix[l]), mod_c[0], mod_c[1])
        aq, ak, av, su, sq, sk, sv = jnp.split(h @ w_in[l], PROJ_SPLITS, axis=-1)
        caq, cak, cav, csu, csq, csk, csv = jnp.split(hc @ w_in[l], PROJ_SPLITS, axis=-1)
        ya, yca = _neighbourhood_attention(_heads(aq), _heads(ak), _heads(av),
                                           _heads(caq), _heads(cak), _heads(cav), na_rpb[l], with_ctx)
        yb, ycb = _s5_mixer(su, csu, s5_a_re[l], s5_a_im[l], s5_log_step[l], s5_b_re[l], s5_b_im[l],
                            s5_c_re[l], s5_c_im[l], s5_d[l], s5_w_glu[l], s5_b_glu[l], with_ctx)
        yc, ycc = _window_gqa(_apply_rope(_heads(sq), cos, sin), _apply_rope(_heads(sk), cos, sin), _heads(sv),
                              _heads(csq), _heads(csk), _heads(csv), sw_sinks[l], with_ctx)
        x = x + mod[:, 2] * (jnp.concatenate([ya, yb, yc], axis=-1) @ w_out[l])
        h = _modulate(_rmsnorm(x, g_ffn[l]), mod[:, 3], mod[:, 4])
        if with_ctx:
            ctx = ctx + mod_c[2] * (jnp.concatenate([yca, ycb, ycc], axis=-1) @ w_out[l])
            hc = _modulate(_rmsnorm(ctx, g_ffn[l]), mod_c[3], mod_c[4])
            f = _moe_ffn(jnp.concatenate([h.reshape(-1, dim), hc.reshape(-1, dim)], axis=0),
                         w_router[l], b_router[l], w_gate_up[l], b_gate_up[l], w_down[l], b_down[l])
            ctx = ctx + mod_c[5] * f[bsz * seq:].reshape(bsz, ctx_len, dim)
            f = f[:bsz * seq]
        else:
            f = _moe_ffn(h.reshape(-1, dim), w_router[l], b_router[l], w_gate_up[l], b_gate_up[l],
                         w_down[l], b_down[l])
        x = x + mod[:, 5] * f.reshape(bsz, seq, dim)
    return _rmsnorm(x, g_final)
```

```cpp
#include <hip/hip_runtime.h>
#include <cstdio>
#include <cstdint>

#ifndef MK_PER_PHASE
#define MK_PER_PHASE 1
#endif

#define LAS __attribute__((address_space(3)))
#define GAS __attribute__((address_space(1)))
typedef unsigned short bf16_t;
typedef short bf16x8 __attribute__((ext_vector_type(8)));
typedef float f32x4 __attribute__((ext_vector_type(4)));
typedef float f32x2 __attribute__((ext_vector_type(2)));
typedef float f32x16 __attribute__((ext_vector_type(16)));
typedef unsigned u32x4 __attribute__((ext_vector_type(4)));
typedef unsigned u32x2 __attribute__((ext_vector_type(2)));

namespace {
constexpr int D = 1024, NBATCH = 4, SEQ = 8192, DEPTH = 4, CTXL = 256;
constexpr int NLAT = NBATCH * SEQ;
constexpr int NCTX = NBATCH * CTXL;
constexpr int TT = NLAT + NCTX;
constexpr int PW = 1280;
constexpr int NEXP = 32, FF = 1024;
constexpr int MCH = 768;
constexpr int SUXW = 1280;
constexpr int MAXTILES = 560;
constexpr int NWAVES = 8, NTHREADS = 512;
constexpr float RMS_EPS = 1e-6f;

constexpr size_t MiB = 1ull << 20;
constexpr size_t WS_CTL = 0;
constexpr size_t WS_MOD = 1 * MiB;
constexpr size_t WS_ROPE = 2 * MiB;
constexpr size_t WS_LP = 3 * MiB;
constexpr size_t WS_BBAR = 8 * MiB;
constexpr size_t WS_WRT = 9 * MiB;
constexpr size_t WS_WGLUT = 10 * MiB;
constexpr size_t WS_WINT = 11 * MiB;
constexpr size_t WS_WOUTT = 27 * MiB;
constexpr size_t WS_WST = 35 * MiB;
constexpr size_t WS_KC = 67 * MiB;
constexpr size_t WS_WGUT = 227 * MiB;
constexpr size_t WS_WDT = 739 * MiB;
constexpr size_t WS_XR = 995 * MiB;
constexpr size_t WS_H = 1127 * MiB;
constexpr size_t WS_P = 1193 * MiB;
constexpr size_t WS_VT = 1276 * MiB;
constexpr size_t WS_SUX = 1309 * MiB;
constexpr size_t WS_SLOC = 1339 * MiB;
constexpr size_t WS_G = 1351 * MiB;
constexpr size_t WS_Y = 1368 * MiB;
constexpr size_t WS_ELIST = 1434 * MiB;
constexpr size_t WS_ELW = 1439 * MiB;
constexpr size_t WS_TOKINFO = 1444 * MiB;
constexpr size_t WS_ACT = 1445 * MiB;
constexpr size_t WS_EO = 1725 * MiB;
constexpr size_t WS_END = 2005 * MiB;
constexpr int CW_BAR = 1024;
constexpr int CW_CNT = 8192;

constexpr int LDS_STAGE = 131072;
constexpr int LDS_MISC = LDS_STAGE;
constexpr int LDS_BYTES = LDS_STAGE + 1024;

__device__ __forceinline__ unsigned f2bf(float f) { unsigned u = __builtin_bit_cast(unsigned, f); return (u + 0x7fffu + ((u >> 16) & 1u)) >> 16; }
__device__ __forceinline__ unsigned pk2(float lo, float hi) { return f2bf(lo) | (f2bf(hi) << 16); }
__device__ __forceinline__ float bf2f(unsigned short b) { return __builtin_bit_cast(float, ((unsigned)b) << 16); }
__device__ __forceinline__ float bflo(unsigned w) { return __builtin_bit_cast(float, w << 16); }
__device__ __forceinline__ float bfhi(unsigned w) { return __builtin_bit_cast(float, w & 0xffff0000u); }
__device__ __forceinline__ float wave_sum(float v) {
#pragma unroll
    for (int o = 1; o < 64; o <<= 1) v += __shfl_xor(v, o);
    return v;
}
__device__ __forceinline__ float fast_exp2(float x) { return __builtin_amdgcn_exp2f(x); }
__device__ __forceinline__ float sigmoidf_(float x) { return 1.0f / (1.0f + __expf(-x)); }
__device__ __forceinline__ float gelu_tanh(float x) {
    const float u = 0.7978845608028654f * (x + 0.044715f * x * x * x);
    const float t = 1.0f - 2.0f / (1.0f + __expf(2.0f * u));
    return 0.5f * x * (1.0f + t);
}

#define XB_TMO      128
#define XB_XCNT(j)  (256  + 64 * (j))
#define XB_XSUB(j)  (1280 + 64 * (j))
#define XB_XGEN(j)  (2304 + 64 * (j))
#define XB_TOP      3328
#define XB_TOPGEN   3392
#define XCD_BAR_WORDS 3456
#define XB_SPIN_CAP (1u << 18)
__device__ __forceinline__ unsigned xb_ld(unsigned* p)              { return __hip_atomic_load(p, __ATOMIC_RELAXED, __HIP_MEMORY_SCOPE_AGENT); }
__device__ __forceinline__ unsigned xb_add(unsigned* p, unsigned v) { return __hip_atomic_fetch_add(p, v, __ATOMIC_RELAXED, __HIP_MEMORY_SCOPE_AGENT); }
__device__ __forceinline__ unsigned xb_xcc_id() { return (unsigned)__builtin_amdgcn_s_getreg((3 << 11) | 20) & 0xFu; }
#define XB_SPIN(cond, bar) do { unsigned _sp = 0; while (cond) { __builtin_amdgcn_s_sleep(1); \
    if ((++_sp & 255u) == 0u) { if (xb_ld(&(bar)[XB_TMO])) break; if (_sp > XB_SPIN_CAP) { atomicAdd(&(bar)[XB_TMO], 1u); break; } } } } while (0)
struct XcdBarrier { unsigned* bar; unsigned x; volatile LAS unsigned* st; };
__device__ __forceinline__ XcdBarrier xcd_barrier_post(unsigned* bar, volatile LAS unsigned* st) {
    XcdBarrier b; b.bar = bar; b.x = xb_xcc_id(); b.st = st;
    if (threadIdx.x == 0) (void)xb_add(&bar[XB_XCNT(b.x)], 1u);
    return b;
}
__device__ __forceinline__ void xcd_barrier_complete(unsigned* bar, unsigned x, unsigned& nloc, unsigned& nx) {
    const unsigned G = gridDim.x * gridDim.y * gridDim.z;
    unsigned sum, cnt, mine, sp = 0u;
    for (;;) {
        sum = 0u; cnt = 0u; mine = 0u;
#pragma unroll
        for (unsigned j = 0; j < 16; ++j) { const unsigned c = xb_ld(&bar[XB_XCNT(j)]); sum += c; cnt += (c > 0u) ? 1u : 0u; mine = (j == x) ? c : mine; }
        if (sum == G) break;
        __builtin_amdgcn_s_sleep(1);
        if ((++sp & 255u) == 0u) { if (xb_ld(&bar[XB_TMO])) break; if (sp > XB_SPIN_CAP) { atomicAdd(&bar[XB_TMO], 1u); break; } }
    }
    nloc = mine > 0u ? mine : 1u; nx = cnt > 0u ? cnt : 1u;
}
__device__ __forceinline__ void xcd_barrier(const XcdBarrier& b) {
    asm volatile("s_waitcnt vmcnt(0)" ::: "memory");
    __syncthreads();
    if (threadIdx.x == 0) {
        unsigned* bar = b.bar;
        __builtin_amdgcn_s_waitcnt(0);
        unsigned nloc = b.st[0], nx = b.st[1];
        if (nloc == 0u) { xcd_barrier_complete(bar, b.x, nloc, nx); b.st[0] = nloc; b.st[1] = nx; }
        const unsigned old = xb_add(&bar[XB_XSUB(b.x)], 1u);
        const unsigned gen = old / nloc;
        if (old + 1u == (gen + 1u) * nloc) {
            __builtin_amdgcn_fence(__ATOMIC_RELEASE, "agent");
            asm volatile("s_waitcnt vmcnt(0)" ::: "memory");
            const unsigned og = xb_add(&bar[XB_TOP], 1u);
            const unsigned tg = og / nx;
            if (og + 1u == (tg + 1u) * nx) xb_add(&bar[XB_TOPGEN], 1u);
            else XB_SPIN(xb_ld(&bar[XB_TOPGEN]) == tg, bar);
            __builtin_amdgcn_fence(__ATOMIC_ACQUIRE, "agent");
            xb_add(&bar[XB_XGEN(b.x)], 1u);
            asm volatile("s_waitcnt vmcnt(0)" ::: "memory");
        } else {
            XB_SPIN(xb_ld(&bar[XB_XGEN(b.x)]) == gen, bar);
            __builtin_amdgcn_fence(__ATOMIC_ACQUIRE, "agent");
            asm volatile("s_waitcnt vmcnt(0)" ::: "memory");
        }
    }
    __syncthreads();
}

constexpr int BM = 256, BK = 64, HALF = 128, HTB = HALF * BK * 2;
__device__ __forceinline__ int lds_byte(int r, int c) { const int st = (r >> 4) * 2 + (c >> 5), rr = r & 15, cc = c & 31, ob = rr * 64 + cc * 2; return st * 1024 + (ob ^ (((ob >> 9) & 1) << 5)); }
__device__ __forceinline__ void stage_rc(int b, int& R, int& C) { const int st = b / 1024, sb = b % 1024, swz = sb ^ (((sb >> 9) & 1) << 5); R = (st >> 1) * 16 + swz / 64; C = (st & 1) * 32 + (swz % 64) / 2; }
__device__ __forceinline__ int perm32(int rho) { const int n = rho >> 4, i = rho & 15; return 8 * (i >> 2) + 4 * n + (i & 3); }
__device__ __forceinline__ unsigned cvt_pk_bf16(float lo, float hi) { unsigned r; asm volatile("v_cvt_pk_bf16_f32 %0, %1, %2" : "=v"(r) : "v"(lo), "v"(hi)); return r; }

struct GUnit { const char* A; const char* B; int p0, p1, p2, p3; };
typedef f32x4 AccT[2][2][4][2];

template <bool GATHER, class Sched, class Epi>
__device__ __forceinline__ void gemm_phase(LAS unsigned char* lds, const int nt_  , const unsigned lda2, const unsigned ldb2  , const Sched& S, const Epi& E) {
    int tid = threadIdx.x; asm volatile("" : "+v"(tid));
    int nt = nt_; asm volatile("" : "+s"(nt));
    const int wid = __builtin_amdgcn_readfirstlane(tid >> 6), lane = tid & 63, wr = wid >> 2, wc = wid & 3, fr = lane & 15, fq = lane >> 4;
    unsigned voffA[2][2], voffB[2]; int RA[2], CA[2];
#pragma unroll
    for (int i = 0; i < 2; ++i) { int R, C; stage_rc(tid * 16 + i * 8192, R, C); const int Rb = (R & ~31) + perm32(R & 31);
        RA[i] = R; CA[i] = C; voffA[0][i] = (unsigned)R * lda2 + (unsigned)C * 2u; voffA[1][i] = voffA[0][i] + 128u * lda2; voffB[i] = (unsigned)Rb * ldb2 + (unsigned)C * 2u; }
    const size_t kstep = (size_t)(BK * 2);
    const size_t hstepB = (size_t)HALF * ldb2;
    const unsigned ldsw = (unsigned)wid * 1024u;
    const int aoff = lds_byte(wr * 64 + fr, fq * 8), boff = lds_byte(wc * 32 + fr, fq * 8);
#define PG_SA(b, h) (((b) * 2 + (h)) * HTB)
#define PG_SB(b, h) ((4 + (b) * 2 + (h)) * HTB)
#define PG_STAGE(bufoff, gbase, voff) do { _Pragma("unroll") for (int _i = 0; _i < 2; ++_i) \
        __builtin_amdgcn_global_load_lds((const unsigned*)((const char*)(gbase) + (voff)[_i]), (LAS unsigned*)(lds + (bufoff) + ldsw + _i * 8192), 16, 0, 0); } while (0)
#define PG_LDA(dst, b, h) do { _Pragma("unroll") for (int m = 0; m < 4; ++m) _Pragma("unroll") for (int k = 0; k < 2; ++k) dst[m][k] = *(const LAS bf16x8*)(lds + PG_SA(b, h) + aoff + m * 2048 + k * 1024); } while (0)
#define PG_LDB(dst, b, h) do { _Pragma("unroll") for (int n = 0; n < 2; ++n) _Pragma("unroll") for (int k = 0; k < 2; ++k) dst[n][k] = *(const LAS bf16x8*)(lds + PG_SB(b, h) + boff + n * 2048 + k * 1024); } while (0)
#define PG_MMA(ai, bj, At, Bt) do { __builtin_amdgcn_s_setprio(1); _Pragma("unroll") for (int m = 0; m < 4; ++m) _Pragma("unroll") for (int n = 0; n < 2; ++n) _Pragma("unroll") for (int k = 0; k < 2; ++k) \
        acc[ai][bj][m][n] = __builtin_amdgcn_mfma_f32_16x16x32_bf16(Bt[n][k], At[m][k], acc[ai][bj][m][n], 0, 0, 0); __builtin_amdgcn_s_setprio(0); } while (0)
#define PG_WAIT_V(n) asm volatile("s_waitcnt vmcnt(" #n ")" ::: "memory")
#define PG_WAIT_L(n) asm volatile("s_waitcnt lgkmcnt(" #n ")" ::: "memory")
#define PG_BAR __builtin_amdgcn_s_barrier()
#define PG_SCHED __builtin_amdgcn_sched_barrier(0)
    GUnit cur, nxt; int ui = 0;
    if (!S.next(0, cur)) return;
    AccT acc;
#pragma unroll
    for (int a = 0; a < 2; ++a)
#pragma unroll
        for (int b = 0; b < 2; ++b)
#pragma unroll
            for (int m = 0; m < 4; ++m)
#pragma unroll
                for (int n = 0; n < 2; ++n) acc[a][b][m][n] = (f32x4){0.f, 0.f, 0.f, 0.f};
    bf16x8 At[4][2], B0[2][2], B1[2][2];
    const char* cA = cur.A; const char* cB = cur.B;
    if (GATHER) {
#pragma unroll
        for (int h = 0; h < 2; ++h)
#pragma unroll
            for (int i = 0; i < 2; ++i) voffA[h][i] = (unsigned)S.row_token(cur, h * 128 + RA[i]) * lda2 + (unsigned)CA[i] * 2u;
    }
    unsigned voffAn[2][2];
#pragma unroll
    for (int h = 0; h < 2; ++h)
#pragma unroll
        for (int i = 0; i < 2; ++i) voffAn[h][i] = voffA[h][i];
    PG_STAGE(PG_SB(0, 0), cB, voffB); PG_STAGE(PG_SA(0, 0), cA, voffA[0]); PG_STAGE(PG_SB(0, 1), cB + hstepB, voffB); PG_STAGE(PG_SA(0, 1), cA, voffA[1]);
    if (wr == 1) PG_BAR;
    PG_WAIT_V(4); PG_BAR;
    PG_STAGE(PG_SB(1, 0), cB + kstep, voffB); PG_STAGE(PG_SA(1, 0), cA + kstep, voffA[0]); PG_STAGE(PG_SB(1, 1), cB + hstepB + kstep, voffB);
    PG_WAIT_V(6); PG_BAR;
    for (;;) {
        const bool has_next = S.next(ui + 1, nxt);
        const char* nA = has_next ? nxt.A : cA; const char* nB = has_next ? nxt.B : cB;
        for (int t = 0; t < nt; t += 2) {
            const bool last = (t == nt - 2);
            const char* a1 = cA + (size_t)(t + 1) * kstep;
            const char* a2 = last ? nA : cA + (size_t)(t + 2) * kstep; const char* b2 = last ? nB : cB + (size_t)(t + 2) * kstep;
            const char* a3 = a2 + kstep; const char* b3 = b2 + kstep;
            if (GATHER) {
                if (last && has_next) {
#pragma unroll
                    for (int h = 0; h < 2; ++h)
#pragma unroll
                        for (int i = 0; i < 2; ++i) voffAn[h][i] = (unsigned)S.row_token(nxt, h * 128 + RA[i]) * lda2 + (unsigned)CA[i] * 2u;
                }
            }
            unsigned vA0[2], vA1[2];
#pragma unroll
            for (int i = 0; i < 2; ++i) { vA0[i] = (GATHER && last) ? voffAn[0][i] : voffA[0][i]; vA1[i] = (GATHER && last) ? voffAn[1][i] : voffA[1][i]; }
            PG_LDB(B0, 0, 0); PG_SCHED; PG_LDA(At, 0, 0); PG_STAGE(PG_SA(1, 1), a1, voffA[1]);
            PG_WAIT_L(8); PG_BAR; PG_WAIT_L(0); PG_MMA(0, 0, At, B0); PG_BAR; PG_SCHED;
            PG_LDB(B1, 0, 1); PG_STAGE(PG_SB(0, 0), b2, voffB);
            PG_BAR; PG_WAIT_L(0); PG_MMA(0, 1, At, B1); PG_BAR;
            PG_LDA(At, 0, 1); PG_STAGE(PG_SA(0, 0), a2, vA0);
            PG_BAR; PG_WAIT_L(0); PG_MMA(1, 0, At, B0); PG_BAR; PG_SCHED;
            PG_STAGE(PG_SB(0, 1), b2 + hstepB, voffB);
            PG_WAIT_V(6); PG_BAR; PG_MMA(1, 1, At, B1); PG_BAR;
            PG_LDB(B0, 1, 0); PG_SCHED; PG_LDA(At, 1, 0); PG_STAGE(PG_SA(0, 1), a2, vA1);
            PG_WAIT_L(8); PG_BAR; PG_WAIT_L(0); PG_MMA(0, 0, At, B0); PG_BAR; PG_SCHED;
            PG_LDB(B1, 1, 1); PG_STAGE(PG_SB(1, 0), b3, voffB);
            PG_BAR; PG_WAIT_L(0); PG_MMA(0, 1, At, B1); PG_BAR;
            PG_LDA(At, 1, 1); PG_STAGE(PG_SA(1, 0), a3, vA0);
            PG_BAR; PG_WAIT_L(0); PG_MMA(1, 0, At, B0); PG_BAR; PG_SCHED;
            PG_STAGE(PG_SB(1, 1), b3 + hstepB, voffB);
            PG_WAIT_V(6); PG_BAR; PG_MMA(1, 1, At, B1); PG_BAR;
        }
        {
            int tz = threadIdx.x; asm volatile("" : "+v"(tz)); const int wz = __builtin_amdgcn_readfirstlane(tz >> 6), lz = tz & 63;
            E(acc, cur, wz >> 2, wz & 3, lz & 15, lz >> 4); }
        if (!has_next) break;
#pragma unroll
        for (int a = 0; a < 2; ++a)
#pragma unroll
            for (int b = 0; b < 2; ++b)
#pragma unroll
                for (int m = 0; m < 4; ++m)
#pragma unroll
                    for (int n = 0; n < 2; ++n) acc[a][b][m][n] = (f32x4){0.f, 0.f, 0.f, 0.f};
        cur = nxt; cA = nA; cB = nB; ++ui;
        if (GATHER) {
#pragma unroll
            for (int h = 0; h < 2; ++h)
#pragma unroll
                for (int i = 0; i < 2; ++i) voffA[h][i] = voffAn[h][i];
        }
    }
    PG_WAIT_V(0);
    if (wr == 0) PG_BAR;
    PG_BAR;
#undef PG_SA
#undef PG_SB
#undef PG_STAGE
#undef PG_LDA
#undef PG_LDB
#undef PG_MMA
#undef PG_WAIT_V
#undef PG_WAIT_L
#undef PG_BAR
#undef PG_SCHED
}

struct Args { const float* in[29]; float* out; unsigned char* ws; int ph_lo, ph_hi; };
struct Frame {
    LAS unsigned char* lds;
    int G, bid;
};
#define PH_LOCALS int tid = threadIdx.x; asm volatile("" : "+v"(tid)); const int lane = tid & 63; const int wave = __builtin_amdgcn_readfirstlane(tid >> 6); (void)lane; (void)wave
typedef const __attribute__((address_space(4))) Args* KArgs;
#define WSP(T, off) ((T*)(A->ws + (off)))
#define FIN(i) (A->in[i])

__device__ __forceinline__ void transpose_item(const float* W, int K, int N, bf16_t* WT, int kb, int n0s, int drow0, LAS float* scr, int lane) {
    const int k0 = 64 * kb;
#pragma unroll 8
    for (int i = 0; i < 32; ++i) { const int kk = 2 * i + (lane >> 5); scr[kk * 33 + (lane & 31)] = W[(size_t)(k0 + kk) * N + n0s + (lane & 31)]; }
    asm volatile("s_waitcnt lgkmcnt(0)" ::: "memory");
    const int c = lane & 7;
#pragma unroll
    for (int j = 0; j < 4; ++j) { const int n = (lane >> 3) + 8 * j; const LAS float* s = scr + (8 * c) * 33 + n;
        u32x4 o; o.x = pk2(s[0 * 33], s[1 * 33]); o.y = pk2(s[2 * 33], s[3 * 33]); o.z = pk2(s[4 * 33], s[5 * 33]); o.w = pk2(s[6 * 33], s[7 * 33]);
        *(u32x4*)(WT + (size_t)(drow0 + n) * K + k0 + 8 * c) = o; }
    asm volatile("s_waitcnt lgkmcnt(0)" ::: "memory");
}
__device__ __forceinline__ int win_src_col(int d) {
    if (d < 768) return d;
    if (d < 1152) return 1408 + (d - 768);
    if (d < 1280) return 1792 + (d - 1152);
    if (d < 1536) return 1152 + (d - 1280);
    if (d < 1920) return 768 + (d - 1536);
    return d;
}
__device__ __forceinline__ int wgu_src_col(int d) { const int t = d >> 8, r = d & 255; return (r < 128) ? (128 * t + r) : (1024 + 128 * t + (r - 128)); }

__device__ __forceinline__ void phase_p0a(KArgs A, Frame& F) {
    PH_LOCALS;
    LAS float* scr = (LAS float*)(F.lds + wave * 16384);
    const int gw = F.bid * NWAVES + wave, NGW = F.G * NWAVES;
    constexpr int I_IN = DEPTH * 16 * 64, I_OUT = DEPTH * 16 * 32, I_GLU = DEPTH * 4 * 8, I_RT = DEPTH * 16, I_GU = DEPTH * NEXP * 16 * 64, I_DN = DEPTH * NEXP * 16 * 32;
    constexpr int NITEMS = I_IN + I_OUT + I_GLU + I_RT + I_GU + I_DN;
    for (int it = gw; it < NITEMS; it += NGW) {
        int r = it;
        if (r < I_IN) { const int l = r / 1024, q = r % 1024, kb = q / 64, nb = q % 64;
            transpose_item(FIN(7) + (size_t)l * D * 2048, D, 2048, WSP(bf16_t, WS_WINT) + (size_t)l * 2048 * D, kb, win_src_col(32 * nb), 32 * nb, scr, lane); continue; } r -= I_IN;
        if (r < I_OUT) { const int l = r / 512, q = r % 512, kb = q / 32, nb = q % 32;
            transpose_item(FIN(8) + (size_t)l * D * D, D, D, WSP(bf16_t, WS_WOUTT) + (size_t)l * D * D, kb, 32 * nb, 32 * nb, scr, lane); continue; } r -= I_OUT;
        if (r < I_GLU) { const int l = r / 32, q = r % 32, kb = q / 8, nb = q % 8;
            transpose_item(FIN(18) + (size_t)l * 256 * 256, 256, 256, WSP(bf16_t, WS_WGLUT) + (size_t)l * 256 * 256, kb, 32 * nb, 32 * nb, scr, lane); continue; } r -= I_GLU;
        if (r < I_RT) { const int l = r / 16, kb = r % 16;
            transpose_item(FIN(22) + (size_t)l * D * NEXP, D, NEXP, WSP(bf16_t, WS_WRT) + (size_t)l * NEXP * D, kb, 0, 0, scr, lane); continue; } r -= I_RT;
        if (r < I_GU) { const int le = r / 1024, q = r % 1024, kb = q / 64, nb = q % 64;
            transpose_item(FIN(24) + (size_t)le * D * 2048, D, 2048, WSP(bf16_t, WS_WGUT) + (size_t)le * 2048 * D, kb, wgu_src_col(32 * nb), 32 * nb, scr, lane); continue; } r -= I_GU;
        { const int le = r / 512, q = r % 512, kb = q / 32, nb = q % 32;
            transpose_item(FIN(26) + (size_t)le * FF * D, FF, D, WSP(bf16_t, WS_WDT) + (size_t)le * D * FF, kb, 32 * nb, 32 * nb, scr, lane); }
    }
    __syncthreads();
    {
        LAS float* cond = (LAS float*)F.lds;
        LAS float* red = (LAS float*)(F.lds + 32768);
        for (int i = tid; i < 5 * D; i += NTHREADS) { const int bi = i / D, k = i % D; const float v = (bi < 4) ? FIN(1)[bi * D + k] : FIN(3)[k]; cond[i] = v / (1.0f + __expf(-v)); }
        __syncthreads();
        for (int u = F.bid; u < DEPTH * 96; u += F.G) {
            const int l = u / 96, j = (u % 96) * 64 + lane;
            const float* w = FIN(4) + (size_t)l * D * 6144 + j;
            float a0 = 0.f, a1 = 0.f, a2 = 0.f, a3 = 0.f, a4 = 0.f;
#pragma unroll 8
            for (int kk = 0; kk < 128; ++kk) { const int k = wave * 128 + kk; const float wv = w[(size_t)k * 6144];
                a0 += cond[k] * wv; a1 += cond[D + k] * wv; a2 += cond[2 * D + k] * wv; a3 += cond[3 * D + k] * wv; a4 += cond[4 * D + k] * wv; }
            red[(wave * 5 + 0) * 64 + lane] = a0; red[(wave * 5 + 1) * 64 + lane] = a1; red[(wave * 5 + 2) * 64 + lane] = a2;
            red[(wave * 5 + 3) * 64 + lane] = a3; red[(wave * 5 + 4) * 64 + lane] = a4;
            __syncthreads();
            if (tid < 320) { const int bi = tid / 64, jj = tid % 64; float s = 0.f;
#pragma unroll
                for (int w8 = 0; w8 < 8; ++w8) s += red[(w8 * 5 + bi) * 64 + jj];
                const int col = (u % 96) * 64 + jj;
                WSP(float, WS_MOD)[((size_t)l * 5 + bi) * 6144 + col] = s + FIN(5)[l * 6144 + col]; }
            __syncthreads();
        }
    }
    const int gt = F.bid * NTHREADS + tid, NGT = F.G * NTHREADS;
    for (int i = gt; i < 128 * 16; i += NGT) { const int pos = i / 16, f = i % 16; const float inv = powf(10000.0f, -(float)f / 16.0f); const float a = (float)pos * inv;
        WSP(float, WS_ROPE)[i] = cosf(a); WSP(float, WS_ROPE)[2048 + i] = sinf(a); }
    for (int i = gt; i < DEPTH * 2 * 16 * 65 * 64; i += NGT) {
        const int p = i % 64, d = (i / 64) % 65, ldg = i / (64 * 65);
        const float are = fminf(FIN(10)[ldg * 64 + p], -1e-4f), aim = FIN(11)[ldg * 64 + p];
        const float step = expf(FIN(12)[ldg]);
        const float re = are * step * (float)d, im = aim * step * (float)d;
        const float mag = expf(re);
        WSP(f32x2, WS_LP)[i] = (f32x2){mag * cosf(im), mag * sinf(im)};
    }
    for (int i = gt; i < DEPTH * 2 * 16 * 64 * 16; i += NGT) {
        const int lp = i / 16;
        const int ldg = lp / 64;
        const float are = fminf(FIN(10)[lp], -1e-4f), aim = FIN(11)[lp];
        const float step = expf(FIN(12)[ldg]);
        const float mag = expf(are * step), lr = mag * cosf(aim * step) - 1.0f, li = mag * sinf(aim * step);
        const float den = are * are + aim * aim;
        const float qr = (lr * are + li * aim) / den, qi = (li * are - lr * aim) / den;
        const float br = FIN(13)[i], bi = FIN(14)[i];
        WSP(f32x2, WS_BBAR)[i] = (f32x2){qr * br - qi * bi, qr * bi + qi * br};
    }
}

__device__ __forceinline__ f32x2 cmul(f32x2 a, f32x2 b) { return (f32x2){a.x * b.x - a.y * b.y, a.x * b.y + a.y * b.x}; }
__device__ __forceinline__ void phase_p0b(KArgs A, Frame& F) {
    PH_LOCALS;
    const f32x2* LP = WSP(f32x2, WS_LP); const f32x2* BB = WSP(f32x2, WS_BBAR);
    LAS float* kv = (LAS float*)F.lds;
    for (int it = F.bid; it < DEPTH * 16 * 64; it += F.G) {
        const int d = it % 64, g = (it / 64) % 16, l = it / 1024;
        const int dir = tid >> 8, ho = (tid >> 4) & 15, hi = tid & 15;
        const int ldg = (l * 2 + dir) * 16 + g;
        const float* cre = FIN(15) + ((size_t)ldg * 16 + ho) * 64; const float* cim = FIN(16) + ((size_t)ldg * 16 + ho) * 64;
        const f32x2* lp = LP + ((size_t)ldg * 65 + d) * 64; const f32x2* bb = BB + (size_t)ldg * 1024 + hi;
        float s = 0.f;
        for (int p = 0; p < 64; ++p) { const f32x2 t = cmul(lp[p], bb[p * 16]); s += cre[p] * t.x - cim[p] * t.y; }
        kv[dir * 256 + ho * 16 + hi] = s;
        __syncthreads();
        bf16_t* KC = WSP(bf16_t, WS_KC) + ((size_t)(l * 16 + g)) * 1024 * SUXW;
        if (d == 0) {
            if (dir == 0) { const float v = kv[ho * 16 + hi] + kv[256 + ho * 16 + hi] + ((ho == hi) ? FIN(17)[l * 256 + g * 16 + ho] : 0.f); const unsigned short b = (unsigned short)f2bf(v);
                for (int t = 0; t < 64; ++t) KC[(size_t)(t * 16 + ho) * SUXW + t * 16 + hi] = b; }
        } else {
            const unsigned short b = (unsigned short)f2bf(s);
            if (dir == 0) { for (int t = d; t < 64; ++t) KC[(size_t)(t * 16 + ho) * SUXW + (t - d) * 16 + hi] = b; }
            else          { for (int t = 0; t < 64 - d; ++t) KC[(size_t)(t * 16 + ho) * SUXW + (t + d) * 16 + hi] = b; }
        }
        __syncthreads();
    }
    const int gt = F.bid * NTHREADS + tid, NGT = F.G * NTHREADS;
    for (int i = gt; i < DEPTH * 16 * 256 * 1024; i += NGT) {
        const int k = i % 1024, n = (i / 1024) % 256, lg = i / (1024 * 256), l = lg / 16, g = lg % 16;
        const int s = k / 16, hi = k % 16, dir = n / 128, ri = (n / 64) & 1, p = n % 64;
        const int ldg = (l * 2 + dir) * 16 + g;
        const int e = dir ? s : 63 - s;
        const f32x2 t = cmul(LP[((size_t)ldg * 65 + e) * 64 + p], BB[(size_t)ldg * 1024 + p * 16 + hi]);
        WSP(bf16_t, WS_WST)[i] = (unsigned short)f2bf(ri ? t.y : t.x);
    }
    for (int i = gt; i < DEPTH * 16 * 1024 * 256; i += NGT) {
        const int n = i % 256, row = (i / 256) % 1024, lg = i / (256 * 1024), l = lg / 16, g = lg % 16;
        const int t = row / 16, ho = row % 16, dir = n / 128, ri = (n / 64) & 1, p = n % 64;
        const int ldg = (l * 2 + dir) * 16 + g;
        const int e = dir ? 64 - t : t + 1;
        const f32x2 c = (f32x2){FIN(15)[((size_t)ldg * 16 + ho) * 64 + p], FIN(16)[((size_t)ldg * 16 + ho) * 64 + p]};
        const f32x2 v = cmul(c, LP[((size_t)ldg * 65 + e) * 64 + p]);
        WSP(bf16_t, WS_KC)[((size_t)lg * 1024 + row) * SUXW + 1024 + n] = (unsigned short)f2bf(ri ? -v.y : v.x);
    }
}

__device__ __forceinline__ void build_tstart(KArgs A, Frame& F, int l) {
    PH_LOCALS;
    LAS int* ts = (LAS int*)(F.lds + LDS_MISC + 64);
    if (tid == 0) { const int* cnt = (const int*)A->ws + CW_CNT + l * 32; int a = 0;
        for (int e = 0; e < 32; ++e) { ts[e] = a; ts[40 + e] = cnt[e]; a += (cnt[e] + 255) >> 8; }
        ts[32] = a; }
    __syncthreads();
}

__device__ __forceinline__ void phase_norm1(KArgs A, Frame& F, int l) {
    PH_LOCALS;
    const bool fin = (l == DEPTH);
    const int nrows = fin ? NLAT : TT;
    if (l > 0) build_tstart(A, F, l - 1);
    const LAS int* ts = (const LAS int*)(F.lds + LDS_MISC + 64);
    const int gw = F.bid * NWAVES + wave, NGW = F.G * NWAVES;
    const float* MOD = WSP(float, WS_MOD);
    float* XR = WSP(float, WS_XR);
    for (int r = gw; r < nrows; r += NGW) {
        const int bi = (r < NLAT) ? (r / SEQ) : 4;
        f32x4 v[4];
        if (l == 0) { const float* src = (r < NLAT) ? (FIN(0) + (size_t)r * D) : (FIN(2) + (size_t)(r - NLAT) * D);
#pragma unroll
            for (int j = 0; j < 4; ++j) v[j] = *(const f32x4*)(src + 4 * lane + 256 * j); }
        else {
            const float* src = XR + (size_t)r * D;
#pragma unroll
            for (int j = 0; j < 4; ++j) v[j] = *(const f32x4*)(src + 4 * lane + 256 * j);
            const int* ti = WSP(int, WS_TOKINFO) + (size_t)r * 4;
            f32x4 a[4];
#pragma unroll
            for (int j = 0; j < 4; ++j) a[j] = (f32x4){0.f, 0.f, 0.f, 0.f};
#pragma unroll
            for (int k = 0; k < 4; ++k) { const int inf = ti[k]; const int e = (inf >> 24) & 31, rank = inf & 0xffffff; const size_t pos = (size_t)ts[e] * 256 + rank;
                const bf16_t* eo = WSP(bf16_t, WS_EO) + pos * D;
#pragma unroll
                for (int j = 0; j < 4; ++j) { const u32x2 w = *(const u32x2*)(eo + 4 * lane + 256 * j); a[j].x += bflo(w.x); a[j].y += bfhi(w.x); a[j].z += bflo(w.y); a[j].w += bfhi(w.y); } }
            const float* m5 = MOD + ((size_t)(l - 1) * 5 + bi) * 6144 + 5 * D;
#pragma unroll
            for (int j = 0; j < 4; ++j) { const f32x4 g5 = *(const f32x4*)(m5 + 4 * lane + 256 * j); v[j] = v[j] + g5 * a[j]; }
        }
        if (!fin) {
#pragma unroll
            for (int j = 0; j < 4; ++j) *(f32x4*)(XR + (size_t)r * D + 4 * lane + 256 * j) = v[j];
        }
        float ss = 0.f;
#pragma unroll
        for (int j = 0; j < 4; ++j) ss += (v[j].x * v[j].x + v[j].y * v[j].y) + (v[j].z * v[j].z + v[j].w * v[j].w);
        const float rinv = 1.0f / sqrtf(wave_sum(ss) * (1.0f / D) + RMS_EPS);
        if (fin) {
#pragma unroll
            for (int j = 0; j < 4; ++j) { const f32x4 g = *(const f32x4*)(FIN(28) + 4 * lane + 256 * j); *(f32x4*)(A->out + (size_t)r * D + 4 * lane + 256 * j) = v[j] * rinv * g; }
        } else {
            const float* gm = FIN(6) + (size_t)l * D; const float* m0 = MOD + ((size_t)l * 5 + bi) * 6144; const float* m1 = m0 + D;
            bf16_t* hrow = WSP(bf16_t, WS_H) + (size_t)r * D;
#pragma unroll
            for (int j = 0; j < 4; ++j) { const int c = 4 * lane + 256 * j; const f32x4 g = *(const f32x4*)(gm + c), sh = *(const f32x4*)(m0 + c), sc = *(const f32x4*)(m1 + c);
                const f32x4 h = v[j] * rinv * g * (sc + 1.0f) + sh;
                u32x2 o; o.x = pk2(h.x, h.y); o.y = pk2(h.z, h.w); *(u32x2*)(hrow + c) = o; }
        }
    }
}

__device__ __forceinline__ void phase_router(KArgs A, Frame& F, int l) {
    PH_LOCALS;
    const int nrows = (l == DEPTH - 1) ? NLAT : TT;
    LAS bf16_t* tile = (LAS bf16_t*)F.lds;
    LAS float* part = (LAS float*)(F.lds + 32 * 1032 * 2);
    LAS float* logit = part + 8 * 32 * 33;
    const float* MOD = WSP(float, WS_MOD);
    const float* XR = WSP(float, WS_XR);
    const bf16_t* WRT = WSP(bf16_t, WS_WRT) + (size_t)l * NEXP * D;
    int* cnt = (int*)A->ws + CW_CNT + l * 32;
    for (int u = F.bid; u < nrows / 32; u += F.G) {
        const int r0 = u * 32;
#pragma unroll 1
        for (int q = 0; q < 4; ++q) {
            const int rl = wave * 4 + q, r = r0 + rl; const int bi = (r < NLAT) ? (r / SEQ) : 4;
            f32x4 v[4]; float ss = 0.f;
#pragma unroll
            for (int j = 0; j < 4; ++j) { v[j] = *(const f32x4*)(XR + (size_t)r * D + 4 * lane + 256 * j); ss += (v[j].x * v[j].x + v[j].y * v[j].y) + (v[j].z * v[j].z + v[j].w * v[j].w); }
            const float rinv = 1.0f / sqrtf(wave_sum(ss) * (1.0f / D) + RMS_EPS);
            const float* gm = FIN(21) + (size_t)l * D; const float* m3 = MOD + ((size_t)l * 5 + bi) * 6144 + 3 * D; const float* m4 = m3 + D;
            bf16_t* hrow = WSP(bf16_t, WS_H) + (size_t)r * D;
#pragma unroll
            for (int j = 0; j < 4; ++j) { const int c = 4 * lane + 256 * j; const f32x4 g = *(const f32x4*)(gm + c), sh = *(const f32x4*)(m3 + c), sc = *(const f32x4*)(m4 + c);
                const f32x4 h = v[j] * rinv * g * (sc + 1.0f) + sh;
                u32x2 o; o.x = pk2(h.x, h.y); o.y = pk2(h.z, h.w); *(u32x2*)(hrow + c) = o; *(LAS u32x2*)(tile + rl * 1032 + c) = o; }
        }
        __syncthreads();
        {
            f32x16 acc;
#pragma unroll
            for (int i = 0; i < 16; ++i) acc[i] = 0.f;
            const int rr = lane & 31, hh = lane >> 5;
#pragma unroll
            for (int s = 0; s < 8; ++s) { const int k = wave * 128 + 16 * s + 8 * hh;
                const bf16x8 a = *(const LAS bf16x8*)(tile + rr * 1032 + k);
                const bf16x8 b = *(const bf16x8*)(WRT + (size_t)rr * D + k);
                acc = __builtin_amdgcn_mfma_f32_32x32x16_bf16(a, b, acc, 0, 0, 0); }
#pragma unroll
            for (int i = 0; i < 16; ++i) { const int tok = (i & 3) + 8 * (i >> 2) + 4 * hh; part[(wave * 32 + tok) * 33 + rr] = acc[i]; }
        }
        __syncthreads();
        for (int i = tid; i < 1024; i += NTHREADS) { const int tok = i >> 5, e = i & 31; float s = FIN(23)[l * 32 + e];
#pragma unroll
            for (int w = 0; w < 8; ++w) s += part[(w * 32 + tok) * 33 + e];
            logit[tok * 33 + e] = s; }
        __syncthreads();
        if (tid < 32) {
            const int r = r0 + tid; float lv[4]; int le[4]; unsigned used = 0u;
#pragma unroll
            for (int k = 0; k < 4; ++k) { float best = -3.0e38f; int be = 0;
                for (int e = 0; e < 32; ++e) { const float x = logit[tid * 33 + e]; if (!((used >> e) & 1u) && x > best) { best = x; be = e; } }
                used |= 1u << be; lv[k] = best; le[k] = be; }
            const float e1 = __expf(lv[1] - lv[0]), e2 = __expf(lv[2] - lv[0]), e3 = __expf(lv[3] - lv[0]); const float inv = 1.0f / (1.0f + e1 + e2 + e3);
            const float wk[4] = {inv, e1 * inv, e2 * inv, e3 * inv};
            int* ti = WSP(int, WS_TOKINFO) + (size_t)r * 4;
#pragma unroll
            for (int k = 0; k < 4; ++k) { const int rank = atomicAdd(&cnt[le[k]], 1);
                WSP(int, WS_ELIST)[(size_t)le[k] * TT + rank] = r; WSP(float, WS_ELW)[(size_t)le[k] * TT + rank] = wk[k]; ti[k] = (le[k] << 24) | rank; }
        }
        __syncthreads();
    }
}

__device__ __forceinline__ void phase_s5scan(KArgs A, Frame& F, int l) {
    PH_LOCALS;
    const int gw = F.bid * NWAVES + wave, NGW = F.G * NWAVES;
    const float* SL = WSP(float, WS_SLOC);
    for (int it = gw; it < NBATCH * 16 * 2; it += NGW) {
        const int dir = it & 1, g = (it >> 1) & 15, b = it >> 5;
        const int ldg = (l * 2 + dir) * 16 + g;
        const f32x2 L64 = WSP(f32x2, WS_LP)[((size_t)ldg * 65 + 64) * 64 + lane];
        bf16_t* sux = WSP(bf16_t, WS_SUX) + (size_t)g * MCH * SUXW;
        float xr = 0.f, xi = 0.f;
#pragma unroll 4
        for (int step = 0; step < 132; ++step) {
            int ch;
            if (step < 4) ch = 512 + 4 * b + (dir ? 3 - step : step);
            else ch = 128 * b + (dir ? 127 - (step - 4) : (step - 4));
            const float sr = SL[(size_t)ch * 4096 + g * 256 + dir * 128 + lane], si = SL[(size_t)ch * 4096 + g * 256 + dir * 128 + 64 + lane];
            bf16_t* o = sux + (size_t)ch * SUXW + 1024 + dir * 128;
            o[lane] = (unsigned short)f2bf(xr); o[64 + lane] = (unsigned short)f2bf(xi);
            const float nr = L64.x * xr - L64.y * xi + sr, ni = L64.x * xi + L64.y * xr + si;
            xr = nr; xi = ni;
        }
    }
}

constexpr float LOG2E = 1.4426950408889634f;
template <int MODE>
__device__ __forceinline__ void attn_item(KArgs A, Frame& F, int lane, int l, int item, const LAS float* rpb) {
    const int r = lane & 31, hh = lane >> 5;
    const bf16_t* P = WSP(bf16_t, WS_P); const bf16_t* VT = WSP(bf16_t, WS_VT);
    int b, head, qtok0, qcol, kcol, vrow, ycol, qrow = 0, mh = 0, qt = 0;
    float m, lsum;
    if (MODE == 0) { mh = item & 1; qrow = (item >> 1) & 127; const int bh = item >> 8; head = bh % 6; b = bh / 6; qtok0 = b * SEQ + qrow * 64 + 32 * mh; }
    else if (MODE == 1) { const int g = item % 3; qt = (item / 3) & 255; const int bk = item / 768; const int kvh = bk & 1; b = bk >> 1; head = kvh * 3 + g; qtok0 = b * SEQ + 32 * qt; }
    else { const int qi = item & 7; const int bh = item >> 3; head = bh % 6; b = bh / 6; qtok0 = NLAT + b * CTXL + 32 * qi; }
    if (MODE == 0 || MODE == 2) { qcol = 64 * head; kcol = 384 + 64 * head; vrow = 64 * head; ycol = 64 * head; m = -1e30f; lsum = 0.f; }
    else { qcol = 768 + 64 * head; kcol = 1152 + 64 * (head / 3); vrow = 384 + 64 * (head / 3); ycol = 640 + 64 * head; m = FIN(20)[l * 6 + head]; lsum = 1.f; }
    bf16x8 qf[4];
#pragma unroll
    for (int s = 0; s < 4; ++s) qf[s] = *(const bf16x8*)(P + (size_t)(qtok0 + r) * PW + qcol + 32 * hh + 8 * s);
    f32x16 O0, O1;
#pragma unroll
    for (int i = 0; i < 16; ++i) { O0[i] = 0.f; O1[i] = 0.f; }
    const int qc = 32 * mh + r;
    const int wsn = min(max(qc - 8, 0), 48);
    const int qpos = 32 * qt + r;
    int ntl;
    int rs = 0, kt0 = 0;
    if (MODE == 0) { rs = min(max(qrow - 4, 0), 120); ntl = 16; }
    else if (MODE == 1) { kt0 = max(qt - 4, 0); ntl = min(qt + 4, 255) - kt0 + 1; }
    else ntl = 0;
    for (int ti = 0; ti < ntl + 8; ++ti) {
        int ktok0, kr = 0, ct = 0, kt = 0; const bool isctx = (ti >= ntl);
        if (isctx) ktok0 = NLAT + b * CTXL + 32 * (ti - ntl);
        else if (MODE == 0) { kr = rs + (ti >> 1); ct = ti & 1; ktok0 = b * SEQ + kr * 64 + 32 * ct; }
        else { kt = kt0 + ti; ktok0 = b * SEQ + 32 * kt; }
        bf16x8 kf[4];
#pragma unroll
        for (int s = 0; s < 4; ++s) kf[s] = *(const bf16x8*)(P + (size_t)(ktok0 + r) * PW + kcol + 32 * hh + 8 * s);
        u32x2 vlo[2][2], vhi[2][2];
#pragma unroll
        for (int mt = 0; mt < 2; ++mt)
#pragma unroll
            for (int s2 = 0; s2 < 2; ++s2) { const bf16_t* vp = VT + (size_t)(vrow + 32 * mt + r) * TT + ktok0 + 16 * s2 + 4 * hh; vlo[mt][s2] = *(const u32x2*)vp; vhi[mt][s2] = *(const u32x2*)(vp + 8); }
        f32x16 sa;
#pragma unroll
        for (int i = 0; i < 16; ++i) sa[i] = 0.f;
#pragma unroll
        for (int s = 0; s < 4; ++s) sa = __builtin_amdgcn_mfma_f32_32x32x16_bf16(kf[s], qf[s], sa, 0, 0, 0);
        float sv[16]; float tmax = -1e30f;
#pragma unroll
        for (int i = 0; i < 16; ++i) {
            const int ki = (i & 3) + 8 * (i >> 2) + 4 * hh;
            bool valid = true; float bias = 0.f;
            if (!isctx) {
                if (MODE == 0) { const int kc = 32 * ct + ki; valid = (kc >= wsn) && (kc < wsn + 16);
                    const int dc = min(max(kc - qc + 15, 0), 30); bias = rpb[head * 465 + (kr - qrow + 7) * 31 + dc]; }
                if (MODE == 1) { const int dpos = qpos - (32 * kt + ki); valid = (dpos <= 128) && (dpos >= -128); }
            }
            const float x = sa[i] * 0.125f + bias;
            sv[i] = valid ? x : -1e30f; tmax = fmaxf(tmax, sv[i]);
        }
        tmax = fmaxf(tmax, __shfl_xor(tmax, 32));
        const float mnew = fmaxf(m, tmax);
        const float alpha = fast_exp2((m - mnew) * LOG2E);
        float psum = 0.f;
#pragma unroll
        for (int i = 0; i < 16; ++i) { const float p = (sv[i] > -1e29f) ? fast_exp2((sv[i] - mnew) * LOG2E) : 0.f; psum += p; sv[i] = p; }
        psum += __shfl_xor(psum, 32);
        lsum = lsum * alpha + psum; m = mnew;
#pragma unroll
        for (int i = 0; i < 16; ++i) { O0[i] *= alpha; O1[i] *= alpha; }
#pragma unroll
        for (int s2 = 0; s2 < 2; ++s2) {
            u32x4 pw; pw.x = pk2(sv[8 * s2 + 0], sv[8 * s2 + 1]); pw.y = pk2(sv[8 * s2 + 2], sv[8 * s2 + 3]); pw.z = pk2(sv[8 * s2 + 4], sv[8 * s2 + 5]); pw.w = pk2(sv[8 * s2 + 6], sv[8 * s2 + 7]);
            const bf16x8 pf = __builtin_bit_cast(bf16x8, pw);
            u32x4 v0; v0.x = vlo[0][s2].x; v0.y = vlo[0][s2].y; v0.z = vhi[0][s2].x; v0.w = vhi[0][s2].y;
            u32x4 v1; v1.x = vlo[1][s2].x; v1.y = vlo[1][s2].y; v1.z = vhi[1][s2].x; v1.w = vhi[1][s2].y;
            O0 = __builtin_amdgcn_mfma_f32_32x32x16_bf16(__builtin_bit_cast(bf16x8, v0), pf, O0, 0, 0, 0);
            O1 = __builtin_amdgcn_mfma_f32_32x32x16_bf16(__builtin_bit_cast(bf16x8, v1), pf, O1, 0, 0, 0);
        }
    }
    const float inv = 1.0f / lsum;
    bf16_t* yrow = WSP(bf16_t, WS_Y) + (size_t)(qtok0 + r) * D + ycol + 4 * hh;
#pragma unroll
    for (int rg = 0; rg < 4; ++rg) {
        u32x2 o0; o0.x = pk2(O0[4 * rg + 0] * inv, O0[4 * rg + 1] * inv); o0.y = pk2(O0[4 * rg + 2] * inv, O0[4 * rg + 3] * inv);
        u32x2 o1; o1.x = pk2(O1[4 * rg + 0] * inv, O1[4 * rg + 1] * inv); o1.y = pk2(O1[4 * rg + 2] * inv, O1[4 * rg + 3] * inv);
        *(u32x2*)(yrow + 8 * rg) = o0; *(u32x2*)(yrow + 32 + 8 * rg) = o1;
    }
}
__device__ __forceinline__ void phase_attn(KArgs A, Frame& F, int l) {
    PH_LOCALS;
    LAS float* rpb = (LAS float*)F.lds;
    for (int i = tid; i < 6 * 465; i += NTHREADS) rpb[i] = FIN(9)[(size_t)l * 6 * 465 + i];
    __syncthreads();
    const int gw = F.bid * NWAVES + wave, NGW = F.G * NWAVES;
    constexpr int N0 = NBATCH * 6 * 128 * 2, N1 = NBATCH * 6 * 256, N2 = NBATCH * 6 * 8;
    const int total = N0 + N1 + ((l < DEPTH - 1) ? 2 * N2 : 0);
    for (int it = gw; it < total; it += NGW) {
        if (it < N0) attn_item<0>(A, F, lane, l, it, rpb);
        else if (it < N0 + N1) attn_item<1>(A, F, lane, l, it - N0, rpb);
        else if (it < N0 + N1 + N2) attn_item<2>(A, F, lane, l, it - N0 - N1, rpb);
        else attn_item<3>(A, F, lane, l, it - N0 - N1 - N2, rpb);
    }
}

#define ACC8(ai, bj, m) const f32x4 a0_ = acc[ai][bj][m][0], a1_ = acc[ai][bj][m][1]; float v[8] = {a0_[0], a0_[1], a0_[2], a0_[3], a1_[0], a1_[1], a1_[2], a1_[3]}
__device__ __forceinline__ u32x4 pack8(const float* v) { u32x4 w; w.x = cvt_pk_bf16(v[0], v[1]); w.y = cvt_pk_bf16(v[2], v[3]); w.z = cvt_pk_bf16(v[4], v[5]); w.w = cvt_pk_bf16(v[6], v[7]); return w; }

struct SchedInproj { int G, c; const char* H; const char* W;
    __device__ __forceinline__ bool next(int i, GUnit& u) const {
        const int idx = i * G + c; if (idx >= 1056) return false;
        if (idx < 792) { const int pm = idx / 6, pn = idx % 6; u.A = H + (size_t)pm * 256 * 2048; u.B = W + (size_t)pn * 256 * 2048; u.p0 = 0; u.p1 = pm; u.p2 = pn; u.p3 = 0; }
        else { const int j = idx - 792, vm = j / 132, tn = j % 132; u.A = W + (size_t)(1536 + 256 * vm) * 2048; u.B = H + (size_t)tn * 256 * 2048; u.p0 = 1; u.p1 = vm; u.p2 = tn; u.p3 = 0; }
        return true; }
    __device__ __forceinline__ int row_token(const GUnit&, int) const { return 0; }
};
struct EpiInproj { bf16_t* P; bf16_t* VT; bf16_t* SUX; const float* ROPE;
    __device__ __forceinline__ void operator()(const AccT& acc, const GUnit& u, int wr, int wc, int fr, int fq) const {
        if (u.p0 == 1) {
#pragma unroll
            for (int ai = 0; ai < 2; ++ai)
#pragma unroll
                for (int m = 0; m < 4; ++m) { const int row = u.p1 * 256 + 128 * ai + 64 * wr + 16 * m + fr;
#pragma unroll
                    for (int bj = 0; bj < 2; ++bj) { ACC8(ai, bj, m); *(u32x4*)(VT + (size_t)row * TT + u.p2 * 256 + 128 * bj + 32 * wc + 8 * fq) = pack8(v); } }
            return;
        }
        const int pm = u.p1, pn = u.p2;
#pragma unroll
        for (int bj = 0; bj < 2; ++bj) {
            const int hh = 2 * pn + bj;
#pragma unroll
            for (int ai = 0; ai < 2; ++ai)
#pragma unroll
                for (int m = 0; m < 4; ++m) {
                    const int row = pm * 256 + 128 * ai + 64 * wr + 16 * m + fr;
                    ACC8(ai, bj, m);
                    if (hh >= 10) {
                        const int g = 8 * (hh - 10) + 2 * wc + (fq >> 1);
                        *(u32x4*)(SUX + ((size_t)g * MCH + (row >> 6)) * SUXW + (row & 63) * 16 + 8 * (fq & 1)) = pack8(v);
                    } else {
                        if (hh >= 6 && pm < 128) {
                            const int t = row & (SEQ - 1); const int pos = (wc & 1) ? (t & 63) : (t >> 6);
                            const float* cs = ROPE + pos * 16 + 8 * (fq & 1);
                            const f32x4 c0 = *(const f32x4*)cs, c1 = *(const f32x4*)(cs + 4), s0 = *(const f32x4*)(cs + 2048), s1 = *(const f32x4*)(cs + 2052);
                            const float cc[8] = {c0[0], c0[1], c0[2], c0[3], c1[0], c1[1], c1[2], c1[3]}, sn[8] = {s0[0], s0[1], s0[2], s0[3], s1[0], s1[1], s1[2], s1[3]};
#pragma unroll
                            for (int e = 0; e < 8; ++e) { const float pr = __shfl_xor(v[e], 32); v[e] = v[e] * cc[e] + ((fq < 2) ? -pr : pr) * sn[e]; }
                        }
                        *(u32x4*)(P + (size_t)row * PW + 128 * hh + 32 * wc + 8 * fq) = pack8(v);
                    }
                }
        }
    }
};
struct SchedS5a { int G, c; const char* SUX; const char* W;
    __device__ __forceinline__ bool next(int i, GUnit& u) const {
        const int idx = i * G + c; if (idx >= 48) return false;
        const int g = idx / 3, pm = idx % 3; u.A = SUX + ((size_t)g * MCH + pm * 256) * (SUXW * 2); u.B = W + (size_t)g * 256 * 2048; u.p0 = 0; u.p1 = pm; u.p2 = g; u.p3 = 0; return true; }
    __device__ __forceinline__ int row_token(const GUnit&, int) const { return 0; }
};
struct EpiS5a { float* SL;
    __device__ __forceinline__ void operator()(const AccT& acc, const GUnit& u, int wr, int wc, int fr, int fq) const {
#pragma unroll
        for (int ai = 0; ai < 2; ++ai)
#pragma unroll
            for (int m = 0; m < 4; ++m) { float* rowp = SL + (size_t)(u.p1 * 256 + 128 * ai + 64 * wr + 16 * m + fr) * 4096 + u.p2 * 256 + 32 * wc + 8 * fq;
#pragma unroll
                for (int bj = 0; bj < 2; ++bj) { *(f32x4*)(rowp + 128 * bj) = acc[ai][bj][m][0]; *(f32x4*)(rowp + 128 * bj + 4) = acc[ai][bj][m][1]; } }
    }
};
struct SchedS5c { int G, c; const char* SUX; const char* KC;
    __device__ __forceinline__ bool next(int i, GUnit& u) const {
        const int idx = i * G + c; if (idx >= 192) return false;
        const int g = idx / 12, q = idx % 12, pm = q / 4, pn = q % 4;
        u.A = SUX + ((size_t)g * MCH + pm * 256) * (SUXW * 2); u.B = KC + ((size_t)g * 1024 + pn * 256) * (SUXW * 2); u.p0 = 0; u.p1 = pm; u.p2 = pn; u.p3 = g; return true; }
    __device__ __forceinline__ int row_token(const GUnit&, int) const { return 0; }
};
struct EpiS5c { bf16_t* Gb;
    __device__ __forceinline__ void operator()(const AccT& acc, const GUnit& u, int wr, int wc, int fr, int fq) const {
#pragma unroll
        for (int ai = 0; ai < 2; ++ai)
#pragma unroll
            for (int m = 0; m < 4; ++m) { const int chunk = u.p1 * 256 + 128 * ai + 64 * wr + 16 * m + fr;
                if (chunk < TT / 64) {
#pragma unroll
                    for (int bj = 0; bj < 2; ++bj) { ACC8(ai, bj, m); const int col = u.p2 * 256 + 128 * bj + 32 * wc + 8 * fq;
#pragma unroll
                        for (int e = 0; e < 8; ++e) v[e] = gelu_tanh(v[e]);
                        *(u32x4*)(Gb + ((size_t)chunk * 64 + (col >> 4)) * 256 + u.p3 * 16 + (col & 15)) = pack8(v); } } }
    }
};
struct SchedGlu { int G, c; const char* Gb; const char* W;
    __device__ __forceinline__ bool next(int i, GUnit& u) const {
        const int idx = i * G + c; if (idx >= 132) return false;
        u.A = Gb + (size_t)idx * 256 * 512; u.B = W; u.p0 = 0; u.p1 = idx; u.p2 = 0; u.p3 = 0; return true; }
    __device__ __forceinline__ int row_token(const GUnit&, int) const { return 0; }
};
struct EpiGlu { const bf16_t* Gb; bf16_t* Y; const float* bglu;
    __device__ __forceinline__ void operator()(const AccT& acc, const GUnit& u, int wr, int wc, int fr, int fq) const {
#pragma unroll
        for (int bj = 0; bj < 2; ++bj) { const int col = 128 * bj + 32 * wc + 8 * fq;
            const f32x4 b0 = *(const f32x4*)(bglu + col), b1 = *(const f32x4*)(bglu + col + 4); const float bb[8] = {b0[0], b0[1], b0[2], b0[3], b1[0], b1[1], b1[2], b1[3]};
#pragma unroll
            for (int ai = 0; ai < 2; ++ai)
#pragma unroll
                for (int m = 0; m < 4; ++m) { const int row = u.p1 * 256 + 128 * ai + 64 * wr + 16 * m + fr; ACC8(ai, bj, m);
                    const u32x4 gw = *(const u32x4*)(Gb + (size_t)row * 256 + col);
                    const float gv[8] = {bflo(gw.x), bfhi(gw.x), bflo(gw.y), bfhi(gw.y), bflo(gw.z), bfhi(gw.z), bflo(gw.w), bfhi(gw.w)};
#pragma unroll
                    for (int e = 0; e < 8; ++e) v[e] = gv[e] * sigmoidf_(v[e] + bb[e]);
                    *(u32x4*)(Y + (size_t)row * D + 384 + col) = pack8(v); asm volatile("" ::: "memory"); } }
    }
};
struct SchedOut { int G, c, nunits; const char* Y; const char* W;
    __device__ __forceinline__ bool next(int i, GUnit& u) const {
        const int idx = i * G + c; if (idx >= nunits) return false;
        const int pm = idx >> 2, pn = idx & 3; u.A = Y + (size_t)pm * 256 * 2048; u.B = W + (size_t)pn * 256 * 2048; u.p0 = 0; u.p1 = pm; u.p2 = pn; u.p3 = 0; return true; }
    __device__ __forceinline__ int row_token(const GUnit&, int) const { return 0; }
};
struct EpiOut { float* XR; const float* MODL;
    __device__ __forceinline__ void operator()(const AccT& acc, const GUnit& u, int wr, int wc, int fr, int fq) const {
        const int bi = (u.p1 < 128) ? (u.p1 >> 5) : 4; const float* m2 = MODL + (size_t)bi * 6144 + 2 * D;
#pragma unroll
        for (int bj = 0; bj < 2; ++bj) { const int col = u.p2 * 256 + 128 * bj + 32 * wc + 8 * fq;
            const f32x4 g0 = *(const f32x4*)(m2 + col), g1 = *(const f32x4*)(m2 + col + 4);
#pragma unroll
            for (int ai = 0; ai < 2; ++ai)
#pragma unroll
                for (int m = 0; m < 4; ++m) { float* xp = XR + (size_t)(u.p1 * 256 + 128 * ai + 64 * wr + 16 * m + fr) * D + col;
                    const f32x4 x0 = *(const f32x4*)xp, x1 = *(const f32x4*)(xp + 4);
                    *(f32x4*)xp = x0 + g0 * acc[ai][bj][m][0]; *(f32x4*)(xp + 4) = x1 + g1 * acc[ai][bj][m][1]; } }
    }
};
struct SchedMoe { int G, c, NT; const LAS int* ts; const char* A; const char* W; size_t wstride; const int* elist; bool gather;
    __device__ __forceinline__ bool next(int i, GUnit& u) const {
        const int idx = i * G + c; const int ntiles = ts[32]; if (idx >= ntiles * NT) return false;
        const int mt = idx / NT, pn = idx % NT; int e = 0; while (ts[e + 1] <= mt) ++e;
        u.A = gather ? A : (A + (size_t)mt * 256 * 2048); u.B = W + (size_t)e * wstride + (size_t)pn * 256 * 2048; u.p0 = mt; u.p1 = pn; u.p2 = e; u.p3 = (mt - ts[e]) * 256; return true; }
    __device__ __forceinline__ int row_token(const GUnit& u, int row) const { const int j = u.p3 + row; return (j < ts[40 + u.p2]) ? elist[(size_t)u.p2 * TT + j] : 0; }
};
struct EpiGateUp { bf16_t* ACT; const float* bgu;
    __device__ __forceinline__ void operator()(const AccT& acc, const GUnit& u, int wr, int wc, int fr, int fq) const {
        const int col = 128 * u.p1 + 32 * wc + 8 * fq; const float* bg = bgu + (size_t)u.p2 * 2048 + col;
        const f32x4 g0 = *(const f32x4*)bg, g1 = *(const f32x4*)(bg + 4), u0 = *(const f32x4*)(bg + 1024), u1 = *(const f32x4*)(bg + 1028);
        const float bgate[8] = {g0[0], g0[1], g0[2], g0[3], g1[0], g1[1], g1[2], g1[3]}, bup[8] = {u0[0], u0[1], u0[2], u0[3], u1[0], u1[1], u1[2], u1[3]};
#pragma unroll
        for (int ai = 0; ai < 2; ++ai)
#pragma unroll
            for (int m = 0; m < 4; ++m) { const size_t row = (size_t)u.p0 * 256 + 128 * ai + 64 * wr + 16 * m + fr;
                const f32x4 ga = acc[ai][0][m][0], gb = acc[ai][0][m][1], ua = acc[ai][1][m][0], ub = acc[ai][1][m][1];
                const float gt[8] = {ga[0], ga[1], ga[2], ga[3], gb[0], gb[1], gb[2], gb[3]}, up[8] = {ua[0], ua[1], ua[2], ua[3], ub[0], ub[1], ub[2], ub[3]};
                float v[8];
#pragma unroll
                for (int e = 0; e < 8; ++e) { const float gg = fminf(gt[e] + bgate[e], 7.0f); const float uu = fminf(fmaxf(up[e] + bup[e], -7.0f), 7.0f); v[e] = gg * sigmoidf_(1.702f * gg) * (uu + 1.0f); }
                *(u32x4*)(ACT + row * FF + col) = pack8(v); }
    }
};
struct EpiDown { bf16_t* EO; const float* bdn; const float* elw; const LAS int* ts;
    __device__ __forceinline__ void operator()(const AccT& acc, const GUnit& u, int wr, int wc, int fr, int fq) const {
        const int cnt = ts[40 + u.p2];
#pragma unroll
        for (int ai = 0; ai < 2; ++ai)
#pragma unroll
            for (int m = 0; m < 4; ++m) { const int rl = 128 * ai + 64 * wr + 16 * m + fr; const int j = u.p3 + rl;
                const float w = (j < cnt) ? elw[(size_t)u.p2 * TT + j] : 0.f;
#pragma unroll
                for (int bj = 0; bj < 2; ++bj) { const int col = u.p1 * 256 + 128 * bj + 32 * wc + 8 * fq; const float* bp = bdn + (size_t)u.p2 * D + col;
                    const f32x4 b0 = *(const f32x4*)bp, b1 = *(const f32x4*)(bp + 4); ACC8(ai, bj, m);
                    const float bb[8] = {b0[0], b0[1], b0[2], b0[3], b1[0], b1[1], b1[2], b1[3]};
#pragma unroll
                    for (int e = 0; e < 8; ++e) v[e] = (v[e] + bb[e]) * w;
                    *(u32x4*)(EO + ((size_t)u.p0 * 256 + rl) * D + col) = pack8(v); } }
    }
};

constexpr int PH_PER_LAYER = 11, NPHASES = 2 + DEPTH * PH_PER_LAYER + 1;

__global__ void __launch_bounds__(NTHREADS, 2) mk_fwd(Args args) {
    extern __shared__ __attribute__((aligned(16))) unsigned char lds_raw[];
    Frame F;
    F.lds = (LAS unsigned char*)lds_raw;
    F.G = gridDim.x; F.bid = blockIdx.x;
    KArgs A0 = (KArgs)__builtin_amdgcn_kernarg_segment_ptr();
    KArgs A = A0; asm volatile("" : "+s"(A));
    volatile LAS unsigned* misc = (volatile LAS unsigned*)(F.lds + LDS_MISC);
    if (threadIdx.x < 16) misc[threadIdx.x] = 0u;
    __syncthreads();
    const int lo = A->ph_lo, hi = A->ph_hi;
    XcdBarrier bar; bar.bar = (unsigned*)A->ws + CW_BAR; bar.x = 0; bar.st = nullptr;
    if (hi - lo > 1) bar = xcd_barrier_post((unsigned*)A->ws + CW_BAR, misc + 8);
    LAS unsigned char* L = F.lds;
    const LAS int* ts = (const LAS int*)(F.lds + LDS_MISC + 64);
    int ph = 0;
#ifdef ONLY_SITE
#define SITE_ON(s) ((s) == ONLY_SITE)
#else
#define SITE_ON(s) true
#endif
#define PH_RUN(s) (SITE_ON(s) && ph >= lo && ph < hi)
#define PH_END do { if (ph >= lo && ph + 1 < hi) xcd_barrier(bar); ++ph; A = A0; asm volatile("" : "+s"(A)); } while (0)

    if (PH_RUN(0)) phase_p0a(A, F);
    PH_END;
    if (PH_RUN(1)) phase_p0b(A, F);
    PH_END;
    for (int l = 0; l < DEPTH; ++l) {
        const bool lastl = (l == DEPTH - 1);
        if (PH_RUN(2)) phase_norm1(A, F, l);
        PH_END;
        if (PH_RUN(3)) {
            SchedInproj S{F.G, F.bid, (const char*)WSP(bf16_t, WS_H), (const char*)(WSP(bf16_t, WS_WINT) + (size_t)l * 2048 * D)};
            EpiInproj E{WSP(bf16_t, WS_P), WSP(bf16_t, WS_VT), WSP(bf16_t, WS_SUX), WSP(float, WS_ROPE)};
            gemm_phase<false>(L, 16, 2048u, 2048u, S, E);
        }
        PH_END;
        if (PH_RUN(4)) {
            SchedS5a S{F.G, F.bid, (const char*)WSP(bf16_t, WS_SUX), (const char*)(WSP(bf16_t, WS_WST) + (size_t)l * 16 * 256 * 1024)};
            EpiS5a E{WSP(float, WS_SLOC)};
            gemm_phase<false>(L, 16, (unsigned)(SUXW * 2), 2048u, S, E);
        }
        PH_END;
        if (PH_RUN(5)) phase_s5scan(A, F, l);
        PH_END;
        if (PH_RUN(6)) {
            SchedS5c S{F.G, F.bid, (const char*)WSP(bf16_t, WS_SUX), (const char*)(WSP(bf16_t, WS_KC) + (size_t)l * 16 * 1024 * SUXW)};
            EpiS5c E{WSP(bf16_t, WS_G)};
            gemm_phase<false>(L, 20, (unsigned)(SUXW * 2), (unsigned)(SUXW * 2), S, E);
        }
        PH_END;
        if (PH_RUN(7)) {
            SchedGlu S{F.G, F.bid, (const char*)WSP(bf16_t, WS_G), (const char*)(WSP(bf16_t, WS_WGLUT) + (size_t)l * 256 * 256)};
            EpiGlu E{WSP(bf16_t, WS_G), WSP(bf16_t, WS_Y), FIN(19) + (size_t)l * 256};
            gemm_phase<false>(L, 4, 512u, 512u, S, E);
        }
        PH_END;
        if (PH_RUN(8)) phase_attn(A, F, l);
        PH_END;
        if (PH_RUN(9)) {
            SchedOut S{F.G, F.bid, (lastl ? 128 : 132) * 4, (const char*)WSP(bf16_t, WS_Y), (const char*)(WSP(bf16_t, WS_WOUTT) + (size_t)l * D * D)};
            EpiOut E{WSP(float, WS_XR), WSP(float, WS_MOD) + (size_t)l * 5 * 6144};
            gemm_phase<false>(L, 16, 2048u, 2048u, S, E);
        }
        PH_END;
        if (PH_RUN(10)) phase_router(A, F, l);
        PH_END;
        if (PH_RUN(11)) {
            build_tstart(A, F, l);
            SchedMoe S{F.G, F.bid, 8, ts, (const char*)WSP(bf16_t, WS_H), (const char*)(WSP(bf16_t, WS_WGUT) + (size_t)l * NEXP * 2048 * D), (size_t)2048 * D * 2, WSP(int, WS_ELIST), true};
            EpiGateUp E{WSP(bf16_t, WS_ACT), FIN(25) + (size_t)l * NEXP * 2048};
            gemm_phase<true>(L, 16, 2048u, 2048u, S, E);
        }
        PH_END;
        if (PH_RUN(12)) {
            build_tstart(A, F, l);
            SchedMoe S{F.G, F.bid, 4, ts, (const char*)WSP(bf16_t, WS_ACT), (const char*)(WSP(bf16_t, WS_WDT) + (size_t)l * NEXP * D * FF), (size_t)D * FF * 2, WSP(int, WS_ELIST), false};
            EpiDown E{WSP(bf16_t, WS_EO), FIN(27) + (size_t)l * NEXP * D, WSP(float, WS_ELW), ts};
            gemm_phase<false>(L, 16, 2048u, 2048u, S, E);
        }
        PH_END;
    }
    if (PH_RUN(13)) phase_norm1(A, F, DEPTH);
#undef PH_RUN
#undef PH_END
}
}

extern "C" void kernel_launch(void* const* d_in, const int* in_sizes, int n_in, void* d_out, int out_size, void* d_ws, size_t ws_size, hipStream_t stream) {
    static int grid = 0;
    if (grid == 0) {
        if (n_in != 29 || out_size != NLAT * D || ws_size < WS_END) { fprintf(stderr, "kernel_launch: unexpected shapes (n_in %d, out %d, ws %zu)\n", n_in, out_size, ws_size); grid = -1; return; }
        int dev = 0, cus = 0;
        if (hipGetDevice(&dev) != hipSuccess || hipDeviceGetAttribute(&cus, hipDeviceAttributeMultiprocessorCount, dev) != hipSuccess) { grid = -1; return; }
        if (hipFuncSetAttribute((const void*)mk_fwd, hipFuncAttributeMaxDynamicSharedMemorySize, LDS_BYTES) != hipSuccess) { fprintf(stderr, "kernel_launch: hipFuncSetAttribute failed\n"); grid = -1; return; }
        int per_cu = 0;
        if (hipOccupancyMaxActiveBlocksPerMultiprocessor(&per_cu, (const void*)mk_fwd, NTHREADS, LDS_BYTES) != hipSuccess || per_cu < 1) { fprintf(stderr, "kernel_launch: occupancy query reports %d\n", per_cu); }
        (void)hipGetLastError();
        grid = cus;
    }
    if (grid < 0) return;
    (void)hipMemsetAsync((char*)d_ws + WS_CTL, 0, 1 * MiB, stream);
    Args a{};
    for (int i = 0; i < 29; ++i) a.in[i] = (const float*)d_in[i];
    a.out = (float*)d_out; a.ws = (unsigned char*)d_ws;
#if MK_PER_PHASE
    for (int p = 0; p < NPHASES; ++p) { a.ph_lo = p; a.ph_hi = p + 1; hipLaunchKernelGGL(mk_fwd, dim3(grid), dim3(NTHREADS), LDS_BYTES, stream, a); }
#else
    a.ph_lo = 0; a.ph_hi = NPHASES;
    hipLaunchKernelGGL(mk_fwd, dim3(grid), dim3(NTHREADS), LDS_BYTES, stream, a);
#endif
}
```

```cpp
#include <hip/hip_runtime.h>
#include <cstdio>
#include <cstdint>

#ifndef MK_PER_PHASE
#define MK_PER_PHASE 0
#endif

#define LAS __attribute__((address_space(3)))
#define GAS __attribute__((address_space(1)))
typedef unsigned short bf16_t;
typedef short bf16x8 __attribute__((ext_vector_type(8)));
typedef float f32x4 __attribute__((ext_vector_type(4)));
typedef float f32x2 __attribute__((ext_vector_type(2)));
typedef float f32x16 __attribute__((ext_vector_type(16)));
typedef unsigned u32x4 __attribute__((ext_vector_type(4)));
typedef unsigned u32x2 __attribute__((ext_vector_type(2)));

namespace {
constexpr int D = 1024, NBATCH = 4, SEQ = 8192, DEPTH = 4, CTXL = 256;
constexpr int NLAT = NBATCH * SEQ;
constexpr int NCTX = NBATCH * CTXL;
constexpr int TT = NLAT + NCTX;
constexpr int PW = 1280;
constexpr int NEXP = 32, FF = 1024;
constexpr int MCH = 768;
constexpr int SUXW = 1280;
constexpr int MAXTILES = 560;
constexpr int NWAVES = 8, NTHREADS = 512;
constexpr float RMS_EPS = 1e-6f;

constexpr size_t MiB = 1ull << 20;
constexpr size_t WS_CTL = 0;
constexpr size_t WS_MOD = 1 * MiB;
constexpr size_t WS_ROPE = 2 * MiB;
constexpr size_t WS_LP = 3 * MiB;
constexpr size_t WS_BBAR = 8 * MiB;
constexpr size_t WS_WRT = 9 * MiB;
constexpr size_t WS_WGLUT = 10 * MiB;
constexpr size_t WS_WINT = 11 * MiB;
constexpr size_t WS_WOUTT = 27 * MiB;
constexpr size_t WS_WST = 35 * MiB;
constexpr size_t WS_KC = 67 * MiB;
constexpr size_t WS_WGUT = 227 * MiB;
constexpr size_t WS_WDT = 739 * MiB;
constexpr size_t WS_XR = 995 * MiB;
constexpr size_t WS_H = 1127 * MiB;
constexpr size_t WS_P = 1193 * MiB;
constexpr size_t WS_VT = 1276 * MiB;
constexpr size_t WS_SUX = 1309 * MiB;
constexpr size_t WS_SLOC = 1339 * MiB;
constexpr size_t WS_G = 1351 * MiB;
constexpr size_t WS_Y = 1368 * MiB;
constexpr size_t WS_ELIST = 1434 * MiB;
constexpr size_t WS_ELW = 1439 * MiB;
constexpr size_t WS_TOKINFO = 1444 * MiB;
constexpr size_t WS_ACT = 1445 * MiB;
constexpr size_t WS_EO = 1725 * MiB;
constexpr size_t WS_END = 2005 * MiB;
constexpr int CW_BAR = 1024;
constexpr int CW_CNT = 8192;

constexpr int LDS_STAGE = 131072;
constexpr int LDS_MISC = LDS_STAGE;
constexpr int LDS_BYTES = LDS_STAGE + 1024;

__device__ __forceinline__ unsigned f2bf(float f) { unsigned u = __builtin_bit_cast(unsigned, f); return (u + 0x7fffu + ((u >> 16) & 1u)) >> 16; }
__device__ __forceinline__ unsigned pk2(float lo, float hi) { return f2bf(lo) | (f2bf(hi) << 16); }
__device__ __forceinline__ float bf2f(unsigned short b) { return __builtin_bit_cast(float, ((unsigned)b) << 16); }
__device__ __forceinline__ float bflo(unsigned w) { return __builtin_bit_cast(float, w << 16); }
__device__ __forceinline__ float bfhi(unsigned w) { return __builtin_bit_cast(float, w & 0xffff0000u); }
__device__ __forceinline__ float wave_sum(float v) {
#pragma unroll
    for (int o = 1; o < 64; o <<= 1) v += __shfl_xor(v, o);
    return v;
}
__device__ __forceinline__ float fast_exp2(float x) { return __builtin_amdgcn_exp2f(x); }
__device__ __forceinline__ float sigmoidf_(float x) { return 1.0f / (1.0f + __expf(-x)); }
__device__ __forceinline__ float gelu_tanh(float x) {
    const float u = 0.7978845608028654f * (x + 0.044715f * x * x * x);
    const float t = 1.0f - 2.0f / (1.0f + __expf(2.0f * u));
    return 0.5f * x * (1.0f + t);
}

#define XB_TMO      128
#define XB_XCNT(j)  (256  + 64 * (j))
#define XB_XSUB(j)  (1280 + 64 * (j))
#define XB_XGEN(j)  (2304 + 64 * (j))
#define XB_TOP      3328
#define XB_TOPGEN   3392
#define XCD_BAR_WORDS 3456
#define XB_SPIN_CAP (1u << 18)
__device__ __forceinline__ unsigned xb_ld(unsigned* p)              { return __hip_atomic_load(p, __ATOMIC_RELAXED, __HIP_MEMORY_SCOPE_AGENT); }
__device__ __forceinline__ unsigned xb_add(unsigned* p, unsigned v) { return __hip_atomic_fetch_add(p, v, __ATOMIC_RELAXED, __HIP_MEMORY_SCOPE_AGENT); }
__device__ __forceinline__ unsigned xb_xcc_id() { return (unsigned)__builtin_amdgcn_s_getreg((3 << 11) | 20) & 0xFu; }
#define XB_SPIN(cond, bar) do { unsigned _sp = 0; while (cond) { __builtin_amdgcn_s_sleep(1); \
    if ((++_sp & 255u) == 0u) { if (xb_ld(&(bar)[XB_TMO])) break; if (_sp > XB_SPIN_CAP) { atomicAdd(&(bar)[XB_TMO], 1u); break; } } } } while (0)
struct XcdBarrier { unsigned* bar; unsigned x; volatile LAS unsigned* st; };
__device__ __forceinline__ XcdBarrier xcd_barrier_post(unsigned* bar, volatile LAS unsigned* st) {
    XcdBarrier b; b.bar = bar; b.x = xb_xcc_id(); b.st = st;
    if (threadIdx.x == 0) (void)xb_add(&bar[XB_XCNT(b.x)], 1u);
    return b;
}
__device__ __forceinline__ void xcd_barrier_complete(unsigned* bar, unsigned x, unsigned& nloc, unsigned& nx) {
    const unsigned G = gridDim.x * gridDim.y * gridDim.z;
    unsigned sum, cnt, mine, sp = 0u;
    for (;;) {
        sum = 0u; cnt = 0u; mine = 0u;
#pragma unroll
        for (unsigned j = 0; j < 16; ++j) { const unsigned c = xb_ld(&bar[XB_XCNT(j)]); sum += c; cnt += (c > 0u) ? 1u : 0u; mine = (j == x) ? c : mine; }
        if (sum == G) break;
        __builtin_amdgcn_s_sleep(1);
        if ((++sp & 255u) == 0u) { if (xb_ld(&bar[XB_TMO])) break; if (sp > XB_SPIN_CAP) { atomicAdd(&bar[XB_TMO], 1u); break; } }
    }
    nloc = mine > 0u ? mine : 1u; nx = cnt > 0u ? cnt : 1u;
}
__device__ __forceinline__ void xcd_barrier(const XcdBarrier& b) {
    asm volatile("s_waitcnt vmcnt(0)" ::: "memory");
    __syncthreads();
    if (threadIdx.x == 0) {
        unsigned* bar = b.bar;
        __builtin_amdgcn_s_waitcnt(0);
        unsigned nloc = b.st[0], nx = b.st[1];
        if (nloc == 0u) { xcd_barrier_complete(bar, b.x, nloc, nx); b.st[0] = nloc; b.st[1] = nx; }
        const unsigned old = xb_add(&bar[XB_XSUB(b.x)], 1u);
        const unsigned gen = old / nloc;
        if (old + 1u == (gen + 1u) * nloc) {
            __builtin_amdgcn_fence(__ATOMIC_RELEASE, "agent");
            asm volatile("s_waitcnt vmcnt(0)" ::: "memory");
            const unsigned og = xb_add(&bar[XB_TOP], 1u);
            const unsigned tg = og / nx;
            if (og + 1u == (tg + 1u) * nx) xb_add(&bar[XB_TOPGEN], 1u);
            else XB_SPIN(xb_ld(&bar[XB_TOPGEN]) == tg, bar);
            __builtin_amdgcn_fence(__ATOMIC_ACQUIRE, "agent");
            xb_add(&bar[XB_XGEN(b.x)], 1u);
            asm volatile("s_waitcnt vmcnt(0)" ::: "memory");
        } else {
            XB_SPIN(xb_ld(&bar[XB_XGEN(b.x)]) == gen, bar);
            __builtin_amdgcn_fence(__ATOMIC_ACQUIRE, "agent");
            asm volatile("s_waitcnt vmcnt(0)" ::: "memory");
        }
    }
    __syncthreads();
}

constexpr int BM = 256, BK = 64, HALF = 128, HTB = HALF * BK * 2;
__device__ __forceinline__ int lds_byte(int r, int c) { const int st = (r >> 4) * 2 + (c >> 5), rr = r & 15, cc = c & 31, ob = rr * 64 + cc * 2; return st * 1024 + (ob ^ (((ob >> 9) & 1) << 5)); }
__device__ __forceinline__ void stage_rc(int b, int& R, int& C) { const int st = b / 1024, sb = b % 1024, swz = sb ^ (((sb >> 9) & 1) << 5); R = (st >> 1) * 16 + swz / 64; C = (st & 1) * 32 + (swz % 64) / 2; }
__device__ __forceinline__ int perm32(int rho) { const int n = rho >> 4, i = rho & 15; return 8 * (i >> 2) + 4 * n + (i & 3); }
__device__ __forceinline__ unsigned cvt_pk_bf16(float lo, float hi) { unsigned r; asm volatile("v_cvt_pk_bf16_f32 %0, %1, %2" : "=v"(r) : "v"(lo), "v"(hi)); return r; }

struct GUnit { const char* A; const char* B; int p0, p1, p2, p3; };
typedef f32x4 AccT[2][2][4][2];

template <bool GATHER, class Sched, class Epi>
__device__ __forceinline__ void gemm_phase(LAS unsigned char* lds, const int nt_  , const unsigned lda2, const unsigned ldb2  , const Sched& S, const Epi& E) {
    int tid = threadIdx.x; asm volatile("" : "+v"(tid));
    int nt = nt_; asm volatile("" : "+s"(nt));
    const int wid = __builtin_amdgcn_readfirstlane(tid >> 6), lane = tid & 63, wr = wid >> 2, wc = wid & 3, fr = lane & 15, fq = lane >> 4;
    unsigned voffA[2][2], voffB[2]; int RA[2], CA[2];
#pragma unroll
    for (int i = 0; i < 2; ++i) { int R, C; stage_rc(tid * 16 + i * 8192, R, C); const int Rb = (R & ~31) + perm32(R & 31);
        RA[i] = R; CA[i] = C; voffA[0][i] = (unsigned)R * lda2 + (unsigned)C * 2u; voffA[1][i] = voffA[0][i] + 128u * lda2; voffB[i] = (unsigned)Rb * ldb2 + (unsigned)C * 2u; }
    const size_t kstep = (size_t)(BK * 2);
    const size_t hstepB = (size_t)HALF * ldb2;
    const unsigned ldsw = (unsigned)wid * 1024u;
    const int aoff = lds_byte(wr * 64 + fr, fq * 8), boff = lds_byte(wc * 32 + fr, fq * 8);
#define PG_SA(b, h) (((b) * 2 + (h)) * HTB)
#define PG_SB(b, h) ((4 + (b) * 2 + (h)) * HTB)
#define PG_STAGE(bufoff, gbase, voff) do { _Pragma("unroll") for (int _i = 0; _i < 2; ++_i) \
        __builtin_amdgcn_global_load_lds((const unsigned*)((const char*)(gbase) + (voff)[_i]), (LAS unsigned*)(lds + (bufoff) + ldsw + _i * 8192), 16, 0, 0); } while (0)
#define PG_LDA(dst, b, h) do { _Pragma("unroll") for (int m = 0; m < 4; ++m) _Pragma("unroll") for (int k = 0; k < 2; ++k) dst[m][k] = *(const LAS bf16x8*)(lds + PG_SA(b, h) + aoff + m * 2048 + k * 1024); } while (0)
#define PG_LDB(dst, b, h) do { _Pragma("unroll") for (int n = 0; n < 2; ++n) _Pragma("unroll") for (int k = 0; k < 2; ++k) dst[n][k] = *(const LAS bf16x8*)(lds + PG_SB(b, h) + boff + n * 2048 + k * 1024); } while (0)
#define PG_MMA(ai, bj, At, Bt) do { __builtin_amdgcn_s_setprio(1); _Pragma("unroll") for (int m = 0; m < 4; ++m) _Pragma("unroll") for (int n = 0; n < 2; ++n) _Pragma("unroll") for (int k = 0; k < 2; ++k) \
        acc[ai][bj][m][n] = __builtin_amdgcn_mfma_f32_16x16x32_bf16(Bt[n][k], At[m][k], acc[ai][bj][m][n], 0, 0, 0); __builtin_amdgcn_s_setprio(0); } while (0)
#define PG_WAIT_V(n) asm volatile("s_waitcnt vmcnt(" #n ")" ::: "memory")
#define PG_WAIT_L(n) asm volatile("s_waitcnt lgkmcnt(" #n ")" ::: "memory")
#define PG_BAR __builtin_amdgcn_s_barrier()
#define PG_SCHED __builtin_amdgcn_sched_barrier(0)
    GUnit cur, nxt; int ui = 0;
    if (!S.next(0, cur)) return;
    AccT acc;
#pragma unroll
    for (int a = 0; a < 2; ++a)
#pragma unroll
        for (int b = 0; b < 2; ++b)
#pragma unroll
            for (int m = 0; m < 4; ++m)
#pragma unroll
                for (int n = 0; n < 2; ++n) acc[a][b][m][n] = (f32x4){0.f, 0.f, 0.f, 0.f};
    bf16x8 At[4][2], B0[2][2], B1[2][2];
    const char* cA = cur.A; const char* cB = cur.B;
    if (GATHER) {
#pragma unroll
        for (int h = 0; h < 2; ++h)
#pragma unroll
            for (int i = 0; i < 2; ++i) voffA[h][i] = (unsigned)S.row_token(cur, h * 128 + RA[i]) * lda2 + (unsigned)CA[i] * 2u;
    }
    unsigned voffAn[2][2];
#pragma unroll
    for (int h = 0; h < 2; ++h)
#pragma unroll
        for (int i = 0; i < 2; ++i) voffAn[h][i] = voffA[h][i];
    PG_STAGE(PG_SB(0, 0), cB, voffB); PG_STAGE(PG_SA(0, 0), cA, voffA[0]); PG_STAGE(PG_SB(0, 1), cB + hstepB, voffB); PG_STAGE(PG_SA(0, 1), cA, voffA[1]);
    if (wr == 1) PG_BAR;
    PG_WAIT_V(4); PG_BAR;
    PG_STAGE(PG_SB(1, 0), cB + kstep, voffB); PG_STAGE(PG_SA(1, 0), cA + kstep, voffA[0]); PG_STAGE(PG_SB(1, 1), cB + hstepB + kstep, voffB);
    PG_WAIT_V(6); PG_BAR;
    for (;;) {
        const bool has_next = S.next(ui + 1, nxt);
        const char* nA = has_next ? nxt.A : cA; const char* nB = has_next ? nxt.B : cB;
        for (int t = 0; t < nt; t += 2) {
            const bool last = (t == nt - 2);
            const char* a1 = cA + (size_t)(t + 1) * kstep;
            const char* a2 = last ? nA : cA + (size_t)(t + 2) * kstep; const char* b2 = last ? nB : cB + (size_t)(t + 2) * kstep;
            const char* a3 = a2 + kstep; const char* b3 = b2 + kstep;
            if (GATHER) {
                if (last && has_next) {
#pragma unroll
                    for (int h = 0; h < 2; ++h)
#pragma unroll
                        for (int i = 0; i < 2; ++i) voffAn[h][i] = (unsigned)S.row_token(nxt, h * 128 + RA[i]) * lda2 + (unsigned)CA[i] * 2u;
                }
            }
            unsigned vA0[2], vA1[2];
#pragma unroll
            for (int i = 0; i < 2; ++i) { vA0[i] = (GATHER && last) ? voffAn[0][i] : voffA[0][i]; vA1[i] = (GATHER && last) ? voffAn[1][i] : voffA[1][i]; }
            PG_LDB(B0, 0, 0); PG_SCHED; PG_LDA(At, 0, 0); PG_STAGE(PG_SA(1, 1), a1, voffA[1]);
            PG_WAIT_L(8); PG_BAR; PG_WAIT_L(0); PG_MMA(0, 0, At, B0); PG_BAR; PG_SCHED;
            PG_LDB(B1, 0, 1); PG_STAGE(PG_SB(0, 0), b2, voffB);
            PG_BAR; PG_WAIT_L(0); PG_MMA(0, 1, At, B1); PG_BAR;
            PG_LDA(At, 0, 1); PG_STAGE(PG_SA(0, 0), a2, vA0);
            PG_BAR; PG_WAIT_L(0); PG_MMA(1, 0, At, B0); PG_BAR; PG_SCHED;
            PG_STAGE(PG_SB(0, 1), b2 + hstepB, voffB);
            PG_WAIT_V(6); PG_BAR; PG_MMA(1, 1, At, B1); PG_BAR;
            PG_LDB(B0, 1, 0); PG_SCHED; PG_LDA(At, 1, 0); PG_STAGE(PG_SA(0, 1), a2, vA1);
            PG_WAIT_L(8); PG_BAR; PG_WAIT_L(0); PG_MMA(0, 0, At, B0); PG_BAR; PG_SCHED;
            PG_LDB(B1, 1, 1); PG_STAGE(PG_SB(1, 0), b3, voffB);
            PG_BAR; PG_WAIT_L(0); PG_MMA(0, 1, At, B1); PG_BAR;
            PG_LDA(At, 1, 1); PG_STAGE(PG_SA(1, 0), a3, vA0);
            PG_BAR; PG_WAIT_L(0); PG_MMA(1, 0, At, B0); PG_BAR; PG_SCHED;
            PG_STAGE(PG_SB(1, 1), b3 + hstepB, voffB);
            PG_WAIT_V(6); PG_BAR; PG_MMA(1, 1, At, B1); PG_BAR;
        }
        {
            int tz = threadIdx.x; asm volatile("" : "+v"(tz)); const int wz = __builtin_amdgcn_readfirstlane(tz >> 6), lz = tz & 63;
            E(acc, cur, wz >> 2, wz & 3, lz & 15, lz >> 4); }
        if (!has_next) break;
#pragma unroll
        for (int a = 0; a < 2; ++a)
#pragma unroll
            for (int b = 0; b < 2; ++b)
#pragma unroll
                for (int m = 0; m < 4; ++m)
#pragma unroll
                    for (int n = 0; n < 2; ++n) acc[a][b][m][n] = (f32x4){0.f, 0.f, 0.f, 0.f};
        cur = nxt; cA = nA; cB = nB; ++ui;
        if (GATHER) {
#pragma unroll
            for (int h = 0; h < 2; ++h)
#pragma unroll
                for (int i = 0; i < 2; ++i) voffA[h][i] = voffAn[h][i];
        }
    }
    PG_WAIT_V(0);
    if (wr == 0) PG_BAR;
    PG_BAR;
#undef PG_SA
#undef PG_SB
#undef PG_STAGE
#undef PG_LDA
#undef PG_LDB
#undef PG_MMA
#undef PG_WAIT_V
#undef PG_WAIT_L
#undef PG_BAR
#undef PG_SCHED
}

struct Args { const float* in[29]; float* out; unsigned char* ws; int ph_lo, ph_hi; };
struct Frame {
    LAS unsigned char* lds;
    int G, bid;
};
#define PH_LOCALS int tid = threadIdx.x; asm volatile("" : "+v"(tid)); const int lane = tid & 63; const int wave = __builtin_amdgcn_readfirstlane(tid >> 6); (void)lane; (void)wave
typedef const __attribute__((address_space(4))) Args* KArgs;
#define WSP(T, off) ((T*)(A->ws + (off)))
#define FIN(i) (A->in[i])

__device__ __forceinline__ void transpose_item(const float* W, int K, int N, bf16_t* WT, int kb, int n0s, int drow0, LAS float* scr, int lane) {
    const int k0 = 64 * kb;
#pragma unroll 8
    for (int i = 0; i < 32; ++i) { const int kk = 2 * i + (lane >> 5); scr[kk * 33 + (lane & 31)] = W[(size_t)(k0 + kk) * N + n0s + (lane & 31)]; }
    asm volatile("s_waitcnt lgkmcnt(0)" ::: "memory");
    const int c = lane & 7;
#pragma unroll
    for (int j = 0; j < 4; ++j) { const int n = (lane >> 3) + 8 * j; const LAS float* s = scr + (8 * c) * 33 + n;
        u32x4 o; o.x = pk2(s[0 * 33], s[1 * 33]); o.y = pk2(s[2 * 33], s[3 * 33]); o.z = pk2(s[4 * 33], s[5 * 33]); o.w = pk2(s[6 * 33], s[7 * 33]);
        *(u32x4*)(WT + (size_t)(drow0 + n) * K + k0 + 8 * c) = o; }
    asm volatile("s_waitcnt lgkmcnt(0)" ::: "memory");
}
__device__ __forceinline__ int win_src_col(int d) {
    if (d < 768) return d;
    if (d < 1152) return 1408 + (d - 768);
    if (d < 1280) return 1792 + (d - 1152);
    if (d < 1536) return 1152 + (d - 1280);
    if (d < 1920) return 768 + (d - 1536);
    return d;
}
__device__ __forceinline__ int wgu_src_col(int d) { const int t = d >> 8, r = d & 255; return (r < 128) ? (128 * t + r) : (1024 + 128 * t + (r - 128)); }

__device__ __forceinline__ void phase_p0a(KArgs A, Frame& F) {
    PH_LOCALS;
    LAS float* scr = (LAS float*)(F.lds + wave * 16384);
    const int gw = F.bid * NWAVES + wave, NGW = F.G * NWAVES;
    constexpr int I_IN = DEPTH * 16 * 64, I_OUT = DEPTH * 16 * 32, I_GLU = DEPTH * 4 * 8, I_RT = DEPTH * 16, I_GU = DEPTH * NEXP * 16 * 64, I_DN = DEPTH * NEXP * 16 * 32;
    constexpr int NITEMS = I_IN + I_OUT + I_GLU + I_RT + I_GU + I_DN;
    for (int it = gw; it < NITEMS; it += NGW) {
        int r = it;
        if (r < I_IN) { const int l = r / 1024, q = r % 1024, kb = q / 64, nb = q % 64;
            transpose_item(FIN(7) + (size_t)l * D * 2048, D, 2048, WSP(bf16_t, WS_WINT) + (size_t)l * 2048 * D, kb, win_src_col(32 * nb), 32 * nb, scr, lane); continue; } r -= I_IN;
        if (r < I_OUT) { const int l = r / 512, q = r % 512, kb = q / 32, nb = q % 32;
            transpose_item(FIN(8) + (size_t)l * D * D, D, D, WSP(bf16_t, WS_WOUTT) + (size_t)l * D * D, kb, 32 * nb, 32 * nb, scr, lane); continue; } r -= I_OUT;
        if (r < I_GLU) { const int l = r / 32, q = r % 32, kb = q / 8, nb = q % 8;
            transpose_item(FIN(18) + (size_t)l * 256 * 256, 256, 256, WSP(bf16_t, WS_WGLUT) + (size_t)l * 256 * 256, kb, 32 * nb, 32 * nb, scr, lane); continue; } r -= I_GLU;
        if (r < I_RT) { const int l = r / 16, kb = r % 16;
            transpose_item(FIN(22) + (size_t)l * D * NEXP, D, NEXP, WSP(bf16_t, WS_WRT) + (size_t)l * NEXP * D, kb, 0, 0, scr, lane); continue; } r -= I_RT;
        if (r < I_GU) { const int le = r / 1024, q = r % 1024, kb = q / 64, nb = q % 64;
            transpose_item(FIN(24) + (size_t)le * D * 2048, D, 2048, WSP(bf16_t, WS_WGUT) + (size_t)le * 2048 * D, kb, wgu_src_col(32 * nb), 32 * nb, scr, lane); continue; } r -= I_GU;
        { const int le = r / 512, q = r % 512, kb = q / 32, nb = q % 32;
            transpose_item(FIN(26) + (size_t)le * FF * D, FF, D, WSP(bf16_t, WS_WDT) + (size_t)le * D * FF, kb, 32 * nb, 32 * nb, scr, lane); }
    }
    __syncthreads();
    {
        LAS float* cond = (LAS float*)F.lds;
        LAS float* red = (LAS float*)(F.lds + 32768);
        for (int i = tid; i < 5 * D; i += NTHREADS) { const int bi = i / D, k = i % D; const float v = (bi < 4) ? FIN(1)[bi * D + k] : FIN(3)[k]; cond[i] = v / (1.0f + __expf(-v)); }
        __syncthreads();
        for (int u = F.bid; u < DEPTH * 96; u += F.G) {
            const int l = u / 96, j = (u % 96) * 64 + lane;
            const float* w = FIN(4) + (size_t)l * D * 6144 + j;
            float a0 = 0.f, a1 = 0.f, a2 = 0.f, a3 = 0.f, a4 = 0.f;
#pragma unroll 8
            for (int kk = 0; kk < 128; ++kk) { const int k = wave * 128 + kk; const float wv = w[(size_t)k * 6144];
                a0 += cond[k] * wv; a1 += cond[D + k] * wv; a2 += cond[2 * D + k] * wv; a3 += cond[3 * D + k] * wv; a4 += cond[4 * D + k] * wv; }
            red[(wave * 5 + 0) * 64 + lane] = a0; red[(wave * 5 + 1) * 64 + lane] = a1; red[(wave * 5 + 2) * 64 + lane] = a2;
            red[(wave * 5 + 3) * 64 + lane] = a3; red[(wave * 5 + 4) * 64 + lane] = a4;
            __syncthreads();
            if (tid < 320) { const int bi = tid / 64, jj = tid % 64; float s = 0.f;
#pragma unroll
                for (int w8 = 0; w8 < 8; ++w8) s += red[(w8 * 5 + bi) * 64 + jj];
                const int col = (u % 96) * 64 + jj;
                WSP(float, WS_MOD)[((size_t)l * 5 + bi) * 6144 + col] = s + FIN(5)[l * 6144 + col]; }
            __syncthreads();
        }
    }
    const int gt = F.bid * NTHREADS + tid, NGT = F.G * NTHREADS;
    for (int i = gt; i < 128 * 16; i += NGT) { const int pos = i / 16, f = i % 16; const float inv = powf(10000.0f, -(float)f / 16.0f); const float a = (float)pos * inv;
        WSP(float, WS_ROPE)[i] = cosf(a); WSP(float, WS_ROPE)[2048 + i] = sinf(a); }
    for (int i = gt; i < DEPTH * 2 * 16 * 65 * 64; i += NGT) {
        const int p = i % 64, d = (i / 64) % 65, ldg = i / (64 * 65);
        const float are = fminf(FIN(10)[ldg * 64 + p], -1e-4f), aim = FIN(11)[ldg * 64 + p];
        const float step = expf(FIN(12)[ldg]);
        const float re = are * step * (float)d, im = aim * step * (float)d;
        const float mag = expf(re);
        WSP(f32x2, WS_LP)[i] = (f32x2){mag * cosf(im), mag * sinf(im)};
    }
    for (int i = gt; i < DEPTH * 2 * 16 * 64 * 16; i += NGT) {
        const int lp = i / 16;
        const int ldg = lp / 64;
        const float are = fminf(FIN(10)[lp], -1e-4f), aim = FIN(11)[lp];
        const float step = expf(FIN(12)[ldg]);
        const float mag = expf(are * step), lr = mag * cosf(aim * step) - 1.0f, li = mag * sinf(aim * step);
        const float den = are * are + aim * aim;
        const float qr = (lr * are + li * aim) / den, qi = (li * are - lr * aim) / den;
        const float br = FIN(13)[i], bi = FIN(14)[i];
        WSP(f32x2, WS_BBAR)[i] = (f32x2){qr * br - qi * bi, qr * bi + qi * br};
    }
}

__device__ __forceinline__ f32x2 cmul(f32x2 a, f32x2 b) { return (f32x2){a.x * b.x - a.y * b.y, a.x * b.y + a.y * b.x}; }
__device__ __forceinline__ void phase_p0b(KArgs A, Frame& F) {
    PH_LOCALS;
    const f32x2* LP = WSP(f32x2, WS_LP); const f32x2* BB = WSP(f32x2, WS_BBAR);
    LAS float* kv = (LAS float*)F.lds;
    for (int it = F.bid; it < DEPTH * 16 * 64; it += F.G) {
        const int d = it % 64, g = (it / 64) % 16, l = it / 1024;
        const int dir = tid >> 8, ho = (tid >> 4) & 15, hi = tid & 15;
        const int ldg = (l * 2 + dir) * 16 + g;
        const float* cre = FIN(15) + ((size_t)ldg * 16 + ho) * 64; const float* cim = FIN(16) + ((size_t)ldg * 16 + ho) * 64;
        const f32x2* lp = LP + ((size_t)ldg * 65 + d) * 64; const f32x2* bb = BB + (size_t)ldg * 1024 + hi;
        float s = 0.f;
        for (int p = 0; p < 64; ++p) { const f32x2 t = cmul(lp[p], bb[p * 16]); s += cre[p] * t.x - cim[p] * t.y; }
        kv[dir * 256 + ho * 16 + hi] = s;
        __syncthreads();
        bf16_t* KC = WSP(bf16_t, WS_KC) + ((size_t)(l * 16 + g)) * 1024 * SUXW;
        if (d == 0) {
            if (dir == 0) { const float v = kv[ho * 16 + hi] + kv[256 + ho * 16 + hi] + ((ho == hi) ? FIN(17)[l * 256 + g * 16 + ho] : 0.f); const unsigned short b = (unsigned short)f2bf(v);
                for (int t = 0; t < 64; ++t) KC[(size_t)(t * 16 + ho) * SUXW + t * 16 + hi] = b; }
        } else {
            const unsigned short b = (unsigned short)f2bf(s);
            if (dir == 0) { for (int t = d; t < 64; ++t) KC[(size_t)(t * 16 + ho) * SUXW + (t - d) * 16 + hi] = b; }
            else          { for (int t = 0; t < 64 - d; ++t) KC[(size_t)(t * 16 + ho) * SUXW + (t + d) * 16 + hi] = b; }
        }
        __syncthreads();
    }
    const int gt = F.bid * NTHREADS + tid, NGT = F.G * NTHREADS;
    for (int i = gt; i < DEPTH * 16 * 256 * 1024; i += NGT) {
        const int k = i % 1024, n = (i / 1024) % 256, lg = i / (1024 * 256), l = lg / 16, g = lg % 16;
        const int s = k / 16, hi = k % 16, dir = n / 128, ri = (n / 64) & 1, p = n % 64;
        const int ldg = (l * 2 + dir) * 16 + g;
        const int e = dir ? s : 63 - s;
        const f32x2 t = cmul(LP[((size_t)ldg * 65 + e) * 64 + p], BB[(size_t)ldg * 1024 + p * 16 + hi]);
        WSP(bf16_t, WS_WST)[i] = (unsigned short)f2bf(ri ? t.y : t.x);
    }
    for (int i = gt; i < DEPTH * 16 * 1024 * 256; i += NGT) {
        const int n = i % 256, row = (i / 256) % 1024, lg = i / (256 * 1024), l = lg / 16, g = lg % 16;
        const int t = row / 16, ho = row % 16, dir = n / 128, ri = (n / 64) & 1, p = n % 64;
        const int ldg = (l * 2 + dir) * 16 + g;
        const int e = dir ? 64 - t : t + 1;
        const f32x2 c = (f32x2){FIN(15)[((size_t)ldg * 16 + ho) * 64 + p], FIN(16)[((size_t)ldg * 16 + ho) * 64 + p]};
        const f32x2 v = cmul(c, LP[((size_t)ldg * 65 + e) * 64 + p]);
        WSP(bf16_t, WS_KC)[((size_t)lg * 1024 + row) * SUXW + 1024 + n] = (unsigned short)f2bf(ri ? -v.y : v.x);
    }
}

__device__ __forceinline__ void build_tstart(KArgs A, Frame& F, int l) {
    PH_LOCALS;
    LAS int* ts = (LAS int*)(F.lds + LDS_MISC + 64);
    if (tid == 0) { const int* cnt = (const int*)A->ws + CW_CNT + l * 32; int a = 0;
        for (int e = 0; e < 32; ++e) { ts[e] = a; ts[40 + e] = cnt[e]; a += (cnt[e] + 255) >> 8; }
        ts[32] = a; }
    __syncthreads();
}

__device__ __forceinline__ void phase_norm1(KArgs A, Frame& F, int l) {
    PH_LOCALS;
    const bool fin = (l == DEPTH);
    const int nrows = fin ? NLAT : TT;
    if (l > 0) build_tstart(A, F, l - 1);
    const LAS int* ts = (const LAS int*)(F.lds + LDS_MISC + 64);
    const int gw = F.bid * NWAVES + wave, NGW = F.G * NWAVES;
    const float* MOD = WSP(float, WS_MOD);
    float* XR = WSP(float, WS_XR);
    for (int r = gw; r < nrows; r += NGW) {
        const int bi = (r < NLAT) ? (r / SEQ) : 4;
        f32x4 v[4];
        if (l == 0) { const float* src = (r < NLAT) ? (FIN(0) + (size_t)r * D) : (FIN(2) + (size_t)(r - NLAT) * D);
#pragma unroll
            for (int j = 0; j < 4; ++j) v[j] = *(const f32x4*)(src + 4 * lane + 256 * j); }
        else {
            const float* src = XR + (size_t)r * D;
#pragma unroll
            for (int j = 0; j < 4; ++j) v[j] = *(const f32x4*)(src + 4 * lane + 256 * j);
            const int* ti = WSP(int, WS_TOKINFO) + (size_t)r * 4;
            f32x4 a[4];
#pragma unroll
            for (int j = 0; j < 4; ++j) a[j] = (f32x4){0.f, 0.f, 0.f, 0.f};
#pragma unroll
            for (int k = 0; k < 4; ++k) { const int inf = ti[k]; const int e = (inf >> 24) & 31, rank = inf & 0xffffff; const size_t pos = (size_t)ts[e] * 256 + rank;
                const bf16_t* eo = WSP(bf16_t, WS_EO) + pos * D;
#pragma unroll
                for (int j = 0; j < 4; ++j) { const u32x2 w = *(const u32x2*)(eo + 4 * lane + 256 * j); a[j].x += bflo(w.x); a[j].y += bfhi(w.x); a[j].z += bflo(w.y); a[j].w += bfhi(w.y); } }
            const float* m5 = MOD + ((size_t)(l - 1) * 5 + bi) * 6144 + 5 * D;
#pragma unroll
            for (int j = 0; j < 4; ++j) { const f32x4 g5 = *(const f32x4*)(m5 + 4 * lane + 256 * j); v[j] = v[j] + g5 * a[j]; }
        }
        if (!fin) {
#pragma unroll
            for (int j = 0; j < 4; ++j) *(f32x4*)(XR + (size_t)r * D + 4 * lane + 256 * j) = v[j];
        }
        float ss = 0.f;
#pragma unroll
        for (int j = 0; j < 4; ++j) ss += (v[j].x * v[j].x + v[j].y * v[j].y) + (v[j].z * v[j].z + v[j].w * v[j].w);
        const float rinv = 1.0f / sqrtf(wave_sum(ss) * (1.0f / D) + RMS_EPS);
        if (fin) {
#pragma unroll
            for (int j = 0; j < 4; ++j) { const f32x4 g = *(const f32x4*)(FIN(28) + 4 * lane + 256 * j); *(f32x4*)(A->out + (size_t)r * D + 4 * lane + 256 * j) = v[j] * rinv * g; }
        } else {
            const float* gm = FIN(6) + (size_t)l * D; const float* m0 = MOD + ((size_t)l * 5 + bi) * 6144; const float* m1 = m0 + D;
            bf16_t* hrow = WSP(bf16_t, WS_H) + (size_t)r * D;
#pragma unroll
            for (int j = 0; j < 4; ++j) { const int c = 4 * lane + 256 * j; const f32x4 g = *(const f32x4*)(gm + c), sh = *(const f32x4*)(m0 + c), sc = *(const f32x4*)(m1 + c);
                const f32x4 h = v[j] * rinv * g * (sc + 1.0f) + sh;
                u32x2 o; o.x = pk2(h.x, h.y); o.y = pk2(h.z, h.w); *(u32x2*)(hrow + c) = o; }
        }
    }
}

__device__ __forceinline__ void phase_router(KArgs A, Frame& F, int l) {
    PH_LOCALS;
    const int nrows = (l == DEPTH - 1) ? NLAT : TT;
    LAS bf16_t* tile = (LAS bf16_t*)F.lds;
    LAS float* part = (LAS float*)(F.lds + 32 * 1032 * 2);
    LAS float* logit = part + 8 * 32 * 33;
    const float* MOD = WSP(float, WS_MOD);
    const float* XR = WSP(float, WS_XR);
    const bf16_t* WRT = WSP(bf16_t, WS_WRT) + (size_t)l * NEXP * D;
    int* cnt = (int*)A->ws + CW_CNT + l * 32;
    for (int u = F.bid; u < nrows / 32; u += F.G) {
        const int r0 = u * 32;
#pragma unroll 1
        for (int q = 0; q < 4; ++q) {
            const int rl = wave * 4 + q, r = r0 + rl; const int bi = (r < NLAT) ? (r / SEQ) : 4;
            f32x4 v[4]; float ss = 0.f;
#pragma unroll
            for (int j = 0; j < 4; ++j) { v[j] = *(const f32x4*)(XR + (size_t)r * D + 4 * lane + 256 * j); ss += (v[j].x * v[j].x + v[j].y * v[j].y) + (v[j].z * v[j].z + v[j].w * v[j].w); }
            const float rinv = 1.0f / sqrtf(wave_sum(ss) * (1.0f / D) + RMS_EPS);
            const float* gm = FIN(21) + (size_t)l * D; const float* m3 = MOD + ((size_t)l * 5 + bi) * 6144 + 3 * D; const float* m4 = m3 + D;
            bf16_t* hrow = WSP(bf16_t, WS_H) + (size_t)r * D;
#pragma unroll
            for (int j = 0; j < 4; ++j) { const int c = 4 * lane + 256 * j; const f32x4 g = *(const f32x4*)(gm + c), sh = *(const f32x4*)(m3 + c), sc = *(const f32x4*)(m4 + c);
                const f32x4 h = v[j] * rinv * g * (sc + 1.0f) + sh;
                u32x2 o; o.x = pk2(h.x, h.y); o.y = pk2(h.z, h.w); *(u32x2*)(hrow + c) = o; *(LAS u32x2*)(tile + rl * 1032 + c) = o; }
        }
        __syncthreads();
        {
            f32x16 acc;
#pragma unroll
            for (int i = 0; i < 16; ++i) acc[i] = 0.f;
            const int rr = lane & 31, hh = lane >> 5;
#pragma unroll
            for (int s = 0; s < 8; ++s) { const int k = wave * 128 + 16 * s + 8 * hh;
                const bf16x8 a = *(const LAS bf16x8*)(tile + rr * 1032 + k);
                const bf16x8 b = *(const bf16x8*)(WRT + (size_t)rr * D + k);
                acc = __builtin_amdgcn_mfma_f32_32x32x16_bf16(a, b, acc, 0, 0, 0); }
#pragma unroll
            for (int i = 0; i < 16; ++i) { const int tok = (i & 3) + 8 * (i >> 2) + 4 * hh; part[(wave * 32 + tok) * 33 + rr] = acc[i]; }
        }
        __syncthreads();
        for (int i = tid; i < 1024; i += NTHREADS) { const int tok = i >> 5, e = i & 31; float s = FIN(23)[l * 32 + e];
#pragma unroll
            for (int w = 0; w < 8; ++w) s += part[(w * 32 + tok) * 33 + e];
            logit[tok * 33 + e] = s; }
        __syncthreads();
        if (tid < 32) {
            const int r = r0 + tid; float lv[4]; int le[4]; unsigned used = 0u;
#pragma unroll
            for (int k = 0; k < 4; ++k) { float best = -3.0e38f; int be = 0;
                for (int e = 0; e < 32; ++e) { const float x = logit[tid * 33 + e]; if (!((used >> e) & 1u) && x > best) { best = x; be = e; } }
                used |= 1u << be; lv[k] = best; le[k] = be; }
            const float e1 = __expf(lv[1] - lv[0]), e2 = __expf(lv[2] - lv[0]), e3 = __expf(lv[3] - lv[0]); const float inv = 1.0f / (1.0f + e1 + e2 + e3);
            const float wk[4] = {inv, e1 * inv, e2 * inv, e3 * inv};
            int* ti = WSP(int, WS_TOKINFO) + (size_t)r * 4;
#pragma unroll
            for (int k = 0; k < 4; ++k) { const int rank = atomicAdd(&cnt[le[k]], 1);
                WSP(int, WS_ELIST)[(size_t)le[k] * TT + rank] = r; WSP(float, WS_ELW)[(size_t)le[k] * TT + rank] = wk[k]; ti[k] = (le[k] << 24) | rank; }
        }
        __syncthreads();
    }
}

__device__ __forceinline__ void phase_s5scan(KArgs A, Frame& F, int l) {
    PH_LOCALS;
    const int gw = F.bid * NWAVES + wave, NGW = F.G * NWAVES;
    const float* SL = WSP(float, WS_SLOC);
    for (int it = gw; it < NBATCH * 16 * 2; it += NGW) {
        const int dir = it & 1, g = (it >> 1) & 15, b = it >> 5;
        const int ldg = (l * 2 + dir) * 16 + g;
        const f32x2 L64 = WSP(f32x2, WS_LP)[((size_t)ldg * 65 + 64) * 64 + lane];
        bf16_t* sux = WSP(bf16_t, WS_SUX) + (size_t)g * MCH * SUXW;
        float xr = 0.f, xi = 0.f;
#pragma unroll 4
        for (int step = 0; step < 132; ++step) {
            int ch;
            if (step < 4) ch = 512 + 4 * b + (dir ? 3 - step : step);
            else ch = 128 * b + (dir ? 127 - (step - 4) : (step - 4));
            const float sr = SL[(size_t)ch * 4096 + g * 256 + dir * 128 + lane], si = SL[(size_t)ch * 4096 + g * 256 + dir * 128 + 64 + lane];
            bf16_t* o = sux + (size_t)ch * SUXW + 1024 + dir * 128;
            o[lane] = (unsigned short)f2bf(xr); o[64 + lane] = (unsigned short)f2bf(xi);
            const float nr = L64.x * xr - L64.y * xi + sr, ni = L64.x * xi + L64.y * xr + si;
            xr = nr; xi = ni;
        }
    }
}

constexpr float LOG2E = 1.4426950408889634f;
template <int MODE>
__device__ __forceinline__ void attn_item(KArgs A, Frame& F, int lane, int l, int item, const LAS float* rpb) {
    const int r = lane & 31, hh = lane >> 5;
    const bf16_t* P = WSP(bf16_t, WS_P); const bf16_t* VT = WSP(bf16_t, WS_VT);
    int b, head, qtok0, qcol, kcol, vrow, ycol, qrow = 0, mh = 0, qt = 0;
    float m, lsum;
    if (MODE == 0) { mh = item & 1; qrow = (item >> 1) & 127; const int bh = item >> 8; head = bh % 6; b = bh / 6; qtok0 = b * SEQ + qrow * 64 + 32 * mh; }
    else if (MODE == 1) { const int g = item % 3; qt = (item / 3) & 255; const int bk = item / 768; const int kvh = bk & 1; b = bk >> 1; head = kvh * 3 + g; qtok0 = b * SEQ + 32 * qt; }
    else { const int qi = item & 7; const int bh = item >> 3; head = bh % 6; b = bh / 6; qtok0 = NLAT + b * CTXL + 32 * qi; }
    if (MODE == 0 || MODE == 2) { qcol = 64 * head; kcol = 384 + 64 * head; vrow = 64 * head; ycol = 64 * head; m = -1e30f; lsum = 0.f; }
    else { qcol = 768 + 64 * head; kcol = 1152 + 64 * (head / 3); vrow = 384 + 64 * (head / 3); ycol = 640 + 64 * head; m = FIN(20)[l * 6 + head]; lsum = 1.f; }
    bf16x8 qf[4];
#pragma unroll
    for (int s = 0; s < 4; ++s) qf[s] = *(const bf16x8*)(P + (size_t)(qtok0 + r) * PW + qcol + 32 * hh + 8 * s);
    f32x16 O0, O1;
#pragma unroll
    for (int i = 0; i < 16; ++i) { O0[i] = 0.f; O1[i] = 0.f; }
    const int qc = 32 * mh + r;
    const int wsn = min(max(qc - 8, 0), 48);
    const int qpos = 32 * qt + r;
    int ntl;
    int rs = 0, kt0 = 0;
    if (MODE == 0) { rs = min(max(qrow - 4, 0), 120); ntl = 16; }
    else if (MODE == 1) { kt0 = max(qt - 4, 0); ntl = min(qt + 4, 255) - kt0 + 1; }
    else ntl = 0;
    for (int ti = 0; ti < ntl + 8; ++ti) {
        int ktok0, kr = 0, ct = 0, kt = 0; const bool isctx = (ti >= ntl);
        if (isctx) ktok0 = NLAT + b * CTXL + 32 * (ti - ntl);
        else if (MODE == 0) { kr = rs + (ti >> 1); ct = ti & 1; ktok0 = b * SEQ + kr * 64 + 32 * ct; }
        else { kt = kt0 + ti; ktok0 = b * SEQ + 32 * kt; }
        bf16x8 kf[4];
#pragma unroll
        for (int s = 0; s < 4; ++s) kf[s] = *(const bf16x8*)(P + (size_t)(ktok0 + r) * PW + kcol + 32 * hh + 8 * s);
        u32x2 vlo[2][2], vhi[2][2];
#pragma unroll
        for (int mt = 0; mt < 2; ++mt)
#pragma unroll
            for (int s2 = 0; s2 < 2; ++s2) { const bf16_t* vp = VT + (size_t)(vrow + 32 * mt + r) * TT + ktok0 + 16 * s2 + 4 * hh; vlo[mt][s2] = *(const u32x2*)vp; vhi[mt][s2] = *(const u32x2*)(vp + 8); }
        f32x16 sa;
#pragma unroll
        for (int i = 0; i < 16; ++i) sa[i] = 0.f;
#pragma unroll
        for (int s = 0; s < 4; ++s) sa = __builtin_amdgcn_mfma_f32_32x32x16_bf16(kf[s], qf[s], sa, 0, 0, 0);
        float sv[16]; float tmax = -1e30f;
#pragma unroll
        for (int i = 0; i < 16; ++i) {
            const int ki = (i & 3) + 8 * (i >> 2) + 4 * hh;
            bool valid = true; float bias = 0.f;
            if (!isctx) {
                if (MODE == 0) { const int kc = 32 * ct + ki; valid = (kc >= wsn) && (kc < wsn + 16);
                    const int dc = min(max(kc - qc + 15, 0), 30); bias = rpb[head * 465 + (kr - qrow + 7) * 31 + dc]; }
                if (MODE == 1) { const int dpos = qpos - (32 * kt + ki); valid = (dpos <= 128) && (dpos >= -128); }
            }
            const float x = sa[i] * 0.125f + bias;
            sv[i] = valid ? x : -1e30f; tmax = fmaxf(tmax, sv[i]);
        }
        tmax = fmaxf(tmax, __shfl_xor(tmax, 32));
        const float mnew = fmaxf(m, tmax);
        const float alpha = fast_exp2((m - mnew) * LOG2E);
        float psum = 0.f;
#pragma unroll
        for (int i = 0; i < 16; ++i) { const float p = (sv[i] > -1e29f) ? fast_exp2((sv[i] - mnew) * LOG2E) : 0.f; psum += p; sv[i] = p; }
        psum += __shfl_xor(psum, 32);
        lsum = lsum * alpha + psum; m = mnew;
#pragma unroll
        for (int i = 0; i < 16; ++i) { O0[i] *= alpha; O1[i] *= alpha; }
#pragma unroll
        for (int s2 = 0; s2 < 2; ++s2) {
            u32x4 pw; pw.x = pk2(sv[8 * s2 + 0], sv[8 * s2 + 1]); pw.y = pk2(sv[8 * s2 + 2], sv[8 * s2 + 3]); pw.z = pk2(sv[8 * s2 + 4], sv[8 * s2 + 5]); pw.w = pk2(sv[8 * s2 + 6], sv[8 * s2 + 7]);
            const bf16x8 pf = __builtin_bit_cast(bf16x8, pw);
            u32x4 v0; v0.x = vlo[0][s2].x; v0.y = vlo[0][s2].y; v0.z = vhi[0][s2].x; v0.w = vhi[0][s2].y;
            u32x4 v1; v1.x = vlo[1][s2].x; v1.y = vlo[1][s2].y; v1.z = vhi[1][s2].x; v1.w = vhi[1][s2].y;
            O0 = __builtin_amdgcn_mfma_f32_32x32x16_bf16(__builtin_bit_cast(bf16x8, v0), pf, O0, 0, 0, 0);
            O1 = __builtin_amdgcn_mfma_f32_32x32x16_bf16(__builtin_bit_cast(bf16x8, v1), pf, O1, 0, 0, 0);
        }
    }
    const float inv = 1.0f / lsum;
    bf16_t* yrow = WSP(bf16_t, WS_Y) + (size_t)(qtok0 + r) * D + ycol + 4 * hh;
#pragma unroll
    for (int rg = 0; rg < 4; ++rg) {
        u32x2 o0; o0.x = pk2(O0[4 * rg + 0] * inv, O0[4 * rg + 1] * inv); o0.y = pk2(O0[4 * rg + 2] * inv, O0[4 * rg + 3] * inv);
        u32x2 o1; o1.x = pk2(O1[4 * rg + 0] * inv, O1[4 * rg + 1] * inv); o1.y = pk2(O1[4 * rg + 2] * inv, O1[4 * rg + 3] * inv);
        *(u32x2*)(yrow + 8 * rg) = o0; *(u32x2*)(yrow + 32 + 8 * rg) = o1;
    }
}
__device__ __forceinline__ void phase_attn(KArgs A, Frame& F, int l) {
    PH_LOCALS;
    LAS float* rpb = (LAS float*)F.lds;
    for (int i = tid; i < 6 * 465; i += NTHREADS) rpb[i] = FIN(9)[(size_t)l * 6 * 465 + i];
    __syncthreads();
    const int gw = F.bid * NWAVES + wave, NGW = F.G * NWAVES;
    constexpr int N0 = NBATCH * 6 * 128 * 2, N1 = NBATCH * 6 * 256, N2 = NBATCH * 6 * 8;
    const int total = N0 + N1 + ((l < DEPTH - 1) ? 2 * N2 : 0);
    for (int it = gw; it < total; it += NGW) {
        if (it < N0) attn_item<0>(A, F, lane, l, it, rpb);
        else if (it < N0 + N1) attn_item<1>(A, F, lane, l, it - N0, rpb);
        else if (it < N0 + N1 + N2) attn_item<2>(A, F, lane, l, it - N0 - N1, rpb);
        else attn_item<3>(A, F, lane, l, it - N0 - N1 - N2, rpb);
    }
}

#define ACC8(ai, bj, m) const f32x4 a0_ = acc[ai][bj][m][0], a1_ = acc[ai][bj][m][1]; float v[8] = {a0_[0], a0_[1], a0_[2], a0_[3], a1_[0], a1_[1], a1_[2], a1_[3]}
__device__ __forceinline__ u32x4 pack8(const float* v) { u32x4 w; w.x = cvt_pk_bf16(v[0], v[1]); w.y = cvt_pk_bf16(v[2], v[3]); w.z = cvt_pk_bf16(v[4], v[5]); w.w = cvt_pk_bf16(v[6], v[7]); return w; }

struct SchedInproj { int G, c; const char* H; const char* W;
    __device__ __forceinline__ bool next(int i, GUnit& u) const {
        const int idx = i * G + c; if (idx >= 1056) return false;
        if (idx < 792) { const int pm = idx / 6, pn = idx % 6; u.A = H + (size_t)pm * 256 * 2048; u.B = W + (size_t)pn * 256 * 2048; u.p0 = 0; u.p1 = pm; u.p2 = pn; u.p3 = 0; }
        else { const int j = idx - 792, vm = j / 132, tn = j % 132; u.A = W + (size_t)(1536 + 256 * vm) * 2048; u.B = H + (size_t)tn * 256 * 2048; u.p0 = 1; u.p1 = vm; u.p2 = tn; u.p3 = 0; }
        return true; }
    __device__ __forceinline__ int row_token(const GUnit&, int) const { return 0; }
};
struct EpiInproj { bf16_t* P; bf16_t* VT; bf16_t* SUX; const float* ROPE;
    __device__ __forceinline__ void operator()(const AccT& acc, const GUnit& u, int wr, int wc, int fr, int fq) const {
        if (u.p0 == 1) {
#pragma unroll
            for (int ai = 0; ai < 2; ++ai)
#pragma unroll
                for (int m = 0; m < 4; ++m) { const int row = u.p1 * 256 + 128 * ai + 64 * wr + 16 * m + fr;
#pragma unroll
                    for (int bj = 0; bj < 2; ++bj) { ACC8(ai, bj, m); *(u32x4*)(VT + (size_t)row * TT + u.p2 * 256 + 128 * bj + 32 * wc + 8 * fq) = pack8(v); } }
            return;
        }
        const int pm = u.p1, pn = u.p2;
#pragma unroll
        for (int bj = 0; bj < 2; ++bj) {
            const int hh = 2 * pn + bj;
#pragma unroll
            for (int ai = 0; ai < 2; ++ai)
#pragma unroll
                for (int m = 0; m < 4; ++m) {
                    const int row = pm * 256 + 128 * ai + 64 * wr + 16 * m + fr;
                    ACC8(ai, bj, m);
                    if (hh >= 10) {
                        const int g = 8 * (hh - 10) + 2 * wc + (fq >> 1);
                        *(u32x4*)(SUX + ((size_t)g * MCH + (row >> 6)) * SUXW + (row & 63) * 16 + 8 * (fq & 1)) = pack8(v);
                    } else {
                        if (hh >= 6 && pm < 128) {
                            const int t = row & (SEQ - 1); const int pos = (wc & 1) ? (t & 63) : (t >> 6);
                            const float* cs = ROPE + pos * 16 + 8 * (fq & 1);
                            const f32x4 c0 = *(const f32x4*)cs, c1 = *(const f32x4*)(cs + 4), s0 = *(const f32x4*)(cs + 2048), s1 = *(const f32x4*)(cs + 2052);
                            const float cc[8] = {c0[0], c0[1], c0[2], c0[3], c1[0], c1[1], c1[2], c1[3]}, sn[8] = {s0[0], s0[1], s0[2], s0[3], s1[0], s1[1], s1[2], s1[3]};
#pragma unroll
                            for (int e = 0; e < 8; ++e) { const float pr = __shfl_xor(v[e], 32); v[e] = v[e] * cc[e] + ((fq < 2) ? -pr : pr) * sn[e]; }
                        }
                        *(u32x4*)(P + (size_t)row * PW + 128 * hh + 32 * wc + 8 * fq) = pack8(v);
                    }
                }
        }
    }
};
struct SchedS5a { int G, c; const char* SUX; const char* W;
    __device__ __forceinline__ bool next(int i, GUnit& u) const {
        const int idx = i * G + c; if (idx >= 48) return false;
        const int g = idx / 3, pm = idx % 3; u.A = SUX + ((size_t)g * MCH + pm * 256) * (SUXW * 2); u.B = W + (size_t)g * 256 * 2048; u.p0 = 0; u.p1 = pm; u.p2 = g; u.p3 = 0; return true; }
    __device__ __forceinline__ int row_token(const GUnit&, int) const { return 0; }
};
struct EpiS5a { float* SL;
    __device__ __forceinline__ void operator()(const AccT& acc, const GUnit& u, int wr, int wc, int fr, int fq) const {
#pragma unroll
        for (int ai = 0; ai < 2; ++ai)
#pragma unroll
            for (int m = 0; m < 4; ++m) { float* rowp = SL + (size_t)(u.p1 * 256 + 128 * ai + 64 * wr + 16 * m + fr) * 4096 + u.p2 * 256 + 32 * wc + 8 * fq;
#pragma unroll
                for (int bj = 0; bj < 2; ++bj) { *(f32x4*)(rowp + 128 * bj) = acc[ai][bj][m][0]; *(f32x4*)(rowp + 128 * bj + 4) = acc[ai][bj][m][1]; } }
    }
};
struct SchedS5c { int G, c; const char* SUX; const char* KC;
    __device__ __forceinline__ bool next(int i, GUnit& u) const {
        const int idx = i * G + c; if (idx >= 192) return false;
        const int g = idx / 12, q = idx % 12, pm = q / 4, pn = q % 4;
        u.A = SUX + ((size_t)g * MCH + pm * 256) * (SUXW * 2); u.B = KC + ((size_t)g * 1024 + pn * 256) * (SUXW * 2); u.p0 = 0; u.p1 = pm; u.p2 = pn; u.p3 = g; return true; }
    __device__ __forceinline__ int row_token(const GUnit&, int) const { return 0; }
};
struct EpiS5c { bf16_t* Gb;
    __device__ __forceinline__ void operator()(const AccT& acc, const GUnit& u, int wr, int wc, int fr, int fq) const {
#pragma unroll
        for (int ai = 0; ai < 2; ++ai)
#pragma unroll
            for (int m = 0; m < 4; ++m) { const int chunk = u.p1 * 256 + 128 * ai + 64 * wr + 16 * m + fr;
                if (chunk < TT / 64) {
#pragma unroll
                    for (int bj = 0; bj < 2; ++bj) { ACC8(ai, bj, m); const int col = u.p2 * 256 + 128 * bj + 32 * wc + 8 * fq;
#pragma unroll
                        for (int e = 0; e < 8; ++e) v[e] = gelu_tanh(v[e]);
                        *(u32x4*)(Gb + ((size_t)chunk * 64 + (col >> 4)) * 256 + u.p3 * 16 + (col & 15)) = pack8(v); } } }
    }
};
struct SchedGlu { int G, c; const char* Gb; const char* W;
    __device__ __forceinline__ bool next(int i, GUnit& u) const {
        const int idx = i * G + c; if (idx >= 132) return false;
        u.A = Gb + (size_t)idx * 256 * 512; u.B = W; u.p0 = 0; u.p1 = idx; u.p2 = 0; u.p3 = 0; return true; }
    __device__ __forceinline__ int row_token(const GUnit&, int) const { return 0; }
};
struct EpiGlu { const bf16_t* Gb; bf16_t* Y; const float* bglu;
    __device__ __forceinline__ void operator()(const AccT& acc, const GUnit& u, int wr, int wc, int fr, int fq) const {
#pragma unroll
        for (int bj = 0; bj < 2; ++bj) { const int col = 128 * bj + 32 * wc + 8 * fq;
            const f32x4 b0 = *(const f32x4*)(bglu + col), b1 = *(const f32x4*)(bglu + col + 4); const float bb[8] = {b0[0], b0[1], b0[2], b0[3], b1[0], b1[1], b1[2], b1[3]};
#pragma unroll
            for (int ai = 0; ai < 2; ++ai)
#pragma unroll
                for (int m = 0; m < 4; ++m) { const int row = u.p1 * 256 + 128 * ai + 64 * wr + 16 * m + fr; ACC8(ai, bj, m);
                    const u32x4 gw = *(const u32x4*)(Gb + (size_t)row * 256 + col);
                    const float gv[8] = {bflo(gw.x), bfhi(gw.x), bflo(gw.y), bfhi(gw.y), bflo(gw.z), bfhi(gw.z), bflo(gw.w), bfhi(gw.w)};
#pragma unroll
                    for (int e = 0; e < 8; ++e) v[e] = gv[e] * sigmoidf_(v[e] + bb[e]);
                    *(u32x4*)(Y + (size_t)row * D + 384 + col) = pack8(v); asm volatile("" ::: "memory"); } }
    }
};
struct SchedOut { int G, c, nunits; const char* Y; const char* W;
    __device__ __forceinline__ bool next(int i, GUnit& u) const {
        const int idx = i * G + c; if (idx >= nunits) return false;
        const int pm = idx >> 2, pn = idx & 3; u.A = Y + (size_t)pm * 256 * 2048; u.B = W + (size_t)pn * 256 * 2048; u.p0 = 0; u.p1 = pm; u.p2 = pn; u.p3 = 0; return true; }
    __device__ __forceinline__ int row_token(const GUnit&, int) const { return 0; }
};
struct EpiOut { float* XR; const float* MODL;
    __device__ __forceinline__ void operator()(const AccT& acc, const GUnit& u, int wr, int wc, int fr, int fq) const {
        const int bi = (u.p1 < 128) ? (u.p1 >> 5) : 4; const float* m2 = MODL + (size_t)bi * 6144 + 2 * D;
#pragma unroll
        for (int bj = 0; bj < 2; ++bj) { const int col = u.p2 * 256 + 128 * bj + 32 * wc + 8 * fq;
            const f32x4 g0 = *(const f32x4*)(m2 + col), g1 = *(const f32x4*)(m2 + col + 4);
#pragma unroll
            for (int ai = 0; ai < 2; ++ai)
#pragma unroll
                for (int m = 0; m < 4; ++m) { float* xp = XR + (size_t)(u.p1 * 256 + 128 * ai + 64 * wr + 16 * m + fr) * D + col;
                    const f32x4 x0 = *(const f32x4*)xp, x1 = *(const f32x4*)(xp + 4);
                    *(f32x4*)xp = x0 + g0 * acc[ai][bj][m][0]; *(f32x4*)(xp + 4) = x1 + g1 * acc[ai][bj][m][1]; } }
    }
};
struct SchedMoe { int G, c, NT; const LAS int* ts; const char* A; const char* W; size_t wstride; const int* elist; bool gather;
    __device__ __forceinline__ bool next(int i, GUnit& u) const {
        const int idx = i * G + c; const int ntiles = ts[32]; if (idx >= ntiles * NT) return false;
        const int mt = idx / NT, pn = idx % NT; int e = 0; while (ts[e + 1] <= mt) ++e;
        u.A = gather ? A : (A + (size_t)mt * 256 * 2048); u.B = W + (size_t)e * wstride + (size_t)pn * 256 * 2048; u.p0 = mt; u.p1 = pn; u.p2 = e; u.p3 = (mt - ts[e]) * 256; return true; }
    __device__ __forceinline__ int row_token(const GUnit& u, int row) const { const int j = u.p3 + row; return (j < ts[40 + u.p2]) ? elist[(size_t)u.p2 * TT + j] : 0; }
};
struct EpiGateUp { bf16_t* ACT; const float* bgu;
    __device__ __forceinline__ void operator()(const AccT& acc, const GUnit& u, int wr, int wc, int fr, int fq) const {
        const int col = 128 * u.p1 + 32 * wc + 8 * fq; const float* bg = bgu + (size_t)u.p2 * 2048 + col;
        const f32x4 g0 = *(const f32x4*)bg, g1 = *(const f32x4*)(bg + 4), u0 = *(const f32x4*)(bg + 1024), u1 = *(const f32x4*)(bg + 1028);
        const float bgate[8] = {g0[0], g0[1], g0[2], g0[3], g1[0], g1[1], g1[2], g1[3]}, bup[8] = {u0[0], u0[1], u0[2], u0[3], u1[0], u1[1], u1[2], u1[3]};
#pragma unroll
        for (int ai = 0; ai < 2; ++ai)
#pragma unroll
            for (int m = 0; m < 4; ++m) { const size_t row = (size_t)u.p0 * 256 + 128 * ai + 64 * wr + 16 * m + fr;
                const f32x4 ga = acc[ai][0][m][0], gb = acc[ai][0][m][1], ua = acc[ai][1][m][0], ub = acc[ai][1][m][1];
                const float gt[8] = {ga[0], ga[1], ga[2], ga[3], gb[0], gb[1], gb[2], gb[3]}, up[8] = {ua[0], ua[1], ua[2], ua[3], ub[0], ub[1], ub[2], ub[3]};
                float v[8];
#pragma unroll
                for (int e = 0; e < 8; ++e) { const float gg = fminf(gt[e] + bgate[e], 7.0f); const float uu = fminf(fmaxf(up[e] + bup[e], -7.0f), 7.0f); v[e] = gg * sigmoidf_(1.702f * gg) * (uu + 1.0f); }
                *(u32x4*)(ACT + row * FF + col) = pack8(v); }
    }
};
struct EpiDown { bf16_t* EO; const float* bdn; const float* elw; const LAS int* ts;
    __device__ __forceinline__ void operator()(const AccT& acc, const GUnit& u, int wr, int wc, int fr, int fq) const {
        const int cnt = ts[40 + u.p2];
#pragma unroll
        for (int ai = 0; ai < 2; ++ai)
#pragma unroll
            for (int m = 0; m < 4; ++m) { const int rl = 128 * ai + 64 * wr + 16 * m + fr; const int j = u.p3 + rl;
                const float w = (j < cnt) ? elw[(size_t)u.p2 * TT + j] : 0.f;
#pragma unroll
                for (int bj = 0; bj < 2; ++bj) { const int col = u.p1 * 256 + 128 * bj + 32 * wc + 8 * fq; const float* bp = bdn + (size_t)u.p2 * D + col;
                    const f32x4 b0 = *(const f32x4*)bp, b1 = *(const f32x4*)(bp + 4); ACC8(ai, bj, m);
                    const float bb[8] = {b0[0], b0[1], b0[2], b0[3], b1[0], b1[1], b1[2], b1[3]};
#pragma unroll
                    for (int e = 0; e < 8; ++e) v[e] = (v[e] + bb[e]) * w;
                    *(u32x4*)(EO + ((size_t)u.p0 * 256 + rl) * D + col) = pack8(v); } }
    }
};

constexpr int PH_PER_LAYER = 11, NPHASES = 2 + DEPTH * PH_PER_LAYER + 1;

__global__ void __launch_bounds__(NTHREADS, 2) mk_fwd(Args args) {
    extern __shared__ __attribute__((aligned(16))) unsigned char lds_raw[];
    Frame F;
    F.lds = (LAS unsigned char*)lds_raw;
    F.G = gridDim.x; F.bid = blockIdx.x;
    KArgs A0 = (KArgs)__builtin_amdgcn_kernarg_segment_ptr();
    KArgs A = A0; asm volatile("" : "+s"(A));
    volatile LAS unsigned* misc = (volatile LAS unsigned*)(F.lds + LDS_MISC);
    if (threadIdx.x < 16) misc[threadIdx.x] = 0u;
    __syncthreads();
    const int lo = A->ph_lo, hi = A->ph_hi;
    XcdBarrier bar; bar.bar = (unsigned*)A->ws + CW_BAR; bar.x = 0; bar.st = nullptr;
    if (hi - lo > 1) bar = xcd_barrier_post((unsigned*)A->ws + CW_BAR, misc + 8);
    LAS unsigned char* L = F.lds;
    const LAS int* ts = (const LAS int*)(F.lds + LDS_MISC + 64);
    int ph = 0;
#ifdef ONLY_SITE
#define SITE_ON(s) ((s) == ONLY_SITE)
#else
#define SITE_ON(s) true
#endif
#define PH_RUN(s) (SITE_ON(s) && ph >= lo && ph < hi)
#define PH_END do { if (ph >= lo && ph + 1 < hi) xcd_barrier(bar); ++ph; A = A0; asm volatile("" : "+s"(A)); } while (0)

    if (PH_RUN(0)) phase_p0a(A, F);
    PH_END;
    if (PH_RUN(1)) phase_p0b(A, F);
    PH_END;
    for (int l = 0; l < DEPTH; ++l) {
        const bool lastl = (l == DEPTH - 1);
        if (PH_RUN(2)) phase_norm1(A, F, l);
        PH_END;
        if (PH_RUN(3)) {
            SchedInproj S{F.G, F.bid, (const char*)WSP(bf16_t, WS_H), (const char*)(WSP(bf16_t, WS_WINT) + (size_t)l * 2048 * D)};
            EpiInproj E{WSP(bf16_t, WS_P), WSP(bf16_t, WS_VT), WSP(bf16_t, WS_SUX), WSP(float, WS_ROPE)};
            gemm_phase<false>(L, 16, 2048u, 2048u, S, E);
        }
        PH_END;
        if (PH_RUN(4)) {
            SchedS5a S{F.G, F.bid, (const char*)WSP(bf16_t, WS_SUX), (const char*)(WSP(bf16_t, WS_WST) + (size_t)l * 16 * 256 * 1024)};
            EpiS5a E{WSP(float, WS_SLOC)};
            gemm_phase<false>(L, 16, (unsigned)(SUXW * 2), 2048u, S, E);
        }
        PH_END;
        if (PH_RUN(5)) phase_s5scan(A, F, l);
        PH_END;
        if (PH_RUN(6)) {
            SchedS5c S{F.G, F.bid, (const char*)WSP(bf16_t, WS_SUX), (const char*)(WSP(bf16_t, WS_KC) + (size_t)l * 16 * 1024 * SUXW)};
            EpiS5c E{WSP(bf16_t, WS_G)};
            gemm_phase<false>(L, 20, (unsigned)(SUXW * 2), (unsigned)(SUXW * 2), S, E);
        }
        PH_END;
        if (PH_RUN(7)) {
            SchedGlu S{F.G, F.bid, (const char*)WSP(bf16_t, WS_G), (const char*)(WSP(bf16_t, WS_WGLUT) + (size_t)l * 256 * 256)};
            EpiGlu E{WSP(bf16_t, WS_G), WSP(bf16_t, WS_Y), FIN(19) + (size_t)l * 256};
            gemm_phase<false>(L, 4, 512u, 512u, S, E);
        }
        PH_END;
        if (PH_RUN(8)) phase_attn(A, F, l);
        PH_END;
        if (PH_RUN(9)) {
            SchedOut S{F.G, F.bid, (lastl ? 128 : 132) * 4, (const char*)WSP(bf16_t, WS_Y), (const char*)(WSP(bf16_t, WS_WOUTT) + (size_t)l * D * D)};
            EpiOut E{WSP(float, WS_XR), WSP(float, WS_MOD) + (size_t)l * 5 * 6144};
            gemm_phase<false>(L, 16, 2048u, 2048u, S, E);
        }
        PH_END;
        if (PH_RUN(10)) phase_router(A, F, l);
        PH_END;
        if (PH_RUN(11)) {
            build_tstart(A, F, l);
            SchedMoe S{F.G, F.bid, 8, ts, (const char*)WSP(bf16_t, WS_H), (const char*)(WSP(bf16_t, WS_WGUT) + (size_t)l * NEXP * 2048 * D), (size_t)2048 * D * 2, WSP(int, WS_ELIST), true};
            EpiGateUp E{WSP(bf16_t, WS_ACT), FIN(25) + (size_t)l * NEXP * 2048};
            gemm_phase<true>(L, 16, 2048u, 2048u, S, E);
        }
        PH_END;
        if (PH_RUN(12)) {
            build_tstart(A, F, l);
            SchedMoe S{F.G, F.bid, 4, ts, (const char*)WSP(bf16_t, WS_ACT), (const char*)(WSP(bf16_t, WS_WDT) + (size_t)l * NEXP * D * FF), (size_t)D * FF * 2, WSP(int, WS_ELIST), false};
            EpiDown E{WSP(bf16_t, WS_EO), FIN(27) + (size_t)l * NEXP * D, WSP(float, WS_ELW), ts};
            gemm_phase<false>(L, 16, 2048u, 2048u, S, E);
        }
        PH_END;
    }
    if (PH_RUN(13)) phase_norm1(A, F, DEPTH);
#undef PH_RUN
#undef PH_END
}
}

extern "C" void kernel_launch(void* const* d_in, const int* in_sizes, int n_in, void* d_out, int out_size, void* d_ws, size_t ws_size, hipStream_t stream) {
    static int grid = 0;
    if (grid == 0) {
        if (n_in != 29 || out_size != NLAT * D || ws_size < WS_END) { fprintf(stderr, "kernel_launch: unexpected shapes (n_in %d, out %d, ws %zu)\n", n_in, out_size, ws_size); grid = -1; return; }
        int dev = 0, cus = 0;
        if (hipGetDevice(&dev) != hipSuccess || hipDeviceGetAttribute(&cus, hipDeviceAttributeMultiprocessorCount, dev) != hipSuccess) { grid = -1; return; }
        if (hipFuncSetAttribute((const void*)mk_fwd, hipFuncAttributeMaxDynamicSharedMemorySize, LDS_BYTES) != hipSuccess) { fprintf(stderr, "kernel_launch: hipFuncSetAttribute failed\n"); grid = -1; return; }
        int per_cu = 0;
        if (hipOccupancyMaxActiveBlocksPerMultiprocessor(&per_cu, (const void*)mk_fwd, NTHREADS, LDS_BYTES) != hipSuccess || per_cu < 1) { fprintf(stderr, "kernel_launch: occupancy query reports %d\n", per_cu); }
        (void)hipGetLastError();
        grid = cus;
    }
    if (grid < 0) return;
    (void)hipMemsetAsync((char*)d_ws + WS_CTL, 0, 1 * MiB, stream);
    Args a{};
    for (int i = 0; i < 29; ++i) a.in[i] = (const float*)d_in[i];
    a.out = (float*)d_out; a.ws = (unsigned char*)d_ws;
#if MK_PER_PHASE
    for (int p = 0; p < NPHASES; ++p) { a.ph_lo = p; a.ph_hi = p + 1; hipLaunchKernelGGL(mk_fwd, dim3(grid), dim3(NTHREADS), LDS_BYTES, stream, a); }
#else
    a.ph_lo = 0; a.ph_hi = NPHASES;
    hipLaunchKernelGGL(mk_fwd, dim3(grid), dim3(NTHREADS), LDS_BYTES, stream, a);
#endif
}
```

```cpp
#include <hip/hip_runtime.h>
#include <cstdio>
#include <cstdint>

#ifndef MK_PER_PHASE
#define MK_PER_PHASE 0
#endif

#define LAS __attribute__((address_space(3)))
#define GAS __attribute__((address_space(1)))
typedef unsigned short bf16_t;
typedef short bf16x8 __attribute__((ext_vector_type(8)));
typedef float f32x4 __attribute__((ext_vector_type(4)));
typedef float f32x2 __attribute__((ext_vector_type(2)));
typedef float f32x16 __attribute__((ext_vector_type(16)));
typedef unsigned u32x4 __attribute__((ext_vector_type(4)));
typedef unsigned u32x2 __attribute__((ext_vector_type(2)));

namespace {
constexpr int D = 1024, NBATCH = 4, SEQ = 8192, DEPTH = 4, CTXL = 256;
constexpr int NLAT = NBATCH * SEQ;
constexpr int NCTX = NBATCH * CTXL;
constexpr int TT = NLAT + NCTX;
constexpr int PW = 1280;
constexpr int NEXP = 32, FF = 1024;
constexpr int MCH = 768;
constexpr int SUXW = 1280;
constexpr int MAXTILES = 560;
constexpr int NWAVES = 8, NTHREADS = 512;
constexpr float RMS_EPS = 1e-6f;

constexpr size_t MiB = 1ull << 20;
constexpr size_t WS_CTL = 0;
constexpr size_t WS_MOD = 1 * MiB;
constexpr size_t WS_ROPE = 2 * MiB;
constexpr size_t WS_LP = 3 * MiB;
constexpr size_t WS_BBAR = 8 * MiB;
constexpr size_t WS_WRT = 9 * MiB;
constexpr size_t WS_WGLUT = 10 * MiB;
constexpr size_t WS_WINT = 11 * MiB;
constexpr size_t WS_WOUTT = 27 * MiB;
constexpr size_t WS_WST = 35 * MiB;
constexpr size_t WS_KC = 67 * MiB;
constexpr size_t WS_WGUT = 227 * MiB;
constexpr size_t WS_WDT = 739 * MiB;
constexpr size_t WS_XR = 995 * MiB;
constexpr size_t WS_H = 1127 * MiB;
constexpr size_t WS_P = 1193 * MiB;
constexpr size_t WS_VT = 1276 * MiB;
constexpr size_t WS_SUX = 1309 * MiB;
constexpr size_t WS_SLOC = 1339 * MiB;
constexpr size_t WS_G = 1351 * MiB;
constexpr size_t WS_Y = 1368 * MiB;
constexpr size_t WS_ELIST = 1434 * MiB;
constexpr size_t WS_ELW = 1439 * MiB;
constexpr size_t WS_TOKINFO = 1444 * MiB;
constexpr size_t WS_ACT = 1445 * MiB;
constexpr size_t WS_EO = 1725 * MiB;
constexpr size_t WS_TOKW = 2005 * MiB;
constexpr size_t WS_DELTA = 2006 * MiB;
constexpr size_t WS_END = 2072 * MiB;
constexpr int CW_BAR = 1024;
constexpr int CW_CNT = 8192;

constexpr int LDS_STAGE = 131072;
constexpr int LDS_MISC = LDS_STAGE;
constexpr int LDS_BIAS = LDS_STAGE + 1024;
constexpr int LDS_ROPE = LDS_STAGE + 4096;
constexpr int LDS_BYTES = LDS_STAGE + 4096 + 16384;

__device__ __forceinline__ unsigned f2bf(float f) { unsigned u = __builtin_bit_cast(unsigned, f); return (u + 0x7fffu + ((u >> 16) & 1u)) >> 16; }
__device__ __forceinline__ unsigned pk2(float lo, float hi) { return f2bf(lo) | (f2bf(hi) << 16); }
__device__ __forceinline__ float bf2f(unsigned short b) { return __builtin_bit_cast(float, ((unsigned)b) << 16); }
__device__ __forceinline__ float bflo(unsigned w) { return __builtin_bit_cast(float, w << 16); }
__device__ __forceinline__ float bfhi(unsigned w) { return __builtin_bit_cast(float, w & 0xffff0000u); }
__device__ __forceinline__ float wave_sum(float v) {
#pragma unroll
    for (int o = 1; o < 64; o <<= 1) v += __shfl_xor(v, o);
    return v;
}
__device__ __forceinline__ float fast_exp2(float x) { return __builtin_amdgcn_exp2f(x); }
__device__ __forceinline__ float sigmoidf_(float x) { return 1.0f / (1.0f + __expf(-x)); }
__device__ __forceinline__ float gelu_tanh(float x) {
    const float u = 0.7978845608028654f * (x + 0.044715f * x * x * x);
    const float t = 1.0f - 2.0f / (1.0f + __expf(2.0f * u));
    return 0.5f * x * (1.0f + t);
}

#define XB_TMO      128
#define XB_XCNT(j)  (256  + 64 * (j))
#define XB_XSUB(j)  (1280 + 64 * (j))
#define XB_XGEN(j)  (2304 + 64 * (j))
#define XB_TOP      3328
#define XB_TOPGEN   3392
#define XCD_BAR_WORDS 3456
#define XB_SPIN_CAP (1u << 18)
__device__ __forceinline__ unsigned xb_ld(unsigned* p)              { return __hip_atomic_load(p, __ATOMIC_RELAXED, __HIP_MEMORY_SCOPE_AGENT); }
__device__ __forceinline__ unsigned xb_add(unsigned* p, unsigned v) { return __hip_atomic_fetch_add(p, v, __ATOMIC_RELAXED, __HIP_MEMORY_SCOPE_AGENT); }
__device__ __forceinline__ unsigned xb_xcc_id() { return (unsigned)__builtin_amdgcn_s_getreg((3 << 11) | 20) & 0xFu; }
#define XB_SPIN(cond, bar) do { unsigned _sp = 0; while (cond) { __builtin_amdgcn_s_sleep(1); \
    if ((++_sp & 255u) == 0u) { if (xb_ld(&(bar)[XB_TMO])) break; if (_sp > XB_SPIN_CAP) { atomicAdd(&(bar)[XB_TMO], 1u); break; } } } } while (0)
struct XcdBarrier { unsigned* bar; unsigned x; volatile LAS unsigned* st; };
__device__ __forceinline__ XcdBarrier xcd_barrier_post(unsigned* bar, volatile LAS unsigned* st) {
    XcdBarrier b; b.bar = bar; b.x = xb_xcc_id(); b.st = st;
    if (threadIdx.x == 0) (void)xb_add(&bar[XB_XCNT(b.x)], 1u);
    return b;
}
__device__ __forceinline__ void xcd_barrier_complete(unsigned* bar, unsigned x, unsigned& nloc, unsigned& nx) {
    const unsigned G = gridDim.x * gridDim.y * gridDim.z;
    unsigned sum, cnt, mine, sp = 0u;
    for (;;) {
        sum = 0u; cnt = 0u; mine = 0u;
#pragma unroll
        for (unsigned j = 0; j < 16; ++j) { const unsigned c = xb_ld(&bar[XB_XCNT(j)]); sum += c; cnt += (c > 0u) ? 1u : 0u; mine = (j == x) ? c : mine; }
        if (sum == G) break;
        __builtin_amdgcn_s_sleep(1);
        if ((++sp & 255u) == 0u) { if (xb_ld(&bar[XB_TMO])) break; if (sp > XB_SPIN_CAP) { atomicAdd(&bar[XB_TMO], 1u); break; } }
    }
    nloc = mine > 0u ? mine : 1u; nx = cnt > 0u ? cnt : 1u;
}
__device__ __forceinline__ void xcd_barrier(const XcdBarrier& b) {
    asm volatile("s_waitcnt vmcnt(0)" ::: "memory");
    __syncthreads();
    if (threadIdx.x == 0) {
        unsigned* bar = b.bar;
        __builtin_amdgcn_s_waitcnt(0);
        unsigned nloc = b.st[0], nx = b.st[1];
        if (nloc == 0u) { xcd_barrier_complete(bar, b.x, nloc, nx); b.st[0] = nloc; b.st[1] = nx; }
        const unsigned old = xb_add(&bar[XB_XSUB(b.x)], 1u);
        const unsigned gen = old / nloc;
        if (old + 1u == (gen + 1u) * nloc) {
            __builtin_amdgcn_fence(__ATOMIC_RELEASE, "agent");
            asm volatile("s_waitcnt vmcnt(0)" ::: "memory");
            const unsigned og = xb_add(&bar[XB_TOP], 1u);
            const unsigned tg = og / nx;
            if (og + 1u == (tg + 1u) * nx) xb_add(&bar[XB_TOPGEN], 1u);
            else XB_SPIN(xb_ld(&bar[XB_TOPGEN]) == tg, bar);
            __builtin_amdgcn_fence(__ATOMIC_ACQUIRE, "agent");
            xb_add(&bar[XB_XGEN(b.x)], 1u);
            asm volatile("s_waitcnt vmcnt(0)" ::: "memory");
        } else {
            XB_SPIN(xb_ld(&bar[XB_XGEN(b.x)]) == gen, bar);
            __builtin_amdgcn_fence(__ATOMIC_ACQUIRE, "agent");
            asm volatile("s_waitcnt vmcnt(0)" ::: "memory");
        }
    }
    __syncthreads();
}

constexpr int BM = 256, BK = 64, HALF = 128, HTB = HALF * BK * 2;
__device__ __forceinline__ int lds_byte(int r, int c) { const int st = (r >> 4) * 2 + (c >> 5), rr = r & 15, cc = c & 31, ob = rr * 64 + cc * 2; return st * 1024 + (ob ^ (((ob >> 9) & 1) << 5)); }
__device__ __forceinline__ void stage_rc(int b, int& R, int& C) { const int st = b / 1024, sb = b % 1024, swz = sb ^ (((sb >> 9) & 1) << 5); R = (st >> 1) * 16 + swz / 64; C = (st & 1) * 32 + (swz % 64) / 2; }
__device__ __forceinline__ int perm32(int rho) { const int n = rho >> 4, i = rho & 15; return 8 * (i >> 2) + 4 * n + (i & 3); }
__device__ __forceinline__ unsigned cvt_pk_bf16(float lo, float hi) { unsigned r; asm volatile("v_cvt_pk_bf16_f32 %0, %1, %2" : "=v"(r) : "v"(lo), "v"(hi)); return r; }

struct GUnit { const char* A; const char* B; int p0, p1, p2, p3; };
typedef f32x4 AccT[2][2][4][2];

template <bool GATHER, class Sched, class Epi>
__device__ __forceinline__ void gemm_phase(LAS unsigned char* lds, const int nt_  , const unsigned lda2, const unsigned ldb2  , const Sched& S, const Epi& E) {
    int tid = threadIdx.x; asm volatile("" : "+v"(tid));
    int nt = nt_; asm volatile("" : "+s"(nt));
    const int wid = __builtin_amdgcn_readfirstlane(tid >> 6), lane = tid & 63, wr = wid >> 2, wc = wid & 3, fr = lane & 15, fq = lane >> 4;
    unsigned voffA[2][2], voffB[2]; int RA[2], CA[2];
#pragma unroll
    for (int i = 0; i < 2; ++i) { int R, C; stage_rc(tid * 16 + i * 8192, R, C); const int Rb = (R & ~31) + perm32(R & 31);
        RA[i] = R; CA[i] = C; voffA[0][i] = (unsigned)R * lda2 + (unsigned)C * 2u; voffA[1][i] = voffA[0][i] + 128u * lda2; voffB[i] = (unsigned)Rb * ldb2 + (unsigned)C * 2u; }
    const size_t kstep = (size_t)(BK * 2);
    const size_t hstepB = (size_t)HALF * ldb2;
    const unsigned ldsw = (unsigned)wid * 1024u;
    const int aoff = lds_byte(wr * 64 + fr, fq * 8), boff = lds_byte(wc * 32 + fr, fq * 8);
#define PG_SA(b, h) (((b) * 2 + (h)) * HTB)
#define PG_SB(b, h) ((4 + (b) * 2 + (h)) * HTB)
#define PG_STAGE(bufoff, gbase, voff) do { _Pragma("unroll") for (int _i = 0; _i < 2; ++_i) \
        __builtin_amdgcn_global_load_lds((const unsigned*)((const char*)(gbase) + (voff)[_i]), (LAS unsigned*)(lds + (bufoff) + ldsw + _i * 8192), 16, 0, 0); } while (0)
#define PG_LDA(dst, b, h) do { _Pragma("unroll") for (int m = 0; m < 4; ++m) _Pragma("unroll") for (int k = 0; k < 2; ++k) dst[m][k] = *(const LAS bf16x8*)(lds + PG_SA(b, h) + aoff + m * 2048 + k * 1024); } while (0)
#define PG_LDB(dst, b, h) do { _Pragma("unroll") for (int n = 0; n < 2; ++n) _Pragma("unroll") for (int k = 0; k < 2; ++k) dst[n][k] = *(const LAS bf16x8*)(lds + PG_SB(b, h) + boff + n * 2048 + k * 1024); } while (0)
#define PG_MMA(ai, bj, At, Bt) do { __builtin_amdgcn_s_setprio(1); _Pragma("unroll") for (int m = 0; m < 4; ++m) _Pragma("unroll") for (int n = 0; n < 2; ++n) _Pragma("unroll") for (int k = 0; k < 2; ++k) \
        acc[ai][bj][m][n] = __builtin_amdgcn_mfma_f32_16x16x32_bf16(Bt[n][k], At[m][k], acc[ai][bj][m][n], 0, 0, 0); __builtin_amdgcn_s_setprio(0); } while (0)
#define PG_WAIT_V(n) asm volatile("s_waitcnt vmcnt(" #n ")" ::: "memory")
#define PG_WAIT_L(n) asm volatile("s_waitcnt lgkmcnt(" #n ")" ::: "memory")
#define PG_BAR __builtin_amdgcn_s_barrier()
#define PG_SCHED __builtin_amdgcn_sched_barrier(0)
    GUnit cur, nxt; int ui = 0;
    if (!S.next(0, cur)) return;
    AccT acc;
#pragma unroll
    for (int a = 0; a < 2; ++a)
#pragma unroll
        for (int b = 0; b < 2; ++b)
#pragma unroll
            for (int m = 0; m < 4; ++m)
#pragma unroll
                for (int n = 0; n < 2; ++n) acc[a][b][m][n] = (f32x4){0.f, 0.f, 0.f, 0.f};
    bf16x8 At[4][2], B0[2][2], B1[2][2];
    const char* cA = cur.A; const char* cB = cur.B;
    S.pre(cur, 0, wid, lane);
    if (GATHER) {
#pragma unroll
        for (int h = 0; h < 2; ++h)
#pragma unroll
            for (int i = 0; i < 2; ++i) voffA[h][i] = (unsigned)S.row_token(cur, h * 128 + RA[i]) * lda2 + (unsigned)CA[i] * 2u;
    }
    unsigned voffAn[2][2];
#pragma unroll
    for (int h = 0; h < 2; ++h)
#pragma unroll
        for (int i = 0; i < 2; ++i) voffAn[h][i] = voffA[h][i];
    PG_STAGE(PG_SB(0, 0), cB, voffB); PG_STAGE(PG_SA(0, 0), cA, voffA[0]); PG_STAGE(PG_SB(0, 1), cB + hstepB, voffB); PG_STAGE(PG_SA(0, 1), cA, voffA[1]);
    if (wr == 1) PG_BAR;
    PG_WAIT_V(4); PG_BAR;
    PG_STAGE(PG_SB(1, 0), cB + kstep, voffB); PG_STAGE(PG_SA(1, 0), cA + kstep, voffA[0]); PG_STAGE(PG_SB(1, 1), cB + hstepB + kstep, voffB);
    PG_WAIT_V(6); PG_BAR;
    for (;;) {
        const bool has_next = S.next(ui + 1, nxt);
        const char* nA = has_next ? nxt.A : cA; const char* nB = has_next ? nxt.B : cB;
        for (int t = 0; t < nt; t += 2) {
            const bool last = (t == nt - 2);
            const char* a1 = cA + (size_t)(t + 1) * kstep;
            const char* a2 = last ? nA : cA + (size_t)(t + 2) * kstep; const char* b2 = last ? nB : cB + (size_t)(t + 2) * kstep;
            const char* a3 = a2 + kstep; const char* b3 = b2 + kstep;
            if (last && has_next) S.pre(nxt, (ui + 1) & 1, wid, lane);
            if (GATHER) {
                if (last && has_next) {
#pragma unroll
                    for (int h = 0; h < 2; ++h)
#pragma unroll
                        for (int i = 0; i < 2; ++i) voffAn[h][i] = (unsigned)S.row_token(nxt, h * 128 + RA[i]) * lda2 + (unsigned)CA[i] * 2u;
                }
            }
            unsigned vA0[2], vA1[2];
#pragma unroll
            for (int i = 0; i < 2; ++i) { vA0[i] = (GATHER && last) ? voffAn[0][i] : voffA[0][i]; vA1[i] = (GATHER && last) ? voffAn[1][i] : voffA[1][i]; }
            PG_LDB(B0, 0, 0); PG_SCHED; PG_LDA(At, 0, 0); PG_STAGE(PG_SA(1, 1), a1, voffA[1]);
            PG_WAIT_L(8); PG_BAR; PG_WAIT_L(0); PG_MMA(0, 0, At, B0); PG_BAR; PG_SCHED;
            PG_LDB(B1, 0, 1); PG_STAGE(PG_SB(0, 0), b2, voffB);
            PG_BAR; PG_WAIT_L(0); PG_MMA(0, 1, At, B1); PG_BAR;
            PG_LDA(At, 0, 1); PG_STAGE(PG_SA(0, 0), a2, vA0);
            PG_BAR; PG_WAIT_L(0); PG_MMA(1, 0, At, B0); PG_BAR; PG_SCHED;
            PG_STAGE(PG_SB(0, 1), b2 + hstepB, voffB);
            PG_WAIT_V(6); PG_BAR; PG_MMA(1, 1, At, B1); PG_BAR;
            PG_LDB(B0, 1, 0); PG_SCHED; PG_LDA(At, 1, 0); PG_STAGE(PG_SA(0, 1), a2, vA1);
            PG_WAIT_L(8); PG_BAR; PG_WAIT_L(0); PG_MMA(0, 0, At, B0); PG_BAR; PG_SCHED;
            PG_LDB(B1, 1, 1); PG_STAGE(PG_SB(1, 0), b3, voffB);
            PG_BAR; PG_WAIT_L(0); PG_MMA(0, 1, At, B1); PG_BAR;
            PG_LDA(At, 1, 1); PG_STAGE(PG_SA(1, 0), a3, vA0);
            PG_BAR; PG_WAIT_L(0); PG_MMA(1, 0, At, B0); PG_BAR; PG_SCHED;
            PG_STAGE(PG_SB(1, 1), b3 + hstepB, voffB);
            PG_WAIT_V(6); PG_BAR; PG_MMA(1, 1, At, B1); PG_BAR;
        }
        {
            int tz = threadIdx.x; asm volatile("" : "+v"(tz)); const int wz = __builtin_amdgcn_readfirstlane(tz >> 6), lz = tz & 63;
            E(acc, cur, ui & 1, wz >> 2, wz & 3, lz & 15, lz >> 4); }
        if (!has_next) break;
#pragma unroll
        for (int a = 0; a < 2; ++a)
#pragma unroll
            for (int b = 0; b < 2; ++b)
#pragma unroll
                for (int m = 0; m < 4; ++m)
#pragma unroll
                    for (int n = 0; n < 2; ++n) acc[a][b][m][n] = (f32x4){0.f, 0.f, 0.f, 0.f};
        cur = nxt; cA = nA; cB = nB; ++ui;
        if (GATHER) {
#pragma unroll
            for (int h = 0; h < 2; ++h)
#pragma unroll
                for (int i = 0; i < 2; ++i) voffA[h][i] = voffAn[h][i];
        }
    }
    PG_WAIT_V(0);
    if (wr == 0) PG_BAR;
    PG_BAR;
#undef PG_SA
#undef PG_SB
#undef PG_STAGE
#undef PG_LDA
#undef PG_LDB
#undef PG_MMA
#undef PG_WAIT_V
#undef PG_WAIT_L
#undef PG_BAR
#undef PG_SCHED
}

struct Args { const float* in[29]; float* out; unsigned char* ws; int ph_lo, ph_hi; };
struct Frame {
    LAS unsigned char* lds;
    int G, bid;
};
#define PH_LOCALS int tid = threadIdx.x; asm volatile("" : "+v"(tid)); const int lane = tid & 63; const int wave = __builtin_amdgcn_readfirstlane(tid >> 6); (void)lane; (void)wave
typedef const __attribute__((address_space(4))) Args* KArgs;
#define WSP(T, off) ((T*)(A->ws + (off)))
#define FIN(i) (A->in[i])

__device__ __forceinline__ void transpose_item(const float* W, int K, int N, bf16_t* WT, int kb, int n0s, int drow0, LAS float* scr, int lane) {
    const int k0 = 64 * kb;
#pragma unroll 8
    for (int i = 0; i < 32; ++i) { const int kk = 2 * i + (lane >> 5); scr[kk * 33 + (lane & 31)] = W[(size_t)(k0 + kk) * N + n0s + (lane & 31)]; }
    asm volatile("s_waitcnt lgkmcnt(0)" ::: "memory");
    const int c = lane & 7;
#pragma unroll
    for (int j = 0; j < 4; ++j) { const int n = (lane >> 3) + 8 * j; const LAS float* s = scr + (8 * c) * 33 + n;
        u32x4 o; o.x = pk2(s[0 * 33], s[1 * 33]); o.y = pk2(s[2 * 33], s[3 * 33]); o.z = pk2(s[4 * 33], s[5 * 33]); o.w = pk2(s[6 * 33], s[7 * 33]);
        *(u32x4*)(WT + (size_t)(drow0 + n) * K + k0 + 8 * c) = o; }
    asm volatile("s_waitcnt lgkmcnt(0)" ::: "memory");
}
__device__ __forceinline__ int win_src_col(int d) {
    if (d < 768) return d;
    if (d < 1152) return 1408 + (d - 768);
    if (d < 1280) return 1792 + (d - 1152);
    if (d < 1536) return 1152 + (d - 1280);
    if (d < 1920) return 768 + (d - 1536);
    return d;
}
__device__ __forceinline__ int wgu_src_col(int d) { const int t = d >> 8, r = d & 255; return (r < 128) ? (128 * t + r) : (1024 + 128 * t + (r - 128)); }

__device__ __forceinline__ void phase_p0a(KArgs A, Frame& F) {
    PH_LOCALS;
    LAS float* scr = (LAS float*)(F.lds + wave * 16384);
    const int gw = F.bid * NWAVES + wave, NGW = F.G * NWAVES;
    constexpr int I_IN = DEPTH * 16 * 64, I_OUT = DEPTH * 16 * 32, I_GLU = DEPTH * 4 * 8, I_RT = DEPTH * 16, I_GU = DEPTH * NEXP * 16 * 64, I_DN = DEPTH * NEXP * 16 * 32;
    constexpr int NITEMS = I_IN + I_OUT + I_GLU + I_RT + I_GU + I_DN;
    for (int it = gw; it < NITEMS; it += NGW) {
        int r = it;
        if (r < I_IN) { const int l = r / 1024, q = r % 1024, kb = q / 64, nb = q % 64;
            transpose_item(FIN(7) + (size_t)l * D * 2048, D, 2048, WSP(bf16_t, WS_WINT) + (size_t)l * 2048 * D, kb, win_src_col(32 * nb), 32 * nb, scr, lane); continue; } r -= I_IN;
        if (r < I_OUT) { const int l = r / 512, q = r % 512, kb = q / 32, nb = q % 32;
            transpose_item(FIN(8) + (size_t)l * D * D, D, D, WSP(bf16_t, WS_WOUTT) + (size_t)l * D * D, kb, 32 * nb, 32 * nb, scr, lane); continue; } r -= I_OUT;
        if (r < I_GLU) { const int l = r / 32, q = r % 32, kb = q / 8, nb = q % 8;
            transpose_item(FIN(18) + (size_t)l * 256 * 256, 256, 256, WSP(bf16_t, WS_WGLUT) + (size_t)l * 256 * 256, kb, 32 * nb, 32 * nb, scr, lane); continue; } r -= I_GLU;
        if (r < I_RT) { const int l = r / 16, kb = r % 16;
            transpose_item(FIN(22) + (size_t)l * D * NEXP, D, NEXP, WSP(bf16_t, WS_WRT) + (size_t)l * NEXP * D, kb, 0, 0, scr, lane); continue; } r -= I_RT;
        if (r < I_GU) { const int le = r / 1024, q = r % 1024, kb = q / 64, nb = q % 64;
            transpose_item(FIN(24) + (size_t)le * D * 2048, D, 2048, WSP(bf16_t, WS_WGUT) + (size_t)le * 2048 * D, kb, wgu_src_col(32 * nb), 32 * nb, scr, lane); continue; } r -= I_GU;
        { const int le = r / 512, q = r % 512, kb = q / 32, nb = q % 32;
            transpose_item(FIN(26) + (size_t)le * FF * D, FF, D, WSP(bf16_t, WS_WDT) + (size_t)le * D * FF, kb, 32 * nb, 32 * nb, scr, lane); }
    }
    __syncthreads();
    {
        LAS float* cond = (LAS float*)F.lds;
        LAS float* red = (LAS float*)(F.lds + 32768);
        for (int i = tid; i < 5 * D; i += NTHREADS) { const int bi = i / D, k = i % D; const float v = (bi < 4) ? FIN(1)[bi * D + k] : FIN(3)[k]; cond[i] = v / (1.0f + __expf(-v)); }
        __syncthreads();
        for (int u = F.bid; u < DEPTH * 96; u += F.G) {
            const int l = u / 96, j = (u % 96) * 64 + lane;
            const float* w = FIN(4) + (size_t)l * D * 6144 + j;
            float a0 = 0.f, a1 = 0.f, a2 = 0.f, a3 = 0.f, a4 = 0.f;
#pragma unroll 8
            for (int kk = 0; kk < 128; ++kk) { const int k = wave * 128 + kk; const float wv = w[(size_t)k * 6144];
                a0 += cond[k] * wv; a1 += cond[D + k] * wv; a2 += cond[2 * D + k] * wv; a3 += cond[3 * D + k] * wv; a4 += cond[4 * D + k] * wv; }
            red[(wave * 5 + 0) * 64 + lane] = a0; red[(wave * 5 + 1) * 64 + lane] = a1; red[(wave * 5 + 2) * 64 + lane] = a2;
            red[(wave * 5 + 3) * 64 + lane] = a3; red[(wave * 5 + 4) * 64 + lane] = a4;
            __syncthreads();
            if (tid < 320) { const int bi = tid / 64, jj = tid % 64; float s = 0.f;
#pragma unroll
                for (int w8 = 0; w8 < 8; ++w8) s += red[(w8 * 5 + bi) * 64 + jj];
                const int col = (u % 96) * 64 + jj;
                WSP(float, WS_MOD)[((size_t)l * 5 + bi) * 6144 + col] = s + FIN(5)[l * 6144 + col]; }
            __syncthreads();
        }
    }
    const int gt = F.bid * NTHREADS + tid, NGT = F.G * NTHREADS;
    for (int i = gt; i < 128 * 16; i += NGT) { const int pos = i / 16, f = i % 16; const float inv = powf(10000.0f, -(float)f / 16.0f); const float a = (float)pos * inv;
        WSP(float, WS_ROPE)[i] = cosf(a); WSP(float, WS_ROPE)[2048 + i] = sinf(a); }
    for (int i = gt; i < DEPTH * 2 * 16 * 65 * 64; i += NGT) {
        const int p = i % 64, d = (i / 64) % 65, ldg = i / (64 * 65);
        const float are = fminf(FIN(10)[ldg * 64 + p], -1e-4f), aim = FIN(11)[ldg * 64 + p];
        const float step = expf(FIN(12)[ldg]);
        const float re = are * step * (float)d, im = aim * step * (float)d;
        const float mag = expf(re);
        WSP(f32x2, WS_LP)[i] = (f32x2){mag * cosf(im), mag * sinf(im)};
    }
    for (int i = gt; i < DEPTH * 2 * 16 * 64 * 16; i += NGT) {
        const int lp = i / 16;
        const int ldg = lp / 64;
        const float are = fminf(FIN(10)[lp], -1e-4f), aim = FIN(11)[lp];
        const float step = expf(FIN(12)[ldg]);
        const float mag = expf(are * step), lr = mag * cosf(aim * step) - 1.0f, li = mag * sinf(aim * step);
        const float den = are * are + aim * aim;
        const float qr = (lr * are + li * aim) / den, qi = (li * are - lr * aim) / den;
        const float br = FIN(13)[i], bi = FIN(14)[i];
        WSP(f32x2, WS_BBAR)[i] = (f32x2){qr * br - qi * bi, qr * bi + qi * br};
    }
}

__device__ __forceinline__ f32x2 cmul(f32x2 a, f32x2 b) { return (f32x2){a.x * b.x - a.y * b.y, a.x * b.y + a.y * b.x}; }
__device__ __forceinline__ void phase_p0b(KArgs A, Frame& F) {
    PH_LOCALS;
    const f32x2* LP = WSP(f32x2, WS_LP); const f32x2* BB = WSP(f32x2, WS_BBAR);
    LAS float* kv = (LAS float*)F.lds;
    for (int it = F.bid; it < DEPTH * 16 * 64; it += F.G) {
        const int d = it % 64, g = (it / 64) % 16, l = it / 1024;
        const int dir = tid >> 8, ho = (tid >> 4) & 15, hi = tid & 15;
        const int ldg = (l * 2 + dir) * 16 + g;
        const float* cre = FIN(15) + ((size_t)ldg * 16 + ho) * 64; const float* cim = FIN(16) + ((size_t)ldg * 16 + ho) * 64;
        const f32x2* lp = LP + ((size_t)ldg * 65 + d) * 64; const f32x2* bb = BB + (size_t)ldg * 1024 + hi;
        float s = 0.f;
        for (int p = 0; p < 64; ++p) { const f32x2 t = cmul(lp[p], bb[p * 16]); s += cre[p] * t.x - cim[p] * t.y; }
        kv[dir * 256 + ho * 16 + hi] = s;
        __syncthreads();
        bf16_t* KC = WSP(bf16_t, WS_KC) + ((size_t)(l * 16 + g)) * 1024 * SUXW;
        if (d == 0) {
            if (dir == 0) { const float v = kv[ho * 16 + hi] + kv[256 + ho * 16 + hi] + ((ho == hi) ? FIN(17)[l * 256 + g * 16 + ho] : 0.f); const unsigned short b = (unsigned short)f2bf(v);
                for (int t = 0; t < 64; ++t) KC[(size_t)(t * 16 + ho) * SUXW + t * 16 + hi] = b; }
        } else {
            const unsigned short b = (unsigned short)f2bf(s);
            if (dir == 0) { for (int t = d; t < 64; ++t) KC[(size_t)(t * 16 + ho) * SUXW + (t - d) * 16 + hi] = b; }
            else          { for (int t = 0; t < 64 - d; ++t) KC[(size_t)(t * 16 + ho) * SUXW + (t + d) * 16 + hi] = b; }
        }
        __syncthreads();
    }
    const int gt = F.bid * NTHREADS + tid, NGT = F.G * NTHREADS;
    for (int i = gt; i < DEPTH * 16 * 256 * 1024; i += NGT) {
        const int k = i % 1024, n = (i / 1024) % 256, lg = i / (1024 * 256), l = lg / 16, g = lg % 16;
        const int s = k / 16, hi = k % 16, dir = n / 128, ri = (n / 64) & 1, p = n % 64;
        const int ldg = (l * 2 + dir) * 16 + g;
        const int e = dir ? s : 63 - s;
        const f32x2 t = cmul(LP[((size_t)ldg * 65 + e) * 64 + p], BB[(size_t)ldg * 1024 + p * 16 + hi]);
        WSP(bf16_t, WS_WST)[i] = (unsigned short)f2bf(ri ? t.y : t.x);
    }
    for (int i = gt; i < DEPTH * 16 * 1024 * 256; i += NGT) {
        const int n = i % 256, row = (i / 256) % 1024, lg = i / (256 * 1024), l = lg / 16, g = lg % 16;
        const int t = row / 16, ho = row % 16, dir = n / 128, ri = (n / 64) & 1, p = n % 64;
        const int ldg = (l * 2 + dir) * 16 + g;
        const int e = dir ? 64 - t : t + 1;
        const f32x2 c = (f32x2){FIN(15)[((size_t)ldg * 16 + ho) * 64 + p], FIN(16)[((size_t)ldg * 16 + ho) * 64 + p]};
        const f32x2 v = cmul(c, LP[((size_t)ldg * 65 + e) * 64 + p]);
        WSP(bf16_t, WS_KC)[((size_t)lg * 1024 + row) * SUXW + 1024 + n] = (unsigned short)f2bf(ri ? -v.y : v.x);
    }
}

__device__ __forceinline__ void build_tstart(KArgs A, Frame& F, int l) {
    PH_LOCALS;
    LAS int* ts = (LAS int*)(F.lds + LDS_MISC + 64);
    if (tid == 0) { const int* cnt = (const int*)A->ws + CW_CNT + l * 32; int a = 0;
        for (int e = 0; e < 32; ++e) { ts[e] = a; ts[40 + e] = cnt[e]; a += (cnt[e] + 255) >> 8; }
        ts[32] = a; }
    __syncthreads();
}

__device__ __forceinline__ void phase_norm1(KArgs A, Frame& F, int l) {
    PH_LOCALS;
    const bool fin = (l == DEPTH);
    const int nrows = fin ? NLAT : TT;
    if (l > 0) build_tstart(A, F, l - 1);
    const LAS int* ts = (const LAS int*)(F.lds + LDS_MISC + 64);
    const int gw = F.bid * NWAVES + wave, NGW = F.G * NWAVES;
    const float* MOD = WSP(float, WS_MOD);
    float* XR = WSP(float, WS_XR);
    for (int r = gw; r < nrows; r += NGW) {
        const int bi = (r < NLAT) ? (r / SEQ) : 4;
        f32x4 v[4];
        if (l == 0) { const float* src = (r < NLAT) ? (FIN(0) + (size_t)r * D) : (FIN(2) + (size_t)(r - NLAT) * D);
#pragma unroll
            for (int j = 0; j < 4; ++j) v[j] = *(const f32x4*)(src + 4 * lane + 256 * j); }
        else {
            const float* src = XR + (size_t)r * D;
#pragma unroll
            for (int j = 0; j < 4; ++j) v[j] = *(const f32x4*)(src + 4 * lane + 256 * j);
            const int* ti = WSP(int, WS_TOKINFO) + (size_t)r * 4;
            f32x4 a[4];
#pragma unroll
            for (int j = 0; j < 4; ++j) a[j] = (f32x4){0.f, 0.f, 0.f, 0.f};
#pragma unroll
            for (int k = 0; k < 4; ++k) { const int inf = ti[k]; const int e = (inf >> 24) & 31, rank = inf & 0xffffff; const size_t pos = (size_t)ts[e] * 256 + rank;
                const bf16_t* eo = WSP(bf16_t, WS_EO) + pos * D; const float wk = WSP(float, WS_TOKW)[(size_t)r * 4 + k]; const float* bd = FIN(27) + ((size_t)(l - 1) * NEXP + e) * D;
#pragma unroll
                for (int j = 0; j < 4; ++j) { const u32x2 w = *(const u32x2*)(eo + 4 * lane + 256 * j); const f32x4 b4 = *(const f32x4*)(bd + 4 * lane + 256 * j);
                    a[j].x += wk * (bflo(w.x) + b4.x); a[j].y += wk * (bfhi(w.x) + b4.y); a[j].z += wk * (bflo(w.y) + b4.z); a[j].w += wk * (bfhi(w.y) + b4.w); } }
            const float* m5 = MOD + ((size_t)(l - 1) * 5 + bi) * 6144 + 5 * D;
#pragma unroll
            for (int j = 0; j < 4; ++j) { const f32x4 g5 = *(const f32x4*)(m5 + 4 * lane + 256 * j); v[j] = v[j] + g5 * a[j]; }
        }
        if (!fin) {
#pragma unroll
            for (int j = 0; j < 4; ++j) *(f32x4*)(XR + (size_t)r * D + 4 * lane + 256 * j) = v[j];
        }
        float ss = 0.f;
#pragma unroll
        for (int j = 0; j < 4; ++j) ss += (v[j].x * v[j].x + v[j].y * v[j].y) + (v[j].z * v[j].z + v[j].w * v[j].w);
        const float rinv = 1.0f / sqrtf(wave_sum(ss) * (1.0f / D) + RMS_EPS);
        if (fin) {
#pragma unroll
            for (int j = 0; j < 4; ++j) { const f32x4 g = *(const f32x4*)(FIN(28) + 4 * lane + 256 * j); *(f32x4*)(A->out + (size_t)r * D + 4 * lane + 256 * j) = v[j] * rinv * g; }
        } else {
            const float* gm = FIN(6) + (size_t)l * D; const float* m0 = MOD + ((size_t)l * 5 + bi) * 6144; const float* m1 = m0 + D;
            bf16_t* hrow = WSP(bf16_t, WS_H) + (size_t)r * D;
#pragma unroll
            for (int j = 0; j < 4; ++j) { const int c = 4 * lane + 256 * j; const f32x4 g = *(const f32x4*)(gm + c), sh = *(const f32x4*)(m0 + c), sc = *(const f32x4*)(m1 + c);
                const f32x4 h = v[j] * rinv * g * (sc + 1.0f) + sh;
                u32x2 o; o.x = pk2(h.x, h.y); o.y = pk2(h.z, h.w); *(u32x2*)(hrow + c) = o; }
        }
    }
}

__device__ __forceinline__ void phase_router(KArgs A, Frame& F, int l) {
    PH_LOCALS;
    const int nrows = (l == DEPTH - 1) ? NLAT : TT;
    LAS bf16_t* tile = (LAS bf16_t*)F.lds;
    LAS float* part = (LAS float*)(F.lds + 32 * 1032 * 2);
    LAS float* logit = part + 8 * 32 * 33;
    const float* MOD = WSP(float, WS_MOD);
    float* XR = WSP(float, WS_XR);
    const bf16_t* WRT = WSP(bf16_t, WS_WRT) + (size_t)l * NEXP * D;
    int* cnt = (int*)A->ws + CW_CNT + l * 32;
    for (int u = F.bid; u < nrows / 32; u += F.G) {
        const int r0 = u * 32;
#pragma unroll 1
        for (int q = 0; q < 4; ++q) {
            const int rl = wave * 4 + q, r = r0 + rl; const int bi = (r < NLAT) ? (r / SEQ) : 4;
            f32x4 v[4]; float ss = 0.f;
#pragma unroll
            for (int j = 0; j < 4; ++j) { const int c = 4 * lane + 256 * j; v[j] = *(const f32x4*)(XR + (size_t)r * D + c);
                const u32x2 dw = *(const u32x2*)(WSP(bf16_t, WS_DELTA) + (size_t)r * D + c); const f32x4 g2 = *(const f32x4*)(MOD + ((size_t)l * 5 + bi) * 6144 + 2 * D + c);
                v[j].x += g2.x * bflo(dw.x); v[j].y += g2.y * bfhi(dw.x); v[j].z += g2.z * bflo(dw.y); v[j].w += g2.w * bfhi(dw.y);
                *(f32x4*)(XR + (size_t)r * D + c) = v[j];
                ss += (v[j].x * v[j].x + v[j].y * v[j].y) + (v[j].z * v[j].z + v[j].w * v[j].w); }
            const float rinv = 1.0f / sqrtf(wave_sum(ss) * (1.0f / D) + RMS_EPS);
            const float* gm = FIN(21) + (size_t)l * D; const float* m3 = MOD + ((size_t)l * 5 + bi) * 6144 + 3 * D; const float* m4 = m3 + D;
            bf16_t* hrow = WSP(bf16_t, WS_H) + (size_t)r * D;
#pragma unroll
            for (int j = 0; j < 4; ++j) { const int c = 4 * lane + 256 * j; const f32x4 g = *(const f32x4*)(gm + c), sh = *(const f32x4*)(m3 + c), sc = *(const f32x4*)(m4 + c);
                const f32x4 h = v[j] * rinv * g * (sc + 1.0f) + sh;
                u32x2 o; o.x = pk2(h.x, h.y); o.y = pk2(h.z, h.w); *(u32x2*)(hrow + c) = o; *(LAS u32x2*)(tile + rl * 1032 + c) = o; }
        }
        __syncthreads();
        {
            f32x16 acc;
#pragma unroll
            for (int i = 0; i < 16; ++i) acc[i] = 0.f;
            const int rr = lane & 31, hh = lane >> 5;
#pragma unroll
            for (int s = 0; s < 8; ++s) { const int k = wave * 128 + 16 * s + 8 * hh;
                const bf16x8 a = *(const LAS bf16x8*)(tile + rr * 1032 + k);
                const bf16x8 b = *(const bf16x8*)(WRT + (size_t)rr * D + k);
                acc = __builtin_amdgcn_mfma_f32_32x32x16_bf16(a, b, acc, 0, 0, 0); }
#pragma unroll
            for (int i = 0; i < 16; ++i) { const int tok = (i & 3) + 8 * (i >> 2) + 4 * hh; part[(wave * 32 + tok) * 33 + rr] = acc[i]; }
        }
        __syncthreads();
        for (int i = tid; i < 1024; i += NTHREADS) { const int tok = i >> 5, e = i & 31; float s = FIN(23)[l * 32 + e];
#pragma unroll
            for (int w = 0; w < 8; ++w) s += part[(w * 32 + tok) * 33 + e];
            logit[tok * 33 + e] = s; }
        __syncthreads();
        if (tid < 32) {
            const int r = r0 + tid; float lv[4]; int le[4]; unsigned used = 0u;
#pragma unroll
            for (int k = 0; k < 4; ++k) { float best = -3.0e38f; int be = 0;
                for (int e = 0; e < 32; ++e) { const float x = logit[tid * 33 + e]; if (!((used >> e) & 1u) && x > best) { best = x; be = e; } }
                used |= 1u << be; lv[k] = best; le[k] = be; }
            const float e1 = __expf(lv[1] - lv[0]), e2 = __expf(lv[2] - lv[0]), e3 = __expf(lv[3] - lv[0]); const float inv = 1.0f / (1.0f + e1 + e2 + e3);
            const float wk[4] = {inv, e1 * inv, e2 * inv, e3 * inv};
            int* ti = WSP(int, WS_TOKINFO) + (size_t)r * 4;
#pragma unroll
            for (int k = 0; k < 4; ++k) { const int rank = atomicAdd(&cnt[le[k]], 1);
                WSP(int, WS_ELIST)[(size_t)le[k] * TT + rank] = r; WSP(float, WS_TOKW)[(size_t)r * 4 + k] = wk[k]; ti[k] = (le[k] << 24) | rank; }
        }
        __syncthreads();
    }
}

__device__ __forceinline__ void phase_s5scan(KArgs A, Frame& F, int l) {
    PH_LOCALS;
    const int gw = F.bid * NWAVES + wave, NGW = F.G * NWAVES;
    const float* SL = WSP(float, WS_SLOC);
    for (int it = gw; it < NBATCH * 16 * 2; it += NGW) {
        const int dir = it & 1, g = (it >> 1) & 15, b = it >> 5;
        const int ldg = (l * 2 + dir) * 16 + g;
        const f32x2 L64 = WSP(f32x2, WS_LP)[((size_t)ldg * 65 + 64) * 64 + lane];
        bf16_t* sux = WSP(bf16_t, WS_SUX) + (size_t)g * MCH * SUXW;
        float xr = 0.f, xi = 0.f;
#pragma unroll 4
        for (int step = 0; step < 132; ++step) {
            int ch;
            if (step < 4) ch = 512 + 4 * b + (dir ? 3 - step : step);
            else ch = 128 * b + (dir ? 127 - (step - 4) : (step - 4));
            const float sr = SL[(size_t)ch * 4096 + g * 256 + dir * 128 + lane], si = SL[(size_t)ch * 4096 + g * 256 + dir * 128 + 64 + lane];
            bf16_t* o = sux + (size_t)ch * SUXW + 1024 + dir * 128;
            o[lane] = (unsigned short)f2bf(xr); o[64 + lane] = (unsigned short)f2bf(xi);
            const float nr = L64.x * xr - L64.y * xi + sr, ni = L64.x * xi + L64.y * xr + si;
            xr = nr; xi = ni;
        }
    }
}

constexpr float LOG2E = 1.4426950408889634f;
constexpr int AT_K = 0, AT_V = 16384, AT_RPB = 32768;
__device__ __forceinline__ void attn_stage(const bf16_t* P, const bf16_t* VT, LAS unsigned char* lds, int buf, int ktok0, int kcol, int vrow, int tid, int wave) {
    const bf16_t* ksrc = P + (size_t)(ktok0 + (tid & 63)) * PW + kcol + 8 * wave;
    const bf16_t* vsrc = VT + (size_t)(vrow + (tid & 63)) * TT + ktok0 + 8 * wave;
    __builtin_amdgcn_global_load_lds((const unsigned*)ksrc, (LAS unsigned*)(lds + AT_K + buf * 8192 + wave * 1024), 16, 0, 0);
    __builtin_amdgcn_global_load_lds((const unsigned*)vsrc, (LAS unsigned*)(lds + AT_V + buf * 8192 + wave * 1024), 16, 0, 0);
}
__device__ __forceinline__ void phase_attn(KArgs A, Frame& F, int l) {
    PH_LOCALS;
    LAS unsigned char* lds = F.lds;
    LAS float* rpb = (LAS float*)(lds + AT_RPB);
    for (int i = tid; i < 6 * 465; i += NTHREADS) rpb[i] = FIN(9)[(size_t)l * 6 * 465 + i] * LOG2E;
    __syncthreads();
    const bf16_t* P = WSP(bf16_t, WS_P); const bf16_t* VT = WSP(bf16_t, WS_VT);
    const int r = lane & 31, hh = lane >> 5;
    const int ngroups = 1536 + ((l < DEPTH - 1) ? 48 : 0);
    for (int gi = F.bid; gi < ngroups; gi += F.G) {
        int mode, b, head, r0 = 0, qt0 = 0;
        if (gi < 768) { mode = 0; r0 = 4 * (gi & 31); const int bh = gi >> 5; head = bh % 6; b = bh / 6; }
        else if (gi < 1536) { mode = 1; const int g2 = gi - 768; qt0 = 8 * (g2 & 31); const int bh = g2 >> 5; head = bh % 6; b = bh / 6; }
        else { const int g2 = gi - 1536; mode = 2 + g2 / 24; const int bh = g2 % 24; head = bh % 6; b = bh / 6; }
        const bool na = (mode == 0 || mode == 2);
        const int qcol = na ? 64 * head : 768 + 64 * head, kcol = na ? 384 + 64 * head : 1152 + 64 * (head / 3);
        const int vrow = na ? 64 * head : 384 + 64 * (head / 3), ycol = na ? 64 * head : 640 + 64 * head;
        int qtok0, qrow = 0, mh = 0, qt = 0;
        if (mode == 0) { qrow = r0 + (wave >> 1); mh = wave & 1; qtok0 = b * SEQ + qrow * 64 + 32 * mh; }
        else if (mode == 1) { qt = qt0 + wave; qtok0 = b * SEQ + 32 * qt; }
        else qtok0 = NLAT + b * CTXL + 32 * wave;
        const int rsw = min(max(qrow - 4, 0), 120);
        const int qc = 32 * mh + r, wsn = min(max(qc - 8, 0), 48);
        const int qpos = 32 * qt + r;
        int nlat = 0, kbase = 0;
        if (mode == 0) { const int kra = min(max(r0 - 4, 0), 120), krb = min(max(r0 - 1, 0), 120) + 7; kbase = kra; nlat = krb - kra + 1; }
        else if (mode == 1) { const int ks0 = max(qt0 - 4, 0) >> 1, ks1 = min(qt0 + 11, 255) >> 1; kbase = ks0; nlat = ks1 - ks0 + 1; }
        const int nsteps = nlat + 4;
        float m = na ? -1e30f : FIN(20)[l * 6 + head] * LOG2E, lsum = na ? 0.f : 1.f;
        bf16x8 qf[4];
#pragma unroll
        for (int s = 0; s < 4; ++s) qf[s] = *(const bf16x8*)(P + (size_t)(qtok0 + r) * PW + qcol + 32 * hh + 8 * s);
        f32x16 O0, O1;
#pragma unroll
        for (int i = 0; i < 16; ++i) { O0[i] = 0.f; O1[i] = 0.f; }
        __builtin_amdgcn_s_barrier();
        attn_stage(P, VT, lds, 0, (nlat > 0) ? b * SEQ + 64 * kbase : NLAT + b * CTXL, kcol, vrow, tid, wave);
        for (int s = 0; s < nsteps; ++s) {
            asm volatile("s_waitcnt vmcnt(0)" ::: "memory");
            __builtin_amdgcn_s_barrier();
            if (s + 1 < nsteps) { const int s1 = s + 1; attn_stage(P, VT, lds, s1 & 1, (s1 < nlat) ? b * SEQ + 64 * (kbase + s1) : NLAT + b * CTXL + 64 * (s1 - nlat), kcol, vrow, tid, wave); }
            const bool isctx = (s >= nlat);
            const int kr = kbase + s;
            if (!isctx && mode == 0 && (kr < rsw || kr > rsw + 7)) continue;
            const LAS unsigned char* kb = lds + AT_K + (s & 1) * 8192; const LAS unsigned char* vb = lds + AT_V + (s & 1) * 8192;
#pragma unroll
            for (int tl = 0; tl < 2; ++tl) {
                const int kt = 2 * kr + tl;
                int dt = kt - qt; dt = dt < 0 ? -dt : dt;
                if (!isctx && mode == 1 && dt > 4) continue;
                const bool masked = !isctx && (mode == 0 || (mode == 1 && dt == 4));
                bf16x8 kf[4];
#pragma unroll
                for (int q = 0; q < 4; ++q) kf[q] = *(const LAS bf16x8*)(kb + (((4 * hh + q) * 64) + 32 * tl + r) * 16);
                bf16x8 vf[2][2];
#pragma unroll
                for (int mt = 0; mt < 2; ++mt)
#pragma unroll
                    for (int s2 = 0; s2 < 2; ++s2) vf[mt][s2] = *(const LAS bf16x8*)(vb + ((((tl * 2 + hh) * 2 + s2) * 64) + 32 * mt + r) * 16);
                f32x16 sa;
#pragma unroll
                for (int i = 0; i < 16; ++i) sa[i] = 0.f;
#pragma unroll
                for (int q = 0; q < 4; ++q) sa = __builtin_amdgcn_mfma_f32_32x32x16_bf16(kf[q], qf[q], sa, 0, 0, 0);
                float sv[16]; float tmax = -1e30f;
                if (masked) {
#pragma unroll
                    for (int i = 0; i < 16; ++i) {
                        const int ki = (i & 3) + 8 * (i >> 2) + 4 * hh;
                        bool valid; float bias = 0.f;
                        if (mode == 0) { const int kc = 32 * tl + ki; valid = (kc >= wsn) && (kc < wsn + 16);
                            const int dc = min(max(kc - qc + 15, 0), 30); bias = rpb[head * 465 + (kr - qrow + 7) * 31 + dc]; }
                        else { const int dpos = qpos - (32 * kt + ki); valid = (dpos <= 128) && (dpos >= -128); }
                        const float x = sa[i] * (0.125f * LOG2E) + bias;
                        sv[i] = valid ? x : -1e30f; tmax = fmaxf(tmax, sv[i]);
                    }
                } else {
#pragma unroll
                    for (int i = 0; i < 16; ++i) { sv[i] = sa[i] * (0.125f * LOG2E); tmax = fmaxf(tmax, sv[i]); }
                }
                tmax = fmaxf(tmax, __shfl_xor(tmax, 32));
                if (__any(tmax > m)) {
                    const float mnew = fmaxf(m, tmax); const float alpha = fast_exp2(m - mnew);
                    lsum *= alpha; m = mnew;
#pragma unroll
                    for (int i = 0; i < 16; ++i) { O0[i] *= alpha; O1[i] *= alpha; }
                }
                float psum = 0.f;
#pragma unroll
                for (int i = 0; i < 16; ++i) { const float p = (sv[i] > -1e29f) ? fast_exp2(sv[i] - m) : 0.f; psum += p; sv[i] = p; }
                psum += __shfl_xor(psum, 32);
                lsum += psum;
#pragma unroll
                for (int s2 = 0; s2 < 2; ++s2) {
                    u32x4 pw; pw.x = cvt_pk_bf16(sv[8 * s2 + 0], sv[8 * s2 + 1]); pw.y = cvt_pk_bf16(sv[8 * s2 + 2], sv[8 * s2 + 3]); pw.z = cvt_pk_bf16(sv[8 * s2 + 4], sv[8 * s2 + 5]); pw.w = cvt_pk_bf16(sv[8 * s2 + 6], sv[8 * s2 + 7]);
                    const bf16x8 pf = __builtin_bit_cast(bf16x8, pw);
                    O0 = __builtin_amdgcn_mfma_f32_32x32x16_bf16(vf[0][s2], pf, O0, 0, 0, 0);
                    O1 = __builtin_amdgcn_mfma_f32_32x32x16_bf16(vf[1][s2], pf, O1, 0, 0, 0);
                }
            }
        }
        const float inv = 1.0f / lsum;
        bf16_t* yrow = WSP(bf16_t, WS_Y) + (size_t)(qtok0 + r) * D + ycol + 4 * hh;
#pragma unroll
        for (int rg = 0; rg < 4; ++rg) {
            u32x2 o0; o0.x = cvt_pk_bf16(O0[4 * rg + 0] * inv, O0[4 * rg + 1] * inv); o0.y = cvt_pk_bf16(O0[4 * rg + 2] * inv, O0[4 * rg + 3] * inv);
            u32x2 o1; o1.x = cvt_pk_bf16(O1[4 * rg + 0] * inv, O1[4 * rg + 1] * inv); o1.y = cvt_pk_bf16(O1[4 * rg + 2] * inv, O1[4 * rg + 3] * inv);
            *(u32x2*)(yrow + 8 * rg) = o0; *(u32x2*)(yrow + 32 + 8 * rg) = o1;
        }
    }
    asm volatile("s_waitcnt vmcnt(0)" ::: "memory");
    __builtin_amdgcn_s_barrier();
}

__device__ __forceinline__ int xcd_unit(int i, int G, int c, int U) {
    if ((G & 7) != 0) { const int idx = i * G + c; return idx < U ? idx : -1; }
    const int x = c & 7, j = c >> 3, per = G >> 3, q = U >> 3, r = U & 7;
    const int start = x * q + (x < r ? x : r), size = q + (x < r ? 1 : 0);
    const int loc = i * per + j;
    return loc < size ? start + loc : -1;
}
#define ACC8(ai, bj, m) const f32x4 a0_ = acc[ai][bj][m][0], a1_ = acc[ai][bj][m][1]; float v[8] = {a0_[0], a0_[1], a0_[2], a0_[3], a1_[0], a1_[1], a1_[2], a1_[3]}
__device__ __forceinline__ u32x4 pack8(const float* v) { u32x4 w; w.x = cvt_pk_bf16(v[0], v[1]); w.y = cvt_pk_bf16(v[2], v[3]); w.z = cvt_pk_bf16(v[4], v[5]); w.w = cvt_pk_bf16(v[6], v[7]); return w; }

struct SchedInproj { int G, c; const char* H; const char* W;
    __device__ __forceinline__ bool next(int i, GUnit& u) const {
        const int idx = xcd_unit(i, G, c, 1056); if (idx < 0) return false;
        if (idx < 792) { const int pm = idx / 6, pn = idx % 6; u.A = H + (size_t)pm * 256 * 2048; u.B = W + (size_t)pn * 256 * 2048; u.p0 = 0; u.p1 = pm; u.p2 = pn; u.p3 = 0; }
        else { const int j = idx - 792, vm = j / 132, tn = j % 132; u.A = W + (size_t)(1536 + 256 * vm) * 2048; u.B = H + (size_t)tn * 256 * 2048; u.p0 = 1; u.p1 = vm; u.p2 = tn; u.p3 = 0; }
        return true; }
    __device__ __forceinline__ int row_token(const GUnit&, int) const { return 0; }
    __device__ __forceinline__ void pre(const GUnit&, int, int, int) const {}
};
struct EpiInproj { bf16_t* P; bf16_t* VT; bf16_t* SUX; const LAS float* ROPE;
    __device__ __forceinline__ void operator()(const AccT& acc, const GUnit& u, int slot, int wr, int wc, int fr, int fq) const {
        if (u.p0 == 1) {
#pragma unroll
            for (int ai = 0; ai < 2; ++ai)
#pragma unroll
                for (int m = 0; m < 4; ++m) { const int row = u.p1 * 256 + 128 * ai + 64 * wr + 16 * m + fr;
#pragma unroll
                    for (int bj = 0; bj < 2; ++bj) { ACC8(ai, bj, m); const u32x4 w = pack8(v);
                        bf16_t* vp = VT + (size_t)row * TT + u.p2 * 256 + 128 * bj + 32 * wc + 8 * (fq >> 1) + 4 * (fq & 1);
                        *(u32x2*)vp = (u32x2){w.x, w.y}; *(u32x2*)(vp + 16) = (u32x2){w.z, w.w}; } }
            return;
        }
        const int pm = u.p1, pn = u.p2;
#pragma unroll
        for (int bj = 0; bj < 2; ++bj) {
            const int hh = 2 * pn + bj;
#pragma unroll
            for (int ai = 0; ai < 2; ++ai)
#pragma unroll
                for (int m = 0; m < 4; ++m) {
                    const int row = pm * 256 + 128 * ai + 64 * wr + 16 * m + fr;
                    ACC8(ai, bj, m);
                    if (hh >= 10) {
                        const int g = 8 * (hh - 10) + 2 * wc + (fq >> 1);
                        *(u32x4*)(SUX + ((size_t)g * MCH + (row >> 6)) * SUXW + (row & 63) * 16 + 8 * (fq & 1)) = pack8(v);
                    } else {
                        if (hh >= 6 && pm < 128) {
                            const int t = row & (SEQ - 1); const int pos = (wc & 1) ? (t & 63) : (t >> 6);
                            const LAS float* cs = ROPE + pos * 16 + 8 * (fq & 1);
                            const f32x4 c0 = *(const LAS f32x4*)cs, c1 = *(const LAS f32x4*)(cs + 4), s0 = *(const LAS f32x4*)(cs + 2048), s1 = *(const LAS f32x4*)(cs + 2052);
                            const float cc[8] = {c0[0], c0[1], c0[2], c0[3], c1[0], c1[1], c1[2], c1[3]}, sn[8] = {s0[0], s0[1], s0[2], s0[3], s1[0], s1[1], s1[2], s1[3]};
#pragma unroll
                            for (int e = 0; e < 8; ++e) { const float pr = __shfl_xor(v[e], 32); v[e] = v[e] * cc[e] + ((fq < 2) ? -pr : pr) * sn[e]; }
                        }
                        *(u32x4*)(P + (size_t)row * PW + 128 * hh + 32 * wc + 8 * fq) = pack8(v);
                    }
                }
        }
    }
};
struct SchedS5a { int G, c; const char* SUX; const char* W;
    __device__ __forceinline__ bool next(int i, GUnit& u) const {
        const int idx = xcd_unit(i, G, c, 48); if (idx < 0) return false;
        const int g = idx / 3, pm = idx % 3; u.A = SUX + ((size_t)g * MCH + pm * 256) * (SUXW * 2); u.B = W + (size_t)g * 256 * 2048; u.p0 = 0; u.p1 = pm; u.p2 = g; u.p3 = 0; return true; }
    __device__ __forceinline__ int row_token(const GUnit&, int) const { return 0; }
    __device__ __forceinline__ void pre(const GUnit&, int, int, int) const {}
};
struct EpiS5a { float* SL;
    __device__ __forceinline__ void operator()(const AccT& acc, const GUnit& u, int slot, int wr, int wc, int fr, int fq) const {
#pragma unroll
        for (int ai = 0; ai < 2; ++ai)
#pragma unroll
            for (int m = 0; m < 4; ++m) { float* rowp = SL + (size_t)(u.p1 * 256 + 128 * ai + 64 * wr + 16 * m + fr) * 4096 + u.p2 * 256 + 32 * wc + 8 * fq;
#pragma unroll
                for (int bj = 0; bj < 2; ++bj) { *(f32x4*)(rowp + 128 * bj) = acc[ai][bj][m][0]; *(f32x4*)(rowp + 128 * bj + 4) = acc[ai][bj][m][1]; } }
    }
};
struct SchedS5c { int G, c; const char* SUX; const char* KC;
    __device__ __forceinline__ bool next(int i, GUnit& u) const {
        const int idx = xcd_unit(i, G, c, 192); if (idx < 0) return false;
        const int g = idx / 12, q = idx % 12, pm = q / 4, pn = q % 4;
        u.A = SUX + ((size_t)g * MCH + pm * 256) * (SUXW * 2); u.B = KC + ((size_t)g * 1024 + pn * 256) * (SUXW * 2); u.p0 = 0; u.p1 = pm; u.p2 = pn; u.p3 = g; return true; }
    __device__ __forceinline__ int row_token(const GUnit&, int) const { return 0; }
    __device__ __forceinline__ void pre(const GUnit&, int, int, int) const {}
};
struct EpiS5c { bf16_t* Gb;
    __device__ __forceinline__ void operator()(const AccT& acc, const GUnit& u, int slot, int wr, int wc, int fr, int fq) const {
#pragma unroll
        for (int ai = 0; ai < 2; ++ai)
#pragma unroll
            for (int m = 0; m < 4; ++m) { const int chunk = u.p1 * 256 + 128 * ai + 64 * wr + 16 * m + fr;
                if (chunk < TT / 64) {
#pragma unroll
                    for (int bj = 0; bj < 2; ++bj) { ACC8(ai, bj, m); const int col = u.p2 * 256 + 128 * bj + 32 * wc + 8 * fq;
#pragma unroll
                        for (int e = 0; e < 8; ++e) v[e] = gelu_tanh(v[e]);
                        *(u32x4*)(Gb + ((size_t)chunk * 64 + (col >> 4)) * 256 + u.p3 * 16 + (col & 15)) = pack8(v); } } }
    }
};
struct SchedGlu { int G, c; const char* Gb; const char* W;
    __device__ __forceinline__ bool next(int i, GUnit& u) const {
        const int idx = xcd_unit(i, G, c, 132); if (idx < 0) return false;
        u.A = Gb + (size_t)idx * 256 * 512; u.B = W; u.p0 = 0; u.p1 = idx; u.p2 = 0; u.p3 = 0; return true; }
    __device__ __forceinline__ int row_token(const GUnit&, int) const { return 0; }
    __device__ __forceinline__ void pre(const GUnit&, int, int, int) const {}
};
struct EpiGlu { const bf16_t* Gb; bf16_t* Y; const float* bglu;
    __device__ __forceinline__ void operator()(const AccT& acc, const GUnit& u, int slot, int wr, int wc, int fr, int fq) const {
#pragma unroll
        for (int bj = 0; bj < 2; ++bj) { const int col = 128 * bj + 32 * wc + 8 * fq;
            const f32x4 b0 = *(const f32x4*)(bglu + col), b1 = *(const f32x4*)(bglu + col + 4); const float bb[8] = {b0[0], b0[1], b0[2], b0[3], b1[0], b1[1], b1[2], b1[3]};
            u32x4 gw[2][4];
#pragma unroll
            for (int ai = 0; ai < 2; ++ai)
#pragma unroll
                for (int m = 0; m < 4; ++m) gw[ai][m] = *(const u32x4*)(Gb + (size_t)(u.p1 * 256 + 128 * ai + 64 * wr + 16 * m + fr) * 256 + col);
#pragma unroll
            for (int ai = 0; ai < 2; ++ai)
#pragma unroll
                for (int m = 0; m < 4; ++m) { const int row = u.p1 * 256 + 128 * ai + 64 * wr + 16 * m + fr; ACC8(ai, bj, m);
                    const u32x4 g4 = gw[ai][m];
                    const float gv[8] = {bflo(g4.x), bfhi(g4.x), bflo(g4.y), bfhi(g4.y), bflo(g4.z), bfhi(g4.z), bflo(g4.w), bfhi(g4.w)};
#pragma unroll
                    for (int e = 0; e < 8; ++e) v[e] = gv[e] * sigmoidf_(v[e] + bb[e]);
                    *(u32x4*)(Y + (size_t)row * D + 384 + col) = pack8(v); } }
    }
};
struct SchedOut { int G, c, nunits; const char* Y; const char* W;
    __device__ __forceinline__ bool next(int i, GUnit& u) const {
        const int idx = xcd_unit(i, G, c, nunits); if (idx < 0) return false;
        const int pm = idx >> 2, pn = idx & 3; u.A = Y + (size_t)pm * 256 * 2048; u.B = W + (size_t)pn * 256 * 2048; u.p0 = 0; u.p1 = pm; u.p2 = pn; u.p3 = 0; return true; }
    __device__ __forceinline__ int row_token(const GUnit&, int) const { return 0; }
    __device__ __forceinline__ void pre(const GUnit&, int, int, int) const {}
};
struct EpiOut { bf16_t* DL;
    __device__ __forceinline__ void operator()(const AccT& acc, const GUnit& u, int slot, int wr, int wc, int fr, int fq) const {
#pragma unroll
        for (int ai = 0; ai < 2; ++ai)
#pragma unroll
            for (int m = 0; m < 4; ++m) { bf16_t* rowp = DL + (size_t)(u.p1 * 256 + 128 * ai + 64 * wr + 16 * m + fr) * D + u.p2 * 256 + 32 * wc + 8 * fq;
#pragma unroll
                for (int bj = 0; bj < 2; ++bj) { ACC8(ai, bj, m); *(u32x4*)(rowp + 128 * bj) = pack8(v); } }
    }
};
struct SchedMoe { int G, c, NT; const LAS int* ts; const char* A; const char* W; size_t wstride; const int* elist; bool gather; const float* bgu; LAS unsigned char* lds;
    __device__ __forceinline__ bool next(int i, GUnit& u) const {
        const int idx = xcd_unit(i, G, c, ts[32] * NT); if (idx < 0) return false;
        const int mt = idx / NT, pn = idx % NT; int e = 0; while (ts[e + 1] <= mt) ++e;
        u.A = gather ? A : (A + (size_t)mt * 256 * 2048); u.B = W + (size_t)e * wstride + (size_t)pn * 256 * 2048; u.p0 = mt; u.p1 = pn; u.p2 = e; u.p3 = (mt - ts[e]) * 256; return true; }
    __device__ __forceinline__ int row_token(const GUnit& u, int row) const { const int j = u.p3 + row; return (j < ts[40 + u.p2]) ? elist[(size_t)u.p2 * TT + j] : 0; }
    __device__ __forceinline__ void pre(const GUnit& u, int slot, int wid, int lane) const {
        if (bgu != nullptr && wid == 0) { const float* src = bgu + (size_t)u.p2 * 2048 + 128 * u.p1 + ((lane & 32) ? 1024 : 0) + 4 * (lane & 31);
            __builtin_amdgcn_global_load_lds((const unsigned*)src, (LAS unsigned*)(lds + LDS_BIAS + slot * 1024), 16, 0, 0); } }
};
struct EpiGateUp { bf16_t* ACT; LAS unsigned char* lds;
    __device__ __forceinline__ void operator()(const AccT& acc, const GUnit& u, int slot, int wr, int wc, int fr, int fq) const {
        const int col = 128 * u.p1 + 32 * wc + 8 * fq; const LAS float* bg = (const LAS float*)(lds + LDS_BIAS + slot * 1024) + 32 * wc + 8 * fq;
        const f32x4 g0 = *(const LAS f32x4*)bg, g1 = *(const LAS f32x4*)(bg + 4), u0 = *(const LAS f32x4*)(bg + 128), u1 = *(const LAS f32x4*)(bg + 132);
        const float bgate[8] = {g0[0], g0[1], g0[2], g0[3], g1[0], g1[1], g1[2], g1[3]}, bup[8] = {u0[0], u0[1], u0[2], u0[3], u1[0], u1[1], u1[2], u1[3]};
#pragma unroll
        for (int ai = 0; ai < 2; ++ai)
#pragma unroll
            for (int m = 0; m < 4; ++m) { const size_t row = (size_t)u.p0 * 256 + 128 * ai + 64 * wr + 16 * m + fr;
                const f32x4 ga = acc[ai][0][m][0], gb = acc[ai][0][m][1], ua = acc[ai][1][m][0], ub = acc[ai][1][m][1];
                const float gt[8] = {ga[0], ga[1], ga[2], ga[3], gb[0], gb[1], gb[2], gb[3]}, up[8] = {ua[0], ua[1], ua[2], ua[3], ub[0], ub[1], ub[2], ub[3]};
                float v[8];
#pragma unroll
                for (int e = 0; e < 8; ++e) { const float gg = fminf(gt[e] + bgate[e], 7.0f); const float uu = fminf(fmaxf(up[e] + bup[e], -7.0f), 7.0f); v[e] = gg * sigmoidf_(1.702f * gg) * (uu + 1.0f); }
                *(u32x4*)(ACT + row * FF + col) = pack8(v); }
    }
};
struct EpiDown { bf16_t* EO;
    __device__ __forceinline__ void operator()(const AccT& acc, const GUnit& u, int slot, int wr, int wc, int fr, int fq) const {
#pragma unroll
        for (int ai = 0; ai < 2; ++ai)
#pragma unroll
            for (int m = 0; m < 4; ++m) { bf16_t* rowp = EO + ((size_t)u.p0 * 256 + 128 * ai + 64 * wr + 16 * m + fr) * D + u.p1 * 256 + 32 * wc + 8 * fq;
#pragma unroll
                for (int bj = 0; bj < 2; ++bj) { ACC8(ai, bj, m); *(u32x4*)(rowp + 128 * bj) = pack8(v); } }
    }
};

constexpr int PH_PER_LAYER = 11, NPHASES = 2 + DEPTH * PH_PER_LAYER + 1;

__global__ void __launch_bounds__(NTHREADS, 2) mk_fwd(Args args) {
    extern __shared__ __attribute__((aligned(16))) unsigned char lds_raw[];
    Frame F;
    F.lds = (LAS unsigned char*)lds_raw;
    F.G = gridDim.x; F.bid = blockIdx.x;
    KArgs A0 = (KArgs)__builtin_amdgcn_kernarg_segment_ptr();
    KArgs A = A0; asm volatile("" : "+s"(A));
    volatile LAS unsigned* misc = (volatile LAS unsigned*)(F.lds + LDS_MISC);
    if (threadIdx.x < 16) misc[threadIdx.x] = 0u;
    __syncthreads();
    const int lo = A->ph_lo, hi = A->ph_hi;
    XcdBarrier bar; bar.bar = (unsigned*)A->ws + CW_BAR; bar.x = 0; bar.st = nullptr;
    if (hi - lo > 1) bar = xcd_barrier_post((unsigned*)A->ws + CW_BAR, misc + 8);
    LAS unsigned char* L = F.lds;
    const LAS int* ts = (const LAS int*)(F.lds + LDS_MISC + 64);
    int ph = 0;
#ifdef ONLY_SITE
#define SITE_ON(s) ((s) == ONLY_SITE)
#else
#define SITE_ON(s) true
#endif
#ifndef DUP_MASK
#define DUP_MASK 0u
#endif
#define PH_RUN(s) (SITE_ON(s) && ph >= lo && ph < hi)
#define PH_REP(s) for (int rep_ = 0; rep_ < (((DUP_MASK >> (s)) & 1u) ? 2 : 1); ++rep_)
#define PH_END do { if (ph >= lo && ph + 1 < hi) xcd_barrier(bar); ++ph; A = A0; asm volatile("" : "+s"(A)); } while (0)

    if (PH_RUN(0)) PH_REP(0) phase_p0a(A, F);
    PH_END;
    if (PH_RUN(1)) PH_REP(1) phase_p0b(A, F);
    PH_END;
    for (int l = 0; l < DEPTH; ++l) {
        const bool lastl = (l == DEPTH - 1);
        if (PH_RUN(2)) phase_norm1(A, F, l);
        PH_END;
        if (PH_RUN(3)) PH_REP(3) {
            SchedInproj S{F.G, F.bid, (const char*)WSP(bf16_t, WS_H), (const char*)(WSP(bf16_t, WS_WINT) + (size_t)l * 2048 * D)};
            { int t0 = threadIdx.x; asm volatile("" : "+v"(t0)); LAS float* rl = (LAS float*)(L + LDS_ROPE); const float* rg = WSP(float, WS_ROPE); for (int i = t0; i < 4096; i += NTHREADS) rl[i] = rg[i]; __syncthreads(); }
            EpiInproj E{WSP(bf16_t, WS_P), WSP(bf16_t, WS_VT), WSP(bf16_t, WS_SUX), (const LAS float*)(L + LDS_ROPE)};
            gemm_phase<false>(L, 16, 2048u, 2048u, S, E);
        }
        PH_END;
        if (PH_RUN(4)) PH_REP(4) {
            SchedS5a S{F.G, F.bid, (const char*)WSP(bf16_t, WS_SUX), (const char*)(WSP(bf16_t, WS_WST) + (size_t)l * 16 * 256 * 1024)};
            EpiS5a E{WSP(float, WS_SLOC)};
            gemm_phase<false>(L, 16, (unsigned)(SUXW * 2), 2048u, S, E);
        }
        PH_END;
        if (PH_RUN(5)) PH_REP(5) phase_s5scan(A, F, l);
        PH_END;
        if (PH_RUN(6)) PH_REP(6) {
            SchedS5c S{F.G, F.bid, (const char*)WSP(bf16_t, WS_SUX), (const char*)(WSP(bf16_t, WS_KC) + (size_t)l * 16 * 1024 * SUXW)};
            EpiS5c E{WSP(bf16_t, WS_G)};
            gemm_phase<false>(L, 20, (unsigned)(SUXW * 2), (unsigned)(SUXW * 2), S, E);
        }
        PH_END;
        if (PH_RUN(7)) PH_REP(7) {
            SchedGlu S{F.G, F.bid, (const char*)WSP(bf16_t, WS_G), (const char*)(WSP(bf16_t, WS_WGLUT) + (size_t)l * 256 * 256)};
            EpiGlu E{WSP(bf16_t, WS_G), WSP(bf16_t, WS_Y), FIN(19) + (size_t)l * 256};
            gemm_phase<false>(L, 4, 512u, 512u, S, E);
        }
        PH_END;
        if (PH_RUN(8)) PH_REP(8) phase_attn(A, F, l);
        PH_END;
        if (PH_RUN(9)) PH_REP(9) {
            SchedOut S{F.G, F.bid, (lastl ? 128 : 132) * 4, (const char*)WSP(bf16_t, WS_Y), (const char*)(WSP(bf16_t, WS_WOUTT) + (size_t)l * D * D)};
            EpiOut E{WSP(bf16_t, WS_DELTA)};
            gemm_phase<false>(L, 16, 2048u, 2048u, S, E);
        }
        PH_END;
        if (PH_RUN(10)) phase_router(A, F, l);
        PH_END;
        if (PH_RUN(11)) PH_REP(11) {
            build_tstart(A, F, l);
            SchedMoe S{F.G, F.bid, 8, ts, (const char*)WSP(bf16_t, WS_H), (const char*)(WSP(bf16_t, WS_WGUT) + (size_t)l * NEXP * 2048 * D), (size_t)2048 * D * 2, WSP(int, WS_ELIST), true, FIN(25) + (size_t)l * NEXP * 2048, L};
            EpiGateUp E{WSP(bf16_t, WS_ACT), L};
            gemm_phase<true>(L, 16, 2048u, 2048u, S, E);
        }
        PH_END;
        if (PH_RUN(12)) PH_REP(12) {
            build_tstart(A, F, l);
            SchedMoe S{F.G, F.bid, 4, ts, (const char*)WSP(bf16_t, WS_ACT), (const char*)(WSP(bf16_t, WS_WDT) + (size_t)l * NEXP * D * FF), (size_t)D * FF * 2, WSP(int, WS_ELIST), false, nullptr, L};
            EpiDown E{WSP(bf16_t, WS_EO)};
            gemm_phase<false>(L, 16, 2048u, 2048u, S, E);
        }
        PH_END;
    }
    if (PH_RUN(13)) phase_norm1(A, F, DEPTH);
#undef PH_RUN
#undef PH_END
}
}

extern "C" void kernel_launch(void* const* d_in, const int* in_sizes, int n_in, void* d_out, int out_size, void* d_ws, size_t ws_size, hipStream_t stream) {
    static int grid = 0;
    if (grid == 0) {
        if (n_in != 29 || out_size != NLAT * D || ws_size < WS_END) { fprintf(stderr, "kernel_launch: unexpected shapes (n_in %d, out %d, ws %zu)\n", n_in, out_size, ws_size); grid = -1; return; }
        int dev = 0, cus = 0;
        if (hipGetDevice(&dev) != hipSuccess || hipDeviceGetAttribute(&cus, hipDeviceAttributeMultiprocessorCount, dev) != hipSuccess) { grid = -1; return; }
        if (hipFuncSetAttribute((const void*)mk_fwd, hipFuncAttributeMaxDynamicSharedMemorySize, LDS_BYTES) != hipSuccess) { fprintf(stderr, "kernel_launch: hipFuncSetAttribute failed\n"); grid = -1; return; }
        int per_cu = 0;
        if (hipOccupancyMaxActiveBlocksPerMultiprocessor(&per_cu, (const void*)mk_fwd, NTHREADS, LDS_BYTES) != hipSuccess || per_cu < 1) { fprintf(stderr, "kernel_launch: occupancy query reports %d\n", per_cu); }
        (void)hipGetLastError();
        grid = cus;
    }
    if (grid < 0) return;
    (void)hipMemsetAsync((char*)d_ws + WS_CTL, 0, 1 * MiB, stream);
    Args a{};
    for (int i = 0; i < 29; ++i) a.in[i] = (const float*)d_in[i];
    a.out = (float*)d_out; a.ws = (unsigned char*)d_ws;
#if MK_PER_PHASE
    for (int p = 0; p < NPHASES; ++p) { a.ph_lo = p; a.ph_hi = p + 1; hipLaunchKernelGGL(mk_fwd, dim3(grid), dim3(NTHREADS), LDS_BYTES, stream, a); }
#else
    a.ph_lo = 0; a.ph_hi = NPHASES;
    hipLaunchKernelGGL(mk_fwd, dim3(grid), dim3(NTHREADS), LDS_BYTES, stream, a);
#endif
}
```

```cpp
#include <hip/hip_runtime.h>
#include <cstdio>
#include <cstdint>

#ifndef MK_PER_PHASE
#define MK_PER_PHASE 0
#endif

#define LAS __attribute__((address_space(3)))
#define GAS __attribute__((address_space(1)))
typedef unsigned short bf16_t;
typedef short bf16x8 __attribute__((ext_vector_type(8)));
typedef float f32x4 __attribute__((ext_vector_type(4)));
typedef float f32x2 __attribute__((ext_vector_type(2)));
typedef float f32x16 __attribute__((ext_vector_type(16)));
typedef unsigned u32x4 __attribute__((ext_vector_type(4)));
typedef unsigned u32x2 __attribute__((ext_vector_type(2)));

namespace {
constexpr int D = 1024, NBATCH = 4, SEQ = 8192, DEPTH = 4, CTXL = 256;
constexpr int NLAT = NBATCH * SEQ;
constexpr int NCTX = NBATCH * CTXL;
constexpr int TT = NLAT + NCTX;
constexpr int PW = 1280;
constexpr int NEXP = 32, FF = 1024;
constexpr int MCH = 768;
constexpr int SUXW = 1280;
constexpr int MAXTILES = 560;
constexpr int NWAVES = 8, NTHREADS = 512;
constexpr float RMS_EPS = 1e-6f;

constexpr size_t MiB = 1ull << 20;
constexpr size_t WS_CTL = 0;
constexpr size_t WS_MOD = 1 * MiB;
constexpr size_t WS_ROPE = 2 * MiB;
constexpr size_t WS_LP = 3 * MiB;
constexpr size_t WS_BBAR = 8 * MiB;
constexpr size_t WS_WRT = 9 * MiB;
constexpr size_t WS_WGLUT = 10 * MiB;
constexpr size_t WS_WINT = 11 * MiB;
constexpr size_t WS_WOUTT = 27 * MiB;
constexpr size_t WS_WST = 35 * MiB;
constexpr size_t WS_KC = 67 * MiB;
constexpr size_t WS_WGUT = 227 * MiB;
constexpr size_t WS_WDT = 739 * MiB;
constexpr size_t WS_XR = 995 * MiB;
constexpr size_t WS_H = 1127 * MiB;
constexpr size_t WS_P = 1193 * MiB;
constexpr size_t WS_VT = 1276 * MiB;
constexpr size_t WS_SUX = 1309 * MiB;
constexpr size_t WS_SLOC = 1339 * MiB;
constexpr size_t WS_G = 1351 * MiB;
constexpr size_t WS_Y = 1368 * MiB;
constexpr size_t WS_ELIST = 1434 * MiB;
constexpr size_t WS_ELW = 1439 * MiB;
constexpr size_t WS_TOKINFO = 1444 * MiB;
constexpr size_t WS_ACT = 1445 * MiB;
constexpr size_t WS_EO = 1725 * MiB;
constexpr size_t WS_TOKW = 2005 * MiB;
constexpr size_t WS_DELTA = 2006 * MiB;
constexpr size_t WS_END = 2072 * MiB;
constexpr int CW_BAR = 1024;
constexpr int CW_CNT = 8192;

constexpr int LDS_STAGE = 131072;
constexpr int LDS_MISC = LDS_STAGE;
constexpr int LDS_BIAS = LDS_STAGE + 1024;
constexpr int LDS_ROPE = LDS_STAGE + 4096;
constexpr int LDS_BYTES = LDS_STAGE + 4096 + 16384;

__device__ __forceinline__ unsigned f2bf(float f) { unsigned u = __builtin_bit_cast(unsigned, f); return (u + 0x7fffu + ((u >> 16) & 1u)) >> 16; }
__device__ __forceinline__ unsigned pk2(float lo, float hi) { return f2bf(lo) | (f2bf(hi) << 16); }
__device__ __forceinline__ float bf2f(unsigned short b) { return __builtin_bit_cast(float, ((unsigned)b) << 16); }
__device__ __forceinline__ float bflo(unsigned w) { return __builtin_bit_cast(float, w << 16); }
__device__ __forceinline__ float bfhi(unsigned w) { return __builtin_bit_cast(float, w & 0xffff0000u); }
__device__ __forceinline__ float wave_sum(float v) {
#pragma unroll
    for (int o = 1; o < 64; o <<= 1) v += __shfl_xor(v, o);
    return v;
}
__device__ __forceinline__ float fast_exp2(float x) { return __builtin_amdgcn_exp2f(x); }
__device__ __forceinline__ float sigmoidf_(float x) { return 1.0f / (1.0f + __expf(-x)); }
__device__ __forceinline__ float gelu_tanh(float x) {
    const float u = 0.7978845608028654f * (x + 0.044715f * x * x * x);
    const float t = 1.0f - 2.0f / (1.0f + __expf(2.0f * u));
    return 0.5f * x * (1.0f + t);
}

#define XB_TMO      128
#define XB_XCNT(j)  (256  + 64 * (j))
#define XB_XSUB(j)  (1280 + 64 * (j))
#define XB_XGEN(j)  (2304 + 64 * (j))
#define XB_TOP      3328
#define XB_TOPGEN   3392
#define XCD_BAR_WORDS 3456
#define XB_SPIN_CAP (1u << 18)
__device__ __forceinline__ unsigned xb_ld(unsigned* p)              { return __hip_atomic_load(p, __ATOMIC_RELAXED, __HIP_MEMORY_SCOPE_AGENT); }
__device__ __forceinline__ unsigned xb_add(unsigned* p, unsigned v) { return __hip_atomic_fetch_add(p, v, __ATOMIC_RELAXED, __HIP_MEMORY_SCOPE_AGENT); }
__device__ __forceinline__ unsigned xb_xcc_id() { return (unsigned)__builtin_amdgcn_s_getreg((3 << 11) | 20) & 0xFu; }
#define XB_SPIN(cond, bar) do { unsigned _sp = 0; while (cond) { __builtin_amdgcn_s_sleep(1); \
    if ((++_sp & 255u) == 0u) { if (xb_ld(&(bar)[XB_TMO])) break; if (_sp > XB_SPIN_CAP) { atomicAdd(&(bar)[XB_TMO], 1u); break; } } } } while (0)
struct XcdBarrier { unsigned* bar; unsigned x; volatile LAS unsigned* st; };
__device__ __forceinline__ XcdBarrier xcd_barrier_post(unsigned* bar, volatile LAS unsigned* st) {
    XcdBarrier b; b.bar = bar; b.x = xb_xcc_id(); b.st = st;
    if (threadIdx.x == 0) (void)xb_add(&bar[XB_XCNT(b.x)], 1u);
    return b;
}
__device__ __forceinline__ void xcd_barrier_complete(unsigned* bar, unsigned x, unsigned& nloc, unsigned& nx) {
    const unsigned G = gridDim.x * gridDim.y * gridDim.z;
    unsigned sum, cnt, mine, sp = 0u;
    for (;;) {
        sum = 0u; cnt = 0u; mine = 0u;
#pragma unroll
        for (unsigned j = 0; j < 16; ++j) { const unsigned c = xb_ld(&bar[XB_XCNT(j)]); sum += c; cnt += (c > 0u) ? 1u : 0u; mine = (j == x) ? c : mine; }
        if (sum == G) break;
        __builtin_amdgcn_s_sleep(1);
        if ((++sp & 255u) == 0u) { if (xb_ld(&bar[XB_TMO])) break; if (sp > XB_SPIN_CAP) { atomicAdd(&bar[XB_TMO], 1u); break; } }
    }
    nloc = mine > 0u ? mine : 1u; nx = cnt > 0u ? cnt : 1u;
}
__device__ __forceinline__ void xcd_barrier(const XcdBarrier& b) {
    asm volatile("s_waitcnt vmcnt(0)" ::: "memory");
    __syncthreads();
    if (threadIdx.x == 0) {
        unsigned* bar = b.bar;
        __builtin_amdgcn_s_waitcnt(0);
        unsigned nloc = b.st[0], nx = b.st[1];
        if (nloc == 0u) { xcd_barrier_complete(bar, b.x, nloc, nx); b.st[0] = nloc; b.st[1] = nx; }
        const unsigned old = xb_add(&bar[XB_XSUB(b.x)], 1u);
        const unsigned gen = old / nloc;
        if (old + 1u == (gen + 1u) * nloc) {
            __builtin_amdgcn_fence(__ATOMIC_RELEASE, "agent");
            asm volatile("s_waitcnt vmcnt(0)" ::: "memory");
            const unsigned og = xb_add(&bar[XB_TOP], 1u);
            const unsigned tg = og / nx;
            if (og + 1u == (tg + 1u) * nx) xb_add(&bar[XB_TOPGEN], 1u);
            else XB_SPIN(xb_ld(&bar[XB_TOPGEN]) == tg, bar);
            __builtin_amdgcn_fence(__ATOMIC_ACQUIRE, "agent");
            xb_add(&bar[XB_XGEN(b.x)], 1u);
            asm volatile("s_waitcnt vmcnt(0)" ::: "memory");
        } else {
            XB_SPIN(xb_ld(&bar[XB_XGEN(b.x)]) == gen, bar);
            __builtin_amdgcn_fence(__ATOMIC_ACQUIRE, "agent");
            asm volatile("s_waitcnt vmcnt(0)" ::: "memory");
        }
    }
    __syncthreads();
}

constexpr int BM = 256, BK = 64, HALF = 128, HTB = HALF * BK * 2;
__device__ __forceinline__ int lds_byte(int r, int c) { const int st = (r >> 4) * 2 + (c >> 5), rr = r & 15, cc = c & 31, ob = rr * 64 + cc * 2; return st * 1024 + (ob ^ (((ob >> 9) & 1) << 5)); }
__device__ __forceinline__ void stage_rc(int b, int& R, int& C) { const int st = b / 1024, sb = b % 1024, swz = sb ^ (((sb >> 9) & 1) << 5); R = (st >> 1) * 16 + swz / 64; C = (st & 1) * 32 + (swz % 64) / 2; }
__device__ __forceinline__ int perm32(int rho) { const int n = rho >> 4, i = rho & 15; return 8 * (i >> 2) + 4 * n + (i & 3); }
__device__ __forceinline__ unsigned cvt_pk_bf16(float lo, float hi) { unsigned r; asm volatile("v_cvt_pk_bf16_f32 %0, %1, %2" : "=v"(r) : "v"(lo), "v"(hi)); return r; }

struct GUnit { const char* A; const char* B; int p0, p1, p2, p3; };
typedef f32x4 AccT[2][2][4][2];

template <bool GATHER, class Sched, class Epi>
__device__ __forceinline__ void gemm_phase(LAS unsigned char* lds, const int nt_  , const unsigned lda2, const unsigned ldb2  , const Sched& S, const Epi& E) {
    int tid = threadIdx.x; asm volatile("" : "+v"(tid));
    int nt = nt_; asm volatile("" : "+s"(nt));
    const int wid = __builtin_amdgcn_readfirstlane(tid >> 6), lane = tid & 63, wr = wid >> 2, wc = wid & 3, fr = lane & 15, fq = lane >> 4;
    unsigned voffA[2][2], voffB[2]; int RA[2], CA[2];
#pragma unroll
    for (int i = 0; i < 2; ++i) { int R, C; stage_rc(tid * 16 + i * 8192, R, C); const int Rb = (R & ~31) + perm32(R & 31);
        RA[i] = R; CA[i] = C; voffA[0][i] = (unsigned)R * lda2 + (unsigned)C * 2u; voffA[1][i] = voffA[0][i] + 128u * lda2; voffB[i] = (unsigned)Rb * ldb2 + (unsigned)C * 2u; }
    const size_t kstep = (size_t)(BK * 2);
    const size_t hstepB = (size_t)HALF * ldb2;
    const unsigned ldsw = (unsigned)wid * 1024u;
    const int aoff = lds_byte(wr * 64 + fr, fq * 8), boff = lds_byte(wc * 32 + fr, fq * 8);
#define PG_SA(b, h) (((b) * 2 + (h)) * HTB)
#define PG_SB(b, h) ((4 + (b) * 2 + (h)) * HTB)
#define PG_STAGE(bufoff, gbase, voff) do { _Pragma("unroll") for (int _i = 0; _i < 2; ++_i) \
        __builtin_amdgcn_global_load_lds((const unsigned*)((const char*)(gbase) + (voff)[_i]), (LAS unsigned*)(lds + (bufoff) + ldsw + _i * 8192), 16, 0, 0); } while (0)
#define PG_LDA(dst, b, h) do { _Pragma("unroll") for (int m = 0; m < 4; ++m) _Pragma("unroll") for (int k = 0; k < 2; ++k) dst[m][k] = *(const LAS bf16x8*)(lds + PG_SA(b, h) + aoff + m * 2048 + k * 1024); } while (0)
#define PG_LDB(dst, b, h) do { _Pragma("unroll") for (int n = 0; n < 2; ++n) _Pragma("unroll") for (int k = 0; k < 2; ++k) dst[n][k] = *(const LAS bf16x8*)(lds + PG_SB(b, h) + boff + n * 2048 + k * 1024); } while (0)
#define PG_MMA(ai, bj, At, Bt) do { __builtin_amdgcn_s_setprio(1); _Pragma("unroll") for (int m = 0; m < 4; ++m) _Pragma("unroll") for (int n = 0; n < 2; ++n) _Pragma("unroll") for (int k = 0; k < 2; ++k) \
        acc[ai][bj][m][n] = __builtin_amdgcn_mfma_f32_16x16x32_bf16(Bt[n][k], At[m][k], acc[ai][bj][m][n], 0, 0, 0); __builtin_amdgcn_s_setprio(0); } while (0)
#define PG_WAIT_V(n) asm volatile("s_waitcnt vmcnt(" #n ")" ::: "memory")
#define PG_WAIT_L(n) asm volatile("s_waitcnt lgkmcnt(" #n ")" ::: "memory")
#define PG_BAR __builtin_amdgcn_s_barrier()
#define PG_SCHED __builtin_amdgcn_sched_barrier(0)
    GUnit cur, nxt; int ui = 0;
    if (!S.next(0, cur)) return;
    AccT acc;
#pragma unroll
    for (int a = 0; a < 2; ++a)
#pragma unroll
        for (int b = 0; b < 2; ++b)
#pragma unroll
            for (int m = 0; m < 4; ++m)
#pragma unroll
                for (int n = 0; n < 2; ++n) acc[a][b][m][n] = (f32x4){0.f, 0.f, 0.f, 0.f};
    bf16x8 At[4][2], B0[2][2], B1[2][2];
    const char* cA = cur.A; const char* cB = cur.B;
    S.pre(cur, 0, wid, lane);
    if (GATHER) {
#pragma unroll
        for (int h = 0; h < 2; ++h)
#pragma unroll
            for (int i = 0; i < 2; ++i) voffA[h][i] = (unsigned)S.row_token(cur, h * 128 + RA[i]) * lda2 + (unsigned)CA[i] * 2u;
    }
    unsigned voffAn[2][2];
#pragma unroll
    for (int h = 0; h < 2; ++h)
#pragma unroll
        for (int i = 0; i < 2; ++i) voffAn[h][i] = voffA[h][i];
    PG_STAGE(PG_SB(0, 0), cB, voffB); PG_STAGE(PG_SA(0, 0), cA, voffA[0]); PG_STAGE(PG_SB(0, 1), cB + hstepB, voffB); PG_STAGE(PG_SA(0, 1), cA, voffA[1]);
    if (wr == 1) PG_BAR;
    PG_WAIT_V(4); PG_BAR;
    PG_STAGE(PG_SB(1, 0), cB + kstep, voffB); PG_STAGE(PG_SA(1, 0), cA + kstep, voffA[0]); PG_STAGE(PG_SB(1, 1), cB + hstepB + kstep, voffB);
    PG_WAIT_V(6); PG_BAR;
    for (;;) {
        const bool has_next = S.next(ui + 1, nxt);
        const char* nA = has_next ? nxt.A : cA; const char* nB = has_next ? nxt.B : cB;
        for (int t = 0; t < nt; t += 2) {
            const bool last = (t == nt - 2);
            const char* a1 = cA + (size_t)(t + 1) * kstep;
            const char* a2 = last ? nA : cA + (size_t)(t + 2) * kstep; const char* b2 = last ? nB : cB + (size_t)(t + 2) * kstep;
            const char* a3 = a2 + kstep; const char* b3 = b2 + kstep;
            if (last && has_next) S.pre(nxt, (ui + 1) & 1, wid, lane);
            if (GATHER) {
                if (last && has_next) {
#pragma unroll
                    for (int h = 0; h < 2; ++h)
#pragma unroll
                        for (int i = 0; i < 2; ++i) voffAn[h][i] = (unsigned)S.row_token(nxt, h * 128 + RA[i]) * lda2 + (unsigned)CA[i] * 2u;
                }
            }
            unsigned vA0[2], vA1[2];
#pragma unroll
            for (int i = 0; i < 2; ++i) { vA0[i] = (GATHER && last) ? voffAn[0][i] : voffA[0][i]; vA1[i] = (GATHER && last) ? voffAn[1][i] : voffA[1][i]; }
            PG_LDB(B0, 0, 0); PG_SCHED; PG_LDA(At, 0, 0); PG_STAGE(PG_SA(1, 1), a1, voffA[1]);
            PG_WAIT_L(8); PG_BAR; PG_WAIT_L(0); PG_MMA(0, 0, At, B0); PG_BAR; PG_SCHED;
            PG_LDB(B1, 0, 1); PG_STAGE(PG_SB(0, 0), b2, voffB);
            PG_BAR; PG_WAIT_L(0); PG_MMA(0, 1, At, B1); PG_BAR;
            PG_LDA(At, 0, 1); PG_STAGE(PG_SA(0, 0), a2, vA0);
            PG_BAR; PG_WAIT_L(0); PG_MMA(1, 0, At, B0); PG_BAR; PG_SCHED;
            PG_STAGE(PG_SB(0, 1), b2 + hstepB, voffB);
            PG_WAIT_V(6); PG_BAR; PG_MMA(1, 1, At, B1); PG_BAR;
            PG_LDB(B0, 1, 0); PG_SCHED; PG_LDA(At, 1, 0); PG_STAGE(PG_SA(0, 1), a2, vA1);
            PG_WAIT_L(8); PG_BAR; PG_WAIT_L(0); PG_MMA(0, 0, At, B0); PG_BAR; PG_SCHED;
            PG_LDB(B1, 1, 1); PG_STAGE(PG_SB(1, 0), b3, voffB);
            PG_BAR; PG_WAIT_L(0); PG_MMA(0, 1, At, B1); PG_BAR;
            PG_LDA(At, 1, 1); PG_STAGE(PG_SA(1, 0), a3, vA0);
            PG_BAR; PG_WAIT_L(0); PG_MMA(1, 0, At, B0); PG_BAR; PG_SCHED;
            PG_STAGE(PG_SB(1, 1), b3 + hstepB, voffB);
            PG_WAIT_V(6); PG_BAR; PG_MMA(1, 1, At, B1); PG_BAR;
        }
        {
            int tz = threadIdx.x; asm volatile("" : "+v"(tz)); const int wz = __builtin_amdgcn_readfirstlane(tz >> 6), lz = tz & 63;
            E(acc, cur, ui & 1, wz >> 2, wz & 3, lz & 15, lz >> 4); }
        if (!has_next) break;
#pragma unroll
        for (int a = 0; a < 2; ++a)
#pragma unroll
            for (int b = 0; b < 2; ++b)
#pragma unroll
                for (int m = 0; m < 4; ++m)
#pragma unroll
                    for (int n = 0; n < 2; ++n) acc[a][b][m][n] = (f32x4){0.f, 0.f, 0.f, 0.f};
        cur = nxt; cA = nA; cB = nB; ++ui;
        if (GATHER) {
#pragma unroll
            for (int h = 0; h < 2; ++h)
#pragma unroll
                for (int i = 0; i < 2; ++i) voffA[h][i] = voffAn[h][i];
        }
    }
    PG_WAIT_V(0);
    if (wr == 0) PG_BAR;
    PG_BAR;
#undef PG_SA
#undef PG_SB
#undef PG_STAGE
#undef PG_LDA
#undef PG_LDB
#undef PG_MMA
#undef PG_WAIT_V
#undef PG_WAIT_L
#undef PG_BAR
#undef PG_SCHED
}

struct Args { const float* in[29]; float* out; unsigned char* ws; int ph_lo, ph_hi; };
struct Frame {
    LAS unsigned char* lds;
    int G, bid;
};
#define PH_LOCALS int tid = threadIdx.x; asm volatile("" : "+v"(tid)); const int lane = tid & 63; const int wave = __builtin_amdgcn_readfirstlane(tid >> 6); (void)lane; (void)wave
typedef const __attribute__((address_space(4))) Args* KArgs;
#define WSP(T, off) ((T*)(A->ws + (off)))
#define FIN(i) (A->in[i])

__device__ __forceinline__ void transpose_item(const float* W, int K, int N, bf16_t* WT, int kb, int n0s, int drow0, LAS float* scr, int lane) {
    const int k0 = 64 * kb;
#pragma unroll 8
    for (int i = 0; i < 32; ++i) { const int kk = 2 * i + (lane >> 5); scr[kk * 33 + (lane & 31)] = W[(size_t)(k0 + kk) * N + n0s + (lane & 31)]; }
    asm volatile("s_waitcnt lgkmcnt(0)" ::: "memory");
    const int c = lane & 7;
#pragma unroll
    for (int j = 0; j < 4; ++j) { const int n = (lane >> 3) + 8 * j; const LAS float* s = scr + (8 * c) * 33 + n;
        u32x4 o; o.x = pk2(s[0 * 33], s[1 * 33]); o.y = pk2(s[2 * 33], s[3 * 33]); o.z = pk2(s[4 * 33], s[5 * 33]); o.w = pk2(s[6 * 33], s[7 * 33]);
        *(u32x4*)(WT + (size_t)(drow0 + n) * K + k0 + 8 * c) = o; }
    asm volatile("s_waitcnt lgkmcnt(0)" ::: "memory");
}
__device__ __forceinline__ int win_src_col(int d) {
    if (d < 768) return d;
    if (d < 1152) return 1408 + (d - 768);
    if (d < 1280) return 1792 + (d - 1152);
    if (d < 1536) return 1152 + (d - 1280);
    if (d < 1920) return 768 + (d - 1536);
    return d;
}
__device__ __forceinline__ int wgu_src_col(int d) { const int t = d >> 8, r = d & 255; return (r < 128) ? (128 * t + r) : (1024 + 128 * t + (r - 128)); }

__device__ __forceinline__ void phase_p0a(KArgs A, Frame& F) {
    PH_LOCALS;
    LAS float* scr = (LAS float*)(F.lds + wave * 16384);
    const int gw = F.bid * NWAVES + wave, NGW = F.G * NWAVES;
    constexpr int I_IN = DEPTH * 16 * 64, I_OUT = DEPTH * 16 * 32, I_GLU = DEPTH * 4 * 8, I_RT = DEPTH * 16, I_GU = DEPTH * NEXP * 16 * 64, I_DN = DEPTH * NEXP * 16 * 32;
    constexpr int NITEMS = I_IN + I_OUT + I_GLU + I_RT + I_GU + I_DN;
    for (int it = gw; it < NITEMS; it += NGW) {
        int r = it;
        if (r < I_IN) { const int l = r / 1024, q = r % 1024, kb = q / 64, nb = q % 64;
            transpose_item(FIN(7) + (size_t)l * D * 2048, D, 2048, WSP(bf16_t, WS_WINT) + (size_t)l * 2048 * D, kb, win_src_col(32 * nb), 32 * nb, scr, lane); continue; } r -= I_IN;
        if (r < I_OUT) { const int l = r / 512, q = r % 512, kb = q / 32, nb = q % 32;
            transpose_item(FIN(8) + (size_t)l * D * D, D, D, WSP(bf16_t, WS_WOUTT) + (size_t)l * D * D, kb, 32 * nb, 32 * nb, scr, lane); continue; } r -= I_OUT;
        if (r < I_GLU) { const int l = r / 32, q = r % 32, kb = q / 8, nb = q % 8;
            transpose_item(FIN(18) + (size_t)l * 256 * 256, 256, 256, WSP(bf16_t, WS_WGLUT) + (size_t)l * 256 * 256, kb, 32 * nb, 32 * nb, scr, lane); continue; } r -= I_GLU;
        if (r < I_RT) { const int l = r / 16, kb = r % 16;
            transpose_item(FIN(22) + (size_t)l * D * NEXP, D, NEXP, WSP(bf16_t, WS_WRT) + (size_t)l * NEXP * D, kb, 0, 0, scr, lane); continue; } r -= I_RT;
        if (r < I_GU) { const int le = r / 1024, q = r % 1024, kb = q / 64, nb = q % 64;
            transpose_item(FIN(24) + (size_t)le * D * 2048, D, 2048, WSP(bf16_t, WS_WGUT) + (size_t)le * 2048 * D, kb, wgu_src_col(32 * nb), 32 * nb, scr, lane); continue; } r -= I_GU;
        { const int le = r / 512, q = r % 512, kb = q / 32, nb = q % 32;
            transpose_item(FIN(26) + (size_t)le * FF * D, FF, D, WSP(bf16_t, WS_WDT) + (size_t)le * D * FF, kb, 32 * nb, 32 * nb, scr, lane); }
    }
    __syncthreads();
    {
        LAS float* cond = (LAS float*)F.lds;
        LAS float* red = (LAS float*)(F.lds + 32768);
        for (int i = tid; i < 5 * D; i += NTHREADS) { const int bi = i / D, k = i % D; const float v = (bi < 4) ? FIN(1)[bi * D + k] : FIN(3)[k]; cond[i] = v / (1.0f + __expf(-v)); }
        __syncthreads();
        for (int u = F.bid; u < DEPTH * 96; u += F.G) {
            const int l = u / 96, j = (u % 96) * 64 + lane;
            const float* w = FIN(4) + (size_t)l * D * 6144 + j;
            float a0 = 0.f, a1 = 0.f, a2 = 0.f, a3 = 0.f, a4 = 0.f;
#pragma unroll 8
            for (int kk = 0; kk < 128; ++kk) { const int k = wave * 128 + kk; const float wv = w[(size_t)k * 6144];
                a0 += cond[k] * wv; a1 += cond[D + k] * wv; a2 += cond[2 * D + k] * wv; a3 += cond[3 * D + k] * wv; a4 += cond[4 * D + k] * wv; }
            red[(wave * 5 + 0) * 64 + lane] = a0; red[(wave * 5 + 1) * 64 + lane] = a1; red[(wave * 5 + 2) * 64 + lane] = a2;
            red[(wave * 5 + 3) * 64 + lane] = a3; red[(wave * 5 + 4) * 64 + lane] = a4;
            __syncthreads();
            if (tid < 320) { const int bi = tid / 64, jj = tid % 64; float s = 0.f;
#pragma unroll
                for (int w8 = 0; w8 < 8; ++w8) s += red[(w8 * 5 + bi) * 64 + jj];
                const int col = (u % 96) * 64 + jj;
                WSP(float, WS_MOD)[((size_t)l * 5 + bi) * 6144 + col] = s + FIN(5)[l * 6144 + col]; }
            __syncthreads();
        }
    }
    const int gt = F.bid * NTHREADS + tid, NGT = F.G * NTHREADS;
    for (int i = gt; i < 128 * 16; i += NGT) { const int pos = i / 16, f = i % 16; const float inv = powf(10000.0f, -(float)f / 16.0f); const float a = (float)pos * inv;
        WSP(float, WS_ROPE)[i] = cosf(a); WSP(float, WS_ROPE)[2048 + i] = sinf(a); }
    for (int i = gt; i < DEPTH * 2 * 16 * 65 * 64; i += NGT) {
        const int p = i % 64, d = (i / 64) % 65, ldg = i / (64 * 65);
        const float are = fminf(FIN(10)[ldg * 64 + p], -1e-4f), aim = FIN(11)[ldg * 64 + p];
        const float step = expf(FIN(12)[ldg]);
        const float re = are * step * (float)d, im = aim * step * (float)d;
        const float mag = expf(re);
        WSP(f32x2, WS_LP)[i] = (f32x2){mag * cosf(im), mag * sinf(im)};
    }
    for (int i = gt; i < DEPTH * 2 * 16 * 64 * 16; i += NGT) {
        const int lp = i / 16;
        const int ldg = lp / 64;
        const float are = fminf(FIN(10)[lp], -1e-4f), aim = FIN(11)[lp];
        const float step = expf(FIN(12)[ldg]);
        const float mag = expf(are * step), lr = mag * cosf(aim * step) - 1.0f, li = mag * sinf(aim * step);
        const float den = are * are + aim * aim;
        const float qr = (lr * are + li * aim) / den, qi = (li * are - lr * aim) / den;
        const float br = FIN(13)[i], bi = FIN(14)[i];
        WSP(f32x2, WS_BBAR)[i] = (f32x2){qr * br - qi * bi, qr * bi + qi * br};
    }
}

__device__ __forceinline__ f32x2 cmul(f32x2 a, f32x2 b) { return (f32x2){a.x * b.x - a.y * b.y, a.x * b.y + a.y * b.x}; }
__device__ __forceinline__ void phase_p0b(KArgs A, Frame& F) {
    PH_LOCALS;
    const f32x2* LP = WSP(f32x2, WS_LP); const f32x2* BB = WSP(f32x2, WS_BBAR);
    LAS float* kv = (LAS float*)F.lds;
    for (int it = F.bid; it < DEPTH * 16 * 64; it += F.G) {
        const int d = it % 64, g = (it / 64) % 16, l = it / 1024;
        const int dir = tid >> 8, ho = (tid >> 4) & 15, hi = tid & 15;
        const int ldg = (l * 2 + dir) * 16 + g;
        const float* cre = FIN(15) + ((size_t)ldg * 16 + ho) * 64; const float* cim = FIN(16) + ((size_t)ldg * 16 + ho) * 64;
        const f32x2* lp = LP + ((size_t)ldg * 65 + d) * 64; const f32x2* bb = BB + (size_t)ldg * 1024 + hi;
        float s = 0.f;
        for (int p = 0; p < 64; ++p) { const f32x2 t = cmul(lp[p], bb[p * 16]); s += cre[p] * t.x - cim[p] * t.y; }
        kv[dir * 256 + ho * 16 + hi] = s;
        __syncthreads();
        bf16_t* KC = WSP(bf16_t, WS_KC) + ((size_t)(l * 16 + g)) * 1024 * SUXW;
        if (d == 0) {
            if (dir == 0) { const float v = kv[ho * 16 + hi] + kv[256 + ho * 16 + hi] + ((ho == hi) ? FIN(17)[l * 256 + g * 16 + ho] : 0.f); const unsigned short b = (unsigned short)f2bf(v);
                for (int t = 0; t < 64; ++t) KC[(size_t)(t * 16 + ho) * SUXW + t * 16 + hi] = b; }
        } else {
            const unsigned short b = (unsigned short)f2bf(s);
            if (dir == 0) { for (int t = d; t < 64; ++t) KC[(size_t)(t * 16 + ho) * SUXW + (t - d) * 16 + hi] = b; }
            else          { for (int t = 0; t < 64 - d; ++t) KC[(size_t)(t * 16 + ho) * SUXW + (t + d) * 16 + hi] = b; }
        }
        __syncthreads();
    }
    const int gt = F.bid * NTHREADS + tid, NGT = F.G * NTHREADS;
    for (int i = gt; i < DEPTH * 16 * 256 * 1024; i += NGT) {
        const int k = i % 1024, n = (i / 1024) % 256, lg = i / (1024 * 256), l = lg / 16, g = lg % 16;
        const int s = k / 16, hi = k % 16, dir = n / 128, ri = (n / 64) & 1, p = n % 64;
        const int ldg = (l * 2 + dir) * 16 + g;
        const int e = dir ? s : 63 - s;
        const f32x2 t = cmul(LP[((size_t)ldg * 65 + e) * 64 + p], BB[(size_t)ldg * 1024 + p * 16 + hi]);
        WSP(bf16_t, WS_WST)[i] = (unsigned short)f2bf(ri ? t.y : t.x);
    }
    for (int i = gt; i < DEPTH * 16 * 1024 * 256; i += NGT) {
        const int n = i % 256, row = (i / 256) % 1024, lg = i / (256 * 1024), l = lg / 16, g = lg % 16;
        const int t = row / 16, ho = row % 16, dir = n / 128, ri = (n / 64) & 1, p = n % 64;
        const int ldg = (l * 2 + dir) * 16 + g;
        const int e = dir ? 64 - t : t + 1;
        const f32x2 c = (f32x2){FIN(15)[((size_t)ldg * 16 + ho) * 64 + p], FIN(16)[((size_t)ldg * 16 + ho) * 64 + p]};
        const f32x2 v = cmul(c, LP[((size_t)ldg * 65 + e) * 64 + p]);
        WSP(bf16_t, WS_KC)[((size_t)lg * 1024 + row) * SUXW + 1024 + n] = (unsigned short)f2bf(ri ? -v.y : v.x);
    }
}

__device__ __forceinline__ void build_tstart(KArgs A, Frame& F, int l) {
    PH_LOCALS;
    LAS int* ts = (LAS int*)(F.lds + LDS_MISC + 64);
    if (tid == 0) { const int* cnt = (const int*)A->ws + CW_CNT + l * 32; int a = 0;
        for (int e = 0; e < 32; ++e) { ts[e] = a; ts[40 + e] = cnt[e]; a += (cnt[e] + 255) >> 8; }
        ts[32] = a; }
    __syncthreads();
}

__device__ __forceinline__ void phase_norm1(KArgs A, Frame& F, int l, const float dsc = 1.0f) {
    PH_LOCALS;
    const bool fin = (l == DEPTH);
    const int nrows = fin ? NLAT : TT;
    if (l > 0) build_tstart(A, F, l - 1);
    const LAS int* ts = (const LAS int*)(F.lds + LDS_MISC + 64);
    const int gw = F.bid * NWAVES + wave, NGW = F.G * NWAVES;
    const float* MOD = WSP(float, WS_MOD);
    float* XR = WSP(float, WS_XR);
    for (int r = gw; r < nrows; r += NGW) {
        const int bi = (r < NLAT) ? (r / SEQ) : 4;
        f32x4 v[4];
        if (l == 0) { const float* src = (r < NLAT) ? (FIN(0) + (size_t)r * D) : (FIN(2) + (size_t)(r - NLAT) * D);
#pragma unroll
            for (int j = 0; j < 4; ++j) v[j] = *(const f32x4*)(src + 4 * lane + 256 * j); }
        else {
            const float* src = XR + (size_t)r * D;
#pragma unroll
            for (int j = 0; j < 4; ++j) v[j] = *(const f32x4*)(src + 4 * lane + 256 * j);
            const int* ti = WSP(int, WS_TOKINFO) + (size_t)r * 4;
            f32x4 a[4];
#pragma unroll
            for (int j = 0; j < 4; ++j) a[j] = (f32x4){0.f, 0.f, 0.f, 0.f};
#pragma unroll
            for (int k = 0; k < 4; ++k) { const int inf = ti[k]; const int e = (inf >> 24) & 31, rank = inf & 0xffffff; const size_t pos = (size_t)ts[e] * 256 + rank;
                const bf16_t* eo = WSP(bf16_t, WS_EO) + pos * D; const float wk = WSP(float, WS_TOKW)[(size_t)r * 4 + k]; const float* bd = FIN(27) + ((size_t)(l - 1) * NEXP + e) * D;
#pragma unroll
                for (int j = 0; j < 4; ++j) { const u32x2 w = *(const u32x2*)(eo + 4 * lane + 256 * j); const f32x4 b4 = *(const f32x4*)(bd + 4 * lane + 256 * j);
                    a[j].x += wk * (bflo(w.x) + b4.x); a[j].y += wk * (bfhi(w.x) + b4.y); a[j].z += wk * (bflo(w.y) + b4.z); a[j].w += wk * (bfhi(w.y) + b4.w); } }
            const float* m5 = MOD + ((size_t)(l - 1) * 5 + bi) * 6144 + 5 * D;
#pragma unroll
            for (int j = 0; j < 4; ++j) { const f32x4 g5 = *(const f32x4*)(m5 + 4 * lane + 256 * j) * dsc; v[j] = v[j] + g5 * a[j]; }
        }
        if (!fin) {
#pragma unroll
            for (int j = 0; j < 4; ++j) *(f32x4*)(XR + (size_t)r * D + 4 * lane + 256 * j) = v[j];
        }
        float ss = 0.f;
#pragma unroll
        for (int j = 0; j < 4; ++j) ss += (v[j].x * v[j].x + v[j].y * v[j].y) + (v[j].z * v[j].z + v[j].w * v[j].w);
        const float rinv = 1.0f / sqrtf(wave_sum(ss) * (1.0f / D) + RMS_EPS);
        if (fin) {
#pragma unroll
            for (int j = 0; j < 4; ++j) { const f32x4 g = *(const f32x4*)(FIN(28) + 4 * lane + 256 * j); *(f32x4*)(A->out + (size_t)r * D + 4 * lane + 256 * j) = v[j] * rinv * g; }
        } else {
            const float* gm = FIN(6) + (size_t)l * D; const float* m0 = MOD + ((size_t)l * 5 + bi) * 6144; const float* m1 = m0 + D;
            bf16_t* hrow = WSP(bf16_t, WS_H) + (size_t)r * D;
#pragma unroll
            for (int j = 0; j < 4; ++j) { const int c = 4 * lane + 256 * j; const f32x4 g = *(const f32x4*)(gm + c), sh = *(const f32x4*)(m0 + c), sc = *(const f32x4*)(m1 + c);
                const f32x4 h = v[j] * rinv * g * (sc + 1.0f) + sh;
                u32x2 o; o.x = pk2(h.x, h.y); o.y = pk2(h.z, h.w); *(u32x2*)(hrow + c) = o; }
        }
    }
}

__device__ __forceinline__ void phase_router(KArgs A, Frame& F, int l, const bool dry = false) {
    PH_LOCALS;
    const int nrows = (l == DEPTH - 1) ? NLAT : TT;
    LAS bf16_t* tile = (LAS bf16_t*)F.lds;
    LAS float* part = (LAS float*)(F.lds + 32 * 1032 * 2);
    LAS float* logit = part + 8 * 32 * 33;
    LAS int* lcnt = (LAS int*)(logit + 32 * 33);
    const float* MOD = WSP(float, WS_MOD);
    float* XR = WSP(float, WS_XR);
    const bf16_t* WRT = WSP(bf16_t, WS_WRT) + (size_t)l * NEXP * D;
    int* cnt = (int*)A->ws + CW_CNT + l * 32 + (dry ? 128 : 0);
    int* elist = dry ? (int*)WSP(float, WS_ELW) : WSP(int, WS_ELIST);
    const float dsc = dry ? 0.0f : 1.0f;
    for (int u = F.bid; u < nrows / 32; u += F.G) {
        const int r0 = u * 32;
        {
            const int rb = r0 + wave * 4; const int bi = (rb < NLAT) ? (rb / SEQ) : 4;
            const float* m2 = MOD + ((size_t)l * 5 + bi) * 6144 + 2 * D; const float* gm = FIN(21) + (size_t)l * D;
            f32x4 v[4][4]; u32x2 dw[4][4];
#pragma unroll
            for (int q = 0; q < 4; ++q)
#pragma unroll
                for (int j = 0; j < 4; ++j) { const int c = 4 * lane + 256 * j; v[q][j] = *(const f32x4*)(XR + (size_t)(rb + q) * D + c); dw[q][j] = *(const u32x2*)(WSP(bf16_t, WS_DELTA) + (size_t)(rb + q) * D + c); }
            float ss[4];
#pragma unroll
            for (int q = 0; q < 4; ++q) { ss[q] = 0.f;
#pragma unroll
                for (int j = 0; j < 4; ++j) { const int c = 4 * lane + 256 * j; const f32x4 g2 = *(const f32x4*)(m2 + c) * dsc;
                    v[q][j].x += g2.x * bflo(dw[q][j].x); v[q][j].y += g2.y * bfhi(dw[q][j].x); v[q][j].z += g2.z * bflo(dw[q][j].y); v[q][j].w += g2.w * bfhi(dw[q][j].y);
                    *(f32x4*)(XR + (size_t)(rb + q) * D + c) = v[q][j];
                    ss[q] += (v[q][j].x * v[q][j].x + v[q][j].y * v[q][j].y) + (v[q][j].z * v[q][j].z + v[q][j].w * v[q][j].w); } }
#pragma unroll
            for (int o = 1; o < 64; o <<= 1) {
#pragma unroll
                for (int q = 0; q < 4; ++q) ss[q] += __shfl_xor(ss[q], o); }
#pragma unroll
            for (int q = 0; q < 4; ++q) { const float rinv = 1.0f / sqrtf(ss[q] * (1.0f / D) + RMS_EPS);
                bf16_t* hrow = WSP(bf16_t, WS_H) + (size_t)(rb + q) * D;
#pragma unroll
                for (int j = 0; j < 4; ++j) { const int c = 4 * lane + 256 * j; const f32x4 g = *(const f32x4*)(gm + c), sh = *(const f32x4*)(m2 + D + c), sc = *(const f32x4*)(m2 + 2 * D + c);
                    const f32x4 h = v[q][j] * rinv * g * (sc + 1.0f) + sh;
                    u32x2 o; o.x = pk2(h.x, h.y); o.y = pk2(h.z, h.w); *(u32x2*)(hrow + c) = o; *(LAS u32x2*)(tile + (wave * 4 + q) * 1032 + c) = o; } }
        }
        if (tid < 32) lcnt[tid] = 0;
        __syncthreads();
        {
            f32x16 acc;
#pragma unroll
            for (int i = 0; i < 16; ++i) acc[i] = 0.f;
            const int rr = lane & 31, hh = lane >> 5;
            bf16x8 bw[8];
#pragma unroll
            for (int s = 0; s < 8; ++s) bw[s] = *(const bf16x8*)(WRT + (size_t)rr * D + wave * 128 + 16 * s + 8 * hh);
#pragma unroll
            for (int s = 0; s < 8; ++s) { const bf16x8 a = *(const LAS bf16x8*)(tile + rr * 1032 + wave * 128 + 16 * s + 8 * hh);
                acc = __builtin_amdgcn_mfma_f32_32x32x16_bf16(a, bw[s], acc, 0, 0, 0); }
#pragma unroll
            for (int i = 0; i < 16; ++i) { const int tok = (i & 3) + 8 * (i >> 2) + 4 * hh; part[(wave * 32 + tok) * 33 + rr] = acc[i]; }
        }
        __syncthreads();
        for (int i = tid; i < 1024; i += NTHREADS) { const int tok = i >> 5, e = i & 31; float s = FIN(23)[l * 32 + e];
#pragma unroll
            for (int w = 0; w < 8; ++w) s += part[(w * 32 + tok) * 33 + e];
            logit[tok * 33 + e] = s; }
        __syncthreads();
        if (wave == 0) {
            const int t = lane & 31, r = r0 + t; const bool act = lane < 32;
            float lg[32];
#pragma unroll
            for (int e = 0; e < 32; ++e) lg[e] = logit[t * 33 + e];
            float lv[4]; int le[4];
#pragma unroll
            for (int k = 0; k < 4; ++k) { float best = -3.0e38f; int be = 0;
#pragma unroll
                for (int e = 0; e < 32; ++e) { const bool gt = lg[e] > best; best = gt ? lg[e] : best; be = gt ? e : be; }
#pragma unroll
                for (int e = 0; e < 32; ++e) lg[e] = (e == be) ? -3.0e38f : lg[e];
                lv[k] = best; le[k] = be; }
            const float e1 = __expf(lv[1] - lv[0]), e2 = __expf(lv[2] - lv[0]), e3 = __expf(lv[3] - lv[0]); const float inv = 1.0f / (1.0f + e1 + e2 + e3);
            const float wk[4] = {inv, e1 * inv, e2 * inv, e3 * inv};
            int lr[4];
#pragma unroll
            for (int k = 0; k < 4; ++k) lr[k] = act ? __hip_atomic_fetch_add(lcnt + le[k], 1, __ATOMIC_RELAXED, __HIP_MEMORY_SCOPE_WORKGROUP) : 0;
            asm volatile("s_waitcnt lgkmcnt(0)" ::: "memory");
            if (act) { const int c = lcnt[t]; const int base = c ? atomicAdd(&cnt[t], c) : 0; lcnt[32 + t] = base; }
            asm volatile("s_waitcnt vmcnt(0) lgkmcnt(0)" ::: "memory");
            if (act) {
                int* ti = WSP(int, WS_TOKINFO) + (size_t)r * 4;
#pragma unroll
                for (int k = 0; k < 4; ++k) { const int rank = lcnt[32 + le[k]] + lr[k];
                    elist[(size_t)le[k] * TT + rank] = r; if (!dry) { WSP(float, WS_TOKW)[(size_t)r * 4 + k] = wk[k]; ti[k] = (le[k] << 24) | rank; } }
            }
        }
        __syncthreads();
    }
}

__device__ __forceinline__ void phase_s5scan(KArgs A, Frame& F, int l) {
    PH_LOCALS;
    const int gw = F.bid * NWAVES + wave, NGW = F.G * NWAVES;
    const float* SL = WSP(float, WS_SLOC);
    for (int it = gw; it < NBATCH * 16 * 2; it += NGW) {
        const int dir = it & 1, g = (it >> 1) & 15, b = it >> 5;
        const int ldg = (l * 2 + dir) * 16 + g;
        const f32x2 L64 = WSP(f32x2, WS_LP)[((size_t)ldg * 65 + 64) * 64 + lane];
        bf16_t* sux = WSP(bf16_t, WS_SUX) + (size_t)g * MCH * SUXW;
        float xr = 0.f, xi = 0.f;
#pragma unroll 4
        for (int step = 0; step < 132; ++step) {
            int ch;
            if (step < 4) ch = 512 + 4 * b + (dir ? 3 - step : step);
            else ch = 128 * b + (dir ? 127 - (step - 4) : (step - 4));
            const float sr = SL[(size_t)ch * 4096 + g * 256 + dir * 128 + lane], si = SL[(size_t)ch * 4096 + g * 256 + dir * 128 + 64 + lane];
            bf16_t* o = sux + (size_t)ch * SUXW + 1024 + dir * 128;
            o[lane] = (unsigned short)f2bf(xr); o[64 + lane] = (unsigned short)f2bf(xi);
            const float nr = L64.x * xr - L64.y * xi + sr, ni = L64.x * xi + L64.y * xr + si;
            xr = nr; xi = ni;
        }
    }
}

constexpr float LOG2E = 1.4426950408889634f;
constexpr int AT_STEP = 32768;
constexpr int AT_RPB = 3 * AT_STEP;
__device__ __forceinline__ void attn_stage(const bf16_t* P, const bf16_t* VT, LAS unsigned char* lds, int slot, int ktok0, int kcol, int vrow, int lane, int wave) {
    LAS unsigned char* base = lds + slot * AT_STEP + wave * 1024;
#pragma unroll
    for (int j = 0; j < 2; ++j) {
        const int dc = 4 * j + (wave >> 1), key = (wave & 1) * 64 + lane;
        __builtin_amdgcn_global_load_lds((const unsigned*)(P + (size_t)(ktok0 + key) * PW + kcol + 8 * dc), (LAS unsigned*)(base + j * 8192), 16, 0, 0);
    }
#pragma unroll
    for (int j = 0; j < 2; ++j) {
        const int q = 8 * j + wave;
        __builtin_amdgcn_global_load_lds((const unsigned*)(VT + (size_t)(vrow + lane) * TT + ktok0 + 8 * q), (LAS unsigned*)(base + 16384 + j * 8192), 16, 0, 0);
    }
}
template <int MM>
__device__ __forceinline__ void attn_tile(const LAS unsigned char* kt_, const LAS unsigned char* vt_, const bf16x8 (&qf)[4], f32x16& O0, f32x16& O1, float& m, float& lsum,
                                          const LAS float* bptr, unsigned vmask, int dbase) {
    bf16x8 kf[4];
#pragma unroll
    for (int q = 0; q < 4; ++q) kf[q] = *(const LAS bf16x8*)(kt_ + q * 2048);
    bf16x8 vf[2][2];
#pragma unroll
    for (int mt = 0; mt < 2; ++mt)
#pragma unroll
        for (int s2 = 0; s2 < 2; ++s2) vf[mt][s2] = *(const LAS bf16x8*)(vt_ + s2 * 1024 + mt * 512);
    f32x16 sa;
#pragma unroll
    for (int i = 0; i < 16; ++i) sa[i] = 0.f;
#pragma unroll
    for (int q = 0; q < 4; ++q) sa = __builtin_amdgcn_mfma_f32_32x32x16_bf16(kf[q], qf[q], sa, 0, 0, 0);
    float sv[16]; float tmax = -3.0e38f;
#pragma unroll
    for (int i = 0; i < 16; ++i) {
        const int ko = (i & 3) + 8 * (i >> 2);
        float x;
        if (MM == 0) x = sa[i] * (0.125f * LOG2E);
        else if (MM == 1) { x = sa[i] * (0.125f * LOG2E) + bptr[ko]; x = ((vmask >> i) & 1u) ? x : -3.0e38f; }
        else { const int dpos = dbase - ko; x = sa[i] * (0.125f * LOG2E); x = (dpos <= 128 && dpos >= -128) ? x : -3.0e38f; }
        sv[i] = x; tmax = fmaxf(tmax, x);
    }
    tmax = fmaxf(tmax, __shfl_xor(tmax, 32));
    if (__any(tmax > m)) {
        const float mnew = fmaxf(m, tmax); const float alpha = fast_exp2(m - mnew);
        lsum *= alpha; m = mnew;
#pragma unroll
        for (int i = 0; i < 16; ++i) { O0[i] *= alpha; O1[i] *= alpha; }
    }
    float psum = 0.f;
#pragma unroll
    for (int i = 0; i < 16; ++i) { const float p = fast_exp2(sv[i] - m); psum += p; sv[i] = p; }
    psum += __shfl_xor(psum, 32);
    lsum += psum;
#pragma unroll
    for (int s2 = 0; s2 < 2; ++s2) {
        u32x4 pw; pw.x = cvt_pk_bf16(sv[8 * s2 + 0], sv[8 * s2 + 1]); pw.y = cvt_pk_bf16(sv[8 * s2 + 2], sv[8 * s2 + 3]); pw.z = cvt_pk_bf16(sv[8 * s2 + 4], sv[8 * s2 + 5]); pw.w = cvt_pk_bf16(sv[8 * s2 + 6], sv[8 * s2 + 7]);
        const bf16x8 pf = __builtin_bit_cast(bf16x8, pw);
        O0 = __builtin_amdgcn_mfma_f32_32x32x16_bf16(vf[0][s2], pf, O0, 0, 0, 0);
        O1 = __builtin_amdgcn_mfma_f32_32x32x16_bf16(vf[1][s2], pf, O1, 0, 0, 0);
    }
}
__device__ __forceinline__ void phase_attn(KArgs A, Frame& F, int l) {
    PH_LOCALS;
    LAS unsigned char* lds = F.lds;
    LAS float* rpb = (LAS float*)(lds + AT_RPB);
    for (int i = tid; i < 6 * 465; i += NTHREADS) rpb[i] = FIN(9)[(size_t)l * 6 * 465 + i] * LOG2E;
    __syncthreads();
    const bf16_t* P = WSP(bf16_t, WS_P); const bf16_t* VT = WSP(bf16_t, WS_VT);
    const int r = lane & 31, hh = lane >> 5;
    const int ngroups = 1536 + ((l < DEPTH - 1) ? 48 : 0);
    for (int gi = F.bid; gi < ngroups; gi += F.G) {
        int mode, b, head, r0 = 0, qt0 = 0;
        if (gi < 768) { mode = 0; r0 = 4 * (gi & 31); const int bh = gi >> 5; head = bh % 6; b = bh / 6; }
        else if (gi < 1536) { mode = 1; const int g2 = gi - 768; qt0 = 8 * (g2 & 31); const int bh = g2 >> 5; head = bh % 6; b = bh / 6; }
        else { const int g2 = gi - 1536; mode = 2 + g2 / 24; const int bh = g2 % 24; head = bh % 6; b = bh / 6; }
        const bool na = (mode == 0 || mode == 2);
        const int qcol = na ? 64 * head : 768 + 64 * head, kcol = na ? 384 + 64 * head : 1152 + 64 * (head / 3);
        const int vrow = na ? 64 * head : 384 + 64 * (head / 3), ycol = na ? 64 * head : 640 + 64 * head;
        int qtok0, qrow = 0, mh = 0, qt = 0;
        if (mode == 0) { qrow = r0 + (wave >> 1); mh = wave & 1; qtok0 = b * SEQ + qrow * 64 + 32 * mh; }
        else if (mode == 1) { qt = qt0 + wave; qtok0 = b * SEQ + 32 * qt; }
        else qtok0 = NLAT + b * CTXL + 32 * wave;
        const int rsw = min(max(qrow - 4, 0), 120);
        const int qc = 32 * mh + r, wsn = min(max(qc - 8, 0), 48);
        const int qpos = 32 * qt + r;
        unsigned vmask0 = 0u, vmask1 = 0u;
#pragma unroll
        for (int i = 0; i < 16; ++i) { const int ki = (i & 3) + 8 * (i >> 2) + 4 * hh; vmask0 |= ((ki >= wsn && ki < wsn + 16) ? 1u : 0u) << i; vmask1 |= ((32 + ki >= wsn && 32 + ki < wsn + 16) ? 1u : 0u) << i; }
        int nlat = 0, kbase = 0, kofs = 0;
        if (mode == 0) { const int kra = min(max(r0 - 4, 0), 120), krb = min(max(r0 - 1, 0), 120) + 7; kbase = kra >> 1; kofs = (kra & 1) * 64; nlat = (krb - kra + 2) >> 1; }
        else if (mode == 1) { const int ks0 = max(qt0 - 4, 0) >> 2, ks1 = min(qt0 + 11, 255) >> 2; kbase = ks0; nlat = ks1 - ks0 + 1; }
        const int nsteps = nlat + 2;
        const int lat0 = b * SEQ + 128 * kbase + kofs, ctx0 = NLAT + b * CTXL;
        float m = na ? -1e30f : FIN(20)[l * 6 + head] * LOG2E, lsum = na ? 0.f : 1.f;
        bf16x8 qf[4];
#pragma unroll
        for (int s = 0; s < 4; ++s) qf[s] = *(const bf16x8*)(P + (size_t)(qtok0 + r) * PW + qcol + 32 * hh + 8 * s);
        f32x16 O0, O1;
#pragma unroll
        for (int i = 0; i < 16; ++i) { O0[i] = 0.f; O1[i] = 0.f; }
        __builtin_amdgcn_s_barrier();
        attn_stage(P, VT, lds, 0, (nlat > 0) ? lat0 : ctx0, kcol, vrow, lane, wave);
        attn_stage(P, VT, lds, 1, (nlat > 1) ? lat0 + 128 : ctx0 + 128 * (1 - nlat), kcol, vrow, lane, wave);
        for (int s = 0; s < nsteps; ++s) {
            if (s + 1 < nsteps) asm volatile("s_waitcnt vmcnt(4)" ::: "memory"); else asm volatile("s_waitcnt vmcnt(0)" ::: "memory");
            __builtin_amdgcn_s_barrier();
            if (s + 2 < nsteps) { const int s2 = s + 2; attn_stage(P, VT, lds, s2 % 3, (s2 < nlat) ? lat0 + 128 * s2 : ctx0 + 128 * (s2 - nlat), kcol, vrow, lane, wave); }
            const bool isctx = (s >= nlat);
            const LAS unsigned char* kb = lds + (s % 3) * AT_STEP; const LAS unsigned char* vb = kb + 16384;
#pragma unroll 1
            for (int tl = 0; tl < 4; ++tl) {
                const int kr = 2 * (kbase + s) + (kofs >> 6) + (tl >> 1), ct = tl & 1;
                const int kt = 4 * (kbase + s) + tl;
                int dt = kt - qt; dt = dt < 0 ? -dt : dt;
                if (!isctx && mode == 0 && (kr < rsw || kr > rsw + 7)) continue;
                if (!isctx && mode == 1 && dt > 4) continue;
                const LAS unsigned char* kt_ = kb + ((4 * hh) * 128 + 32 * tl + r) * 16;
                const LAS unsigned char* vt_ = vb + ((tl * 4 + hh * 2) * 64 + r) * 16;
                if (isctx || (mode == 1 && dt < 4)) attn_tile<0>(kt_, vt_, qf, O0, O1, m, lsum, nullptr, 0u, 0);
                else if (mode == 0) attn_tile<1>(kt_, vt_, qf, O0, O1, m, lsum, rpb + head * 465 + (kr - qrow + 7) * 31 + (32 * ct + 4 * hh - qc + 15), ct ? vmask1 : vmask0, 0);
                else attn_tile<2>(kt_, vt_, qf, O0, O1, m, lsum, nullptr, 0u, qpos - 32 * kt - 4 * hh);
            }
        }
        const float inv = 1.0f / lsum;
        bf16_t* yrow = WSP(bf16_t, WS_Y) + (size_t)(qtok0 + r) * D + ycol + 4 * hh;
#pragma unroll
        for (int rg = 0; rg < 4; ++rg) {
            u32x2 o0; o0.x = cvt_pk_bf16(O0[4 * rg + 0] * inv, O0[4 * rg + 1] * inv); o0.y = cvt_pk_bf16(O0[4 * rg + 2] * inv, O0[4 * rg + 3] * inv);
            u32x2 o1; o1.x = cvt_pk_bf16(O1[4 * rg + 0] * inv, O1[4 * rg + 1] * inv); o1.y = cvt_pk_bf16(O1[4 * rg + 2] * inv, O1[4 * rg + 3] * inv);
            *(u32x2*)(yrow + 8 * rg) = o0; *(u32x2*)(yrow + 32 + 8 * rg) = o1;
        }
    }
    asm volatile("s_waitcnt vmcnt(0)" ::: "memory");
    __builtin_amdgcn_s_barrier();
}

__device__ __forceinline__ int xcd_unit(int i, int G, int c, int U) {
    if ((G & 7) != 0) { const int idx = i * G + c; return idx < U ? idx : -1; }
    const int x = c & 7, j = c >> 3, per = G >> 3, q = U >> 3, r = U & 7;
    const int start = x * q + (x < r ? x : r), size = q + (x < r ? 1 : 0);
    const int loc = i * per + j;
    return loc < size ? start + loc : -1;
}
#define ACC8(ai, bj, m) const f32x4 a0_ = acc[ai][bj][m][0], a1_ = acc[ai][bj][m][1]; float v[8] = {a0_[0], a0_[1], a0_[2], a0_[3], a1_[0], a1_[1], a1_[2], a1_[3]}
__device__ __forceinline__ u32x4 pack8(const float* v) { u32x4 w; w.x = cvt_pk_bf16(v[0], v[1]); w.y = cvt_pk_bf16(v[2], v[3]); w.z = cvt_pk_bf16(v[4], v[5]); w.w = cvt_pk_bf16(v[6], v[7]); return w; }

struct SchedInproj { int G, c; const char* H; const char* W;
    __device__ __forceinline__ bool next(int i, GUnit& u) const {
        const int idx = xcd_unit(i, G, c, 1056); if (idx < 0) return false;
        if (idx < 792) { const int pm = idx / 6, pn = idx % 6; u.A = H + (size_t)pm * 256 * 2048; u.B = W + (size_t)pn * 256 * 2048; u.p0 = 0; u.p1 = pm; u.p2 = pn; u.p3 = 0; }
        else { const int j = idx - 792, vm = j / 132, tn = j % 132; u.A = W + (size_t)(1536 + 256 * vm) * 2048; u.B = H + (size_t)tn * 256 * 2048; u.p0 = 1; u.p1 = vm; u.p2 = tn; u.p3 = 0; }
        return true; }
    __device__ __forceinline__ int row_token(const GUnit&, int) const { return 0; }
    __device__ __forceinline__ void pre(const GUnit&, int, int, int) const {}
};
struct EpiInproj { bf16_t* P; bf16_t* VT; bf16_t* SUX; const LAS float* ROPE;
    __device__ __forceinline__ void operator()(const AccT& acc, const GUnit& u, int slot, int wr, int wc, int fr, int fq) const {
        if (u.p0 == 1) {
#pragma unroll
            for (int ai = 0; ai < 2; ++ai)
#pragma unroll
                for (int m = 0; m < 4; ++m) { const int row = u.p1 * 256 + 128 * ai + 64 * wr + 16 * m + fr;
#pragma unroll
                    for (int bj = 0; bj < 2; ++bj) { ACC8(ai, bj, m); const u32x4 w = pack8(v);
                        bf16_t* vp = VT + (size_t)row * TT + u.p2 * 256 + 128 * bj + 32 * wc + 8 * (fq >> 1) + 4 * (fq & 1);
                        *(u32x2*)vp = (u32x2){w.x, w.y}; *(u32x2*)(vp + 16) = (u32x2){w.z, w.w}; } }
            return;
        }
        const int pm = u.p1, pn = u.p2;
#pragma unroll
        for (int bj = 0; bj < 2; ++bj) {
            const int hh = 2 * pn + bj;
#pragma unroll
            for (int ai = 0; ai < 2; ++ai)
#pragma unroll
                for (int m = 0; m < 4; ++m) {
                    const int row = pm * 256 + 128 * ai + 64 * wr + 16 * m + fr;
                    ACC8(ai, bj, m);
                    if (hh >= 10) {
                        const int g = 8 * (hh - 10) + 2 * wc + (fq >> 1);
                        *(u32x4*)(SUX + ((size_t)g * MCH + (row >> 6)) * SUXW + (row & 63) * 16 + 8 * (fq & 1)) = pack8(v);
                    } else {
                        if (hh >= 6 && pm < 128) {
                            const int t = row & (SEQ - 1); const int pos = (wc & 1) ? (t & 63) : (t >> 6);
                            const LAS float* cs = ROPE + pos * 16 + 8 * (fq & 1);
                            const f32x4 c0 = *(const LAS f32x4*)cs, c1 = *(const LAS f32x4*)(cs + 4), s0 = *(const LAS f32x4*)(cs + 2048), s1 = *(const LAS f32x4*)(cs + 2052);
                            const float cc[8] = {c0[0], c0[1], c0[2], c0[3], c1[0], c1[1], c1[2], c1[3]}, sn[8] = {s0[0], s0[1], s0[2], s0[3], s1[0], s1[1], s1[2], s1[3]};
#pragma unroll
                            for (int e = 0; e < 8; ++e) { const float pr = __shfl_xor(v[e], 32); v[e] = v[e] * cc[e] + ((fq < 2) ? -pr : pr) * sn[e]; }
                        }
                        *(u32x4*)(P + (size_t)row * PW + 128 * hh + 32 * wc + 8 * fq) = pack8(v);
                    }
                }
        }
    }
};
struct SchedS5a { int G, c; const char* SUX; const char* W;
    __device__ __forceinline__ bool next(int i, GUnit& u) const {
        const int idx = xcd_unit(i, G, c, 48); if (idx < 0) return false;
        const int g = idx / 3, pm = idx % 3; u.A = SUX + ((size_t)g * MCH + pm * 256) * (SUXW * 2); u.B = W + (size_t)g * 256 * 2048; u.p0 = 0; u.p1 = pm; u.p2 = g; u.p3 = 0; return true; }
    __device__ __forceinline__ int row_token(const GUnit&, int) const { return 0; }
    __device__ __forceinline__ void pre(const GUnit&, int, int, int) const {}
};
struct EpiS5a { float* SL;
    __device__ __forceinline__ void operator()(const AccT& acc, const GUnit& u, int slot, int wr, int wc, int fr, int fq) const {
#pragma unroll
        for (int ai = 0; ai < 2; ++ai)
#pragma unroll
            for (int m = 0; m < 4; ++m) { float* rowp = SL + (size_t)(u.p1 * 256 + 128 * ai + 64 * wr + 16 * m + fr) * 4096 + u.p2 * 256 + 32 * wc + 8 * fq;
#pragma unroll
                for (int bj = 0; bj < 2; ++bj) { *(f32x4*)(rowp + 128 * bj) = acc[ai][bj][m][0]; *(f32x4*)(rowp + 128 * bj + 4) = acc[ai][bj][m][1]; } }
    }
};
struct SchedS5c { int G, c; const char* SUX; const char* KC;
    __device__ __forceinline__ bool next(int i, GUnit& u) const {
        const int idx = xcd_unit(i, G, c, 192); if (idx < 0) return false;
        const int g = idx / 12, q = idx % 12, pm = q / 4, pn = q % 4;
        u.A = SUX + ((size_t)g * MCH + pm * 256) * (SUXW * 2); u.B = KC + ((size_t)g * 1024 + pn * 256) * (SUXW * 2); u.p0 = 0; u.p1 = pm; u.p2 = pn; u.p3 = g; return true; }
    __device__ __forceinline__ int row_token(const GUnit&, int) const { return 0; }
    __device__ __forceinline__ void pre(const GUnit&, int, int, int) const {}
};
struct EpiS5c { bf16_t* Gb;
    __device__ __forceinline__ void operator()(const AccT& acc, const GUnit& u, int slot, int wr, int wc, int fr, int fq) const {
#pragma unroll
        for (int ai = 0; ai < 2; ++ai)
#pragma unroll
            for (int m = 0; m < 4; ++m) { const int chunk = u.p1 * 256 + 128 * ai + 64 * wr + 16 * m + fr;
                if (chunk < TT / 64) {
#pragma unroll
                    for (int bj = 0; bj < 2; ++bj) { ACC8(ai, bj, m); const int col = u.p2 * 256 + 128 * bj + 32 * wc + 8 * fq;
#pragma unroll
                        for (int e = 0; e < 8; ++e) v[e] = gelu_tanh(v[e]);
                        *(u32x4*)(Gb + ((size_t)chunk * 64 + (col >> 4)) * 256 + u.p3 * 16 + (col & 15)) = pack8(v); } } }
    }
};
struct SchedGlu { int G, c; const char* Gb; const char* W;
    __device__ __forceinline__ bool next(int i, GUnit& u) const {
        const int idx = xcd_unit(i, G, c, 132); if (idx < 0) return false;
        u.A = Gb + (size_t)idx * 256 * 512; u.B = W; u.p0 = 0; u.p1 = idx; u.p2 = 0; u.p3 = 0; return true; }
    __device__ __forceinline__ int row_token(const GUnit&, int) const { return 0; }
    __device__ __forceinline__ void pre(const GUnit&, int, int, int) const {}
};
struct EpiGlu { const bf16_t* Gb; bf16_t* Y; const float* bglu;
    __device__ __forceinline__ void operator()(const AccT& acc, const GUnit& u, int slot, int wr, int wc, int fr, int fq) const {
#pragma unroll
        for (int bj = 0; bj < 2; ++bj) { const int col = 128 * bj + 32 * wc + 8 * fq;
            const f32x4 b0 = *(const f32x4*)(bglu + col), b1 = *(const f32x4*)(bglu + col + 4); const float bb[8] = {b0[0], b0[1], b0[2], b0[3], b1[0], b1[1], b1[2], b1[3]};
            u32x4 gw[2][4];
#pragma unroll
            for (int ai = 0; ai < 2; ++ai)
#pragma unroll
                for (int m = 0; m < 4; ++m) gw[ai][m] = *(const u32x4*)(Gb + (size_t)(u.p1 * 256 + 128 * ai + 64 * wr + 16 * m + fr) * 256 + col);
#pragma unroll
            for (int ai = 0; ai < 2; ++ai)
#pragma unroll
                for (int m = 0; m < 4; ++m) { const int row = u.p1 * 256 + 128 * ai + 64 * wr + 16 * m + fr; ACC8(ai, bj, m);
                    const u32x4 g4 = gw[ai][m];
                    const float gv[8] = {bflo(g4.x), bfhi(g4.x), bflo(g4.y), bfhi(g4.y), bflo(g4.z), bfhi(g4.z), bflo(g4.w), bfhi(g4.w)};
#pragma unroll
                    for (int e = 0; e < 8; ++e) v[e] = gv[e] * sigmoidf_(v[e] + bb[e]);
                    *(u32x4*)(Y + (size_t)row * D + 384 + col) = pack8(v); } }
    }
};
struct SchedOut { int G, c, nunits; const char* Y; const char* W;
    __device__ __forceinline__ bool next(int i, GUnit& u) const {
        const int idx = xcd_unit(i, G, c, nunits); if (idx < 0) return false;
        const int pm = idx >> 2, pn = idx & 3; u.A = Y + (size_t)pm * 256 * 2048; u.B = W + (size_t)pn * 256 * 2048; u.p0 = 0; u.p1 = pm; u.p2 = pn; u.p3 = 0; return true; }
    __device__ __forceinline__ int row_token(const GUnit&, int) const { return 0; }
    __device__ __forceinline__ void pre(const GUnit&, int, int, int) const {}
};
struct EpiOut { bf16_t* DL;
    __device__ __forceinline__ void operator()(const AccT& acc, const GUnit& u, int slot, int wr, int wc, int fr, int fq) const {
#pragma unroll
        for (int ai = 0; ai < 2; ++ai)
#pragma unroll
            for (int m = 0; m < 4; ++m) { bf16_t* rowp = DL + (size_t)(u.p1 * 256 + 128 * ai + 64 * wr + 16 * m + fr) * D + u.p2 * 256 + 32 * wc + 8 * fq;
#pragma unroll
                for (int bj = 0; bj < 2; ++bj) { ACC8(ai, bj, m); *(u32x4*)(rowp + 128 * bj) = pack8(v); } }
    }
};
struct SchedMoe { int G, c, NT; const LAS int* ts; const char* A; const char* W; size_t wstride; const int* elist; bool gather; const float* bgu; LAS unsigned char* lds;
    __device__ __forceinline__ bool next(int i, GUnit& u) const {
        const int idx = xcd_unit(i, G, c, ts[32] * NT); if (idx < 0) return false;
        const int mt = idx / NT, pn = idx % NT; int e = 0; while (ts[e + 1] <= mt) ++e;
        u.A = gather ? A : (A + (size_t)mt * 256 * 2048); u.B = W + (size_t)e * wstride + (size_t)pn * 256 * 2048; u.p0 = mt; u.p1 = pn; u.p2 = e; u.p3 = (mt - ts[e]) * 256; return true; }
    __device__ __forceinline__ int row_token(const GUnit& u, int row) const { const int j = u.p3 + row; return (j < ts[40 + u.p2]) ? elist[(size_t)u.p2 * TT + j] : 0; }
    __device__ __forceinline__ void pre(const GUnit& u, int slot, int wid, int lane) const {
        if (bgu != nullptr && wid == 0) { const float* src = bgu + (size_t)u.p2 * 2048 + 128 * u.p1 + ((lane & 32) ? 1024 : 0) + 4 * (lane & 31);
            __builtin_amdgcn_global_load_lds((const unsigned*)src, (LAS unsigned*)(lds + LDS_BIAS + slot * 1024), 16, 0, 0); } }
};
struct EpiGateUp { bf16_t* ACT; LAS unsigned char* lds;
    __device__ __forceinline__ void operator()(const AccT& acc, const GUnit& u, int slot, int wr, int wc, int fr, int fq) const {
        const int col = 128 * u.p1 + 32 * wc + 8 * fq; const LAS float* bg = (const LAS float*)(lds + LDS_BIAS + slot * 1024) + 32 * wc + 8 * fq;
        const f32x4 g0 = *(const LAS f32x4*)bg, g1 = *(const LAS f32x4*)(bg + 4), u0 = *(const LAS f32x4*)(bg + 128), u1 = *(const LAS f32x4*)(bg + 132);
        const float bgate[8] = {g0[0], g0[1], g0[2], g0[3], g1[0], g1[1], g1[2], g1[3]}, bup[8] = {u0[0], u0[1], u0[2], u0[3], u1[0], u1[1], u1[2], u1[3]};
#pragma unroll
        for (int ai = 0; ai < 2; ++ai)
#pragma unroll
            for (int m = 0; m < 4; ++m) { const size_t row = (size_t)u.p0 * 256 + 128 * ai + 64 * wr + 16 * m + fr;
                const f32x4 ga = acc[ai][0][m][0], gb = acc[ai][0][m][1], ua = acc[ai][1][m][0], ub = acc[ai][1][m][1];
                const float gt[8] = {ga[0], ga[1], ga[2], ga[3], gb[0], gb[1], gb[2], gb[3]}, up[8] = {ua[0], ua[1], ua[2], ua[3], ub[0], ub[1], ub[2], ub[3]};
                float v[8];
#pragma unroll
                for (int e = 0; e < 8; ++e) { const float gg = fminf(gt[e] + bgate[e], 7.0f); const float uu = fminf(fmaxf(up[e] + bup[e], -7.0f), 7.0f); v[e] = gg * sigmoidf_(1.702f * gg) * (uu + 1.0f); }
                *(u32x4*)(ACT + row * FF + col) = pack8(v); }
    }
};
struct EpiDown { bf16_t* EO;
    __device__ __forceinline__ void operator()(const AccT& acc, const GUnit& u, int slot, int wr, int wc, int fr, int fq) const {
#pragma unroll
        for (int ai = 0; ai < 2; ++ai)
#pragma unroll
            for (int m = 0; m < 4; ++m) { bf16_t* rowp = EO + ((size_t)u.p0 * 256 + 128 * ai + 64 * wr + 16 * m + fr) * D + u.p1 * 256 + 32 * wc + 8 * fq;
#pragma unroll
                for (int bj = 0; bj < 2; ++bj) { ACC8(ai, bj, m); *(u32x4*)(rowp + 128 * bj) = pack8(v); } }
    }
};

constexpr int PH_PER_LAYER = 11, NPHASES = 2 + DEPTH * PH_PER_LAYER + 1;

__global__ void __launch_bounds__(NTHREADS, 2) mk_fwd(Args args) {
    extern __shared__ __attribute__((aligned(16))) unsigned char lds_raw[];
    Frame F;
    F.lds = (LAS unsigned char*)lds_raw;
    F.G = gridDim.x; F.bid = blockIdx.x;
    KArgs A0 = (KArgs)__builtin_amdgcn_kernarg_segment_ptr();
    KArgs A = A0; asm volatile("" : "+s"(A));
    volatile LAS unsigned* misc = (volatile LAS unsigned*)(F.lds + LDS_MISC);
    if (threadIdx.x < 16) misc[threadIdx.x] = 0u;
    __syncthreads();
    const int lo = A->ph_lo, hi = A->ph_hi;
    XcdBarrier bar; bar.bar = (unsigned*)A->ws + CW_BAR; bar.x = 0; bar.st = nullptr;
    if (hi - lo > 1) bar = xcd_barrier_post((unsigned*)A->ws + CW_BAR, misc + 8);
    LAS unsigned char* L = F.lds;
    const LAS int* ts = (const LAS int*)(F.lds + LDS_MISC + 64);
    int ph = 0;
#ifdef ONLY_SITE
#define SITE_ON(s) ((s) == ONLY_SITE)
#else
#define SITE_ON(s) true
#endif
#ifndef DUP_MASK
#define DUP_MASK 0u
#endif
#define PH_RUN(s) (SITE_ON(s) && ph >= lo && ph < hi)
#define PH_REP(s) for (int rep_ = 0; rep_ < (((DUP_MASK >> (s)) & 1u) ? 2 : 1); ++rep_)
#define PH_END do { if (ph >= lo && ph + 1 < hi) xcd_barrier(bar); ++ph; A = A0; asm volatile("" : "+s"(A)); } while (0)

    if (PH_RUN(0)) PH_REP(0) phase_p0a(A, F);
    PH_END;
    if (PH_RUN(1)) PH_REP(1) phase_p0b(A, F);
    PH_END;
    for (int l = 0; l < DEPTH; ++l) {
        const bool lastl = (l == DEPTH - 1);
        if (PH_RUN(2)) { phase_norm1(A, F, l); if ((DUP_MASK >> 2) & 1u) phase_norm1(A, F, l, 0.0f); }
        PH_END;
        if (PH_RUN(3)) PH_REP(3) {
            SchedInproj S{F.G, F.bid, (const char*)WSP(bf16_t, WS_H), (const char*)(WSP(bf16_t, WS_WINT) + (size_t)l * 2048 * D)};
            { int t0 = threadIdx.x; asm volatile("" : "+v"(t0)); LAS float* rl = (LAS float*)(L + LDS_ROPE); const float* rg = WSP(float, WS_ROPE); for (int i = t0; i < 4096; i += NTHREADS) rl[i] = rg[i]; __syncthreads(); }
            EpiInproj E{WSP(bf16_t, WS_P), WSP(bf16_t, WS_VT), WSP(bf16_t, WS_SUX), (const LAS float*)(L + LDS_ROPE)};
            gemm_phase<false>(L, 16, 2048u, 2048u, S, E);
        }
        PH_END;
        if (PH_RUN(4)) PH_REP(4) {
            SchedS5a S{F.G, F.bid, (const char*)WSP(bf16_t, WS_SUX), (const char*)(WSP(bf16_t, WS_WST) + (size_t)l * 16 * 256 * 1024)};
            EpiS5a E{WSP(float, WS_SLOC)};
            gemm_phase<false>(L, 16, (unsigned)(SUXW * 2), 2048u, S, E);
        }
        PH_END;
        if (PH_RUN(5)) PH_REP(5) phase_s5scan(A, F, l);
        PH_END;
        if (PH_RUN(6)) PH_REP(6) {
            SchedS5c S{F.G, F.bid, (const char*)WSP(bf16_t, WS_SUX), (const char*)(WSP(bf16_t, WS_KC) + (size_t)l * 16 * 1024 * SUXW)};
            EpiS5c E{WSP(bf16_t, WS_G)};
            gemm_phase<false>(L, 20, (unsigned)(SUXW * 2), (unsigned)(SUXW * 2), S, E);
        }
        PH_END;
        if (PH_RUN(7)) PH_REP(7) {
            SchedGlu S{F.G, F.bid, (const char*)WSP(bf16_t, WS_G), (const char*)(WSP(bf16_t, WS_WGLUT) + (size_t)l * 256 * 256)};
            EpiGlu E{WSP(bf16_t, WS_G), WSP(bf16_t, WS_Y), FIN(19) + (size_t)l * 256};
            gemm_phase<false>(L, 4, 512u, 512u, S, E);
        }
        PH_END;
        if (PH_RUN(8)) PH_REP(8) phase_attn(A, F, l);
        PH_END;
        if (PH_RUN(9)) PH_REP(9) {
            SchedOut S{F.G, F.bid, (lastl ? 128 : 132) * 4, (const char*)WSP(bf16_t, WS_Y), (const char*)(WSP(bf16_t, WS_WOUTT) + (size_t)l * D * D)};
            EpiOut E{WSP(bf16_t, WS_DELTA)};
            gemm_phase<false>(L, 16, 2048u, 2048u, S, E);
        }
        PH_END;
        if (PH_RUN(10)) { phase_router(A, F, l); if ((DUP_MASK >> 10) & 1u) phase_router(A, F, l, true); }
        PH_END;
        if (PH_RUN(11)) PH_REP(11) {
            build_tstart(A, F, l);
            SchedMoe S{F.G, F.bid, 8, ts, (const char*)WSP(bf16_t, WS_H), (const char*)(WSP(bf16_t, WS_WGUT) + (size_t)l * NEXP * 2048 * D), (size_t)2048 * D * 2, WSP(int, WS_ELIST), true, FIN(25) + (size_t)l * NEXP * 2048, L};
            EpiGateUp E{WSP(bf16_t, WS_ACT), L};
            gemm_phase<true>(L, 16, 2048u, 2048u, S, E);
        }
        PH_END;
        if (PH_RUN(12)) PH_REP(12) {
            build_tstart(A, F, l);
            SchedMoe S{F.G, F.bid, 4, ts, (const char*)WSP(bf16_t, WS_ACT), (const char*)(WSP(bf16_t, WS_WDT) + (size_t)l * NEXP * D * FF), (size_t)D * FF * 2, WSP(int, WS_ELIST), false, nullptr, L};
            EpiDown E{WSP(bf16_t, WS_EO)};
            gemm_phase<false>(L, 16, 2048u, 2048u, S, E);
        }
        PH_END;
    }
    if (PH_RUN(13)) phase_norm1(A, F, DEPTH);
#undef PH_RUN
#undef PH_END
}
}

extern "C" void kernel_launch(void* const* d_in, const int* in_sizes, int n_in, void* d_out, int out_size, void* d_ws, size_t ws_size, hipStream_t stream) {
    static int grid = 0;
    if (grid == 0) {
        if (n_in != 29 || out_size != NLAT * D || ws_size < WS_END) { fprintf(stderr, "kernel_launch: unexpected shapes (n_in %d, out %d, ws %zu)\n", n_in, out_size, ws_size); grid = -1; return; }
        int dev = 0, cus = 0;
        if (hipGetDevice(&dev) != hipSuccess || hipDeviceGetAttribute(&cus, hipDeviceAttributeMultiprocessorCount, dev) != hipSuccess) { grid = -1; return; }
        if (hipFuncSetAttribute((const void*)mk_fwd, hipFuncAttributeMaxDynamicSharedMemorySize, LDS_BYTES) != hipSuccess) { fprintf(stderr, "kernel_launch: hipFuncSetAttribute failed\n"); grid = -1; return; }
        int per_cu = 0;
        if (hipOccupancyMaxActiveBlocksPerMultiprocessor(&per_cu, (const void*)mk_fwd, NTHREADS, LDS_BYTES) != hipSuccess || per_cu < 1) { fprintf(stderr, "kernel_launch: occupancy query reports %d\n", per_cu); }
        (void)hipGetLastError();
        grid = cus;
    }
    if (grid < 0) return;
    (void)hipMemsetAsync((char*)d_ws + WS_CTL, 0, 1 * MiB, stream);
    Args a{};
    for (int i = 0; i < 29; ++i) a.in[i] = (const float*)d_in[i];
    a.out = (float*)d_out; a.ws = (unsigned char*)d_ws;
#if MK_PER_PHASE
    for (int p = 0; p < NPHASES; ++p) { a.ph_lo = p; a.ph_hi = p + 1; hipLaunchKernelGGL(mk_fwd, dim3(grid), dim3(NTHREADS), LDS_BYTES, stream, a); }
#else
    a.ph_lo = 0; a.ph_hi = NPHASES;
    hipLaunchKernelGGL(mk_fwd, dim3(grid), dim3(NTHREADS), LDS_BYTES, stream, a);
#endif
}
```

```cpp
#include <hip/hip_runtime.h>
#include <cstdio>
#include <cstdint>

#ifndef MK_PER_PHASE
#define MK_PER_PHASE 0
#endif

#define LAS __attribute__((address_space(3)))
#define GAS __attribute__((address_space(1)))
typedef unsigned short bf16_t;
typedef short bf16x8 __attribute__((ext_vector_type(8)));
typedef float f32x4 __attribute__((ext_vector_type(4)));
typedef float f32x2 __attribute__((ext_vector_type(2)));
typedef float f32x16 __attribute__((ext_vector_type(16)));
typedef unsigned u32x4 __attribute__((ext_vector_type(4)));
typedef unsigned u32x2 __attribute__((ext_vector_type(2)));
typedef int v8i __attribute__((ext_vector_type(8)));
typedef int v4i __attribute__((ext_vector_type(4)));

namespace {
constexpr int D = 1024, NBATCH = 4, SEQ = 8192, DEPTH = 4, CTXL = 256;
constexpr int NLAT = NBATCH * SEQ;
constexpr int NCTX = NBATCH * CTXL;
constexpr int TT = NLAT + NCTX;
constexpr int PW = 1280;
constexpr int NEXP = 32, FF = 1024;
constexpr int MCH = 768;
constexpr int SUXW = 1280;
constexpr int MAXTILES = 560;
constexpr int NWAVES = 8, NTHREADS = 512;
constexpr float RMS_EPS = 1e-6f;

constexpr size_t MiB = 1ull << 20;
constexpr size_t WS_CTL = 0;
constexpr size_t WS_MOD = 1 * MiB;
constexpr size_t WS_ROPE = 2 * MiB;
constexpr size_t WS_LP = 3 * MiB;
constexpr size_t WS_BBAR = 8 * MiB;
constexpr size_t WS_WRT = 9 * MiB;
constexpr size_t WS_WGLUT = 10 * MiB;
constexpr size_t WS_WINT = 11 * MiB;
constexpr size_t WS_WOUTT = 27 * MiB;
constexpr size_t WS_WST = 35 * MiB;
constexpr size_t WS_KC = 67 * MiB;
constexpr size_t WS_WGUT = 227 * MiB;
constexpr size_t WS_WDT = 739 * MiB;
constexpr size_t WS_XR = 995 * MiB;
constexpr size_t WS_H = 1127 * MiB;
constexpr size_t WS_P = 1193 * MiB;
constexpr size_t WS_VT = 1276 * MiB;
constexpr size_t WS_SUX = 1309 * MiB;
constexpr size_t WS_SLOC = 1339 * MiB;
constexpr size_t WS_G = 1351 * MiB;
constexpr size_t WS_Y = 1368 * MiB;
constexpr size_t WS_ELIST = 1434 * MiB;
constexpr size_t WS_ELW = 1439 * MiB;
constexpr size_t WS_TOKINFO = 1444 * MiB;
constexpr size_t WS_ACT = 1445 * MiB;
constexpr size_t WS_EO = 1725 * MiB;
constexpr size_t WS_TOKW = 2005 * MiB;
constexpr size_t WS_DELTA = 2006 * MiB;
constexpr size_t WS_H8 = 2072 * MiB;
constexpr size_t WS_END = 2106 * MiB;
constexpr int CW_BAR = 1024;
constexpr int CW_CNT = 8192;

constexpr int LDS_STAGE = 131072;
constexpr int LDS_MISC = LDS_STAGE;
constexpr int LDS_BIAS = LDS_STAGE + 1024;
constexpr int LDS_ROPE = LDS_STAGE + 4096;
constexpr int LDS_BYTES = LDS_STAGE + 4096 + 16384;

__device__ __forceinline__ unsigned f2bf(float f) { unsigned u = __builtin_bit_cast(unsigned, f); return (u + 0x7fffu + ((u >> 16) & 1u)) >> 16; }
__device__ __forceinline__ unsigned pk2(float lo, float hi) { return f2bf(lo) | (f2bf(hi) << 16); }
__device__ __forceinline__ float bf2f(unsigned short b) { return __builtin_bit_cast(float, ((unsigned)b) << 16); }
__device__ __forceinline__ float bflo(unsigned w) { return __builtin_bit_cast(float, w << 16); }
__device__ __forceinline__ float bfhi(unsigned w) { return __builtin_bit_cast(float, w & 0xffff0000u); }
__device__ __forceinline__ float wave_sum(float v) {
#pragma unroll
    for (int o = 1; o < 64; o <<= 1) v += __shfl_xor(v, o);
    return v;
}
constexpr float FP8_SW = 64.0f, FP8_SH = 16.0f, FP8_SA = 8.0f;
__device__ __forceinline__ unsigned pk4_fp8(float a, float b, float c, float d) {
    a = fminf(fmaxf(a, -448.f), 448.f); b = fminf(fmaxf(b, -448.f), 448.f); c = fminf(fmaxf(c, -448.f), 448.f); d = fminf(fmaxf(d, -448.f), 448.f);
    int v = 0; v = __builtin_amdgcn_cvt_pk_fp8_f32(a, b, v, false); v = __builtin_amdgcn_cvt_pk_fp8_f32(c, d, v, true); return (unsigned)v; }
__device__ __forceinline__ float fast_exp2(float x) { return __builtin_amdgcn_exp2f(x); }
__device__ __forceinline__ float sigmoidf_(float x) { return 1.0f / (1.0f + __expf(-x)); }
__device__ __forceinline__ float gelu_tanh(float x) {
    const float u = 0.7978845608028654f * (x + 0.044715f * x * x * x);
    const float t = 1.0f - 2.0f / (1.0f + __expf(2.0f * u));
    return 0.5f * x * (1.0f + t);
}

#define XB_TMO      128
#define XB_XCNT(j)  (256  + 64 * (j))
#define XB_XSUB(j)  (1280 + 64 * (j))
#define XB_XGEN(j)  (2304 + 64 * (j))
#define XB_TOP      3328
#define XB_TOPGEN   3392
#define XCD_BAR_WORDS 3456
#define XB_SPIN_CAP (1u << 18)
__device__ __forceinline__ unsigned xb_ld(unsigned* p)              { return __hip_atomic_load(p, __ATOMIC_RELAXED, __HIP_MEMORY_SCOPE_AGENT); }
__device__ __forceinline__ unsigned xb_add(unsigned* p, unsigned v) { return __hip_atomic_fetch_add(p, v, __ATOMIC_RELAXED, __HIP_MEMORY_SCOPE_AGENT); }
__device__ __forceinline__ unsigned xb_xcc_id() { return (unsigned)__builtin_amdgcn_s_getreg((3 << 11) | 20) & 0xFu; }
#define XB_SPIN(cond, bar) do { unsigned _sp = 0; while (cond) { __builtin_amdgcn_s_sleep(1); \
    if ((++_sp & 255u) == 0u) { if (xb_ld(&(bar)[XB_TMO])) break; if (_sp > XB_SPIN_CAP) { atomicAdd(&(bar)[XB_TMO], 1u); break; } } } } while (0)
struct XcdBarrier { unsigned* bar; unsigned x; volatile LAS unsigned* st; };
__device__ __forceinline__ XcdBarrier xcd_barrier_post(unsigned* bar, volatile LAS unsigned* st) {
    XcdBarrier b; b.bar = bar; b.x = xb_xcc_id(); b.st = st;
    if (threadIdx.x == 0) (void)xb_add(&bar[XB_XCNT(b.x)], 1u);
    return b;
}
__device__ __forceinline__ void xcd_barrier_complete(unsigned* bar, unsigned x, unsigned& nloc, unsigned& nx) {
    const unsigned G = gridDim.x * gridDim.y * gridDim.z;
    unsigned sum, cnt, mine, sp = 0u;
    for (;;) {
        sum = 0u; cnt = 0u; mine = 0u;
#pragma unroll
        for (unsigned j = 0; j < 16; ++j) { const unsigned c = xb_ld(&bar[XB_XCNT(j)]); sum += c; cnt += (c > 0u) ? 1u : 0u; mine = (j == x) ? c : mine; }
        if (sum == G) break;
        __builtin_amdgcn_s_sleep(1);
        if ((++sp & 255u) == 0u) { if (xb_ld(&bar[XB_TMO])) break; if (sp > XB_SPIN_CAP) { atomicAdd(&bar[XB_TMO], 1u); break; } }
    }
    nloc = mine > 0u ? mine : 1u; nx = cnt > 0u ? cnt : 1u;
}
__device__ __forceinline__ void xcd_barrier(const XcdBarrier& b) {
    asm volatile("s_waitcnt vmcnt(0)" ::: "memory");
    __syncthreads();
    if (threadIdx.x == 0) {
        unsigned* bar = b.bar;
        __builtin_amdgcn_s_waitcnt(0);
        unsigned nloc = b.st[0], nx = b.st[1];
        if (nloc == 0u) { xcd_barrier_complete(bar, b.x, nloc, nx); b.st[0] = nloc; b.st[1] = nx; }
        const unsigned old = xb_add(&bar[XB_XSUB(b.x)], 1u);
        const unsigned gen = old / nloc;
        if (old + 1u == (gen + 1u) * nloc) {
            __builtin_amdgcn_fence(__ATOMIC_RELEASE, "agent");
            asm volatile("s_waitcnt vmcnt(0)" ::: "memory");
            const unsigned og = xb_add(&bar[XB_TOP], 1u);
            const unsigned tg = og / nx;
            if (og + 1u == (tg + 1u) * nx) xb_add(&bar[XB_TOPGEN], 1u);
            else XB_SPIN(xb_ld(&bar[XB_TOPGEN]) == tg, bar);
            __builtin_amdgcn_fence(__ATOMIC_ACQUIRE, "agent");
            xb_add(&bar[XB_XGEN(b.x)], 1u);
            asm volatile("s_waitcnt vmcnt(0)" ::: "memory");
        } else {
            XB_SPIN(xb_ld(&bar[XB_XGEN(b.x)]) == gen, bar);
            __builtin_amdgcn_fence(__ATOMIC_ACQUIRE, "agent");
            asm volatile("s_waitcnt vmcnt(0)" ::: "memory");
        }
    }
    __syncthreads();
}

constexpr int BM = 256, BK = 64, HALF = 128, HTB = HALF * BK * 2;
__device__ __forceinline__ int lds_byte(int r, int c) { const int st = (r >> 4) * 2 + (c >> 5), rr = r & 15, cc = c & 31, ob = rr * 64 + cc * 2; return st * 1024 + (ob ^ (((ob >> 9) & 1) << 5)); }
__device__ __forceinline__ void stage_rc(int b, int& R, int& C) { const int st = b / 1024, sb = b % 1024, swz = sb ^ (((sb >> 9) & 1) << 5); R = (st >> 1) * 16 + swz / 64; C = (st & 1) * 32 + (swz % 64) / 2; }
__device__ __forceinline__ int perm32(int rho) { const int n = rho >> 4, i = rho & 15; return 8 * (i >> 2) + 4 * n + (i & 3); }
__device__ __forceinline__ unsigned cvt_pk_bf16(float lo, float hi) { unsigned r; asm volatile("v_cvt_pk_bf16_f32 %0, %1, %2" : "=v"(r) : "v"(lo), "v"(hi)); return r; }

struct GUnit { const char* A; const char* B; int p0, p1, p2, p3; };
typedef f32x4 AccT[2][2][4][2];

template <bool GATHER, bool FP8, class Sched, class Epi>
__device__ __forceinline__ void gemm_phase(LAS unsigned char* lds, const int nt_  , const unsigned lda2, const unsigned ldb2  , const Sched& S, const Epi& E) {
    int tid = threadIdx.x; asm volatile("" : "+v"(tid));
    int nt = nt_; asm volatile("" : "+s"(nt));
    const int wid = __builtin_amdgcn_readfirstlane(tid >> 6), lane = tid & 63, wr = wid >> 2, wc = wid & 3, fr = lane & 15, fq = lane >> 4;
    unsigned voffA[2][2], voffB[2]; int RA[2], CA[2];
#pragma unroll
    for (int i = 0; i < 2; ++i) { int R, C;
        if (FP8) { const int g = tid + 512 * i; R = (g >> 7) * 16 + (g & 15); C = ((g >> 4) & 7) * 8; }
        else stage_rc(tid * 16 + i * 8192, R, C);
        const int Rb = (R & ~31) + perm32(R & 31);
        RA[i] = R; CA[i] = C; voffA[0][i] = (unsigned)R * lda2 + (unsigned)C * 2u; voffA[1][i] = voffA[0][i] + 128u * lda2; voffB[i] = (unsigned)Rb * ldb2 + (unsigned)C * 2u; }
    const size_t kstep = (size_t)(BK * 2);
    const size_t hstepB = (size_t)HALF * ldb2;
    const unsigned ldsw = (unsigned)wid * 1024u;
    const int aoff = FP8 ? ((wr * 4) * 128 + 2 * fq * 16 + fr) * 16 : lds_byte(wr * 64 + fr, fq * 8), boff = FP8 ? ((wc * 2) * 128 + 2 * fq * 16 + fr) * 16 : lds_byte(wc * 32 + fr, fq * 8);
#define PG_SA(b, h) (((b) * 2 + (h)) * HTB)
#define PG_SB(b, h) ((4 + (b) * 2 + (h)) * HTB)
#define PG_STAGE(bufoff, gbase, voff) do { _Pragma("unroll") for (int _i = 0; _i < 2; ++_i) \
        __builtin_amdgcn_global_load_lds((const unsigned*)((const char*)(gbase) + (voff)[_i]), (LAS unsigned*)(lds + (bufoff) + ldsw + _i * 8192), 16, 0, 0); } while (0)
#define PG_LD32(p) __builtin_shufflevector(*(const LAS v4i*)(p), *(const LAS v4i*)((p) + 256), 0, 1, 2, 3, 4, 5, 6, 7)
#define PG_LDA(dst, b, h) do { if (FP8) { _Pragma("unroll") for (int m = 0; m < 4; ++m) dst##8[m] = PG_LD32(lds + PG_SA(b, h) + aoff + m * 2048); } \
        else { _Pragma("unroll") for (int m = 0; m < 4; ++m) _Pragma("unroll") for (int k = 0; k < 2; ++k) dst[m][k] = *(const LAS bf16x8*)(lds + PG_SA(b, h) + aoff + m * 2048 + k * 1024); } } while (0)
#define PG_LDB(dst, b, h) do { if (FP8) { _Pragma("unroll") for (int n = 0; n < 2; ++n) dst##8[n] = PG_LD32(lds + PG_SB(b, h) + boff + n * 2048); } \
        else { _Pragma("unroll") for (int n = 0; n < 2; ++n) _Pragma("unroll") for (int k = 0; k < 2; ++k) dst[n][k] = *(const LAS bf16x8*)(lds + PG_SB(b, h) + boff + n * 2048 + k * 1024); } } while (0)
#define PG_MMA(ai, bj, At, Bt) do { __builtin_amdgcn_s_setprio(1); \
        if (FP8) { _Pragma("unroll") for (int m = 0; m < 4; ++m) _Pragma("unroll") for (int n = 0; n < 2; ++n) \
            asm volatile("v_mfma_f32_16x16x128_f8f6f4 %0, %1, %2, %0" : "+v"(acc[ai][bj][m][n]) : "v"(Bt##8[n]), "v"(At##8[m])); }   \
        else { _Pragma("unroll") for (int m = 0; m < 4; ++m) _Pragma("unroll") for (int n = 0; n < 2; ++n) _Pragma("unroll") for (int k = 0; k < 2; ++k) \
            acc[ai][bj][m][n] = __builtin_amdgcn_mfma_f32_16x16x32_bf16(Bt[n][k], At[m][k], acc[ai][bj][m][n], 0, 0, 0); } \
        __builtin_amdgcn_s_setprio(0); } while (0)
#define PG_WAIT_V(n) asm volatile("s_waitcnt vmcnt(" #n ")" ::: "memory")
#define PG_WAIT_L(n) asm volatile("s_waitcnt lgkmcnt(" #n ")" ::: "memory")
#define PG_BAR __builtin_amdgcn_s_barrier()
#define PG_SCHED __builtin_amdgcn_sched_barrier(0)
    GUnit cur, nxt; int ui = 0;
    if (!S.next(0, cur)) return;
    AccT acc;
#pragma unroll
    for (int a = 0; a < 2; ++a)
#pragma unroll
        for (int b = 0; b < 2; ++b)
#pragma unroll
            for (int m = 0; m < 4; ++m)
#pragma unroll
                for (int n = 0; n < 2; ++n) acc[a][b][m][n] = (f32x4){0.f, 0.f, 0.f, 0.f};
    bf16x8 At[4][2], B0[2][2], B1[2][2]; v8i At8[4], B08[2], B18[2];
    const char* cA = cur.A; const char* cB = cur.B;
    S.pre(cur, 0, wid, lane);
    if (GATHER) {
#pragma unroll
        for (int h = 0; h < 2; ++h)
#pragma unroll
            for (int i = 0; i < 2; ++i) voffA[h][i] = (unsigned)S.row_token(cur, h * 128 + RA[i]) * lda2 + (unsigned)CA[i] * 2u;
    }
    unsigned voffAn[2][2];
#pragma unroll
    for (int h = 0; h < 2; ++h)
#pragma unroll
        for (int i = 0; i < 2; ++i) voffAn[h][i] = voffA[h][i];
    PG_STAGE(PG_SB(0, 0), cB, voffB); PG_STAGE(PG_SA(0, 0), cA, voffA[0]); PG_STAGE(PG_SB(0, 1), cB + hstepB, voffB); PG_STAGE(PG_SA(0, 1), cA, voffA[1]);
    if (wr == 1) PG_BAR;
    PG_WAIT_V(4); PG_BAR;
    PG_STAGE(PG_SB(1, 0), cB + kstep, voffB); PG_STAGE(PG_SA(1, 0), cA + kstep, voffA[0]); PG_STAGE(PG_SB(1, 1), cB + hstepB + kstep, voffB);
    PG_WAIT_V(6); PG_BAR;
    for (;;) {
        const bool has_next = S.next(ui + 1, nxt);
        const char* nA = has_next ? nxt.A : cA; const char* nB = has_next ? nxt.B : cB;
        for (int t = 0; t < nt; t += 2) {
            const bool last = (t == nt - 2);
            const char* a1 = cA + (size_t)(t + 1) * kstep;
            const char* a2 = last ? nA : cA + (size_t)(t + 2) * kstep; const char* b2 = last ? nB : cB + (size_t)(t + 2) * kstep;
            const char* a3 = a2 + kstep; const char* b3 = b2 + kstep;
            if (last && has_next) S.pre(nxt, (ui + 1) & 1, wid, lane);
            if (GATHER) {
                if (last && has_next) {
#pragma unroll
                    for (int h = 0; h < 2; ++h)
#pragma unroll
                        for (int i = 0; i < 2; ++i) voffAn[h][i] = (unsigned)S.row_token(nxt, h * 128 + RA[i]) * lda2 + (unsigned)CA[i] * 2u;
                }
            }
            unsigned vA0[2], vA1[2];
#pragma unroll
            for (int i = 0; i < 2; ++i) { vA0[i] = (GATHER && last) ? voffAn[0][i] : voffA[0][i]; vA1[i] = (GATHER && last) ? voffAn[1][i] : voffA[1][i]; }
            PG_LDB(B0, 0, 0); PG_SCHED; PG_LDA(At, 0, 0); PG_STAGE(PG_SA(1, 1), a1, voffA[1]);
            PG_WAIT_L(8); PG_BAR; PG_WAIT_L(0); PG_MMA(0, 0, At, B0); PG_BAR; PG_SCHED;
            PG_LDB(B1, 0, 1); PG_STAGE(PG_SB(0, 0), b2, voffB);
            PG_BAR; PG_WAIT_L(0); PG_MMA(0, 1, At, B1); PG_BAR;
            PG_LDA(At, 0, 1); PG_STAGE(PG_SA(0, 0), a2, vA0);
            PG_BAR; PG_WAIT_L(0); PG_MMA(1, 0, At, B0); PG_BAR; PG_SCHED;
            PG_STAGE(PG_SB(0, 1), b2 + hstepB, voffB);
            PG_WAIT_V(6); PG_BAR; PG_MMA(1, 1, At, B1); PG_BAR;
            PG_LDB(B0, 1, 0); PG_SCHED; PG_LDA(At, 1, 0); PG_STAGE(PG_SA(0, 1), a2, vA1);
            PG_WAIT_L(8); PG_BAR; PG_WAIT_L(0); PG_MMA(0, 0, At, B0); PG_BAR; PG_SCHED;
            PG_LDB(B1, 1, 1); PG_STAGE(PG_SB(1, 0), b3, voffB);
            PG_BAR; PG_WAIT_L(0); PG_MMA(0, 1, At, B1); PG_BAR;
            PG_LDA(At, 1, 1); PG_STAGE(PG_SA(1, 0), a3, vA0);
            PG_BAR; PG_WAIT_L(0); PG_MMA(1, 0, At, B0); PG_BAR; PG_SCHED;
            PG_STAGE(PG_SB(1, 1), b3 + hstepB, voffB);
            PG_WAIT_V(6); PG_BAR; PG_MMA(1, 1, At, B1); PG_BAR;
        }
        if (FP8) asm volatile("s_nop 15\n\ts_nop 15" ::: "memory");
        {
            int tz = threadIdx.x; asm volatile("" : "+v"(tz)); const int wz = __builtin_amdgcn_readfirstlane(tz >> 6), lz = tz & 63;
            E(acc, cur, ui & 1, wz >> 2, wz & 3, lz & 15, lz >> 4); }
        if (!has_next) break;
#pragma unroll
        for (int a = 0; a < 2; ++a)
#pragma unroll
            for (int b = 0; b < 2; ++b)
#pragma unroll
                for (int m = 0; m < 4; ++m)
#pragma unroll
                    for (int n = 0; n < 2; ++n) acc[a][b][m][n] = (f32x4){0.f, 0.f, 0.f, 0.f};
        cur = nxt; cA = nA; cB = nB; ++ui;
        if (GATHER) {
#pragma unroll
            for (int h = 0; h < 2; ++h)
#pragma unroll
                for (int i = 0; i < 2; ++i) voffA[h][i] = voffAn[h][i];
        }
    }
    PG_WAIT_V(0);
    if (wr == 0) PG_BAR;
    PG_BAR;
#undef PG_SA
#undef PG_SB
#undef PG_STAGE
#undef PG_LDA
#undef PG_LD32
#undef PG_LDB
#undef PG_MMA
#undef PG_WAIT_V
#undef PG_WAIT_L
#undef PG_BAR
#undef PG_SCHED
}

struct Args { const float* in[29]; float* out; unsigned char* ws; int ph_lo, ph_hi; };
struct Frame {
    LAS unsigned char* lds;
    int G, bid;
};
#define PH_LOCALS int tid = threadIdx.x; asm volatile("" : "+v"(tid)); const int lane = tid & 63; const int wave = __builtin_amdgcn_readfirstlane(tid >> 6); (void)lane; (void)wave
typedef const __attribute__((address_space(4))) Args* KArgs;
#define WSP(T, off) ((T*)(A->ws + (off)))
#define FIN(i) (A->in[i])

template <bool F8 = false>
__device__ __forceinline__ void transpose_item(const float* W, int K, int N, bf16_t* WT, int kb, int n0s, int drow0, LAS float* scr, int lane) {
    const int k0 = 64 * kb;
#pragma unroll 8
    for (int i = 0; i < 32; ++i) { const int kk = 2 * i + (lane >> 5); scr[kk * 33 + (lane & 31)] = W[(size_t)(k0 + kk) * N + n0s + (lane & 31)]; }
    asm volatile("s_waitcnt lgkmcnt(0)" ::: "memory");
    const int c = lane & 7;
#pragma unroll
    for (int j = 0; j < 4; ++j) { const int n = (lane >> 3) + 8 * j; const LAS float* s = scr + (8 * c) * 33 + n;
        if (F8) { *(u32x2*)((unsigned char*)WT + (size_t)(drow0 + n) * K + k0 + 8 * c) = (u32x2){pk4_fp8(s[0 * 33] * FP8_SW, s[1 * 33] * FP8_SW, s[2 * 33] * FP8_SW, s[3 * 33] * FP8_SW), pk4_fp8(s[4 * 33] * FP8_SW, s[5 * 33] * FP8_SW, s[6 * 33] * FP8_SW, s[7 * 33] * FP8_SW)}; }
        else { u32x4 o; o.x = pk2(s[0 * 33], s[1 * 33]); o.y = pk2(s[2 * 33], s[3 * 33]); o.z = pk2(s[4 * 33], s[5 * 33]); o.w = pk2(s[6 * 33], s[7 * 33]);
        *(u32x4*)(WT + (size_t)(drow0 + n) * K + k0 + 8 * c) = o; } }
    asm volatile("s_waitcnt lgkmcnt(0)" ::: "memory");
}
__device__ __forceinline__ int win_src_col(int d) {
    if (d < 768) return d;
    if (d < 1152) return 1408 + (d - 768);
    if (d < 1280) return 1792 + (d - 1152);
    if (d < 1536) return 1152 + (d - 1280);
    if (d < 1920) return 768 + (d - 1536);
    return d;
}
__device__ __forceinline__ int wgu_src_col(int d) { const int t = d >> 8, r = d & 255; return (r < 128) ? (128 * t + r) : (1024 + 128 * t + (r - 128)); }

__device__ __forceinline__ void phase_p0a(KArgs A, Frame& F) {
    PH_LOCALS;
    LAS float* scr = (LAS float*)(F.lds + wave * 16384);
    const int gw = F.bid * NWAVES + wave, NGW = F.G * NWAVES;
    constexpr int I_IN = DEPTH * 16 * 64, I_OUT = DEPTH * 16 * 32, I_GLU = DEPTH * 4 * 8, I_RT = DEPTH * 16, I_GU = DEPTH * NEXP * 16 * 64, I_DN = DEPTH * NEXP * 16 * 32;
    constexpr int NITEMS = I_IN + I_OUT + I_GLU + I_RT + I_GU + I_DN;
    for (int it = gw; it < NITEMS; it += NGW) {
        int r = it;
        if (r < I_IN) { const int l = r / 1024, q = r % 1024, kb = q / 64, nb = q % 64;
            transpose_item(FIN(7) + (size_t)l * D * 2048, D, 2048, WSP(bf16_t, WS_WINT) + (size_t)l * 2048 * D, kb, win_src_col(32 * nb), 32 * nb, scr, lane); continue; } r -= I_IN;
        if (r < I_OUT) { const int l = r / 512, q = r % 512, kb = q / 32, nb = q % 32;
            transpose_item(FIN(8) + (size_t)l * D * D, D, D, WSP(bf16_t, WS_WOUTT) + (size_t)l * D * D, kb, 32 * nb, 32 * nb, scr, lane); continue; } r -= I_OUT;
        if (r < I_GLU) { const int l = r / 32, q = r % 32, kb = q / 8, nb = q % 8;
            transpose_item(FIN(18) + (size_t)l * 256 * 256, 256, 256, WSP(bf16_t, WS_WGLUT) + (size_t)l * 256 * 256, kb, 32 * nb, 32 * nb, scr, lane); continue; } r -= I_GLU;
        if (r < I_RT) { const int l = r / 16, kb = r % 16;
            transpose_item(FIN(22) + (size_t)l * D * NEXP, D, NEXP, WSP(bf16_t, WS_WRT) + (size_t)l * NEXP * D, kb, 0, 0, scr, lane); continue; } r -= I_RT;
        if (r < I_GU) { const int le = r / 1024, q = r % 1024, kb = q / 64, nb = q % 64;
            transpose_item<true>(FIN(24) + (size_t)le * D * 2048, D, 2048, (bf16_t*)(WSP(unsigned char, WS_WGUT) + (size_t)le * 2048 * D), kb, wgu_src_col(32 * nb), 32 * nb, scr, lane); continue; } r -= I_GU;
        { const int le = r / 512, q = r % 512, kb = q / 32, nb = q % 32;
            transpose_item<true>(FIN(26) + (size_t)le * FF * D, FF, D, (bf16_t*)(WSP(unsigned char, WS_WDT) + (size_t)le * D * FF), kb, 32 * nb, 32 * nb, scr, lane); }
    }
    __syncthreads();
    {
        LAS float* cond = (LAS float*)F.lds;
        LAS float* red = (LAS float*)(F.lds + 32768);
        for (int i = tid; i < 5 * D; i += NTHREADS) { const int bi = i / D, k = i % D; const float v = (bi < 4) ? FIN(1)[bi * D + k] : FIN(3)[k]; cond[i] = v / (1.0f + __expf(-v)); }
        __syncthreads();
        for (int u = F.bid; u < DEPTH * 96; u += F.G) {
            const int l = u / 96, j = (u % 96) * 64 + lane;
            const float* w = FIN(4) + (size_t)l * D * 6144 + j;
            float a0 = 0.f, a1 = 0.f, a2 = 0.f, a3 = 0.f, a4 = 0.f;
#pragma unroll 8
            for (int kk = 0; kk < 128; ++kk) { const int k = wave * 128 + kk; const float wv = w[(size_t)k * 6144];
                a0 += cond[k] * wv; a1 += cond[D + k] * wv; a2 += cond[2 * D + k] * wv; a3 += cond[3 * D + k] * wv; a4 += cond[4 * D + k] * wv; }
            red[(wave * 5 + 0) * 64 + lane] = a0; red[(wave * 5 + 1) * 64 + lane] = a1; red[(wave * 5 + 2) * 64 + lane] = a2;
            red[(wave * 5 + 3) * 64 + lane] = a3; red[(wave * 5 + 4) * 64 + lane] = a4;
            __syncthreads();
            if (tid < 320) { const int bi = tid / 64, jj = tid % 64; float s = 0.f;
#pragma unroll
                for (int w8 = 0; w8 < 8; ++w8) s += red[(w8 * 5 + bi) * 64 + jj];
                const int col = (u % 96) * 64 + jj;
                WSP(float, WS_MOD)[((size_t)l * 5 + bi) * 6144 + col] = s + FIN(5)[l * 6144 + col]; }
            __syncthreads();
        }
    }
    const int gt = F.bid * NTHREADS + tid, NGT = F.G * NTHREADS;
    for (int i = gt; i < 128 * 16; i += NGT) { const int pos = i / 16, f = i % 16; const float inv = powf(10000.0f, -(float)f / 16.0f); const float a = (float)pos * inv;
        WSP(float, WS_ROPE)[i] = cosf(a); WSP(float, WS_ROPE)[2048 + i] = sinf(a); }
    for (int i = gt; i < DEPTH * 2 * 16 * 65 * 64; i += NGT) {
        const int p = i % 64, d = (i / 64) % 65, ldg = i / (64 * 65);
        const float are = fminf(FIN(10)[ldg * 64 + p], -1e-4f), aim = FIN(11)[ldg * 64 + p];
        const float step = expf(FIN(12)[ldg]);
        const float re = are * step * (float)d, im = aim * step * (float)d;
        const float mag = expf(re);
        WSP(f32x2, WS_LP)[i] = (f32x2){mag * cosf(im), mag * sinf(im)};
    }
    for (int i = gt; i < DEPTH * 2 * 16 * 64 * 16; i += NGT) {
        const int lp = i / 16;
        const int ldg = lp / 64;
        const float are = fminf(FIN(10)[lp], -1e-4f), aim = FIN(11)[lp];
        const float step = expf(FIN(12)[ldg]);
        const float mag = expf(are * step), lr = mag * cosf(aim * step) - 1.0f, li = mag * sinf(aim * step);
        const float den = are * are + aim * aim;
        const float qr = (lr * are + li * aim) / den, qi = (li * are - lr * aim) / den;
        const float br = FIN(13)[i], bi = FIN(14)[i];
        WSP(f32x2, WS_BBAR)[i] = (f32x2){qr * br - qi * bi, qr * bi + qi * br};
    }
}

__device__ __forceinline__ f32x2 cmul(f32x2 a, f32x2 b) { return (f32x2){a.x * b.x - a.y * b.y, a.x * b.y + a.y * b.x}; }
__device__ __forceinline__ void phase_p0b(KArgs A, Frame& F) {
    PH_LOCALS;
    const f32x2* LP = WSP(f32x2, WS_LP); const f32x2* BB = WSP(f32x2, WS_BBAR);
    LAS float* kv = (LAS float*)F.lds;
    for (int it = F.bid; it < DEPTH * 16 * 64; it += F.G) {
        const int d = it % 64, g = (it / 64) % 16, l = it / 1024;
        const int dir = tid >> 8, ho = (tid >> 4) & 15, hi = tid & 15;
        const int ldg = (l * 2 + dir) * 16 + g;
        const float* cre = FIN(15) + ((size_t)ldg * 16 + ho) * 64; const float* cim = FIN(16) + ((size_t)ldg * 16 + ho) * 64;
        const f32x2* lp = LP + ((size_t)ldg * 65 + d) * 64; const f32x2* bb = BB + (size_t)ldg * 1024 + hi;
        float s = 0.f;
        for (int p = 0; p < 64; ++p) { const f32x2 t = cmul(lp[p], bb[p * 16]); s += cre[p] * t.x - cim[p] * t.y; }
        kv[dir * 256 + ho * 16 + hi] = s;
        __syncthreads();
        bf16_t* KC = WSP(bf16_t, WS_KC) + ((size_t)(l * 16 + g)) * 1024 * SUXW;
        if (d == 0) {
            if (dir == 0) { const float v = kv[ho * 16 + hi] + kv[256 + ho * 16 + hi] + ((ho == hi) ? FIN(17)[l * 256 + g * 16 + ho] : 0.f); const unsigned short b = (unsigned short)f2bf(v);
                for (int t = 0; t < 64; ++t) KC[(size_t)(t * 16 + ho) * SUXW + t * 16 + hi] = b; }
        } else {
            const unsigned short b = (unsigned short)f2bf(s);
            if (dir == 0) { for (int t = d; t < 64; ++t) KC[(size_t)(t * 16 + ho) * SUXW + (t - d) * 16 + hi] = b; }
            else          { for (int t = 0; t < 64 - d; ++t) KC[(size_t)(t * 16 + ho) * SUXW + (t + d) * 16 + hi] = b; }
        }
        __syncthreads();
    }
    const int gt = F.bid * NTHREADS + tid, NGT = F.G * NTHREADS;
    for (int i = gt; i < DEPTH * 16 * 256 * 1024; i += NGT) {
        const int k = i % 1024, n = (i / 1024) % 256, lg = i / (1024 * 256), l = lg / 16, g = lg % 16;
        const int s = k / 16, hi = k % 16, dir = n / 128, ri = (n / 64) & 1, p = n % 64;
        const int ldg = (l * 2 + dir) * 16 + g;
        const int e = dir ? s : 63 - s;
        const f32x2 t = cmul(LP[((size_t)ldg * 65 + e) * 64 + p], BB[(size_t)ldg * 1024 + p * 16 + hi]);
        WSP(bf16_t, WS_WST)[i] = (unsigned short)f2bf(ri ? t.y : t.x);
    }
    for (int i = gt; i < DEPTH * 16 * 1024 * 256; i += NGT) {
        const int n = i % 256, row = (i / 256) % 1024, lg = i / (256 * 1024), l = lg / 16, g = lg % 16;
        const int t = row / 16, ho = row % 16, dir = n / 128, ri = (n / 64) & 1, p = n % 64;
        const int ldg = (l * 2 + dir) * 16 + g;
        const int e = dir ? 64 - t : t + 1;
        const f32x2 c = (f32x2){FIN(15)[((size_t)ldg * 16 + ho) * 64 + p], FIN(16)[((size_t)ldg * 16 + ho) * 64 + p]};
        const f32x2 v = cmul(c, LP[((size_t)ldg * 65 + e) * 64 + p]);
        WSP(bf16_t, WS_KC)[((size_t)lg * 1024 + row) * SUXW + 1024 + n] = (unsigned short)f2bf(ri ? -v.y : v.x);
    }
}

__device__ __forceinline__ void build_tstart(KArgs A, Frame& F, int l) {
    PH_LOCALS;
    LAS int* ts = (LAS int*)(F.lds + LDS_MISC + 64);
    if (tid == 0) { const int* cnt = (const int*)A->ws + CW_CNT + l * 32; int a = 0;
        for (int e = 0; e < 32; ++e) { ts[e] = a; ts[40 + e] = cnt[e]; a += (cnt[e] + 255) >> 8; }
        ts[32] = a; }
    __syncthreads();
}

__device__ __forceinline__ void phase_norm1(KArgs A, Frame& F, int l, const float dsc = 1.0f) {
    PH_LOCALS;
    const bool fin = (l == DEPTH);
    const int nrows = fin ? NLAT : TT;
    if (l > 0) build_tstart(A, F, l - 1);
    const LAS int* ts = (const LAS int*)(F.lds + LDS_MISC + 64);
    const int gw = F.bid * NWAVES + wave, NGW = F.G * NWAVES;
    const float* MOD = WSP(float, WS_MOD);
    float* XR = WSP(float, WS_XR);
    for (int r = gw; r < nrows; r += NGW) {
        const int bi = (r < NLAT) ? (r / SEQ) : 4;
        f32x4 v[4];
        if (l == 0) { const float* src = (r < NLAT) ? (FIN(0) + (size_t)r * D) : (FIN(2) + (size_t)(r - NLAT) * D);
#pragma unroll
            for (int j = 0; j < 4; ++j) v[j] = *(const f32x4*)(src + 4 * lane + 256 * j); }
        else {
            const float* src = XR + (size_t)r * D;
#pragma unroll
            for (int j = 0; j < 4; ++j) v[j] = *(const f32x4*)(src + 4 * lane + 256 * j);
            const int* ti = WSP(int, WS_TOKINFO) + (size_t)r * 4;
            f32x4 a[4];
#pragma unroll
            for (int j = 0; j < 4; ++j) a[j] = (f32x4){0.f, 0.f, 0.f, 0.f};
#pragma unroll
            for (int k = 0; k < 4; ++k) { const int inf = ti[k]; const int e = (inf >> 24) & 31, rank = inf & 0xffffff; const size_t pos = (size_t)ts[e] * 256 + rank;
                const bf16_t* eo = WSP(bf16_t, WS_EO) + pos * D; const float wk = WSP(float, WS_TOKW)[(size_t)r * 4 + k]; const float* bd = FIN(27) + ((size_t)(l - 1) * NEXP + e) * D;
#pragma unroll
                for (int j = 0; j < 4; ++j) { const u32x2 w = *(const u32x2*)(eo + 4 * lane + 256 * j); const f32x4 b4 = *(const f32x4*)(bd + 4 * lane + 256 * j);
                    a[j].x += wk * (bflo(w.x) + b4.x); a[j].y += wk * (bfhi(w.x) + b4.y); a[j].z += wk * (bflo(w.y) + b4.z); a[j].w += wk * (bfhi(w.y) + b4.w); } }
            const float* m5 = MOD + ((size_t)(l - 1) * 5 + bi) * 6144 + 5 * D;
#pragma unroll
            for (int j = 0; j < 4; ++j) { const f32x4 g5 = *(const f32x4*)(m5 + 4 * lane + 256 * j) * dsc; v[j] = v[j] + g5 * a[j]; }
        }
        if (!fin) {
#pragma unroll
            for (int j = 0; j < 4; ++j) *(f32x4*)(XR + (size_t)r * D + 4 * lane + 256 * j) = v[j];
        }
        float ss = 0.f;
#pragma unroll
        for (int j = 0; j < 4; ++j) ss += (v[j].x * v[j].x + v[j].y * v[j].y) + (v[j].z * v[j].z + v[j].w * v[j].w);
        const float rinv = 1.0f / sqrtf(wave_sum(ss) * (1.0f / D) + RMS_EPS);
        if (fin) {
#pragma unroll
            for (int j = 0; j < 4; ++j) { const f32x4 g = *(const f32x4*)(FIN(28) + 4 * lane + 256 * j); *(f32x4*)(A->out + (size_t)r * D + 4 * lane + 256 * j) = v[j] * rinv * g; }
        } else {
            const float* gm = FIN(6) + (size_t)l * D; const float* m0 = MOD + ((size_t)l * 5 + bi) * 6144; const float* m1 = m0 + D;
            bf16_t* hrow = WSP(bf16_t, WS_H) + (size_t)r * D;
#pragma unroll
            for (int j = 0; j < 4; ++j) { const int c = 4 * lane + 256 * j; const f32x4 g = *(const f32x4*)(gm + c), sh = *(const f32x4*)(m0 + c), sc = *(const f32x4*)(m1 + c);
                const f32x4 h = v[j] * rinv * g * (sc + 1.0f) + sh;
                u32x2 o; o.x = pk2(h.x, h.y); o.y = pk2(h.z, h.w); *(u32x2*)(hrow + c) = o; }
        }
    }
}

__device__ __forceinline__ void phase_router(KArgs A, Frame& F, int l, const bool dry = false) {
    PH_LOCALS;
    const int nrows = (l == DEPTH - 1) ? NLAT : TT;
    LAS bf16_t* tile = (LAS bf16_t*)F.lds;
    LAS float* part = (LAS float*)(F.lds + 32 * 1032 * 2);
    LAS float* logit = part + 8 * 32 * 33;
    LAS int* lcnt = (LAS int*)(logit + 32 * 33);
    const float* MOD = WSP(float, WS_MOD);
    float* XR = WSP(float, WS_XR);
    const bf16_t* WRT = WSP(bf16_t, WS_WRT) + (size_t)l * NEXP * D;
    int* cnt = (int*)A->ws + CW_CNT + l * 32 + (dry ? 128 : 0);
    int* elist = dry ? (int*)WSP(float, WS_ELW) : WSP(int, WS_ELIST);
    const float dsc = dry ? 0.0f : 1.0f;
    for (int u = F.bid; u < nrows / 32; u += F.G) {
        const int r0 = u * 32;
        {
            const int rb = r0 + wave * 4; const int bi = (rb < NLAT) ? (rb / SEQ) : 4;
            const float* m2 = MOD + ((size_t)l * 5 + bi) * 6144 + 2 * D; const float* gm = FIN(21) + (size_t)l * D;
            f32x4 v[4][4]; u32x2 dw[4][4];
#pragma unroll
            for (int q = 0; q < 4; ++q)
#pragma unroll
                for (int j = 0; j < 4; ++j) { const int c = 4 * lane + 256 * j; v[q][j] = *(const f32x4*)(XR + (size_t)(rb + q) * D + c); dw[q][j] = *(const u32x2*)(WSP(bf16_t, WS_DELTA) + (size_t)(rb + q) * D + c); }
            float ss[4];
#pragma unroll
            for (int q = 0; q < 4; ++q) { ss[q] = 0.f;
#pragma unroll
                for (int j = 0; j < 4; ++j) { const int c = 4 * lane + 256 * j; const f32x4 g2 = *(const f32x4*)(m2 + c) * dsc;
                    v[q][j].x += g2.x * bflo(dw[q][j].x); v[q][j].y += g2.y * bfhi(dw[q][j].x); v[q][j].z += g2.z * bflo(dw[q][j].y); v[q][j].w += g2.w * bfhi(dw[q][j].y);
                    *(f32x4*)(XR + (size_t)(rb + q) * D + c) = v[q][j];
                    ss[q] += (v[q][j].x * v[q][j].x + v[q][j].y * v[q][j].y) + (v[q][j].z * v[q][j].z + v[q][j].w * v[q][j].w); } }
#pragma unroll
            for (int o = 1; o < 64; o <<= 1) {
#pragma unroll
                for (int q = 0; q < 4; ++q) ss[q] += __shfl_xor(ss[q], o); }
#pragma unroll
            for (int q = 0; q < 4; ++q) { const float rinv = 1.0f / sqrtf(ss[q] * (1.0f / D) + RMS_EPS);
                unsigned char* hrow = WSP(unsigned char, WS_H8) + (size_t)(rb + q) * D;
#pragma unroll
                for (int j = 0; j < 4; ++j) { const int c = 4 * lane + 256 * j; const f32x4 g = *(const f32x4*)(gm + c), sh = *(const f32x4*)(m2 + D + c), sc = *(const f32x4*)(m2 + 2 * D + c);
                    const f32x4 h = v[q][j] * rinv * g * (sc + 1.0f) + sh;
                    u32x2 o; o.x = pk2(h.x, h.y); o.y = pk2(h.z, h.w); *(LAS u32x2*)(tile + (wave * 4 + q) * 1032 + c) = o;
                    *(unsigned*)(hrow + c) = pk4_fp8(h.x * FP8_SH, h.y * FP8_SH, h.z * FP8_SH, h.w * FP8_SH); } }
        }
        if (tid < 32) lcnt[tid] = 0;
        __syncthreads();
        {
            f32x16 acc;
#pragma unroll
            for (int i = 0; i < 16; ++i) acc[i] = 0.f;
            const int rr = lane & 31, hh = lane >> 5;
            bf16x8 bw[8];
#pragma unroll
            for (int s = 0; s < 8; ++s) bw[s] = *(const bf16x8*)(WRT + (size_t)rr * D + wave * 128 + 16 * s + 8 * hh);
#pragma unroll
            for (int s = 0; s < 8; ++s) { const bf16x8 a = *(const LAS bf16x8*)(tile + rr * 1032 + wave * 128 + 16 * s + 8 * hh);
                acc = __builtin_amdgcn_mfma_f32_32x32x16_bf16(a, bw[s], acc, 0, 0, 0); }
#pragma unroll
            for (int i = 0; i < 16; ++i) { const int tok = (i & 3) + 8 * (i >> 2) + 4 * hh; part[(wave * 32 + tok) * 33 + rr] = acc[i]; }
        }
        __syncthreads();
        for (int i = tid; i < 1024; i += NTHREADS) { const int tok = i >> 5, e = i & 31; float s = FIN(23)[l * 32 + e];
#pragma unroll
            for (int w = 0; w < 8; ++w) s += part[(w * 32 + tok) * 33 + e];
            logit[tok * 33 + e] = s; }
        __syncthreads();
        if (wave == 0) {
            const int t = lane & 31, r = r0 + t; const bool act = lane < 32;
            float lg[32];
#pragma unroll
            for (int e = 0; e < 32; ++e) lg[e] = logit[t * 33 + e];
            float lv[4]; int le[4];
#pragma unroll
            for (int k = 0; k < 4; ++k) { float best = -3.0e38f; int be = 0;
#pragma unroll
                for (int e = 0; e < 32; ++e) { const bool gt = lg[e] > best; best = gt ? lg[e] : best; be = gt ? e : be; }
#pragma unroll
                for (int e = 0; e < 32; ++e) lg[e] = (e == be) ? -3.0e38f : lg[e];
                lv[k] = best; le[k] = be; }
            const float e1 = __expf(lv[1] - lv[0]), e2 = __expf(lv[2] - lv[0]), e3 = __expf(lv[3] - lv[0]); const float inv = 1.0f / (1.0f + e1 + e2 + e3);
            const float wk[4] = {inv, e1 * inv, e2 * inv, e3 * inv};
            int lr[4];
#pragma unroll
            for (int k = 0; k < 4; ++k) lr[k] = act ? __hip_atomic_fetch_add(lcnt + le[k], 1, __ATOMIC_RELAXED, __HIP_MEMORY_SCOPE_WORKGROUP) : 0;
            asm volatile("s_waitcnt lgkmcnt(0)" ::: "memory");
            if (act) { const int c = lcnt[t]; const int base = c ? atomicAdd(&cnt[t], c) : 0; lcnt[32 + t] = base; }
            asm volatile("s_waitcnt vmcnt(0) lgkmcnt(0)" ::: "memory");
            if (act) {
                int* ti = WSP(int, WS_TOKINFO) + (size_t)r * 4;
#pragma unroll
                for (int k = 0; k < 4; ++k) { const int rank = lcnt[32 + le[k]] + lr[k];
                    elist[(size_t)le[k] * TT + rank] = r; if (!dry) { WSP(float, WS_TOKW)[(size_t)r * 4 + k] = wk[k]; ti[k] = (le[k] << 24) | rank; } }
            }
        }
        __syncthreads();
    }
}

__device__ __forceinline__ void phase_s5scan(KArgs A, Frame& F, int l) {
    PH_LOCALS;
    const int gw = F.bid * NWAVES + wave, NGW = F.G * NWAVES;
    const float* SL = WSP(float, WS_SLOC);
    for (int it = gw; it < NBATCH * 16 * 2; it += NGW) {
        const int dir = it & 1, g = (it >> 1) & 15, b = it >> 5;
        const int ldg = (l * 2 + dir) * 16 + g;
        const f32x2 L64 = WSP(f32x2, WS_LP)[((size_t)ldg * 65 + 64) * 64 + lane];
        bf16_t* sux = WSP(bf16_t, WS_SUX) + (size_t)g * MCH * SUXW;
        float xr = 0.f, xi = 0.f;
#pragma unroll 4
        for (int step = 0; step < 132; ++step) {
            int ch;
            if (step < 4) ch = 512 + 4 * b + (dir ? 3 - step : step);
            else ch = 128 * b + (dir ? 127 - (step - 4) : (step - 4));
            const float sr = SL[(size_t)ch * 4096 + g * 256 + dir * 128 + lane], si = SL[(size_t)ch * 4096 + g * 256 + dir * 128 + 64 + lane];
            bf16_t* o = sux + (size_t)ch * SUXW + 1024 + dir * 128;
            o[lane] = (unsigned short)f2bf(xr); o[64 + lane] = (unsigned short)f2bf(xi);
            const float nr = L64.x * xr - L64.y * xi + sr, ni = L64.x * xi + L64.y * xr + si;
            xr = nr; xi = ni;
        }
    }
}

constexpr float LOG2E = 1.4426950408889634f;
constexpr int AT_STEP = 32768;
constexpr int AT_RPB = 3 * AT_STEP;
__device__ __forceinline__ void attn_stage(const bf16_t* P, const bf16_t* VT, LAS unsigned char* lds, int slot, int ktok0, int kcol, int vrow, int lane, int wave) {
    LAS unsigned char* base = lds + slot * AT_STEP + wave * 1024;
#pragma unroll
    for (int j = 0; j < 2; ++j) {
        const int dc = 4 * j + (wave >> 1), key = (wave & 1) * 64 + lane;
        __builtin_amdgcn_global_load_lds((const unsigned*)(P + (size_t)(ktok0 + key) * PW + kcol + 8 * dc), (LAS unsigned*)(base + j * 8192), 16, 0, 0);
    }
#pragma unroll
    for (int j = 0; j < 2; ++j) {
        const int q = 8 * j + wave;
        __builtin_amdgcn_global_load_lds((const unsigned*)(VT + (size_t)(vrow + lane) * TT + ktok0 + 8 * q), (LAS unsigned*)(base + 16384 + j * 8192), 16, 0, 0);
    }
}
template <int MM>
__device__ __forceinline__ void attn_tile(const LAS unsigned char* kt_, const LAS unsigned char* vt_, const bf16x8 (&qf)[4], f32x16& O0, f32x16& O1, float& m, float& lsum,
                                          const LAS float* bptr, unsigned vmask, int dbase) {
    bf16x8 kf[4];
#pragma unroll
    for (int q = 0; q < 4; ++q) kf[q] = *(const LAS bf16x8*)(kt_ + q * 2048);
    bf16x8 vf[2][2];
#pragma unroll
    for (int mt = 0; mt < 2; ++mt)
#pragma unroll
        for (int s2 = 0; s2 < 2; ++s2) vf[mt][s2] = *(const LAS bf16x8*)(vt_ + s2 * 1024 + mt * 512);
    f32x16 sa;
#pragma unroll
    for (int i = 0; i < 16; ++i) sa[i] = 0.f;
#pragma unroll
    for (int q = 0; q < 4; ++q) sa = __builtin_amdgcn_mfma_f32_32x32x16_bf16(kf[q], qf[q], sa, 0, 0, 0);
    float sv[16]; float tmax = -3.0e38f;
#pragma unroll
    for (int i = 0; i < 16; ++i) {
        const int ko = (i & 3) + 8 * (i >> 2);
        float x;
        if (MM == 0) x = sa[i] * (0.125f * LOG2E);
        else if (MM == 1) { x = sa[i] * (0.125f * LOG2E) + bptr[ko]; x = ((vmask >> i) & 1u) ? x : -3.0e38f; }
        else { const int dpos = dbase - ko; x = sa[i] * (0.125f * LOG2E); x = (dpos <= 128 && dpos >= -128) ? x : -3.0e38f; }
        sv[i] = x; tmax = fmaxf(tmax, x);
    }
    tmax = fmaxf(tmax, __shfl_xor(tmax, 32));
    if (__any(tmax > m)) {
        const float mnew = fmaxf(m, tmax); const float alpha = fast_exp2(m - mnew);
        lsum *= alpha; m = mnew;
#pragma unroll
        for (int i = 0; i < 16; ++i) { O0[i] *= alpha; O1[i] *= alpha; }
    }
    float psum = 0.f;
#pragma unroll
    for (int i = 0; i < 16; ++i) { const float p = fast_exp2(sv[i] - m); psum += p; sv[i] = p; }
    psum += __shfl_xor(psum, 32);
    lsum += psum;
#pragma unroll
    for (int s2 = 0; s2 < 2; ++s2) {
        u32x4 pw; pw.x = cvt_pk_bf16(sv[8 * s2 + 0], sv[8 * s2 + 1]); pw.y = cvt_pk_bf16(sv[8 * s2 + 2], sv[8 * s2 + 3]); pw.z = cvt_pk_bf16(sv[8 * s2 + 4], sv[8 * s2 + 5]); pw.w = cvt_pk_bf16(sv[8 * s2 + 6], sv[8 * s2 + 7]);
        const bf16x8 pf = __builtin_bit_cast(bf16x8, pw);
        O0 = __builtin_amdgcn_mfma_f32_32x32x16_bf16(vf[0][s2], pf, O0, 0, 0, 0);
        O1 = __builtin_amdgcn_mfma_f32_32x32x16_bf16(vf[1][s2], pf, O1, 0, 0, 0);
    }
}
__device__ __forceinline__ void phase_attn(KArgs A, Frame& F, int l) {
    PH_LOCALS;
    LAS unsigned char* lds = F.lds;
    LAS float* rpb = (LAS float*)(lds + AT_RPB);
    for (int i = tid; i < 6 * 465; i += NTHREADS) rpb[i] = FIN(9)[(size_t)l * 6 * 465 + i] * LOG2E;
    __syncthreads();
    const bf16_t* P = WSP(bf16_t, WS_P); const bf16_t* VT = WSP(bf16_t, WS_VT);
    const int r = lane & 31, hh = lane >> 5;
    const int ngroups = 1536 + ((l < DEPTH - 1) ? 48 : 0);
    for (int gi = F.bid; gi < ngroups; gi += F.G) {
        int mode, b, head, r0 = 0, qt0 = 0;
        if (gi < 768) { mode = 0; r0 = 4 * (gi & 31); const int bh = gi >> 5; head = bh % 6; b = bh / 6; }
        else if (gi < 1536) { mode = 1; const int g2 = gi - 768; qt0 = 8 * (g2 & 31); const int bh = g2 >> 5; head = bh % 6; b = bh / 6; }
        else { const int g2 = gi - 1536; mode = 2 + g2 / 24; const int bh = g2 % 24; head = bh % 6; b = bh / 6; }
        const bool na = (mode == 0 || mode == 2);
        const int qcol = na ? 64 * head : 768 + 64 * head, kcol = na ? 384 + 64 * head : 1152 + 64 * (head / 3);
        const int vrow = na ? 64 * head : 384 + 64 * (head / 3), ycol = na ? 64 * head : 640 + 64 * head;
        int qtok0, qrow = 0, mh = 0, qt = 0;
        if (mode == 0) { qrow = r0 + (wave >> 1); mh = wave & 1; qtok0 = b * SEQ + qrow * 64 + 32 * mh; }
        else if (mode == 1) { qt = qt0 + wave; qtok0 = b * SEQ + 32 * qt; }
        else qtok0 = NLAT + b * CTXL + 32 * wave;
        const int rsw = min(max(qrow - 4, 0), 120);
        const int qc = 32 * mh + r, wsn = min(max(qc - 8, 0), 48);
        const int qpos = 32 * qt + r;
        unsigned vmask0 = 0u, vmask1 = 0u;
#pragma unroll
        for (int i = 0; i < 16; ++i) { const int ki = (i & 3) + 8 * (i >> 2) + 4 * hh; vmask0 |= ((ki >= wsn && ki < wsn + 16) ? 1u : 0u) << i; vmask1 |= ((32 + ki >= wsn && 32 + ki < wsn + 16) ? 1u : 0u) << i; }
        int nlat = 0, kbase = 0, kofs = 0;
        if (mode == 0) { const int kra = min(max(r0 - 4, 0), 120), krb = min(max(r0 - 1, 0), 120) + 7; kbase = kra >> 1; kofs = (kra & 1) * 64; nlat = (krb - kra + 2) >> 1; }
        else if (mode == 1) { const int ks0 = max(qt0 - 4, 0) >> 2, ks1 = min(qt0 + 11, 255) >> 2; kbase = ks0; nlat = ks1 - ks0 + 1; }
        const int nsteps = nlat + 2;
        const int lat0 = b * SEQ + 128 * kbase + kofs, ctx0 = NLAT + b * CTXL;
        float m = na ? -1e30f : FIN(20)[l * 6 + head] * LOG2E, lsum = na ? 0.f : 1.f;
        bf16x8 qf[4];
#pragma unroll
        for (int s = 0; s < 4; ++s) qf[s] = *(const bf16x8*)(P + (size_t)(qtok0 + r) * PW + qcol + 32 * hh + 8 * s);
        f32x16 O0, O1;
#pragma unroll
        for (int i = 0; i < 16; ++i) { O0[i] = 0.f; O1[i] = 0.f; }
        __builtin_amdgcn_s_barrier();
        attn_stage(P, VT, lds, 0, (nlat > 0) ? lat0 : ctx0, kcol, vrow, lane, wave);
        attn_stage(P, VT, lds, 1, (nlat > 1) ? lat0 + 128 : ctx0 + 128 * (1 - nlat), kcol, vrow, lane, wave);
        for (int s = 0; s < nsteps; ++s) {
            if (s + 1 < nsteps) asm volatile("s_waitcnt vmcnt(4)" ::: "memory"); else asm volatile("s_waitcnt vmcnt(0)" ::: "memory");
            __builtin_amdgcn_s_barrier();
            if (s + 2 < nsteps) { const int s2 = s + 2; attn_stage(P, VT, lds, s2 % 3, (s2 < nlat) ? lat0 + 128 * s2 : ctx0 + 128 * (s2 - nlat), kcol, vrow, lane, wave); }
            const bool isctx = (s >= nlat);
            const LAS unsigned char* kb = lds + (s % 3) * AT_STEP; const LAS unsigned char* vb = kb + 16384;
#pragma unroll 1
            for (int tl = 0; tl < 4; ++tl) {
                const int kr = 2 * (kbase + s) + (kofs >> 6) + (tl >> 1), ct = tl & 1;
                const int kt = 4 * (kbase + s) + tl;
                int dt = kt - qt; dt = dt < 0 ? -dt : dt;
                if (!isctx && mode == 0 && (kr < rsw || kr > rsw + 7)) continue;
                if (!isctx && mode == 1 && dt > 4) continue;
                const LAS unsigned char* kt_ = kb + ((4 * hh) * 128 + 32 * tl + r) * 16;
                const LAS unsigned char* vt_ = vb + ((tl * 4 + hh * 2) * 64 + r) * 16;
                if (isctx || (mode == 1 && dt < 4)) attn_tile<0>(kt_, vt_, qf, O0, O1, m, lsum, nullptr, 0u, 0);
                else if (mode == 0) attn_tile<1>(kt_, vt_, qf, O0, O1, m, lsum, rpb + head * 465 + (kr - qrow + 7) * 31 + (32 * ct + 4 * hh - qc + 15), ct ? vmask1 : vmask0, 0);
                else attn_tile<2>(kt_, vt_, qf, O0, O1, m, lsum, nullptr, 0u, qpos - 32 * kt - 4 * hh);
            }
        }
        const float inv = 1.0f / lsum;
        bf16_t* yrow = WSP(bf16_t, WS_Y) + (size_t)(qtok0 + r) * D + ycol + 4 * hh;
#pragma unroll
        for (int rg = 0; rg < 4; ++rg) {
            u32x2 o0; o0.x = cvt_pk_bf16(O0[4 * rg + 0] * inv, O0[4 * rg + 1] * inv); o0.y = cvt_pk_bf16(O0[4 * rg + 2] * inv, O0[4 * rg + 3] * inv);
            u32x2 o1; o1.x = cvt_pk_bf16(O1[4 * rg + 0] * inv, O1[4 * rg + 1] * inv); o1.y = cvt_pk_bf16(O1[4 * rg + 2] * inv, O1[4 * rg + 3] * inv);
            *(u32x2*)(yrow + 8 * rg) = o0; *(u32x2*)(yrow + 32 + 8 * rg) = o1;
        }
    }
    asm volatile("s_waitcnt vmcnt(0)" ::: "memory");
    __builtin_amdgcn_s_barrier();
}

__device__ __forceinline__ int xcd_unit(int i, int G, int c, int U) {
    if ((G & 7) != 0) { const int idx = i * G + c; return idx < U ? idx : -1; }
    const int x = c & 7, j = c >> 3, per = G >> 3, q = U >> 3, r = U & 7;
    const int start = x * q + (x < r ? x : r), size = q + (x < r ? 1 : 0);
    const int loc = i * per + j;
    return loc < size ? start + loc : -1;
}
#define ACC8(ai, bj, m) const f32x4 a0_ = acc[ai][bj][m][0], a1_ = acc[ai][bj][m][1]; float v[8] = {a0_[0], a0_[1], a0_[2], a0_[3], a1_[0], a1_[1], a1_[2], a1_[3]}
__device__ __forceinline__ u32x4 pack8(const float* v) { u32x4 w; w.x = cvt_pk_bf16(v[0], v[1]); w.y = cvt_pk_bf16(v[2], v[3]); w.z = cvt_pk_bf16(v[4], v[5]); w.w = cvt_pk_bf16(v[6], v[7]); return w; }

struct SchedInproj { int G, c; const char* H; const char* W;
    __device__ __forceinline__ bool next(int i, GUnit& u) const {
        const int idx = xcd_unit(i, G, c, 1056); if (idx < 0) return false;
        if (idx < 792) { const int pm = idx / 6, pn = idx % 6; u.A = H + (size_t)pm * 256 * 2048; u.B = W + (size_t)pn * 256 * 2048; u.p0 = 0; u.p1 = pm; u.p2 = pn; u.p3 = 0; }
        else { const int j = idx - 792, vm = j / 132, tn = j % 132; u.A = W + (size_t)(1536 + 256 * vm) * 2048; u.B = H + (size_t)tn * 256 * 2048; u.p0 = 1; u.p1 = vm; u.p2 = tn; u.p3 = 0; }
        return true; }
    __device__ __forceinline__ int row_token(const GUnit&, int) const { return 0; }
    __device__ __forceinline__ void pre(const GUnit&, int, int, int) const {}
};
struct EpiInproj { bf16_t* P; bf16_t* VT; bf16_t* SUX; const LAS float* ROPE;
    __device__ __forceinline__ void operator()(const AccT& acc, const GUnit& u, int slot, int wr, int wc, int fr, int fq) const {
        if (u.p0 == 1) {
#pragma unroll
            for (int ai = 0; ai < 2; ++ai)
#pragma unroll
                for (int m = 0; m < 4; ++m) { const int row = u.p1 * 256 + 128 * ai + 64 * wr + 16 * m + fr;
#pragma unroll
                    for (int bj = 0; bj < 2; ++bj) { ACC8(ai, bj, m); const u32x4 w = pack8(v);
                        bf16_t* vp = VT + (size_t)row * TT + u.p2 * 256 + 128 * bj + 32 * wc + 8 * (fq >> 1) + 4 * (fq & 1);
                        *(u32x2*)vp = (u32x2){w.x, w.y}; *(u32x2*)(vp + 16) = (u32x2){w.z, w.w}; } }
            return;
        }
        const int pm = u.p1, pn = u.p2;
#pragma unroll
        for (int bj = 0; bj < 2; ++bj) {
            const int hh = 2 * pn + bj;
#pragma unroll
            for (int ai = 0; ai < 2; ++ai)
#pragma unroll
                for (int m = 0; m < 4; ++m) {
                    const int row = pm * 256 + 128 * ai + 64 * wr + 16 * m + fr;
                    ACC8(ai, bj, m);
                    if (hh >= 10) {
                        const int g = 8 * (hh - 10) + 2 * wc + (fq >> 1);
                        *(u32x4*)(SUX + ((size_t)g * MCH + (row >> 6)) * SUXW + (row & 63) * 16 + 8 * (fq & 1)) = pack8(v);
                    } else {
                        if (hh >= 6 && pm < 128) {
                            const int t = row & (SEQ - 1); const int pos = (wc & 1) ? (t & 63) : (t >> 6);
                            const LAS float* cs = ROPE + pos * 16 + 8 * (fq & 1);
                            const f32x4 c0 = *(const LAS f32x4*)cs, c1 = *(const LAS f32x4*)(cs + 4), s0 = *(const LAS f32x4*)(cs + 2048), s1 = *(const LAS f32x4*)(cs + 2052);
                            const float cc[8] = {c0[0], c0[1], c0[2], c0[3], c1[0], c1[1], c1[2], c1[3]}, sn[8] = {s0[0], s0[1], s0[2], s0[3], s1[0], s1[1], s1[2], s1[3]};
#pragma unroll
                            for (int e = 0; e < 8; ++e) { const float pr = __shfl_xor(v[e], 32); v[e] = v[e] * cc[e] + ((fq < 2) ? -pr : pr) * sn[e]; }
                        }
                        *(u32x4*)(P + (size_t)row * PW + 128 * hh + 32 * wc + 8 * fq) = pack8(v);
                    }
                }
        }
    }
};
struct SchedS5a { int G, c; const char* SUX; const char* W;
    __device__ __forceinline__ bool next(int i, GUnit& u) const {
        const int idx = xcd_unit(i, G, c, 48); if (idx < 0) return false;
        const int g = idx / 3, pm = idx % 3; u.A = SUX + ((size_t)g * MCH + pm * 256) * (SUXW * 2); u.B = W + (size_t)g * 256 * 2048; u.p0 = 0; u.p1 = pm; u.p2 = g; u.p3 = 0; return true; }
    __device__ __forceinline__ int row_token(const GUnit&, int) const { return 0; }
    __device__ __forceinline__ void pre(const GUnit&, int, int, int) const {}
};
struct EpiS5a { float* SL;
    __device__ __forceinline__ void operator()(const AccT& acc, const GUnit& u, int slot, int wr, int wc, int fr, int fq) const {
#pragma unroll
        for (int ai = 0; ai < 2; ++ai)
#pragma unroll
            for (int m = 0; m < 4; ++m) { float* rowp = SL + (size_t)(u.p1 * 256 + 128 * ai + 64 * wr + 16 * m + fr) * 4096 + u.p2 * 256 + 32 * wc + 8 * fq;
#pragma unroll
                for (int bj = 0; bj < 2; ++bj) { *(f32x4*)(rowp + 128 * bj) = acc[ai][bj][m][0]; *(f32x4*)(rowp + 128 * bj + 4) = acc[ai][bj][m][1]; } }
    }
};
struct SchedS5c { int G, c; const char* SUX; const char* KC;
    __device__ __forceinline__ bool next(int i, GUnit& u) const {
        const int idx = xcd_unit(i, G, c, 192); if (idx < 0) return false;
        const int g = idx / 12, q = idx % 12, pm = q / 4, pn = q % 4;
        u.A = SUX + ((size_t)g * MCH + pm * 256) * (SUXW * 2); u.B = KC + ((size_t)g * 1024 + pn * 256) * (SUXW * 2); u.p0 = 0; u.p1 = pm; u.p2 = pn; u.p3 = g; return true; }
    __device__ __forceinline__ int row_token(const GUnit&, int) const { return 0; }
    __device__ __forceinline__ void pre(const GUnit&, int, int, int) const {}
};
struct EpiS5c { bf16_t* Gb;
    __device__ __forceinline__ void operator()(const AccT& acc, const GUnit& u, int slot, int wr, int wc, int fr, int fq) const {
#pragma unroll
        for (int ai = 0; ai < 2; ++ai)
#pragma unroll
            for (int m = 0; m < 4; ++m) { const int chunk = u.p1 * 256 + 128 * ai + 64 * wr + 16 * m + fr;
                if (chunk < TT / 64) {
#pragma unroll
                    for (int bj = 0; bj < 2; ++bj) { ACC8(ai, bj, m); const int col = u.p2 * 256 + 128 * bj + 32 * wc + 8 * fq;
#pragma unroll
                        for (int e = 0; e < 8; ++e) v[e] = gelu_tanh(v[e]);
                        *(u32x4*)(Gb + ((size_t)chunk * 64 + (col >> 4)) * 256 + u.p3 * 16 + (col & 15)) = pack8(v); } } }
    }
};
struct SchedGlu { int G, c; const char* Gb; const char* W;
    __device__ __forceinline__ bool next(int i, GUnit& u) const {
        const int idx = xcd_unit(i, G, c, 132); if (idx < 0) return false;
        u.A = Gb + (size_t)idx * 256 * 512; u.B = W; u.p0 = 0; u.p1 = idx; u.p2 = 0; u.p3 = 0; return true; }
    __device__ __forceinline__ int row_token(const GUnit&, int) const { return 0; }
    __device__ __forceinline__ void pre(const GUnit&, int, int, int) const {}
};
struct EpiGlu { const bf16_t* Gb; bf16_t* Y; const float* bglu;
    __device__ __forceinline__ void operator()(const AccT& acc, const GUnit& u, int slot, int wr, int wc, int fr, int fq) const {
#pragma unroll
        for (int bj = 0; bj < 2; ++bj) { const int col = 128 * bj + 32 * wc + 8 * fq;
            const f32x4 b0 = *(const f32x4*)(bglu + col), b1 = *(const f32x4*)(bglu + col + 4); const float bb[8] = {b0[0], b0[1], b0[2], b0[3], b1[0], b1[1], b1[2], b1[3]};
            u32x4 gw[2][4];
#pragma unroll
            for (int ai = 0; ai < 2; ++ai)
#pragma unroll
                for (int m = 0; m < 4; ++m) gw[ai][m] = *(const u32x4*)(Gb + (size_t)(u.p1 * 256 + 128 * ai + 64 * wr + 16 * m + fr) * 256 + col);
#pragma unroll
            for (int ai = 0; ai < 2; ++ai)
#pragma unroll
                for (int m = 0; m < 4; ++m) { const int row = u.p1 * 256 + 128 * ai + 64 * wr + 16 * m + fr; ACC8(ai, bj, m);
                    const u32x4 g4 = gw[ai][m];
                    const float gv[8] = {bflo(g4.x), bfhi(g4.x), bflo(g4.y), bfhi(g4.y), bflo(g4.z), bfhi(g4.z), bflo(g4.w), bfhi(g4.w)};
#pragma unroll
                    for (int e = 0; e < 8; ++e) v[e] = gv[e] * sigmoidf_(v[e] + bb[e]);
                    *(u32x4*)(Y + (size_t)row * D + 384 + col) = pack8(v); } }
    }
};
struct SchedOut { int G, c, nunits; const char* Y; const char* W;
    __device__ __forceinline__ bool next(int i, GUnit& u) const {
        const int idx = xcd_unit(i, G, c, nunits); if (idx < 0) return false;
        const int pm = idx >> 2, pn = idx & 3; u.A = Y + (size_t)pm * 256 * 2048; u.B = W + (size_t)pn * 256 * 2048; u.p0 = 0; u.p1 = pm; u.p2 = pn; u.p3 = 0; return true; }
    __device__ __forceinline__ int row_token(const GUnit&, int) const { return 0; }
    __device__ __forceinline__ void pre(const GUnit&, int, int, int) const {}
};
struct EpiOut { bf16_t* DL;
    __device__ __forceinline__ void operator()(const AccT& acc, const GUnit& u, int slot, int wr, int wc, int fr, int fq) const {
#pragma unroll
        for (int ai = 0; ai < 2; ++ai)
#pragma unroll
            for (int m = 0; m < 4; ++m) { bf16_t* rowp = DL + (size_t)(u.p1 * 256 + 128 * ai + 64 * wr + 16 * m + fr) * D + u.p2 * 256 + 32 * wc + 8 * fq;
#pragma unroll
                for (int bj = 0; bj < 2; ++bj) { ACC8(ai, bj, m); *(u32x4*)(rowp + 128 * bj) = pack8(v); } }
    }
};
struct SchedMoe { int G, c, NT; const LAS int* ts; const char* A; const char* W; size_t wstride; const int* elist; bool gather; const float* bgu; LAS unsigned char* lds; bool rev;
    __device__ __forceinline__ bool next(int i, GUnit& u) const {
        const int idx = xcd_unit(i, G, c, ts[32] * NT); if (idx < 0) return false;
        const int mt = rev ? (ts[32] - 1 - idx / NT) : idx / NT, pn = idx % NT; int e = 0; while (ts[e + 1] <= mt) ++e;
        u.A = gather ? A : (A + (size_t)mt * 256 * 1024); u.B = W + (size_t)e * wstride + (size_t)pn * 256 * 1024;   u.p0 = mt; u.p1 = pn; u.p2 = e; u.p3 = (mt - ts[e]) * 256; return true; }
    __device__ __forceinline__ int row_token(const GUnit& u, int row) const { const int j = u.p3 + row; return (j < ts[40 + u.p2]) ? elist[(size_t)u.p2 * TT + j] : 0; }
    __device__ __forceinline__ void pre(const GUnit& u, int slot, int wid, int lane) const {
        if (bgu != nullptr && wid == 0) { const float* src = bgu + (size_t)u.p2 * 2048 + 128 * u.p1 + ((lane & 32) ? 1024 : 0) + 4 * (lane & 31);
            __builtin_amdgcn_global_load_lds((const unsigned*)src, (LAS unsigned*)(lds + LDS_BIAS + slot * 1024), 16, 0, 0); } }
};
struct EpiGateUp { unsigned char* ACT; LAS unsigned char* lds;
    __device__ __forceinline__ void operator()(const AccT& acc, const GUnit& u, int slot, int wr, int wc, int fr, int fq) const {
        const int col = 128 * u.p1 + 32 * wc + 8 * fq; const LAS float* bg = (const LAS float*)(lds + LDS_BIAS + slot * 1024) + 32 * wc + 8 * fq;
        const f32x4 g0 = *(const LAS f32x4*)bg, g1 = *(const LAS f32x4*)(bg + 4), u0 = *(const LAS f32x4*)(bg + 128), u1 = *(const LAS f32x4*)(bg + 132);
        const float bgate[8] = {g0[0], g0[1], g0[2], g0[3], g1[0], g1[1], g1[2], g1[3]}, bup[8] = {u0[0], u0[1], u0[2], u0[3], u1[0], u1[1], u1[2], u1[3]};
#pragma unroll
        for (int ai = 0; ai < 2; ++ai)
#pragma unroll
            for (int m = 0; m < 4; ++m) { const size_t row = (size_t)u.p0 * 256 + 128 * ai + 64 * wr + 16 * m + fr;
                const f32x4 ga = acc[ai][0][m][0], gb = acc[ai][0][m][1], ua = acc[ai][1][m][0], ub = acc[ai][1][m][1];
                const float gt[8] = {ga[0], ga[1], ga[2], ga[3], gb[0], gb[1], gb[2], gb[3]}, up[8] = {ua[0], ua[1], ua[2], ua[3], ub[0], ub[1], ub[2], ub[3]};
                float v[8];
#pragma unroll
                for (int e = 0; e < 8; ++e) { const float gg = fminf(gt[e] * (1.0f / (FP8_SH * FP8_SW)) + bgate[e], 7.0f); const float uu = fminf(fmaxf(up[e] * (1.0f / (FP8_SH * FP8_SW)) + bup[e], -7.0f), 7.0f); v[e] = FP8_SA * gg * sigmoidf_(1.702f * gg) * (uu + 1.0f); }
                *(u32x2*)(ACT + row * FF + col) = (u32x2){pk4_fp8(v[0], v[1], v[2], v[3]), pk4_fp8(v[4], v[5], v[6], v[7])}; }
    }
};
struct EpiDown { bf16_t* EO;
    __device__ __forceinline__ void operator()(const AccT& acc, const GUnit& u, int slot, int wr, int wc, int fr, int fq) const {
#pragma unroll
        for (int ai = 0; ai < 2; ++ai)
#pragma unroll
            for (int m = 0; m < 4; ++m) { bf16_t* rowp = EO + ((size_t)u.p0 * 256 + 128 * ai + 64 * wr + 16 * m + fr) * D + u.p1 * 256 + 32 * wc + 8 * fq;
#pragma unroll
                for (int bj = 0; bj < 2; ++bj) { ACC8(ai, bj, m);
#pragma unroll
                    for (int e = 0; e < 8; ++e) v[e] *= (1.0f / (FP8_SA * FP8_SW));
                    *(u32x4*)(rowp + 128 * bj) = pack8(v); } }
    }
};

constexpr int PH_PER_LAYER = 11, NPHASES = 2 + DEPTH * PH_PER_LAYER + 1;

__global__ void __launch_bounds__(NTHREADS, 2) mk_fwd(Args args) {
    extern __shared__ __attribute__((aligned(16))) unsigned char lds_raw[];
    Frame F;
    F.lds = (LAS unsigned char*)lds_raw;
    F.G = gridDim.x; F.bid = blockIdx.x;
    KArgs A0 = (KArgs)__builtin_amdgcn_kernarg_segment_ptr();
    KArgs A = A0; asm volatile("" : "+s"(A));
    volatile LAS unsigned* misc = (volatile LAS unsigned*)(F.lds + LDS_MISC);
    if (threadIdx.x < 16) misc[threadIdx.x] = 0u;
    __syncthreads();
    const int lo = A->ph_lo, hi = A->ph_hi;
    XcdBarrier bar; bar.bar = (unsigned*)A->ws + CW_BAR; bar.x = 0; bar.st = nullptr;
    if (hi - lo > 1) bar = xcd_barrier_post((unsigned*)A->ws + CW_BAR, misc + 8);
    LAS unsigned char* L = F.lds;
    const LAS int* ts = (const LAS int*)(F.lds + LDS_MISC + 64);
    int ph = 0;
#ifdef ONLY_SITE
#define SITE_ON(s) ((s) == ONLY_SITE)
#else
#define SITE_ON(s) true
#endif
#ifndef DUP_MASK
#define DUP_MASK 0u
#endif
#define PH_RUN(s) (SITE_ON(s) && ph >= lo && ph < hi)
#define PH_REP(s) for (int rep_ = 0; rep_ < (((DUP_MASK >> (s)) & 1u) ? 2 : 1); ++rep_)
#define PH_END do { if (ph >= lo && ph + 1 < hi) xcd_barrier(bar); ++ph; A = A0; asm volatile("" : "+s"(A)); } while (0)

    if (PH_RUN(0)) PH_REP(0) phase_p0a(A, F);
    PH_END;
    if (PH_RUN(1)) PH_REP(1) phase_p0b(A, F);
    PH_END;
    for (int l = 0; l < DEPTH; ++l) {
        const bool lastl = (l == DEPTH - 1);
        if (PH_RUN(2)) { phase_norm1(A, F, l); if ((DUP_MASK >> 2) & 1u) phase_norm1(A, F, l, 0.0f); }
        PH_END;
        if (PH_RUN(3)) PH_REP(3) {
            SchedInproj S{F.G, F.bid, (const char*)WSP(bf16_t, WS_H), (const char*)(WSP(bf16_t, WS_WINT) + (size_t)l * 2048 * D)};
            { int t0 = threadIdx.x; asm volatile("" : "+v"(t0)); LAS float* rl = (LAS float*)(L + LDS_ROPE); const float* rg = WSP(float, WS_ROPE); for (int i = t0; i < 4096; i += NTHREADS) rl[i] = rg[i]; __syncthreads(); }
            EpiInproj E{WSP(bf16_t, WS_P), WSP(bf16_t, WS_VT), WSP(bf16_t, WS_SUX), (const LAS float*)(L + LDS_ROPE)};
            gemm_phase<false, false>(L, 16, 2048u, 2048u, S, E);
        }
        PH_END;
        if (PH_RUN(4)) PH_REP(4) {
            SchedS5a S{F.G, F.bid, (const char*)WSP(bf16_t, WS_SUX), (const char*)(WSP(bf16_t, WS_WST) + (size_t)l * 16 * 256 * 1024)};
            EpiS5a E{WSP(float, WS_SLOC)};
            gemm_phase<false, false>(L, 16, (unsigned)(SUXW * 2), 2048u, S, E);
        }
        PH_END;
        if (PH_RUN(5)) PH_REP(5) phase_s5scan(A, F, l);
        PH_END;
        if (PH_RUN(6)) PH_REP(6) {
            SchedS5c S{F.G, F.bid, (const char*)WSP(bf16_t, WS_SUX), (const char*)(WSP(bf16_t, WS_KC) + (size_t)l * 16 * 1024 * SUXW)};
            EpiS5c E{WSP(bf16_t, WS_G)};
            gemm_phase<false, false>(L, 20, (unsigned)(SUXW * 2), (unsigned)(SUXW * 2), S, E);
        }
        PH_END;
        if (PH_RUN(7)) PH_REP(7) {
            SchedGlu S{F.G, F.bid, (const char*)WSP(bf16_t, WS_G), (const char*)(WSP(bf16_t, WS_WGLUT) + (size_t)l * 256 * 256)};
            EpiGlu E{WSP(bf16_t, WS_G), WSP(bf16_t, WS_Y), FIN(19) + (size_t)l * 256};
            gemm_phase<false, false>(L, 4, 512u, 512u, S, E);
        }
        PH_END;
        if (PH_RUN(8)) PH_REP(8) phase_attn(A, F, l);
        PH_END;
        if (PH_RUN(9)) PH_REP(9) {
            SchedOut S{F.G, F.bid, (lastl ? 128 : 132) * 4, (const char*)WSP(bf16_t, WS_Y), (const char*)(WSP(bf16_t, WS_WOUTT) + (size_t)l * D * D)};
            EpiOut E{WSP(bf16_t, WS_DELTA)};
            gemm_phase<false, false>(L, 16, 2048u, 2048u, S, E);
        }
        PH_END;
        if (PH_RUN(10)) { phase_router(A, F, l); if ((DUP_MASK >> 10) & 1u) phase_router(A, F, l, true); }
        PH_END;
        if (PH_RUN(11)) PH_REP(11) {
            build_tstart(A, F, l);
            SchedMoe S{F.G, F.bid, 8, ts, (const char*)WSP(unsigned char, WS_H8), (const char*)(WSP(unsigned char, WS_WGUT) + (size_t)l * NEXP * 2048 * D), (size_t)2048 * D, WSP(int, WS_ELIST), true, FIN(25) + (size_t)l * NEXP * 2048, L, false};
            EpiGateUp E{WSP(unsigned char, WS_ACT), L};
            gemm_phase<true, true>(L, 8, 1024u, 1024u, S, E);
        }
        PH_END;
        if (PH_RUN(12)) PH_REP(12) {
            build_tstart(A, F, l);
            SchedMoe S{F.G, F.bid, 4, ts, (const char*)WSP(unsigned char, WS_ACT), (const char*)(WSP(unsigned char, WS_WDT) + (size_t)l * NEXP * D * FF), (size_t)D * FF, WSP(int, WS_ELIST), false, nullptr, L, true};
            EpiDown E{WSP(bf16_t, WS_EO)};
            gemm_phase<false, true>(L, 8, 1024u, 1024u, S, E);
        }
        PH_END;
    }
    if (PH_RUN(13)) phase_norm1(A, F, DEPTH);
#undef PH_RUN
#undef PH_END
}
}

extern "C" void kernel_launch(void* const* d_in, const int* in_sizes, int n_in, void* d_out, int out_size, void* d_ws, size_t ws_size, hipStream_t stream) {
    static int grid = 0;
    if (grid == 0) {
        if (n_in != 29 || out_size != NLAT * D || ws_size < WS_END) { fprintf(stderr, "kernel_launch: unexpected shapes (n_in %d, out %d, ws %zu)\n", n_in, out_size, ws_size); grid = -1; return; }
        int dev = 0, cus = 0;
        if (hipGetDevice(&dev) != hipSuccess || hipDeviceGetAttribute(&cus, hipDeviceAttributeMultiprocessorCount, dev) != hipSuccess) { grid = -1; return; }
        if (hipFuncSetAttribute((const void*)mk_fwd, hipFuncAttributeMaxDynamicSharedMemorySize, LDS_BYTES) != hipSuccess) { fprintf(stderr, "kernel_launch: hipFuncSetAttribute failed\n"); grid = -1; return; }
        int per_cu = 0;
        if (hipOccupancyMaxActiveBlocksPerMultiprocessor(&per_cu, (const void*)mk_fwd, NTHREADS, LDS_BYTES) != hipSuccess || per_cu < 1) { fprintf(stderr, "kernel_launch: occupancy query reports %d\n", per_cu); }
        (void)hipGetLastError();
        grid = cus;
    }
    if (grid < 0) return;
    (void)hipMemsetAsync((char*)d_ws + WS_CTL, 0, 1 * MiB, stream);
    Args a{};
    for (int i = 0; i < 29; ++i) a.in[i] = (const float*)d_in[i];
    a.out = (float*)d_out; a.ws = (unsigned char*)d_ws;
#if MK_PER_PHASE
    for (int p = 0; p < NPHASES; ++p) { a.ph_lo = p; a.ph_hi = p + 1; hipLaunchKernelGGL(mk_fwd, dim3(grid), dim3(NTHREADS), LDS_BYTES, stream, a); }
#else
    a.ph_lo = 0; a.ph_hi = NPHASES;
    hipLaunchKernelGGL(mk_fwd, dim3(grid), dim3(NTHREADS), LDS_BYTES, stream, a);
#endif
}
```

```cpp
#include <hip/hip_runtime.h>
#include <cstdio>
#include <cstdint>

#ifndef MK_PER_PHASE
#define MK_PER_PHASE 0
#endif

#ifndef PROBE_SEL
#define PROBE_SEL -1
#endif
#define LAS __attribute__((address_space(3)))
#define GAS __attribute__((address_space(1)))
typedef unsigned short bf16_t;
typedef short bf16x8 __attribute__((ext_vector_type(8)));
typedef float f32x4 __attribute__((ext_vector_type(4)));
typedef float f32x2 __attribute__((ext_vector_type(2)));
typedef float f32x16 __attribute__((ext_vector_type(16)));
typedef unsigned u32x4 __attribute__((ext_vector_type(4)));
typedef unsigned u32x2 __attribute__((ext_vector_type(2)));
typedef int v8i __attribute__((ext_vector_type(8)));
typedef int v4i __attribute__((ext_vector_type(4)));

namespace {
constexpr int D = 1024, NBATCH = 4, SEQ = 8192, DEPTH = 4, CTXL = 256;
constexpr int NLAT = NBATCH * SEQ;
constexpr int NCTX = NBATCH * CTXL;
constexpr int TT = NLAT + NCTX;
constexpr int PW = 1280;
constexpr int NEXP = 32, FF = 1024;
constexpr int MCH = 768;
constexpr int SUXW = 1280;
constexpr int MAXTILES = 560;
constexpr int NWAVES = 8, NTHREADS = 512;
constexpr float RMS_EPS = 1e-6f;
constexpr int P8 = 1152;

constexpr size_t MiB = 1ull << 20;
constexpr size_t WS_CTL = 0;
constexpr size_t WS_MOD = 1 * MiB;
constexpr size_t WS_ROPE = 2 * MiB;
constexpr size_t WS_LP = 3 * MiB;
constexpr size_t WS_BBAR = 8 * MiB;
constexpr size_t WS_WRT = 9 * MiB;
constexpr size_t WS_WGLUT = 10 * MiB;
constexpr size_t WS_WINT = 11 * MiB;
constexpr size_t WS_WOUTT = 27 * MiB;
constexpr size_t WS_WST = 35 * MiB;
constexpr size_t WS_KC = 67 * MiB;
constexpr size_t WS_WGUT = 227 * MiB;
constexpr size_t WS_WDT = 739 * MiB;
constexpr size_t WS_XR = 995 * MiB;
constexpr size_t WS_H = 1127 * MiB;
constexpr size_t WS_P = 1193 * MiB;
constexpr size_t WS_VT = 1276 * MiB;
constexpr size_t WS_SUX = 1309 * MiB;
constexpr size_t WS_SLOC = 1339 * MiB;
constexpr size_t WS_G = 1351 * MiB;
constexpr size_t WS_Y = 1368 * MiB;
constexpr size_t WS_ELIST = 1434 * MiB;
constexpr size_t WS_ELW = 1439 * MiB;
constexpr size_t WS_TOKINFO = 1444 * MiB;
constexpr size_t WS_ACT = 1445 * MiB;
constexpr size_t WS_EO = 1725 * MiB;
constexpr size_t WS_TOKW = 2005 * MiB;
constexpr size_t WS_DELTA = 2006 * MiB;
constexpr size_t WS_H8 = 2072 * MiB;
constexpr size_t WS_END = 2112 * MiB;
constexpr int CW_BAR = 1024;
constexpr int CW_CNT = 8192;
constexpr int CW_STAT = 12288;
constexpr int CW_XC = 12800;
constexpr int CW_QUEUE = 12544;

constexpr int LDS_STAGE = 131072;
constexpr int LDS_MISC = LDS_STAGE;
constexpr int LDS_BIAS = LDS_STAGE + 1024;
constexpr int LDS_ROPE = LDS_STAGE + 4096;
constexpr int LDS_TOK = LDS_STAGE + 4096 + 16384;
constexpr int LDS_T2E = LDS_TOK + 2048;
constexpr int LDS_BYTES = LDS_T2E + 2560;

__device__ __forceinline__ unsigned f2bf(float f) { unsigned u = __builtin_bit_cast(unsigned, f); return (u + 0x7fffu + ((u >> 16) & 1u)) >> 16; }
__device__ __forceinline__ unsigned pk2(float lo, float hi) { return f2bf(lo) | (f2bf(hi) << 16); }
__device__ __forceinline__ float bf2f(unsigned short b) { return __builtin_bit_cast(float, ((unsigned)b) << 16); }
__device__ __forceinline__ float bflo(unsigned w) { return __builtin_bit_cast(float, w << 16); }
__device__ __forceinline__ float bfhi(unsigned w) { return __builtin_bit_cast(float, w & 0xffff0000u); }
__device__ __forceinline__ f32x4 bf4_to_f32(u32x2 w) { return (f32x4){bflo(w.x), bfhi(w.x), bflo(w.y), bfhi(w.y)}; }
__device__ __forceinline__ u32x2 f32_to_bf4(f32x4 v) { u32x2 o; o.x = pk2(v.x, v.y); o.y = pk2(v.z, v.w); return o; }
__device__ __forceinline__ float wave_sum(float v) {
#pragma unroll
    for (int o = 1; o < 64; o <<= 1) v += __shfl_xor(v, o);
    return v;
}
constexpr float FP8_SW = 64.0f, FP8_SH = 16.0f, FP8_SA = 8.0f, FP8_SE = 16.0f, FP8_SY = 16.0f;
__device__ __forceinline__ unsigned pk4_fp8(float a, float b, float c, float d) {
    a = fminf(fmaxf(a, -448.f), 448.f); b = fminf(fmaxf(b, -448.f), 448.f); c = fminf(fmaxf(c, -448.f), 448.f); d = fminf(fmaxf(d, -448.f), 448.f);
    int v = 0; v = __builtin_amdgcn_cvt_pk_fp8_f32(a, b, v, false); v = __builtin_amdgcn_cvt_pk_fp8_f32(c, d, v, true); return (unsigned)v; }
__device__ __forceinline__ unsigned pk4_fp8_nc(float a, float b, float c, float d) {
    int v = 0; v = __builtin_amdgcn_cvt_pk_fp8_f32(a, b, v, false); v = __builtin_amdgcn_cvt_pk_fp8_f32(c, d, v, true); return (unsigned)v; }
__device__ __forceinline__ float fast_exp2(float x) { return __builtin_amdgcn_exp2f(x); }
__device__ __forceinline__ float sigmoidf_(float x) { return __builtin_amdgcn_rcpf(1.0f + __builtin_amdgcn_exp2f(-1.4426950408889634f * x)); }
__device__ __forceinline__ float gelu_tanh(float x) {
    const float u = 0.7978845608028654f * (x + 0.044715f * x * x * x);
    const float t = 1.0f - 2.0f * __builtin_amdgcn_rcpf(1.0f + __builtin_amdgcn_exp2f(2.8853900817779268f * u));
    return 0.5f * x * (1.0f + t);
}

#define XB_TMO      128
#define XB_XCNT(j)  (256  + 64 * (j))
#define XB_XSUB(j)  (1280 + 64 * (j))
#define XB_XGEN(j)  (2304 + 64 * (j))
#define XB_TOP      3328
#define XB_TOPGEN   3392
#define XCD_BAR_WORDS 3456
#define XB_SPIN_CAP (1u << 18)
__device__ __forceinline__ unsigned xb_ld(unsigned* p)              { return __hip_atomic_load(p, __ATOMIC_RELAXED, __HIP_MEMORY_SCOPE_AGENT); }
__device__ __forceinline__ unsigned xb_add(unsigned* p, unsigned v) { return __hip_atomic_fetch_add(p, v, __ATOMIC_RELAXED, __HIP_MEMORY_SCOPE_AGENT); }
__device__ __forceinline__ unsigned xb_xcc_id() { return (unsigned)__builtin_amdgcn_s_getreg((3 << 11) | 20) & 0xFu; }
#define XB_SPIN(cond, bar) do { unsigned _sp = 0; while (cond) { __builtin_amdgcn_s_sleep(1); \
    if ((++_sp & 255u) == 0u) { if (xb_ld(&(bar)[XB_TMO])) break; if (_sp > XB_SPIN_CAP) { atomicAdd(&(bar)[XB_TMO], 1u); break; } } } } while (0)
struct XcdBarrier { unsigned* bar; unsigned x; volatile LAS unsigned* st; };
__device__ __forceinline__ XcdBarrier xcd_barrier_post(unsigned* bar, volatile LAS unsigned* st) {
    XcdBarrier b; b.bar = bar; b.x = xb_xcc_id(); b.st = st;
    if (threadIdx.x == 0) (void)xb_add(&bar[XB_XCNT(b.x)], 1u);
    return b;
}
__device__ __forceinline__ void xcd_barrier_complete(unsigned* bar, unsigned x, unsigned& nloc, unsigned& nx) {
    const unsigned G = gridDim.x * gridDim.y * gridDim.z;
    unsigned sum, cnt, mine, sp = 0u;
    for (;;) {
        sum = 0u; cnt = 0u; mine = 0u;
#pragma unroll
        for (unsigned j = 0; j < 16; ++j) { const unsigned c = xb_ld(&bar[XB_XCNT(j)]); sum += c; cnt += (c > 0u) ? 1u : 0u; mine = (j == x) ? c : mine; }
        if (sum == G) break;
        __builtin_amdgcn_s_sleep(1);
        if ((++sp & 255u) == 0u) { if (xb_ld(&bar[XB_TMO])) break; if (sp > XB_SPIN_CAP) { atomicAdd(&bar[XB_TMO], 1u); break; } }
    }
    nloc = mine > 0u ? mine : 1u; nx = cnt > 0u ? cnt : 1u;
}
__device__ __forceinline__ void xcd_barrier(const XcdBarrier& b) {
    asm volatile("s_waitcnt vmcnt(0)" ::: "memory");
    __syncthreads();
    if (threadIdx.x == 0) {
        unsigned* bar = b.bar;
        __builtin_amdgcn_s_waitcnt(0);
        unsigned nloc = b.st[0], nx = b.st[1];
        if (nloc == 0u) { xcd_barrier_complete(bar, b.x, nloc, nx); b.st[0] = nloc; b.st[1] = nx; }
        const unsigned old = xb_add(&bar[XB_XSUB(b.x)], 1u);
        const unsigned gen = old / nloc;
        if (old + 1u == (gen + 1u) * nloc) {
            __builtin_amdgcn_fence(__ATOMIC_RELEASE, "agent");
            asm volatile("s_waitcnt vmcnt(0)" ::: "memory");
            const unsigned og = xb_add(&bar[XB_TOP], 1u);
            const unsigned tg = og / nx;
            if (og + 1u == (tg + 1u) * nx) xb_add(&bar[XB_TOPGEN], 1u);
            else XB_SPIN(xb_ld(&bar[XB_TOPGEN]) == tg, bar);
            __builtin_amdgcn_fence(__ATOMIC_ACQUIRE, "agent");
            xb_add(&bar[XB_XGEN(b.x)], 1u);
            asm volatile("s_waitcnt vmcnt(0)" ::: "memory");
        } else {
            XB_SPIN(xb_ld(&bar[XB_XGEN(b.x)]) == gen, bar);
            __builtin_amdgcn_fence(__ATOMIC_ACQUIRE, "agent");
            asm volatile("s_waitcnt vmcnt(0)" ::: "memory");
        }
    }
    __syncthreads();
}

__device__ __forceinline__ void xc_signal(unsigned* c) {
    asm volatile("s_waitcnt vmcnt(0)" ::: "memory");
    __syncthreads();
    if (threadIdx.x == 0) { __builtin_amdgcn_fence(__ATOMIC_RELEASE, "agent"); asm volatile("s_waitcnt vmcnt(0)" ::: "memory"); (void)xb_add(c, 1u); }
}
__device__ __forceinline__ void xc_wait(unsigned* c, unsigned n, unsigned* bar) {
    if (threadIdx.x == 0) { XB_SPIN(xb_ld(c) < n, bar); __builtin_amdgcn_fence(__ATOMIC_ACQUIRE, "agent"); asm volatile("s_waitcnt vmcnt(0)" ::: "memory"); }
    __syncthreads();
}

constexpr float LOG2E_ = 1.4426950408889634f;
constexpr int BM = 256, BK = 64, HALF = 128, HTB = HALF * BK * 2;
__device__ __forceinline__ int lds_byte(int r, int c) { const int st = (r >> 4) * 2 + (c >> 5), rr = r & 15, cc = c & 31, ob = rr * 64 + cc * 2; return st * 1024 + (ob ^ (((ob >> 9) & 1) << 5)); }
__device__ __forceinline__ void stage_rc(int b, int& R, int& C) { const int st = b / 1024, sb = b % 1024, swz = sb ^ (((sb >> 9) & 1) << 5); R = (st >> 1) * 16 + swz / 64; C = (st & 1) * 32 + (swz % 64) / 2; }
__device__ __forceinline__ int perm32(int rho) { const int n = rho >> 4, i = rho & 15; return 8 * (i >> 2) + 4 * n + (i & 3); }
__device__ __forceinline__ unsigned cvt_pk_bf16(float lo, float hi) { unsigned r; asm volatile("v_cvt_pk_bf16_f32 %0, %1, %2" : "=v"(r) : "v"(lo), "v"(hi)); return r; }
__device__ __forceinline__ u32x4 pack8(const float* v) { u32x4 w; w.x = cvt_pk_bf16(v[0], v[1]); w.y = cvt_pk_bf16(v[2], v[3]); w.z = cvt_pk_bf16(v[4], v[5]); w.w = cvt_pk_bf16(v[6], v[7]); return w; }

struct GUnit { const char* A; const char* B; int p0, p1, p2, p3; };
typedef f32x4 AccT[2][2][4][2];

template <bool GATHER, bool FP8, class Sched, class Epi>
__device__ __forceinline__ void gemm_phase(LAS unsigned char* lds, const int nt_  , const unsigned lda2, const unsigned ldb2  , const Sched& S, const Epi& E) {
    int tid = threadIdx.x; asm volatile("" : "+v"(tid));
    int nt = nt_; asm volatile("" : "+s"(nt));
    const int wid = __builtin_amdgcn_readfirstlane(tid >> 6), lane = tid & 63, wr = wid >> 2, wc = wid & 3, fr = lane & 15, fq = lane >> 4;
    unsigned voffA[2][2], voffB[2]; int RA[2], CA[2];
#pragma unroll
    for (int i = 0; i < 2; ++i) { int R, C;
        if (FP8) { const int g = tid + 512 * i; R = (g >> 7) * 16 + (g & 15); C = ((g >> 4) & 7) * 8; }
        else stage_rc(tid * 16 + i * 8192, R, C);
        const int Rb = (R & ~31) + perm32(R & 31);
        RA[i] = R; CA[i] = C; voffA[0][i] = S.voffA(0, R, C * 2, lda2); voffA[1][i] = S.voffA(1, R, C * 2, lda2); voffB[i] = (unsigned)Rb * ldb2 + (unsigned)C * 2u; }
    const size_t kstep = (size_t)(BK * 2);
    const size_t kstepA = S.kstepA();
    const size_t hstepB = (size_t)HALF * ldb2;
    const unsigned ldsw = (unsigned)wid * 1024u;
    const int aoff = FP8 ? ((wr * 4) * 128 + 2 * fq * 16 + fr) * 16 : lds_byte(wr * 64 + fr, fq * 8), boff = FP8 ? ((wc * 2) * 128 + 2 * fq * 16 + fr) * 16 : lds_byte(wc * 32 + fr, fq * 8);
#define PG_SA(b, h) (((b) * 2 + (h)) * HTB)
#define PG_SB(b, h) ((4 + (b) * 2 + (h)) * HTB)
#define PG_STAGE(bufoff, gbase, voff) do { _Pragma("unroll") for (int _i = 0; _i < 2; ++_i) \
        __builtin_amdgcn_global_load_lds((const unsigned*)((const char*)(gbase) + (voff)[_i]), (LAS unsigned*)(lds + (bufoff) + ldsw + _i * 8192), 16, 0, 0); } while (0)
#define PG_LD32(p) __builtin_shufflevector(*(const LAS v4i*)(p), *(const LAS v4i*)((p) + 256), 0, 1, 2, 3, 4, 5, 6, 7)
#define PG_LDA(dst, b, h) do { if (FP8) { _Pragma("unroll") for (int m = 0; m < 4; ++m) dst##8[m] = PG_LD32(lds + PG_SA(b, h) + aoff + m * 2048); } \
        else { _Pragma("unroll") for (int m = 0; m < 4; ++m) _Pragma("unroll") for (int k = 0; k < 2; ++k) dst[m][k] = *(const LAS bf16x8*)(lds + PG_SA(b, h) + aoff + m * 2048 + k * 1024); } } while (0)
#define PG_LDB(dst, b, h) do { if (FP8) { _Pragma("unroll") for (int n = 0; n < 2; ++n) dst##8[n] = PG_LD32(lds + PG_SB(b, h) + boff + n * 2048); } \
        else { _Pragma("unroll") for (int n = 0; n < 2; ++n) _Pragma("unroll") for (int k = 0; k < 2; ++k) dst[n][k] = *(const LAS bf16x8*)(lds + PG_SB(b, h) + boff + n * 2048 + k * 1024); } } while (0)
#define PG_MMA(ai, bj, At, Bt) do { __builtin_amdgcn_s_setprio(1); \
        if (FP8) { _Pragma("unroll") for (int m = 0; m < 4; ++m) _Pragma("unroll") for (int n = 0; n < 2; ++n) \
            asm volatile("v_mfma_f32_16x16x128_f8f6f4 %0, %1, %2, %0" : "+v"(acc[ai][bj][m][n]) : "v"(Bt##8[n]), "v"(At##8[m])); }   \
        else { _Pragma("unroll") for (int m = 0; m < 4; ++m) _Pragma("unroll") for (int n = 0; n < 2; ++n) _Pragma("unroll") for (int k = 0; k < 2; ++k) \
            acc[ai][bj][m][n] = __builtin_amdgcn_mfma_f32_16x16x32_bf16(Bt[n][k], At[m][k], acc[ai][bj][m][n], 0, 0, 0); } \
        __builtin_amdgcn_s_setprio(0); } while (0)
#define PG_WAIT_V(n) asm volatile("s_waitcnt vmcnt(" #n ")" ::: "memory")
#define PG_WAIT_L(n) asm volatile("s_waitcnt lgkmcnt(" #n ")" ::: "memory")
#define PG_BAR __builtin_amdgcn_s_barrier()
#define PG_SCHED __builtin_amdgcn_sched_barrier(0)
    GUnit cur, nxt; int ui = 0;
    if (!S.next(0, cur)) return;
#if PROBE_SEL >= 0
    unsigned pc_k = 0, pc_e = 0, pc_g = 0, pc_n = 0, pc_t0 = 0, pc_t1 = 0, pc_w = 0;
#define PCYC() ({ const unsigned long long c_ = __builtin_amdgcn_s_memtime(); asm volatile("s_waitcnt lgkmcnt(0)" ::: "memory"); (unsigned)c_; })
#endif
    AccT acc;
#pragma unroll
    for (int a = 0; a < 2; ++a)
#pragma unroll
        for (int b = 0; b < 2; ++b)
#pragma unroll
            for (int m = 0; m < 4; ++m)
#pragma unroll
                for (int n = 0; n < 2; ++n) acc[a][b][m][n] = (f32x4){0.f, 0.f, 0.f, 0.f};
    bf16x8 At[4][2], B0[2][2], B1[2][2]; v8i At8[4], B08[2], B18[2];
    const char* cA = cur.A; const char* cB = cur.B;
    S.pre(cur, 0, wid, lane);
    if (GATHER) {
#pragma unroll
        for (int h = 0; h < 2; ++h)
#pragma unroll
            for (int i = 0; i < 2; ++i) voffA[h][i] = (unsigned)S.row_token(cur, h * 128 + RA[i]) * lda2 + (unsigned)CA[i] * 2u;
    }
    unsigned voffAn[2][2];
#pragma unroll
    for (int h = 0; h < 2; ++h)
#pragma unroll
        for (int i = 0; i < 2; ++i) voffAn[h][i] = voffA[h][i];
    PG_STAGE(PG_SB(0, 0), cB, voffB); PG_STAGE(PG_SB(0, 1), cB + hstepB, voffB); PG_STAGE(PG_SA(0, 0), cA, voffA[0]); PG_STAGE(PG_SA(0, 1), cA, voffA[1]);
    if (wr == 1) PG_BAR;
    PG_WAIT_V(2); PG_BAR;
    PG_STAGE(PG_SB(1, 0), cB + kstep, voffB); PG_STAGE(PG_SA(1, 0), cA + kstepA, voffA[0]); PG_STAGE(PG_SB(1, 1), cB + hstepB + kstep, voffB);
    PG_WAIT_V(6); PG_BAR;
    for (;;) {
        const bool has_next = S.next(ui + 1, nxt);
        const char* nA = has_next ? nxt.A : cA; const char* nB = has_next ? nxt.B : cB;
#if PROBE_SEL >= 0
        pc_t0 = PCYC(); if (ui > 0) pc_g += (pc_t0 - pc_t1) & 0xFFFFFu;
#endif
        for (int t = 0; t < nt; t += 2) {
            const bool last = (t == nt - 2);
            const char* a1 = cA + (size_t)(t + 1) * kstepA;
            const char* a2 = last ? nA : cA + (size_t)(t + 2) * kstepA; const char* b2 = last ? nB : cB + (size_t)(t + 2) * kstep;
            const char* a3 = a2 + kstepA; const char* b3 = b2 + kstep;
            if (t == nt - 4 && has_next) S.pre(nxt, (ui + 1) & 1, wid, lane);
            if (GATHER) {
                if (last && has_next) {
                    int tq = threadIdx.x; asm volatile("" : "+v"(tq));
#pragma unroll
                    for (int i = 0; i < 2; ++i) { int R2, C2;
                        if (FP8) { const int g = tq + 512 * i; R2 = (g >> 7) * 16 + (g & 15); C2 = ((g >> 4) & 7) * 8; } else stage_rc(tq * 16 + i * 8192, R2, C2);
#pragma unroll
                        for (int h = 0; h < 2; ++h) voffAn[h][i] = (unsigned)S.row_token_lds(nxt, (ui + 1) & 1, h * 128 + R2) * lda2 + (unsigned)C2 * 2u; }
                }
            }
            unsigned vA0[2], vA1[2];
#pragma unroll
            for (int i = 0; i < 2; ++i) { vA0[i] = (GATHER && last) ? voffAn[0][i] : voffA[0][i]; vA1[i] = (GATHER && last) ? voffAn[1][i] : voffA[1][i]; }
            PG_LDB(B0, 0, 0); PG_LDB(B1, 0, 1); PG_SCHED; PG_LDA(At, 0, 0); PG_STAGE(PG_SA(1, 1), a1, voffA[1]);
            PG_WAIT_V(8); PG_WAIT_L(0); PG_BAR; PG_MMA(0, 0, At, B0); PG_MMA(0, 1, At, B1); PG_BAR; PG_SCHED;
            PG_LDA(At, 0, 1); PG_STAGE(PG_SB(0, 0), b2, voffB); PG_STAGE(PG_SB(0, 1), b2 + hstepB, voffB); PG_STAGE(PG_SA(0, 0), a2, vA0);
            PG_WAIT_V(8); PG_WAIT_L(0); PG_BAR; PG_MMA(1, 0, At, B0); PG_MMA(1, 1, At, B1); PG_BAR; PG_SCHED;
            PG_LDB(B0, 1, 0); PG_LDB(B1, 1, 1); PG_SCHED; PG_LDA(At, 1, 0); PG_STAGE(PG_SA(0, 1), a2, vA1);
            PG_WAIT_V(8); PG_WAIT_L(0); PG_BAR; PG_MMA(0, 0, At, B0); PG_MMA(0, 1, At, B1); PG_BAR; PG_SCHED;
            PG_LDA(At, 1, 1); PG_STAGE(PG_SB(1, 0), b3, voffB); PG_STAGE(PG_SB(1, 1), b3 + hstepB, voffB); PG_STAGE(PG_SA(1, 0), a3, vA0);
            PG_WAIT_V(8); PG_WAIT_L(0); PG_BAR; PG_MMA(1, 0, At, B0); PG_MMA(1, 1, At, B1); PG_BAR; PG_SCHED;
        }
#if PROBE_SEL >= 0
        pc_t1 = PCYC(); pc_k += (pc_t1 - pc_t0) & 0xFFFFFu; ++pc_n;
#endif
        if (wr == 0) PG_BAR;
        if (FP8) asm volatile("s_nop 15\n\ts_nop 15" ::: "memory");
        {
            int tz = threadIdx.x; asm volatile("" : "+v"(tz)); const int wz = __builtin_amdgcn_readfirstlane(tz >> 6), lz = tz & 63;
            E(acc, cur, ui & 1, wz >> 2, wz & 3, lz & 15, lz >> 4); }
#if PROBE_SEL >= 0
        { const unsigned te = PCYC(); pc_e += (te - pc_t1) & 0xFFFFFu; }
#endif
        if (!has_next) break;
#pragma unroll
        for (int a = 0; a < 2; ++a)
#pragma unroll
            for (int b = 0; b < 2; ++b)
#pragma unroll
                for (int m = 0; m < 4; ++m)
#pragma unroll
                    for (int n = 0; n < 2; ++n) acc[a][b][m][n] = (f32x4){0.f, 0.f, 0.f, 0.f};
        cur = nxt; cA = nA; cB = nB; ++ui;
        if (wr == 1) PG_BAR;
        if (GATHER) {
#pragma unroll
            for (int h = 0; h < 2; ++h)
#pragma unroll
                for (int i = 0; i < 2; ++i) voffA[h][i] = voffAn[h][i];
        }
    }
    PG_WAIT_V(0);
    PG_BAR;
#if PROBE_SEL >= 0
    if (S.stat != nullptr && tid == 0) { atomicAdd(S.stat + 0, pc_k); atomicAdd(S.stat + 1, pc_e); atomicAdd(S.stat + 2, pc_g); atomicAdd(S.stat + 3, pc_n); }
#undef PCYC
#endif
#undef PG_SA
#undef PG_SB
#undef PG_STAGE
#undef PG_LDA
#undef PG_LD32
#undef PG_LDB
#undef PG_MMA
#undef PG_WAIT_V
#undef PG_WAIT_L
#undef PG_BAR
#undef PG_SCHED
}

struct Args { const float* in[29]; float* out; unsigned char* ws; int ph_lo, ph_hi; };
struct Frame {
    LAS unsigned char* lds;
    int G, bid;
};
#define PH_LOCALS int tid = threadIdx.x; asm volatile("" : "+v"(tid)); const int lane = tid & 63; const int wave = __builtin_amdgcn_readfirstlane(tid >> 6); (void)lane; (void)wave
typedef const __attribute__((address_space(4))) Args* KArgs;
#define WSP(T, off) ((T*)(A->ws + (off)))
#define FIN(i) (A->in[i])

template <bool F8 = false>
__device__ __forceinline__ void transpose_item(const float* W, int K, int N, bf16_t* WT, int kb, int n0s, int drow0, LAS float* scr, int lane) {
    const int k0 = 64 * kb;
    float wv[32];
#pragma unroll
    for (int i = 0; i < 32; ++i) wv[i] = __builtin_nontemporal_load(W + (size_t)(k0 + 2 * i + (lane >> 5)) * N + n0s + (lane & 31));
#pragma unroll
    for (int i = 0; i < 32; ++i) scr[(2 * i + (lane >> 5)) * 33 + (lane & 31)] = wv[i];
    asm volatile("s_waitcnt lgkmcnt(0)" ::: "memory");
    const int c = lane & 7;
#pragma unroll
    for (int j = 0; j < 4; ++j) { const int n = (lane >> 3) + 8 * j; const LAS float* s = scr + (8 * c) * 33 + n;
        if (F8) { *(u32x2*)((unsigned char*)WT + (size_t)(drow0 + n) * P8 + k0 + 8 * c) = (u32x2){pk4_fp8_nc(s[0 * 33] * FP8_SW, s[1 * 33] * FP8_SW, s[2 * 33] * FP8_SW, s[3 * 33] * FP8_SW), pk4_fp8_nc(s[4 * 33] * FP8_SW, s[5 * 33] * FP8_SW, s[6 * 33] * FP8_SW, s[7 * 33] * FP8_SW)}; }
        else { u32x4 o; o.x = pk2(s[0 * 33], s[1 * 33]); o.y = pk2(s[2 * 33], s[3 * 33]); o.z = pk2(s[4 * 33], s[5 * 33]); o.w = pk2(s[6 * 33], s[7 * 33]);
        *(u32x4*)(WT + (size_t)(drow0 + n) * K + k0 + 8 * c) = o; } }
    asm volatile("s_waitcnt lgkmcnt(0)" ::: "memory");
}
__device__ __forceinline__ void transpose_pair_f8(const float* W, int N, unsigned char* WT, int kbp, int n0s, int drow0, LAS float* scr, int lane) {
    const int k0 = 128 * kbp;
    float wv[64];
#pragma unroll
    for (int i = 0; i < 64; ++i) wv[i] = __builtin_nontemporal_load(W + (size_t)(k0 + 2 * i + (lane >> 5)) * N + n0s + (lane & 31));
    const int c = lane & 7;
#pragma unroll
    for (int hp = 0; hp < 2; ++hp) {
#pragma unroll
        for (int i = 0; i < 32; ++i) scr[(2 * i + (lane >> 5)) * 33 + (lane & 31)] = wv[32 * hp + i];
        asm volatile("s_waitcnt lgkmcnt(0)" ::: "memory");
#pragma unroll
        for (int j = 0; j < 4; ++j) { const int n = (lane >> 3) + 8 * j; const LAS float* s = scr + (8 * c) * 33 + n;
            *(u32x2*)(WT + (size_t)(drow0 + n) * P8 + k0 + 64 * hp + 8 * c) = (u32x2){pk4_fp8_nc(s[0 * 33] * FP8_SW, s[1 * 33] * FP8_SW, s[2 * 33] * FP8_SW, s[3 * 33] * FP8_SW), pk4_fp8_nc(s[4 * 33] * FP8_SW, s[5 * 33] * FP8_SW, s[6 * 33] * FP8_SW, s[7 * 33] * FP8_SW)}; }
        asm volatile("s_waitcnt lgkmcnt(0)" ::: "memory");
    }
}
__device__ __forceinline__ int win_src_col(int d) {
    if (d < 768) return d;
    if (d < 1152) return 1408 + (d - 768);
    if (d < 1280) return 1792 + (d - 1152);
    if (d < 1536) return 1152 + (d - 1280);
    if (d < 1920) return 768 + (d - 1536);
    return d;
}
__device__ __forceinline__ int wgu_src_col(int d) { const int t = d >> 8, r = d & 255; return (r < 128) ? (128 * t + r) : (1024 + 128 * t + (r - 128)); }

constexpr int EXP_ITEMS = NEXP * 8 * 64 + NEXP * 8 * 32;
__device__ __forceinline__ void expert_item(KArgs A, int L, int r, LAS float* scr, int lane) {
    if (r < NEXP * 8 * 64) { const int le = L * NEXP + r / 512, q = r % 512, kb = q / 64, nb = q % 64;
        transpose_pair_f8(FIN(24) + (size_t)le * D * 2048, 2048, WSP(unsigned char, WS_WGUT) + (size_t)le * 2048 * P8, kb, wgu_src_col(32 * nb), 32 * nb, scr, lane); }
    else { r -= NEXP * 8 * 64; const int le = L * NEXP + r / 256, q = r % 256, kb = q / 32, nb = q % 32;
        transpose_pair_f8(FIN(26) + (size_t)le * FF * D, D, WSP(unsigned char, WS_WDT) + (size_t)le * D * P8, kb, 32 * nb, 32 * nb, scr, lane); }
}
__device__ __forceinline__ int conv_fill(KArgs A, Frame& F, int L, int nb) {
    if (L < 0 || L >= DEPTH || nb <= 0) return 0;
    PH_LOCALS;
    LAS float* scr = (LAS float*)(F.lds + wave * 16384);
    volatile LAS int* slot = (volatile LAS int*)(F.lds + LDS_MISC + 16);
    int* q = (int*)A->ws + CW_QUEUE + L;
    for (int b = 0; b < nb; ++b) {
        __syncthreads();
        if (tid == 0) *slot = atomicAdd(q, 1);
        __syncthreads();
        const int idx = *slot * NWAVES + wave;
        if (idx >= EXP_ITEMS) return b;
        expert_item(A, L, idx, scr, lane);
    }
    return nb;
}
__device__ __forceinline__ void conv_fill2(KArgs A, Frame& F, int l, int nb) { const int done = conv_fill(A, F, l, nb); conv_fill(A, F, l + 1, nb - done); }
__device__ __forceinline__ void phase_p0a(KArgs A, Frame& F) {
    PH_LOCALS;
    LAS float* scr = (LAS float*)(F.lds + wave * 16384);
    const int gw = F.bid * NWAVES + wave, NGW = F.G * NWAVES;
    constexpr int I_IN = DEPTH * 8 * 64, I_OUT = DEPTH * 8 * 32, I_GLU = DEPTH * 4 * 8, I_RT = DEPTH * 16, I_EX = 0;
    constexpr int NITEMS = I_IN + I_OUT + I_GLU + I_RT + I_EX;
    for (int it = gw; it < NITEMS; it += NGW) {
        int r = it;
        if (r < I_IN) { const int l = r / 512, q = r % 512, kb = q / 64, nb = q % 64;
            transpose_pair_f8(FIN(7) + (size_t)l * D * 2048, 2048, WSP(unsigned char, WS_WINT) + (size_t)l * 2048 * P8, kb, win_src_col(32 * nb), 32 * nb, scr, lane); continue; } r -= I_IN;
        if (r < I_OUT) { const int l = r / 256, q = r % 256, kb = q / 32, nb = q % 32;
            transpose_pair_f8(FIN(8) + (size_t)l * D * D, D, WSP(unsigned char, WS_WOUTT) + (size_t)l * D * P8, kb, 32 * nb, 32 * nb, scr, lane); continue; } r -= I_OUT;
        if (r < I_GLU) { const int l = r / 32, q = r % 32, kb = q / 8, nb = q % 8;
            transpose_item(FIN(18) + (size_t)l * 256 * 256, 256, 256, WSP(bf16_t, WS_WGLUT) + (size_t)l * 256 * 256, kb, 32 * nb, 32 * nb, scr, lane); continue; } r -= I_GLU;
        if (r < I_RT) { const int l = r / 16, kb = r % 16;
            transpose_item(FIN(22) + (size_t)l * D * NEXP, D, NEXP, WSP(bf16_t, WS_WRT) + (size_t)l * NEXP * D, kb, 0, 0, scr, lane); continue; } r -= I_RT;
        expert_item(A, 0, r, scr, lane);
    }
    __syncthreads();
    {
        LAS float* cond = (LAS float*)F.lds;
        LAS float* red = (LAS float*)(F.lds + 32768);
        for (int i = tid; i < 5 * D; i += NTHREADS) { const int bi = i / D, k = i % D; const float v = (bi < 4) ? FIN(1)[bi * D + k] : FIN(3)[k]; cond[i] = v / (1.0f + __expf(-v)); }
        __syncthreads();
        for (int u = F.bid; u < DEPTH * 96; u += F.G) {
            const int l = u / 96, j = (u % 96) * 64 + lane;
            const float* w = FIN(4) + (size_t)l * D * 6144 + j;
            float a0 = 0.f, a1 = 0.f, a2 = 0.f, a3 = 0.f, a4 = 0.f;
#pragma unroll 1
            for (int kb = 0; kb < 128; kb += 32) {
                float wv[32];
#pragma unroll
                for (int kk = 0; kk < 32; ++kk) wv[kk] = __builtin_nontemporal_load(w + (size_t)(wave * 128 + kb + kk) * 6144);
#pragma unroll
                for (int kk = 0; kk < 32; ++kk) { const int k = wave * 128 + kb + kk;
                    a0 += cond[k] * wv[kk]; a1 += cond[D + k] * wv[kk]; a2 += cond[2 * D + k] * wv[kk]; a3 += cond[3 * D + k] * wv[kk]; a4 += cond[4 * D + k] * wv[kk]; } }
            red[(wave * 5 + 0) * 64 + lane] = a0; red[(wave * 5 + 1) * 64 + lane] = a1; red[(wave * 5 + 2) * 64 + lane] = a2;
            red[(wave * 5 + 3) * 64 + lane] = a3; red[(wave * 5 + 4) * 64 + lane] = a4;
            __syncthreads();
            if (tid < 320) { const int bi = tid / 64, jj = tid % 64; float s = 0.f;
#pragma unroll
                for (int w8 = 0; w8 < 8; ++w8) s += red[(w8 * 5 + bi) * 64 + jj];
                const int col = (u % 96) * 64 + jj;
                WSP(float, WS_MOD)[((size_t)l * 5 + bi) * 6144 + col] = s + FIN(5)[l * 6144 + col]; }
            __syncthreads();
        }
    }
    const int gt = F.bid * NTHREADS + tid, NGT = F.G * NTHREADS;
    for (int i = gt; i < 128 * 16; i += NGT) { const int pos = i / 16, f = i % 16; const float inv = powf(10000.0f, -(float)f / 16.0f); const float a = (float)pos * inv;
        WSP(float, WS_ROPE)[i] = cosf(a); WSP(float, WS_ROPE)[2048 + i] = sinf(a); }
    for (int i = gt; i < DEPTH * 2 * 16 * 65 * 64; i += NGT) {
        const int p = i % 64, d = (i / 64) % 65, ldg = i / (64 * 65);
        const float are = fminf(FIN(10)[ldg * 64 + p], -1e-4f), aim = FIN(11)[ldg * 64 + p];
        const float step = expf(FIN(12)[ldg]);
        const float re = are * step * (float)d, im = aim * step * (float)d;
        const float mag = expf(re);
        WSP(f32x2, WS_LP)[i] = (f32x2){mag * cosf(im), mag * sinf(im)};
    }
    for (int i = gt; i < DEPTH * 2 * 16 * 64 * 16; i += NGT) {
        const int lp = i / 16;
        const int ldg = lp / 64;
        const float are = fminf(FIN(10)[lp], -1e-4f), aim = FIN(11)[lp];
        const float step = expf(FIN(12)[ldg]);
        const float mag = expf(are * step), lr = mag * cosf(aim * step) - 1.0f, li = mag * sinf(aim * step);
        const float den = are * are + aim * aim;
        const float qr = (lr * are + li * aim) / den, qi = (li * are - lr * aim) / den;
        const float br = FIN(13)[i], bi = FIN(14)[i];
        WSP(f32x2, WS_BBAR)[i] = (f32x2){qr * br - qi * bi, qr * bi + qi * br};
    }
}

__device__ __forceinline__ f32x2 cmul(f32x2 a, f32x2 b) { return (f32x2){a.x * b.x - a.y * b.y, a.x * b.y + a.y * b.x}; }
__device__ __forceinline__ void phase_p0b(KArgs A, Frame& F) {
    PH_LOCALS;
    const f32x2* LP = WSP(f32x2, WS_LP); const f32x2* BB = WSP(f32x2, WS_BBAR);
    LAS float* kc = (LAS float*)F.lds;
    for (int it = F.bid; it < DEPTH * 16 * 4; it += F.G) {
        const int qr = it & 3, lg = it >> 2, l = lg >> 4, g = lg & 15;
        for (int i = tid; i < 128 * 64; i += NTHREADS) kc[i] = 0.f;
        __syncthreads();
        {
            const int pq = tid & 3, hi = (tid >> 2) & 15, hol = (tid >> 6) & 3, dir = tid >> 8, ho = 4 * qr + hol;
            const int ldg = (l * 2 + dir) * 16 + g;
            const float* cre = FIN(15) + ((size_t)ldg * 16 + ho) * 64; const float* cim = FIN(16) + ((size_t)ldg * 16 + ho) * 64;
            float acc[64];
#pragma unroll
            for (int d = 0; d < 64; ++d) acc[d] = 0.f;
#pragma unroll 1
            for (int pp = 0; pp < 16; ++pp) { const int p = 16 * pq + pp;
                f32x2 z = cmul((f32x2){cre[p], cim[p]}, BB[(size_t)ldg * 1024 + p * 16 + hi]);
                const f32x2 lam = LP[((size_t)ldg * 65 + 1) * 64 + p];
#pragma unroll
                for (int d = 0; d < 64; ++d) { acc[d] += z.x; z = cmul(z, lam); }
            }
            const int R = (dir * 4 + hol) * 16 + hi;
#pragma unroll
            for (int d = 0; d < 64; ++d) (void)__hip_atomic_fetch_add(kc + R * 64 + ((d + R) & 63), acc[d], __ATOMIC_RELAXED, __HIP_MEMORY_SCOPE_WORKGROUP);
        }
        __syncthreads();
        {
            bf16_t* KC = WSP(bf16_t, WS_KC) + (size_t)lg * 1024 * SUXW;
            const int s = lane;
#pragma unroll 1
            for (int rr = 0; rr < 32; ++rr) {
                const int r = wave * 32 + rr, t = r >> 2, hol = r & 3, ho = 4 * qr + hol;
                const float dsk = FIN(17)[l * 256 + g * 16 + ho];
                float v[16];
#pragma unroll
                for (int hi = 0; hi < 16; ++hi) {
                    const int R0 = (0 * 4 + hol) * 16 + hi, R1 = (1 * 4 + hol) * 16 + hi; const int dd = (s < t) ? t - s : s - t;
                    const float a0 = kc[R0 * 64 + ((dd + R0) & 63)], a1 = kc[R1 * 64 + ((dd + R1) & 63)];
                    v[hi] = (s < t) ? a0 : (s > t) ? a1 : (a0 + a1 + ((hi == ho) ? dsk : 0.f));
                }
                bf16_t* dst = KC + (size_t)(t * 16 + ho) * SUXW + s * 16;
                *(u32x4*)dst = pack8(v); *(u32x4*)(dst + 8) = pack8(v + 8);
                const int q4 = lane >> 4, dir = q4 >> 1, ri = q4 & 1, p0 = 4 * (lane & 15);
                const int ldg = (l * 2 + dir) * 16 + g, e = dir ? 64 - t : t + 1;
                float cv[4];
#pragma unroll
                for (int j = 0; j < 4; ++j) { const int p = p0 + j; const f32x2 c = (f32x2){FIN(15)[((size_t)ldg * 16 + ho) * 64 + p], FIN(16)[((size_t)ldg * 16 + ho) * 64 + p]};
                    const f32x2 w = cmul(c, LP[((size_t)ldg * 65 + e) * 64 + p]); cv[j] = ri ? -w.y : w.x; }
                *(u32x2*)(KC + (size_t)(t * 16 + ho) * SUXW + 1024 + q4 * 64 + p0) = (u32x2){cvt_pk_bf16(cv[0], cv[1]), cvt_pk_bf16(cv[2], cv[3])};
            }
        }
        {
            bf16_t* WT = WSP(bf16_t, WS_WST) + (size_t)lg * 256 * 1024;
            const int s = lane;
#pragma unroll 1
            for (int rr = 0; rr < 8; ++rr) {
                const int n = 64 * qr + wave * 8 + rr, dir = n >> 7, ri = (n >> 6) & 1, p = n & 63;
                const int ldg = (l * 2 + dir) * 16 + g, e = dir ? s : 63 - s;
                const f32x2 lp = LP[((size_t)ldg * 65 + e) * 64 + p];
                float v[16];
#pragma unroll
                for (int hi = 0; hi < 16; ++hi) { const f32x2 w = cmul(lp, BB[(size_t)ldg * 1024 + p * 16 + hi]); v[hi] = ri ? w.y : w.x; }
                bf16_t* dst = WT + (size_t)n * 1024 + s * 16;
                *(u32x4*)dst = pack8(v); *(u32x4*)(dst + 8) = pack8(v + 8);
            }
        }
        __syncthreads();
    }
}

__device__ __forceinline__ void build_tstart(KArgs A, Frame& F, int l) {
    PH_LOCALS;
    LAS int* ts = (LAS int*)(F.lds + LDS_MISC + 64);
    if (tid == 0) { const int* cnt = (const int*)A->ws + CW_CNT + l * 32; int a = 0;
        for (int e = 0; e < 32; ++e) { ts[e] = a; ts[40 + e] = cnt[e]; a += (cnt[e] + 255) >> 8; }
        ts[32] = a; }
    __syncthreads();
    if (tid < 32) { LAS int* t2e = (LAS int*)(F.lds + LDS_T2E); for (int mt = ts[tid]; mt < ts[tid + 1]; ++mt) t2e[mt] = tid; }
    __syncthreads();
}

template <int NR>
__device__ __forceinline__ void norm1_rows(KArgs A, const LAS int* ts, const LAS float* mv, const int l, const int lane_, const int (&rows)[NR]) {
    int lane = lane_; asm volatile("" : "+v"(lane));
    const bool fin = (l == DEPTH);
    bf16_t* XR = WSP(bf16_t, WS_XR);
    f32x4 v[NR][4];
    int bi[NR];
#pragma unroll
    for (int q = 0; q < NR; ++q) bi[q] = (rows[q] < NLAT) ? (rows[q] / SEQ) : 4;
    if (l == 0) {
#pragma unroll
        for (int q = 0; q < NR; ++q) { const int r = rows[q]; const float* src = (r < NLAT) ? (FIN(0) + (size_t)r * D) : (FIN(2) + (size_t)(r - NLAT) * D);
#pragma unroll
            for (int j = 0; j < 4; ++j) v[q][j] = *(const f32x4*)(src + 4 * lane + 256 * j); }
    } else {
        int inf[NR][4]; float wk[NR][4];
#pragma unroll
        for (int q = 0; q < NR; ++q) { const v4i t4 = *(const v4i*)(WSP(int, WS_TOKINFO) + (size_t)rows[q] * 4); const f32x4 w4 = *(const f32x4*)(WSP(float, WS_TOKW) + (size_t)rows[q] * 4);
#pragma unroll
            for (int k = 0; k < 4; ++k) { inf[q][k] = t4[k]; wk[q][k] = w4[k]; } }
        unsigned ew[NR][4][4];
#pragma unroll
        for (int q = 0; q < NR; ++q) {
#pragma unroll
            for (int j = 0; j < 4; ++j) v[q][j] = bf4_to_f32(*(const u32x2*)(XR + (size_t)rows[q] * D + 4 * lane + 256 * j));
#pragma unroll
            for (int k = 0; k < 4; ++k) { const int e = (inf[q][k] >> 24) & 31, rank = inf[q][k] & 0xffffff; const unsigned char* eo = WSP(unsigned char, WS_EO) + ((size_t)ts[e] * 256 + rank) * D;
#pragma unroll
                for (int j = 0; j < 4; ++j) ew[q][k][j] = *(const unsigned*)(eo + 4 * lane + 256 * j); } }
#pragma unroll
        for (int q = 0; q < NR; ++q) {
            f32x4 a[4];
#pragma unroll
            for (int j = 0; j < 4; ++j) a[j] = (f32x4){0.f, 0.f, 0.f, 0.f};
#pragma unroll
            for (int k = 0; k < 4; ++k) { const float w1 = wk[q][k] * (1.0f / FP8_SE);
#pragma unroll
                for (int j = 0; j < 4; ++j) { const int w = (int)ew[q][k][j];
                    const f32x2 lo = __builtin_amdgcn_cvt_pk_f32_fp8(w, false), hi = __builtin_amdgcn_cvt_pk_f32_fp8(w, true);
                    a[j].x += w1 * lo.x; a[j].y += w1 * lo.y; a[j].z += w1 * hi.x; a[j].w += w1 * hi.y; } }
            const LAS float* m5 = mv + bi[q] * D + 4 * lane;
#pragma unroll
            for (int j = 0; j < 4; ++j) { const f32x4 g5 = *(const LAS f32x4*)(m5 + 256 * j); v[q][j] = v[q][j] + g5 * a[j]; }
        }
    }
    float ss[NR];
#pragma unroll
    for (int q = 0; q < NR; ++q) {
        if (!fin) {
#pragma unroll
            for (int j = 0; j < 4; ++j) *(u32x2*)(XR + (size_t)rows[q] * D + 4 * lane + 256 * j) = f32_to_bf4(v[q][j]);
        }
        ss[q] = 0.f;
#pragma unroll
        for (int j = 0; j < 4; ++j) ss[q] += (v[q][j].x * v[q][j].x + v[q][j].y * v[q][j].y) + (v[q][j].z * v[q][j].z + v[q][j].w * v[q][j].w);
    }
#pragma unroll
    for (int o = 1; o < 64; o <<= 1) {
#pragma unroll
        for (int q = 0; q < NR; ++q) ss[q] += __builtin_bit_cast(float, __builtin_amdgcn_ds_bpermute((lane ^ o) << 2, __builtin_bit_cast(int, ss[q]))); }
#pragma unroll
    for (int q = 0; q < NR; ++q) {
        const int r = rows[q];
        const float rinv = 1.0f / sqrtf(ss[q] * (1.0f / D) + RMS_EPS);
        if (fin) {
            float pscale = 1.0f;
#if PROBE_SEL >= 0
            { const unsigned* st = (const unsigned*)A->ws + CW_STAT; const float n = fmaxf((float)st[3], 1.0f);
              float val = (PROBE_SEL == 0) ? (float)st[0] / n * 5e-4f : (PROBE_SEL == 4) ? (float)st[0] / n * 4e-4f : (PROBE_SEL == 1) ? (float)st[1] / n * 1e-2f : (PROBE_SEL == 2) ? (float)st[2] / n * 1e-2f : (float)st[3];
              val = fminf(fmaxf(rintf(val), 0.0f), 300.0f); pscale = 1.0f + sqrtf(val * 1e-3f); }
#endif
#pragma unroll
            for (int j = 0; j < 4; ++j) { const f32x4 g = *(const LAS f32x4*)(mv + 5 * D + 4 * lane + 256 * j); *(f32x4*)(A->out + (size_t)r * D + 4 * lane + 256 * j) = v[q][j] * rinv * g * pscale; }
        } else {
            const LAS float* ga = mv + (5 + bi[q]) * D;
            unsigned char* hrow = WSP(unsigned char, WS_H8) + (size_t)r * P8;
#pragma unroll
            for (int j = 0; j < 4; ++j) { const int c = 4 * lane + 256 * j; const f32x4 g = *(const LAS f32x4*)(ga + c), sh = *(const LAS f32x4*)(ga + 5 * D + c);
                const f32x4 h = v[q][j] * rinv * g + sh;
                *(unsigned*)(hrow + c) = pk4_fp8(h.x * FP8_SH, h.y * FP8_SH, h.z * FP8_SH, h.w * FP8_SH); }
        }
    }
}
__device__ __forceinline__ void phase_norm1(KArgs A, Frame& F, int l, const float dsc = 1.0f) {
    PH_LOCALS;
    const int nrows = (l == DEPTH) ? NLAT : TT;
    if (l > 0) build_tstart(A, F, l - 1);
    const LAS int* ts = (const LAS int*)(F.lds + LDS_MISC + 64);
    LAS float* mv = (LAS float*)F.lds;
    {   const float* MOD = WSP(float, WS_MOD);
        for (int i = tid; i < 5 * D; i += NTHREADS) { const int b = i >> 10, c = i & (D - 1);
            mv[i] = (l > 0) ? MOD[((size_t)(l - 1) * 5 + b) * 6144 + 5 * D + c] * dsc : 0.f;
            if (l < DEPTH) { const float* m0 = MOD + ((size_t)l * 5 + b) * 6144; mv[5 * D + i] = FIN(6)[(size_t)l * D + c] * (m0[D + c] + 1.0f); mv[10 * D + i] = m0[c]; }
            else mv[5 * D + i] = FIN(28)[c]; }
        __syncthreads(); }
    const int gw = F.bid * NWAVES + wave, NGW = F.G * NWAVES;
    int r = gw;
    for (; r + NGW < nrows; r += 2 * NGW) { const int rows[2] = {r, r + NGW}; norm1_rows<2>(A, ts, mv, l, lane, rows); }
    for (; r < nrows; r += NGW) { const int rows[1] = {r}; norm1_rows<1>(A, ts, mv, l, lane, rows); }
}

__device__ __forceinline__ void phase_router(KArgs A, Frame& F, int l, const bool dry = false) {
    PH_LOCALS;
    const int nrows = (l == DEPTH - 1) ? NLAT : TT;
    LAS bf16_t* tile = (LAS bf16_t*)F.lds;
    LAS float* part = (LAS float*)(F.lds + 32 * 1032 * 2);
    LAS float* logit = part + 8 * 32 * 33;
    LAS int* lcnt = (LAS int*)(logit + 32 * 33);
    const float* MOD = WSP(float, WS_MOD);
    bf16_t* XR = WSP(bf16_t, WS_XR);
    const bf16_t* WRT = WSP(bf16_t, WS_WRT) + (size_t)l * NEXP * D;
    int* cnt = (int*)A->ws + CW_CNT + l * 32 + (dry ? 128 : 0);
    int* elist = dry ? (int*)WSP(float, WS_ELW) : WSP(int, WS_ELIST);
    const float dsc = dry ? 0.0f : 1.0f;
    LAS float* rv = (LAS float*)(F.lds + 104448);
    const int nunits = nrows / 32; const bool contig = (F.G == 256);
    int cur_b = -1;
    bf16x8 bw[8];
#pragma unroll
    for (int s = 0; s < 8; ++s) bw[s] = *(const bf16x8*)(WRT + (size_t)(lane & 31) * D + wave * 128 + 16 * s + 8 * (lane >> 5));
    for (int k = 0;; ++k) {
        int u;
        if (contig) { if (k < 4) u = 4 * F.bid + k; else if (k == 4 && F.bid < 32 && nunits > 1024) u = 1024 + F.bid; else break; }
        else { u = F.bid + k * F.G; if (u >= nunits) break; }
        const int r0 = u * 32;
        const int bi = (r0 < NLAT) ? (r0 / SEQ) : 4;
        if (bi != cur_b) {
            const float* m2 = MOD + ((size_t)l * 5 + bi) * 6144 + 2 * D; const float* gm = FIN(21) + (size_t)l * D;
            for (int i = tid; i < D; i += NTHREADS) { rv[D + i] = gm[i] * (m2[2 * D + i] + 1.0f); rv[2 * D + i] = m2[D + i]; }
            __syncthreads(); cur_b = bi; }
        {
            const int rb = r0 + wave * 4;
            f32x4 v[4][4];
#pragma unroll
            for (int q = 0; q < 4; ++q)
#pragma unroll
                for (int j = 0; j < 4; ++j) { const int c = 4 * lane + 256 * j; v[q][j] = bf4_to_f32(*(const u32x2*)(XR + (size_t)(rb + q) * D + c)); }
            float ss[4];
#pragma unroll
            for (int q = 0; q < 4; ++q) { ss[q] = 0.f;
#pragma unroll
                for (int j = 0; j < 4; ++j) {
                    ss[q] += (v[q][j].x * v[q][j].x + v[q][j].y * v[q][j].y) + (v[q][j].z * v[q][j].z + v[q][j].w * v[q][j].w); } }
#pragma unroll
            for (int o = 1; o < 64; o <<= 1) {
#pragma unroll
                for (int q = 0; q < 4; ++q) ss[q] += __builtin_bit_cast(float, __builtin_amdgcn_ds_bpermute((lane ^ o) << 2, __builtin_bit_cast(int, ss[q]))); }
#pragma unroll
            for (int q = 0; q < 4; ++q) { const float rinv = 1.0f / sqrtf(ss[q] * (1.0f / D) + RMS_EPS);
                unsigned char* hrow = WSP(unsigned char, WS_H8) + (size_t)(rb + q) * P8;
#pragma unroll
                for (int j = 0; j < 4; ++j) { const int c = 4 * lane + 256 * j; const f32x4 g = *(const LAS f32x4*)(rv + D + c), sh = *(const LAS f32x4*)(rv + 2 * D + c);
                    const f32x4 h = v[q][j] * rinv * g + sh;
                    u32x2 o; o.x = pk2(h.x, h.y); o.y = pk2(h.z, h.w); *(LAS u32x2*)(tile + (wave * 4 + q) * 1032 + c) = o;
                    *(unsigned*)(hrow + c) = pk4_fp8(h.x * FP8_SH, h.y * FP8_SH, h.z * FP8_SH, h.w * FP8_SH); } }
        }
        if (tid < 32) lcnt[tid] = 0;
        __syncthreads();
        {
            f32x16 acc;
#pragma unroll
            for (int i = 0; i < 16; ++i) acc[i] = 0.f;
            const int rr = lane & 31, hh = lane >> 5;
#pragma unroll
            for (int s = 0; s < 8; ++s) { const bf16x8 a = *(const LAS bf16x8*)(tile + rr * 1032 + wave * 128 + 16 * s + 8 * hh);
                acc = __builtin_amdgcn_mfma_f32_32x32x16_bf16(a, bw[s], acc, 0, 0, 0); }
#pragma unroll
            for (int i = 0; i < 16; ++i) { const int tok = (i & 3) + 8 * (i >> 2) + 4 * hh; part[(wave * 32 + tok) * 33 + rr] = acc[i]; }
        }
        __syncthreads();
        for (int i = tid; i < 1024; i += NTHREADS) { const int tok = i >> 5, e = i & 31; float s = FIN(23)[l * 32 + e];
#pragma unroll
            for (int w = 0; w < 8; ++w) s += part[(w * 32 + tok) * 33 + e];
            logit[tok * 33 + e] = s; }
        __syncthreads();
        if (wave == 0) {
            const int t = lane & 31, r = r0 + t; const bool act = lane < 32;
            float lg[32];
#pragma unroll
            for (int e = 0; e < 32; ++e) lg[e] = logit[t * 33 + e];
            float lv[4]; int le[4];
#pragma unroll
            for (int k = 0; k < 4; ++k) { float best = -3.0e38f; int be = 0;
#pragma unroll
                for (int e = 0; e < 32; ++e) { const bool gt = lg[e] > best; best = gt ? lg[e] : best; be = gt ? e : be; }
#pragma unroll
                for (int e = 0; e < 32; ++e) lg[e] = (e == be) ? -3.0e38f : lg[e];
                lv[k] = best; le[k] = be; }
            const float e1 = __expf(lv[1] - lv[0]), e2 = __expf(lv[2] - lv[0]), e3 = __expf(lv[3] - lv[0]); const float inv = 1.0f / (1.0f + e1 + e2 + e3);
            const float wk[4] = {inv, e1 * inv, e2 * inv, e3 * inv};
            int lr[4];
#pragma unroll
            for (int k = 0; k < 4; ++k) lr[k] = act ? __hip_atomic_fetch_add(lcnt + le[k], 1, __ATOMIC_RELAXED, __HIP_MEMORY_SCOPE_WORKGROUP) : 0;
            asm volatile("s_waitcnt lgkmcnt(0)" ::: "memory");
            if (act) { const int c = lcnt[t]; const int base = c ? atomicAdd(&cnt[t], c) : 0; lcnt[32 + t] = base; }
            asm volatile("s_waitcnt vmcnt(0) lgkmcnt(0)" ::: "memory");
            if (act) {
                int* ti = WSP(int, WS_TOKINFO) + (size_t)r * 4;
#pragma unroll
                for (int k = 0; k < 4; ++k) { const int rank = lcnt[32 + le[k]] + lr[k];
                    elist[(size_t)le[k] * TT + rank] = r; if (!dry) { WSP(float, WS_TOKW)[(size_t)r * 4 + k] = wk[k]; ti[k] = (le[k] << 24) | rank; } }
            }
        }
    }
    __syncthreads();
}

__device__ __forceinline__ void phase_s5scan(KArgs A, Frame& F, int l) {
    PH_LOCALS;
    const int gw = F.bid * NWAVES + wave, NGW = F.G * NWAVES;
    const float* SL = WSP(float, WS_SLOC);
    for (int it = gw; it < NBATCH * 16 * 2; it += NGW) {
        const int dir = it & 1, g = (it >> 1) & 15, b = it >> 5;
        const int ldg = (l * 2 + dir) * 16 + g;
        const f32x2 L64 = WSP(f32x2, WS_LP)[((size_t)ldg * 65 + 64) * 64 + lane];
        bf16_t* sux = WSP(bf16_t, WS_SUX) + (size_t)g * MCH * SUXW;
        float xr = 0.f, xi = 0.f;
#pragma unroll 4
        for (int step = 0; step < 132; ++step) {
            int ch;
            if (step < 4) ch = 512 + 4 * b + (dir ? 3 - step : step);
            else ch = 128 * b + (dir ? 127 - (step - 4) : (step - 4));
            const float sr = SL[(size_t)ch * 4096 + g * 256 + dir * 128 + lane], si = SL[(size_t)ch * 4096 + g * 256 + dir * 128 + 64 + lane];
            bf16_t* o = sux + (size_t)ch * SUXW + 1024 + dir * 128;
            o[lane] = (unsigned short)f2bf(xr); o[64 + lane] = (unsigned short)f2bf(xi);
            const float nr = L64.x * xr - L64.y * xi + sr, ni = L64.x * xi + L64.y * xr + si;
            xr = nr; xi = ni;
        }
    }
}

constexpr float LOG2E = 1.4426950408889634f;
__device__ __forceinline__ float xhalf_max(float x) { const unsigned xu = __builtin_bit_cast(unsigned, x); const auto r = __builtin_amdgcn_permlane32_swap(xu, xu, false, false);
    const unsigned a = r[0], b = r[1]; return fmaxf(__builtin_bit_cast(float, a), __builtin_bit_cast(float, b)); }
__device__ __forceinline__ float xhalf_sum(float x) { const unsigned xu = __builtin_bit_cast(unsigned, x); const auto r = __builtin_amdgcn_permlane32_swap(xu, xu, false, false);
    const unsigned a = r[0], b = r[1]; return __builtin_bit_cast(float, a) + __builtin_bit_cast(float, b); }
constexpr int AT_STEP = 32768;
constexpr int AT_RPB = 3 * AT_STEP;
__device__ __forceinline__ void attn_stage(const bf16_t* P, const bf16_t* VT, LAS unsigned char* lds, int slot, int ktok0, int kcol, int vrow, int lane, int wave) {
    LAS unsigned char* base = lds + slot * AT_STEP + wave * 1024;
#pragma unroll
    for (int j = 0; j < 2; ++j) {
        const int dc = 4 * j + (wave >> 1), key = (wave & 1) * 64 + lane;
        __builtin_amdgcn_global_load_lds((const unsigned*)(P + (size_t)(ktok0 + key) * PW + kcol + 8 * dc), (LAS unsigned*)(base + j * 8192), 16, 0, 0);
    }
#pragma unroll
    for (int j = 0; j < 2; ++j) {
        const int q = 8 * j + wave;
        __builtin_amdgcn_global_load_lds((const unsigned*)(VT + (size_t)(vrow + lane) * TT + ktok0 + 8 * q), (LAS unsigned*)(base + 16384 + j * 8192), 16, 0, 0);
    }
}
__device__ __forceinline__ void attn_tile(const int mm, const LAS unsigned char* kt_, const LAS unsigned char* vt_, const bf16x8 (&qf)[4], f32x16& O0, f32x16& O1, f32x16& negm, float& lsum,
                                          const LAS float* bptr, unsigned vmask, int dbase) {
    bf16x8 kf[4];
#pragma unroll
    for (int q = 0; q < 4; ++q) kf[q] = *(const LAS bf16x8*)(kt_ + q * 2048);
    bf16x8 vf[2][2];
#pragma unroll
    for (int mt = 0; mt < 2; ++mt)
#pragma unroll
        for (int s2 = 0; s2 < 2; ++s2) vf[mt][s2] = *(const LAS bf16x8*)(vt_ + s2 * 1024 + mt * 512);
    f32x16 sa = __builtin_amdgcn_mfma_f32_32x32x16_bf16(kf[0], qf[0], negm, 0, 0, 0);
#pragma unroll
    for (int q = 1; q < 4; ++q) sa = __builtin_amdgcn_mfma_f32_32x32x16_bf16(kf[q], qf[q], sa, 0, 0, 0);
    float sv[16];
#pragma unroll
    for (int i = 0; i < 16; ++i) sv[i] = sa[i];
    if (mm == 1) {
#pragma unroll
        for (int i = 0; i < 16; ++i) { const float x = sv[i] + bptr[(i & 3) + 8 * (i >> 2)]; sv[i] = ((vmask >> i) & 1u) ? x : -3.0e38f; }
    } else if (mm == 2) {
#pragma unroll
        for (int i = 0; i < 16; ++i) { const int dpos = dbase - ((i & 3) + 8 * (i >> 2)); sv[i] = (dpos <= 128 && dpos >= -128) ? sv[i] : -3.0e38f; }
    }
    float tmax = fmaxf(fmaxf(fmaxf(sv[0], sv[1]), fmaxf(sv[2], sv[3])), fmaxf(fmaxf(sv[4], sv[5]), fmaxf(sv[6], sv[7])));
    tmax = fmaxf(tmax, fmaxf(fmaxf(fmaxf(sv[8], sv[9]), fmaxf(sv[10], sv[11])), fmaxf(fmaxf(sv[12], sv[13]), fmaxf(sv[14], sv[15]))));
    tmax = xhalf_max(tmax);
    if (__any(tmax > 8.0f)) {
        const float d = (tmax > 8.0f) ? tmax : 0.f; const float alpha = fast_exp2(-d);
        lsum *= alpha;
#pragma unroll
        for (int i = 0; i < 16; ++i) { O0[i] *= alpha; O1[i] *= alpha; sv[i] -= d; negm[i] -= d; }
    }
    float psum = 0.f;
#pragma unroll
    for (int i = 0; i < 16; ++i) { const float p = fast_exp2(sv[i]); psum += p; sv[i] = p; }
    lsum += xhalf_sum(psum);
#pragma unroll
    for (int s2 = 0; s2 < 2; ++s2) {
        u32x4 pw; pw.x = cvt_pk_bf16(sv[8 * s2 + 0], sv[8 * s2 + 1]); pw.y = cvt_pk_bf16(sv[8 * s2 + 2], sv[8 * s2 + 3]); pw.z = cvt_pk_bf16(sv[8 * s2 + 4], sv[8 * s2 + 5]); pw.w = cvt_pk_bf16(sv[8 * s2 + 6], sv[8 * s2 + 7]);
        const bf16x8 pf = __builtin_bit_cast(bf16x8, pw);
        O0 = __builtin_amdgcn_mfma_f32_32x32x16_bf16(vf[0][s2], pf, O0, 0, 0, 0);
        O1 = __builtin_amdgcn_mfma_f32_32x32x16_bf16(vf[1][s2], pf, O1, 0, 0, 0);
    }
}
__device__ __forceinline__ void phase_attn(KArgs A, Frame& F, int l, const int part) {
    PH_LOCALS;
    LAS unsigned char* lds = F.lds;
    LAS float* rpb = (LAS float*)(lds + AT_RPB);
    for (int i = tid; i < 6 * 465; i += NTHREADS) rpb[i] = FIN(9)[(size_t)l * 6 * 465 + i] * LOG2E;
    __syncthreads();
    const bf16_t* P = WSP(bf16_t, WS_P); const bf16_t* VT = WSP(bf16_t, WS_VT);
    const int r = lane & 31, hh = lane >> 5;
    const int ngroups = 1536 + ((l < DEPTH - 1) ? 48 : 0);
    const bool std_grid = (F.G == 256);
    for (int k = 0;; ++k) {
        int gi;
        if (!std_grid) { gi = F.bid + k * F.G; if (part == 1 || gi >= ngroups) { if (part == 1) break; if (gi >= ngroups) break; } }
        else if (part == 0) {
            const int c = F.bid;
            if (c < 16) { if (k < 2) gi = 256 * k + c; else if (k < 5) gi = 768 + 576 + c + 16 * (k - 2); else break; }
            else if (c < 48) { if (k < 3) gi = 256 * k + c; else if (k < 6) gi = 768 + 624 + (c - 16) + 32 * (k - 3); else break; }
            else if (c < 64) { if (k < 3) gi = 256 * k + c; else if (k == 3) gi = 512 + (c - 48); else if (k < 7) gi = 768 + 720 + (c - 48) + 16 * (k - 4); else break; }
            else { if (k < 2) gi = 256 * k + c; else if (k == 2) gi = 768 + (c - 64); else break; } }
        else {
            const int c = F.bid;
            if (c < 64) break;
            if (k == 0) gi = 512 + c;
            else if (k < 3) gi = 768 + (c - 64) + 192 * k;
            else if (k == 3 && c >= 196 && c < 244 && ngroups > 1536) gi = 1536 + (c - 196);
            else break; }
        int mode, b, head, r0 = 0, qt0 = 0;
        if (gi < 768) { mode = 0; r0 = 4 * (gi & 31); const int bh = gi >> 5; head = bh % 6; b = bh / 6; }
        else if (gi < 1536) { mode = 1; const int g2 = gi - 768; qt0 = 8 * (g2 & 31); const int bh = g2 >> 5; head = bh % 6; b = bh / 6; }
        else { const int g2 = gi - 1536; mode = 2 + g2 / 24; const int bh = g2 % 24; head = bh % 6; b = bh / 6; }
        const bool na = (mode == 0 || mode == 2);
        const int qcol = na ? 64 * head : 768 + 64 * head, kcol = na ? 384 + 64 * head : 1152 + 64 * (head / 3);
        const int vrow = na ? 64 * head : 384 + 64 * (head / 3), ycol = na ? 64 * head : 640 + 64 * head;
        int qtok0, qrow = 0, mh = 0, qt = 0;
        if (mode == 0) { qrow = r0 + (wave >> 1); mh = wave & 1; qtok0 = b * SEQ + qrow * 64 + 32 * mh; }
        else if (mode == 1) { qt = qt0 + wave; qtok0 = b * SEQ + 32 * qt; }
        else qtok0 = NLAT + b * CTXL + 32 * wave;
        const int rsw = min(max(qrow - 4, 0), 120);
        const int qc = 32 * mh + r, wsn = min(max(qc - 8, 0), 48);
        const int qpos = 32 * qt + r;
        unsigned vmask0 = 0u, vmask1 = 0u;
#pragma unroll
        for (int i = 0; i < 16; ++i) { const int ki = (i & 3) + 8 * (i >> 2) + 4 * hh; vmask0 |= ((ki >= wsn && ki < wsn + 16) ? 1u : 0u) << i; vmask1 |= ((32 + ki >= wsn && 32 + ki < wsn + 16) ? 1u : 0u) << i; }
        int nlat = 0, kbase = 0, kofs = 0;
        if (mode == 0) { const int kra = min(max(r0 - 4, 0), 120), krb = min(max(r0 - 1, 0), 120) + 7; kbase = kra >> 1; kofs = (kra & 1) * 64; nlat = (krb - kra + 2) >> 1; }
        else if (mode == 1) { const int ks0 = max(qt0 - 4, 0) >> 2, ks1 = min(qt0 + 11, 255) >> 2; kbase = ks0; nlat = ks1 - ks0 + 1; }
        const int nsteps = nlat + 2;
        const int lat0 = b * SEQ + 128 * kbase + kofs, ctx0 = NLAT + b * CTXL;
        float lsum = na ? 0.f : fast_exp2(FIN(20)[l * 6 + head] * LOG2E);
        f32x16 negm;
#pragma unroll
        for (int i = 0; i < 16; ++i) negm[i] = 0.f;
        bf16x8 qf[4];
#pragma unroll
        for (int s = 0; s < 4; ++s) qf[s] = *(const bf16x8*)(P + (size_t)(qtok0 + r) * PW + qcol + 32 * hh + 8 * s);
        f32x16 O0, O1;
#pragma unroll
        for (int i = 0; i < 16; ++i) { O0[i] = 0.f; O1[i] = 0.f; }
        __builtin_amdgcn_s_barrier();
        attn_stage(P, VT, lds, 0, (nlat > 0) ? lat0 : ctx0, kcol, vrow, lane, wave);
        attn_stage(P, VT, lds, 1, (nlat > 1) ? lat0 + 128 : ctx0 + 128 * (1 - nlat), kcol, vrow, lane, wave);
        for (int s = 0; s < nsteps; ++s) {
            if (s + 1 < nsteps) asm volatile("s_waitcnt vmcnt(4)" ::: "memory"); else asm volatile("s_waitcnt vmcnt(0)" ::: "memory");
            __builtin_amdgcn_s_barrier();
            if (s + 2 < nsteps) { const int s2 = s + 2; attn_stage(P, VT, lds, s2 % 3, (s2 < nlat) ? lat0 + 128 * s2 : ctx0 + 128 * (s2 - nlat), kcol, vrow, lane, wave); }
            const bool isctx = (s >= nlat);
            const LAS unsigned char* kb = lds + (s % 3) * AT_STEP; const LAS unsigned char* vb = kb + 16384;
#pragma unroll 1
            for (int tl = 0; tl < 4; ++tl) {
                const int kr = 2 * (kbase + s) + (kofs >> 6) + (tl >> 1), ct = tl & 1;
                const int kt = 4 * (kbase + s) + tl;
                int dt = kt - qt; dt = dt < 0 ? -dt : dt;
                if (!isctx && mode == 0 && (kr < rsw || kr > rsw + 7)) continue;
                if (!isctx && mode == 1 && dt > 4) continue;
                const LAS unsigned char* kt_ = kb + ((4 * hh) * 128 + 32 * tl + r) * 16;
                const LAS unsigned char* vt_ = vb + ((tl * 4 + hh * 2) * 64 + r) * 16;
                const int mm = (isctx || (mode == 1 && dt < 4)) ? 0 : (mode == 0 ? 1 : 2);
                attn_tile(mm, kt_, vt_, qf, O0, O1, negm, lsum, rpb + head * 465 + (kr - qrow + 7) * 31 + (32 * ct + 4 * hh - qc + 15), ct ? vmask1 : vmask0, qpos - 32 * kt - 4 * hh);
            }
        }
        const float inv = FP8_SY / lsum;
        unsigned char* yrow = WSP(unsigned char, WS_Y) + (size_t)(qtok0 + r) * P8 + ycol + 4 * hh;
#pragma unroll
        for (int rg = 0; rg < 4; ++rg) {
            *(unsigned*)(yrow + 8 * rg) = pk4_fp8(O0[4 * rg + 0] * inv, O0[4 * rg + 1] * inv, O0[4 * rg + 2] * inv, O0[4 * rg + 3] * inv);
            *(unsigned*)(yrow + 32 + 8 * rg) = pk4_fp8(O1[4 * rg + 0] * inv, O1[4 * rg + 1] * inv, O1[4 * rg + 2] * inv, O1[4 * rg + 3] * inv);
        }
    }
    asm volatile("s_waitcnt vmcnt(0)" ::: "memory");
    __builtin_amdgcn_s_barrier();
}

__device__ __forceinline__ int xcd_unit(int i, int G, int c, int U) {
    if ((G & 7) != 0) { const int idx = i * G + c; return idx < U ? idx : -1; }
    const int x = c & 7, j = c >> 3, per = G >> 3, q = U >> 3, r = U & 7;
    const int start = x * q + (x < r ? x : r), size = q + (x < r ? 1 : 0);
    const int loc = i * per + j;
    return loc < size ? start + loc : -1;
}
__device__ __forceinline__ int xcd_max_units(int G, int U) {
    if ((G & 7) != 0) return (U + G - 1) / G;
    const int per = G >> 3; return ((U + 7) / 8 + per - 1) / per;
}
#define ACC8(ai, bj, m) const f32x4 a0_ = acc[ai][bj][m][0], a1_ = acc[ai][bj][m][1]; float v[8] = {a0_[0], a0_[1], a0_[2], a0_[3], a1_[0], a1_[1], a1_[2], a1_[3]}

struct SchedInproj { int G, c; const char* H; const char* W; unsigned* stat = nullptr;
    __device__ __forceinline__ bool next(int i, GUnit& u) const {
        const int idx = xcd_unit(i, G, c, 1056); if (idx < 0) return false;
        if (idx < 792) { const int pm = idx / 6, pn = idx % 6; u.A = H + (size_t)pm * 256 * P8; u.B = W + (size_t)pn * 256 * P8; u.p0 = 0; u.p1 = pm; u.p2 = pn; u.p3 = 0; }
        else { const int j = idx - 792, vm = j / 132, tn = j % 132; u.A = W + (size_t)(1536 + 256 * vm) * P8; u.B = H + (size_t)tn * 256 * P8; u.p0 = 1; u.p1 = vm; u.p2 = tn; u.p3 = 0; }
        return true; }
    __device__ __forceinline__ int row_token(const GUnit&, int) const { return 0; }
    __device__ __forceinline__ size_t kstepA() const { return 128; }
    __device__ __forceinline__ unsigned voffA(int h, int R, int cb, unsigned lda2) const { return (unsigned)(h * 128 + R) * lda2 + (unsigned)cb; }
    __device__ __forceinline__ int row_token_lds(const GUnit&, int, int) const { return 0; }
    __device__ __forceinline__ void pre(const GUnit&, int, int, int) const {}
};
struct EpiInproj { bf16_t* P; bf16_t* VT; bf16_t* SUX; const LAS float* ROPE;
    __device__ __forceinline__ void operator()(const AccT& acc, const GUnit& u, int slot, int wr, int wc, int fr, int fq) const {
        if (u.p0 == 1) {
#pragma unroll
            for (int ai = 0; ai < 2; ++ai)
#pragma unroll
                for (int m = 0; m < 4; ++m) { const int row = u.p1 * 256 + 128 * ai + 64 * wr + 16 * m + fr;
#pragma unroll
                    for (int bj = 0; bj < 2; ++bj) { ACC8(ai, bj, m);
#pragma unroll
                        for (int e = 0; e < 8; ++e) v[e] *= (1.0f / (FP8_SH * FP8_SW));
                        const u32x4 w = pack8(v);
                        bf16_t* vp = VT + (size_t)row * TT + u.p2 * 256 + 128 * bj + 32 * wc + 8 * (fq >> 1) + 4 * (fq & 1);
                        *(u32x2*)vp = (u32x2){w.x, w.y}; *(u32x2*)(vp + 16) = (u32x2){w.z, w.w}; } }
            return;
        }
        const int pm = u.p1, pn = u.p2;
#pragma unroll
        for (int bj = 0; bj < 2; ++bj) {
            const int hh = 2 * pn + bj;
            const bool rope = (hh >= 6 && hh < 10 && pm < 128), scale = (hh < 3 || (hh >= 6 && hh < 9));
            if (hh >= 10) half<4>(acc, bj, pm, hh, wr, wc, fr, fq);
            else if (rope && scale) half<3>(acc, bj, pm, hh, wr, wc, fr, fq);
            else if (rope) half<2>(acc, bj, pm, hh, wr, wc, fr, fq);
            else if (scale) half<1>(acc, bj, pm, hh, wr, wc, fr, fq);
            else half<0>(acc, bj, pm, hh, wr, wc, fr, fq);
        }
    }
    template <int KIND>
    __device__ __forceinline__ void half(const AccT& acc, const int bj, const int pm, const int hh, const int wr, const int wc, const int fr, const int fq) const {
        const bool lo32 = fq < 2;
#pragma unroll
        for (int ai = 0; ai < 2; ++ai)
#pragma unroll
            for (int m = 0; m < 4; ++m) {
                const int row = pm * 256 + 128 * ai + 64 * wr + 16 * m + fr;
                const f32x4 a0_ = bj ? acc[ai][1][m][0] : acc[ai][0][m][0], a1_ = bj ? acc[ai][1][m][1] : acc[ai][0][m][1];
                float v[8] = {a0_[0], a0_[1], a0_[2], a0_[3], a1_[0], a1_[1], a1_[2], a1_[3]};
#pragma unroll
                for (int e = 0; e < 8; ++e) v[e] *= (1.0f / (FP8_SH * FP8_SW));
                if (KIND == 4) {
                    const int g = 8 * (hh - 10) + 2 * wc + (fq >> 1);
                    *(u32x4*)(SUX + ((size_t)g * MCH + (row >> 6)) * SUXW + (row & 63) * 16 + 8 * (fq & 1)) = pack8(v);
                } else {
                    if (KIND == 2 || KIND == 3) {
                        const int t = row & (SEQ - 1); const int pos = (wc & 1) ? (t & 63) : (t >> 6);
                        const LAS float* cs = ROPE + pos * 16 + 8 * (fq & 1);
                        const f32x4 c0 = *(const LAS f32x4*)cs, c1 = *(const LAS f32x4*)(cs + 4), s0 = *(const LAS f32x4*)(cs + 2048), s1 = *(const LAS f32x4*)(cs + 2052);
                        const float sg = lo32 ? -1.0f : 1.0f;
                        const float cc[8] = {c0[0], c0[1], c0[2], c0[3], c1[0], c1[1], c1[2], c1[3]}, sn[8] = {s0[0] * sg, s0[1] * sg, s0[2] * sg, s0[3] * sg, s1[0] * sg, s1[1] * sg, s1[2] * sg, s1[3] * sg};
#pragma unroll
                        for (int e = 0; e < 8; ++e) { const unsigned xu = __builtin_bit_cast(unsigned, v[e]); const auto sw = __builtin_amdgcn_permlane32_swap(xu, xu, false, false); const unsigned lo_ = sw[0], hi_ = sw[1];
                            const unsigned pu = lo32 ? hi_ : lo_; v[e] = v[e] * cc[e] + __builtin_bit_cast(float, pu) * sn[e]; }
                    }
                    if (KIND == 1 || KIND == 3) {
#pragma unroll
                        for (int e = 0; e < 8; ++e) v[e] *= (0.125f * LOG2E_); }
                    *(u32x4*)(P + (size_t)row * PW + 128 * hh + 32 * wc + 8 * fq) = pack8(v);
                }
            }
    }
};
struct SchedS5a { int G, c; const char* SUX; const char* W; unsigned* stat = nullptr;
    __device__ __forceinline__ bool next(int i, GUnit& u) const {
        const int idx = xcd_unit(i, G, c, 48); if (idx < 0) return false;
        const int g = idx / 3, pm = idx % 3; u.A = SUX + ((size_t)g * MCH + pm * 256) * (SUXW * 2); u.B = W + (size_t)g * 256 * 2048; u.p0 = 0; u.p1 = pm; u.p2 = g; u.p3 = 0; return true; }
    __device__ __forceinline__ int row_token(const GUnit&, int) const { return 0; }
    __device__ __forceinline__ size_t kstepA() const { return 128; }
    __device__ __forceinline__ unsigned voffA(int h, int R, int cb, unsigned lda2) const { return (unsigned)(h * 128 + R) * lda2 + (unsigned)cb; }
    __device__ __forceinline__ int row_token_lds(const GUnit&, int, int) const { return 0; }
    __device__ __forceinline__ void pre(const GUnit&, int, int, int) const {}
};
struct EpiS5a { float* SL;
    __device__ __forceinline__ void operator()(const AccT& acc, const GUnit& u, int slot, int wr, int wc, int fr, int fq) const {
#pragma unroll
        for (int ai = 0; ai < 2; ++ai)
#pragma unroll
            for (int m = 0; m < 4; ++m) { float* rowp = SL + (size_t)(u.p1 * 256 + 128 * ai + 64 * wr + 16 * m + fr) * 4096 + u.p2 * 256 + 32 * wc + 8 * fq;
#pragma unroll
                for (int bj = 0; bj < 2; ++bj) { *(f32x4*)(rowp + 128 * bj) = acc[ai][bj][m][0]; *(f32x4*)(rowp + 128 * bj + 4) = acc[ai][bj][m][1]; } }
    }
};
struct SchedS5c { int G, c; const char* SUX; const char* KC; unsigned* stat = nullptr;
    __device__ __forceinline__ bool next(int i, GUnit& u) const {
        const int idx = xcd_unit(i, G, c, 192); if (idx < 0) return false;
        const int g = idx / 12, q = idx % 12, pm = q / 4, pn = q % 4;
        u.A = SUX + ((size_t)g * MCH + pm * 256) * (SUXW * 2); u.B = KC + ((size_t)g * 1024 + pn * 256) * (SUXW * 2); u.p0 = 0; u.p1 = pm; u.p2 = pn; u.p3 = g; return true; }
    __device__ __forceinline__ int row_token(const GUnit&, int) const { return 0; }
    __device__ __forceinline__ size_t kstepA() const { return 128; }
    __device__ __forceinline__ unsigned voffA(int h, int R, int cb, unsigned lda2) const { return (unsigned)(h * 128 + R) * lda2 + (unsigned)cb; }
    __device__ __forceinline__ int row_token_lds(const GUnit&, int, int) const { return 0; }
    __device__ __forceinline__ void pre(const GUnit&, int, int, int) const {}
};
struct EpiS5c { bf16_t* Gb;
    __device__ __forceinline__ void operator()(const AccT& acc, const GUnit& u, int slot, int wr, int wc, int fr, int fq) const {
#pragma unroll
        for (int ai = 0; ai < 2; ++ai)
#pragma unroll
            for (int m = 0; m < 4; ++m) { const int chunk = u.p1 * 256 + 128 * ai + 64 * wr + 16 * m + fr;
                if (chunk < TT / 64) {
#pragma unroll
                    for (int bj = 0; bj < 2; ++bj) { ACC8(ai, bj, m); const int col = u.p2 * 256 + 128 * bj + 32 * wc + 8 * fq;
#pragma unroll
                        for (int e = 0; e < 8; ++e) v[e] = gelu_tanh(v[e]);
                        *(u32x4*)(Gb + ((size_t)chunk * 64 + (col >> 4)) * 256 + u.p3 * 16 + (col & 15)) = pack8(v); } } }
    }
};
struct SchedGlu { int G, c; const char* Gb; const char* W; unsigned* stat = nullptr;
    __device__ __forceinline__ bool next(int i, GUnit& u) const {
        const int idx = xcd_unit(i, G, c, 132); if (idx < 0) return false;
        u.A = Gb + (size_t)idx * 256 * 512; u.B = W; u.p0 = 0; u.p1 = idx; u.p2 = 0; u.p3 = 0; return true; }
    __device__ __forceinline__ int row_token(const GUnit&, int) const { return 0; }
    __device__ __forceinline__ size_t kstepA() const { return 128; }
    __device__ __forceinline__ unsigned voffA(int h, int R, int cb, unsigned lda2) const { return (unsigned)(h * 128 + R) * lda2 + (unsigned)cb; }
    __device__ __forceinline__ int row_token_lds(const GUnit&, int, int) const { return 0; }
    __device__ __forceinline__ void pre(const GUnit&, int, int, int) const {}
};
struct EpiGlu { const bf16_t* Gb; unsigned char* Y; const float* bglu;
    __device__ __forceinline__ void operator()(const AccT& acc, const GUnit& u, int slot, int wr, int wc, int fr, int fq) const {
#pragma unroll
        for (int bj = 0; bj < 2; ++bj) { const int col = 128 * bj + 32 * wc + 8 * fq;
            const f32x4 b0 = *(const f32x4*)(bglu + col), b1 = *(const f32x4*)(bglu + col + 4); const float bb[8] = {b0[0], b0[1], b0[2], b0[3], b1[0], b1[1], b1[2], b1[3]};
            u32x4 gw[2][4];
#pragma unroll
            for (int ai = 0; ai < 2; ++ai)
#pragma unroll
                for (int m = 0; m < 4; ++m) gw[ai][m] = *(const u32x4*)(Gb + (size_t)(u.p1 * 256 + 128 * ai + 64 * wr + 16 * m + fr) * 256 + col);
#pragma unroll
            for (int ai = 0; ai < 2; ++ai)
#pragma unroll
                for (int m = 0; m < 4; ++m) { const int row = u.p1 * 256 + 128 * ai + 64 * wr + 16 * m + fr; ACC8(ai, bj, m);
                    const u32x4 g4 = gw[ai][m];
                    const float gv[8] = {bflo(g4.x), bfhi(g4.x), bflo(g4.y), bfhi(g4.y), bflo(g4.z), bfhi(g4.z), bflo(g4.w), bfhi(g4.w)};
#pragma unroll
                    for (int e = 0; e < 8; ++e) v[e] = (FP8_SY * gv[e]) * sigmoidf_(v[e] + bb[e]);
                    *(u32x2*)(Y + (size_t)row * P8 + 384 + col) = (u32x2){pk4_fp8(v[0], v[1], v[2], v[3]), pk4_fp8(v[4], v[5], v[6], v[7])}; } }
    }
};
struct SchedOut { int G, c, nunits; const char* Y; const char* W; unsigned* stat = nullptr;
    __device__ __forceinline__ bool next(int i, GUnit& u) const {
        const int idx = xcd_unit(i, G, c, nunits); if (idx < 0) return false;
        const int pm = idx >> 2, pn = idx & 3; u.A = Y + (size_t)pm * 256 * P8; u.B = W + (size_t)pn * 256 * P8; u.p0 = 0; u.p1 = pm; u.p2 = pn; u.p3 = 0; return true; }
    __device__ __forceinline__ int row_token(const GUnit&, int) const { return 0; }
    __device__ __forceinline__ size_t kstepA() const { return 128; }
    __device__ __forceinline__ unsigned voffA(int h, int R, int cb, unsigned lda2) const { return (unsigned)(h * 128 + R) * lda2 + (unsigned)cb; }
    __device__ __forceinline__ int row_token_lds(const GUnit&, int, int) const { return 0; }
    __device__ __forceinline__ void pre(const GUnit&, int, int, int) const {}
};
struct EpiOut { bf16_t* XR; const float* G2;
    __device__ __forceinline__ void operator()(const AccT& acc, const GUnit& u, int slot, int wr, int wc, int fr, int fq) const {
        const int bi = (u.p1 < 128) ? (u.p1 >> 5) : 4;
        const float* gp = G2 + (size_t)bi * 6144 + u.p2 * 256 + 32 * wc + 8 * fq;
        const f32x4 ga0 = *(const f32x4*)gp, ga1 = *(const f32x4*)(gp + 4), gb0 = *(const f32x4*)(gp + 128), gb1 = *(const f32x4*)(gp + 132);
        constexpr float SC = 1.0f / (FP8_SY * FP8_SW);
        const float gg[2][8] = {{ga0[0] * SC, ga0[1] * SC, ga0[2] * SC, ga0[3] * SC, ga1[0] * SC, ga1[1] * SC, ga1[2] * SC, ga1[3] * SC}, {gb0[0] * SC, gb0[1] * SC, gb0[2] * SC, gb0[3] * SC, gb1[0] * SC, gb1[1] * SC, gb1[2] * SC, gb1[3] * SC}};
#pragma unroll
        for (int ai = 0; ai < 2; ++ai) {
            u32x4 xw[4][2];
#pragma unroll
            for (int m = 0; m < 4; ++m)
#pragma unroll
                for (int bj = 0; bj < 2; ++bj) xw[m][bj] = *(const u32x4*)(XR + (size_t)(u.p1 * 256 + 128 * ai + 64 * wr + 16 * m + fr) * D + u.p2 * 256 + 32 * wc + 8 * fq + 128 * bj);
#pragma unroll
            for (int m = 0; m < 4; ++m) { bf16_t* rowp = XR + (size_t)(u.p1 * 256 + 128 * ai + 64 * wr + 16 * m + fr) * D + u.p2 * 256 + 32 * wc + 8 * fq;
#pragma unroll
                for (int bj = 0; bj < 2; ++bj) { ACC8(ai, bj, m);
                    const u32x4 x4 = xw[m][bj];
                    const float xv[8] = {bflo(x4.x), bfhi(x4.x), bflo(x4.y), bfhi(x4.y), bflo(x4.z), bfhi(x4.z), bflo(x4.w), bfhi(x4.w)};
#pragma unroll
                    for (int e = 0; e < 8; ++e) v[e] = xv[e] + gg[bj][e] * v[e];
                    *(u32x4*)(rowp + 128 * bj) = pack8(v); } } }
    }
};
struct SchedMoe { int G, c, NT; const LAS int* ts; const char* A; const char* W; size_t wstride; const int* elist; bool gather; const float* bgu; LAS unsigned char* lds; bool rev; unsigned* stat = nullptr;
    __device__ __forceinline__ bool next(int i, GUnit& u) const {
        const int idx = xcd_unit(i, G, c, ts[32] * NT); if (idx < 0) return false;
        const int mt = rev ? (ts[32] - 1 - idx / NT) : idx / NT, pn = idx % NT; const int e = ((const LAS int*)(lds + LDS_T2E))[mt];
        u.A = gather ? A : (A + (size_t)mt * 262144); u.B = W + (size_t)e * wstride + (size_t)pn * 256 * P8;   u.p0 = mt; u.p1 = pn; u.p2 = e; u.p3 = (mt - ts[e]) * 256; return true; }
    __device__ __forceinline__ int row_token(const GUnit& u, int row) const { const int j = min(u.p3 + row, ts[40 + u.p2] - 1); return elist[(size_t)u.p2 * TT + j]; }
    __device__ __forceinline__ size_t kstepA() const { return gather ? 128 : 32768; }
    __device__ __forceinline__ unsigned voffA(int h, int R, int cb, unsigned lda2) const {
        if (gather) return (unsigned)(h * 128 + R) * lda2 + (unsigned)cb;
        const int ch = cb >> 4; return (unsigned)((((h * 2 + (R >> 6)) * 4 + ((R >> 4) & 3)) * 4 + (ch >> 1)) * 512 + (R & 15) * 32 + (ch & 1) * 16); }
    __device__ __forceinline__ int row_token_lds(const GUnit& u, int slot, int row) const { const int t = ((const LAS int*)(lds + LDS_TOK + slot * 1024))[row]; return (u.p3 + row < ts[40 + u.p2]) ? t : 0; }
    __device__ __forceinline__ void pre(const GUnit& u, int slot, int wid, int lane) const {
        if (bgu != nullptr && wid == 0) { const float* src = bgu + (size_t)u.p2 * 2048 + 128 * u.p1 + ((lane & 32) ? 1024 : 0) + 4 * (lane & 31);
            __builtin_amdgcn_global_load_lds((const unsigned*)src, (LAS unsigned*)(lds + LDS_BIAS + slot * 1024), 16, 0, 0); }
        if (gather && wid == 1) __builtin_amdgcn_global_load_lds((const unsigned*)(elist + (size_t)u.p2 * TT + u.p3 + 4 * lane), (LAS unsigned*)(lds + LDS_TOK + slot * 1024), 16, 0, 0); }
};
struct EpiGateUp { unsigned char* ACT; LAS unsigned char* lds;
    __device__ __forceinline__ void operator()(const AccT& acc, const GUnit& u, int slot, int wr, int wc, int fr, int fq) const {
        const int col = 128 * u.p1 + 32 * wc + 8 * fq; const LAS float* bg = (const LAS float*)(lds + LDS_BIAS + slot * 1024) + 32 * wc + 8 * fq;
        const f32x4 g0 = *(const LAS f32x4*)bg, g1 = *(const LAS f32x4*)(bg + 4), u0 = *(const LAS f32x4*)(bg + 128), u1 = *(const LAS f32x4*)(bg + 132);
        const float bgate[8] = {g0[0], g0[1], g0[2], g0[3], g1[0], g1[1], g1[2], g1[3]}, bup[8] = {u0[0], u0[1], u0[2], u0[3], u1[0], u1[1], u1[2], u1[3]};
#pragma unroll
        for (int ai = 0; ai < 2; ++ai)
#pragma unroll
            for (int m = 0; m < 4; ++m) { const size_t row = (size_t)u.p0 * 256 + 128 * ai + 64 * wr + 16 * m + fr;
                const f32x4 ga = acc[ai][0][m][0], gb = acc[ai][0][m][1], ua = acc[ai][1][m][0], ub = acc[ai][1][m][1];
                const float gt[8] = {ga[0], ga[1], ga[2], ga[3], gb[0], gb[1], gb[2], gb[3]}, up[8] = {ua[0], ua[1], ua[2], ua[3], ub[0], ub[1], ub[2], ub[3]};
                float v[8];
#pragma unroll
                for (int e = 0; e < 8; e += 2) {
                    const f32x2 g2 = (f32x2){gt[e], gt[e + 1]} * (1.0f / (FP8_SH * FP8_SW)) + (f32x2){bgate[e], bgate[e + 1]};
                    const f32x2 u2 = (f32x2){up[e], up[e + 1]} * (FP8_SA / (FP8_SH * FP8_SW)) + (f32x2){bup[e], bup[e + 1]} * FP8_SA;
                    const f32x2 gg = (f32x2){fminf(g2.x, 7.0f), fminf(g2.y, 7.0f)};
                    const f32x2 uu = (f32x2){fminf(fmaxf(u2.x, -7.0f * FP8_SA), 7.0f * FP8_SA), fminf(fmaxf(u2.y, -7.0f * FP8_SA), 7.0f * FP8_SA)} + FP8_SA;
                    const f32x2 ex = gg * (-1.702f * 1.4426950408889634f);
                    const f32x2 den = (f32x2){__builtin_amdgcn_exp2f(ex.x), __builtin_amdgcn_exp2f(ex.y)} + 1.0f;
                    const f32x2 sg = (f32x2){__builtin_amdgcn_rcpf(den.x), __builtin_amdgcn_rcpf(den.y)};
                    const f32x2 o = gg * sg * uu; v[e] = o.x; v[e + 1] = o.y; }
                *(u32x2*)(ACT + ((size_t)u.p0 * 8 + u.p1) * 32768 + ((((ai * 2 + wr) * 4 + m) * 4 + wc) * 512 + fr * 32 + fq * 8)) = (u32x2){pk4_fp8_nc(v[0], v[1], v[2], v[3]), pk4_fp8_nc(v[4], v[5], v[6], v[7])}; }
    }
};
struct EpiDown { unsigned char* EO; const float* bd; bool dry;
    __device__ __forceinline__ void operator()(const AccT& acc, const GUnit& u, int slot, int wr, int wc, int fr, int fq) const {
        if (dry) return;
#pragma unroll
        for (int bj = 0; bj < 2; ++bj) {
            const float* bp = bd + (size_t)u.p2 * D + u.p1 * 256 + 128 * bj + 32 * wc + 8 * fq;
            const f32x4 b0 = *(const f32x4*)bp * FP8_SE, b1 = *(const f32x4*)(bp + 4) * FP8_SE; const float bb[8] = {b0[0], b0[1], b0[2], b0[3], b1[0], b1[1], b1[2], b1[3]};
#pragma unroll
            for (int ai = 0; ai < 2; ++ai)
#pragma unroll
                for (int m = 0; m < 4; ++m) { unsigned char* rowp = EO + ((size_t)u.p0 * 256 + 128 * ai + 64 * wr + 16 * m + fr) * D + u.p1 * 256 + 32 * wc + 8 * fq;
                    ACC8(ai, bj, m);
#pragma unroll
                    for (int e = 0; e < 8; ++e) v[e] = v[e] * (FP8_SE / (FP8_SA * FP8_SW)) + bb[e];
                    *(u32x2*)(rowp + 128 * bj) = (u32x2){pk4_fp8(v[0], v[1], v[2], v[3]), pk4_fp8(v[4], v[5], v[6], v[7])}; } }
    }
};

constexpr int PH_PER_LAYER = 7, NPHASES = 1 + DEPTH * PH_PER_LAYER + 1;

__global__ void __launch_bounds__(NTHREADS, 2) mk_fwd(Args args) {
    extern __shared__ __attribute__((aligned(16))) unsigned char lds_raw[];
    Frame F;
    F.lds = (LAS unsigned char*)lds_raw;
    F.G = gridDim.x; F.bid = blockIdx.x;
    KArgs A0 = (KArgs)__builtin_amdgcn_kernarg_segment_ptr();
    KArgs A = A0; asm volatile("" : "+s"(A));
    volatile LAS unsigned* misc = (volatile LAS unsigned*)(F.lds + LDS_MISC);
    if (threadIdx.x < 16) misc[threadIdx.x] = 0u;
    __syncthreads();
    const int lo = A->ph_lo, hi = A->ph_hi;
    XcdBarrier bar; bar.bar = (unsigned*)A->ws + CW_BAR; bar.x = 0; bar.st = nullptr;
    if (hi - lo > 1) bar = xcd_barrier_post((unsigned*)A->ws + CW_BAR, misc + 8);
    LAS unsigned char* L = F.lds;
    const LAS int* ts = (const LAS int*)(F.lds + LDS_MISC + 64);
    int ph = 0;
#ifdef ONLY_SITE
#define SITE_ON(s) ((s) == ONLY_SITE)
#define ONLY_SITE_BUILD true
#else
#define SITE_ON(s) true
#define ONLY_SITE_BUILD false
#endif
#ifndef DUP_MASK
#define DUP_MASK 0u
#endif
#define PH_RUN(s) (SITE_ON(s) && ph >= lo && ph < hi)
#define PH_REP(s) for (int rep_ = 0; rep_ < (((DUP_MASK >> (s)) & 1u) ? 2 : 1); ++rep_)
#define PH_END do { if (ph >= lo && ph + 1 < hi) xcd_barrier(bar); ++ph; A = A0; asm volatile("" : "+s"(A)); } while (0)

    if (PH_RUN(0)) PH_REP(0) phase_p0a(A, F);
    PH_END;
    for (int l = 0; l < DEPTH; ++l) {
        const bool lastl = (l == DEPTH - 1);
        if (PH_RUN(2)) { if (l == 0) { phase_p0b(A, F); __syncthreads(); }
            phase_norm1(A, F, l); if ((DUP_MASK >> 2) & 1u) phase_norm1(A, F, l, 0.0f); }
        PH_END;
        if (PH_RUN(3)) PH_REP(3) {
            SchedInproj S{F.G, F.bid, (const char*)WSP(unsigned char, WS_H8), (const char*)(WSP(unsigned char, WS_WINT) + (size_t)l * 2048 * P8)};
            { int t0 = threadIdx.x; asm volatile("" : "+v"(t0)); LAS float* rl = (LAS float*)(L + LDS_ROPE); const float* rg = WSP(float, WS_ROPE); for (int i = t0; i < 4096; i += NTHREADS) rl[i] = rg[i]; __syncthreads(); }
            EpiInproj E{WSP(bf16_t, WS_P), WSP(bf16_t, WS_VT), WSP(bf16_t, WS_SUX), (const LAS float*)(L + LDS_ROPE)};
            gemm_phase<false, true>(L, 8, (unsigned)P8, (unsigned)P8, S, E);
            if (xcd_unit(4, F.G, F.bid, 1056) < 0) conv_fill2(A, F, l, 5);
        }
        PH_END;
        if (PH_RUN(4)) {
            const bool std_ = (F.G == 256);
            unsigned* xc = (unsigned*)A->ws + CW_XC + l * 16;
            if (F.bid < 48) {
                SchedS5a S{48, F.bid, (const char*)WSP(bf16_t, WS_SUX), (const char*)(WSP(bf16_t, WS_WST) + (size_t)l * 16 * 256 * 1024)};
                EpiS5a E{WSP(float, WS_SLOC)};
                gemm_phase<false, false>(L, 16, (unsigned)(SUXW * 2), 2048u, S, E);
                if (std_) xc_signal(xc + 0);
            }
            if (std_ && F.bid < 16) { xc_wait(xc + 0, 48u, bar.bar); phase_s5scan(A, F, l); xc_signal(xc + 1); }
            phase_attn(A, F, l, 0);
            if (!std_) { xcd_barrier(bar); phase_s5scan(A, F, l); xcd_barrier(bar); }
            if (!std_ || F.bid >= 64) {
                if (std_) xc_wait(xc + 1, 16u, bar.bar);
                SchedS5c S{std_ ? 192 : F.G, std_ ? F.bid - 64 : F.bid, (const char*)WSP(bf16_t, WS_SUX), (const char*)(WSP(bf16_t, WS_KC) + (size_t)l * 16 * 1024 * SUXW)};
                EpiS5c E{WSP(bf16_t, WS_G)};
                gemm_phase<false, false>(L, 20, (unsigned)(SUXW * 2), (unsigned)(SUXW * 2), S, E);
                if (std_) xc_signal(xc + 2);
            }
            if (!std_) xcd_barrier(bar);
            phase_attn(A, F, l, 1);
            if (!std_ || (F.bid >= 64 && F.bid < 196)) {
                if (std_) xc_wait(xc + 2, 192u, bar.bar);
                SchedGlu S{std_ ? 132 : F.G, std_ ? F.bid - 64 : F.bid, (const char*)WSP(bf16_t, WS_G), (const char*)(WSP(bf16_t, WS_WGLUT) + (size_t)l * 256 * 256)};
                EpiGlu E{WSP(bf16_t, WS_G), WSP(unsigned char, WS_Y), FIN(19) + (size_t)l * 256};
                gemm_phase<false, false>(L, 4, 512u, 512u, S, E);
            }
            if (std_ && F.bid >= 244) conv_fill2(A, F, l, 3);
        }
        PH_END;
        if (PH_RUN(9)) PH_REP(9) {
            SchedOut S{F.G, F.bid, (lastl ? 128 : 132) * 4, (const char*)WSP(unsigned char, WS_Y), (const char*)(WSP(unsigned char, WS_WOUTT) + (size_t)l * D * P8)};
            EpiOut E{WSP(bf16_t, WS_XR), WSP(float, WS_MOD) + (size_t)l * 5 * 6144 + 2 * D};
            gemm_phase<false, true>(L, 8, (unsigned)P8, (unsigned)P8, S, E);
            if (xcd_unit(2, F.G, F.bid, (lastl ? 128 : 132) * 4) < 0) conv_fill2(A, F, l, 3);
        }
        PH_END;
        if (PH_RUN(10)) { (void)conv_fill(A, F, l, 1 << 30);
            phase_router(A, F, l); if ((DUP_MASK >> 10) & 1u) phase_router(A, F, l, true); }
        PH_END;
        if (PH_RUN(11)) PH_REP(11) {
            build_tstart(A, F, l);
            SchedMoe S{F.G, F.bid, 8, ts, (const char*)WSP(unsigned char, WS_H8), (const char*)(WSP(unsigned char, WS_WGUT) + (size_t)l * NEXP * 2048 * P8), (size_t)2048 * P8, WSP(int, WS_ELIST), true, FIN(25) + (size_t)l * NEXP * 2048, L, false};
            EpiGateUp E{WSP(unsigned char, WS_ACT), L};
            gemm_phase<true, true>(L, 8, (unsigned)P8, (unsigned)P8, S, E);
            if (xcd_unit(xcd_max_units(F.G, ts[32] * 8) - 1, F.G, F.bid, ts[32] * 8) < 0) conv_fill2(A, F, l, 4);
        }
        PH_END;
        if (PH_RUN(12)) PH_REP(12) {
            if (lo + 1 == hi || ONLY_SITE_BUILD) build_tstart(A, F, l);
            SchedMoe S{F.G, F.bid, 4, ts, (const char*)WSP(unsigned char, WS_ACT), (const char*)(WSP(unsigned char, WS_WDT) + (size_t)l * NEXP * D * P8), (size_t)D * P8, WSP(int, WS_ELIST), false, nullptr, L, true};
            EpiDown E{WSP(unsigned char, WS_EO), FIN(27) + (size_t)l * NEXP * D, (((DUP_MASK >> 20) & 1u) != 0u) && rep_ == 0};
#if PROBE_SEL >= 0
            if (l == 1) S.stat = (unsigned*)A->ws + CW_STAT;
#endif
            gemm_phase<false, true>(L, 8, (unsigned)P8, (unsigned)P8, S, E);
            if (xcd_unit(xcd_max_units(F.G, ts[32] * 4) - 1, F.G, F.bid, ts[32] * 4) < 0) conv_fill2(A, F, l, 4);
        }
        PH_END;
    }
    if (PH_RUN(13)) phase_norm1(A, F, DEPTH);
#undef PH_RUN
#undef PH_END
}
}

extern "C" void kernel_launch(void* const* d_in, const int* in_sizes, int n_in, void* d_out, int out_size, void* d_ws, size_t ws_size, hipStream_t stream) {
    static int grid = 0;
    if (grid == 0) {
        if (n_in != 29 || out_size != NLAT * D || ws_size < WS_END) { fprintf(stderr, "kernel_launch: unexpected shapes (n_in %d, out %d, ws %zu)\n", n_in, out_size, ws_size); grid = -1; return; }
        int dev = 0, cus = 0;
        if (hipGetDevice(&dev) != hipSuccess || hipDeviceGetAttribute(&cus, hipDeviceAttributeMultiprocessorCount, dev) != hipSuccess) { grid = -1; return; }
        if (hipFuncSetAttribute((const void*)mk_fwd, hipFuncAttributeMaxDynamicSharedMemorySize, LDS_BYTES) != hipSuccess) { fprintf(stderr, "kernel_launch: hipFuncSetAttribute failed\n"); grid = -1; return; }
        int per_cu = 0;
        if (hipOccupancyMaxActiveBlocksPerMultiprocessor(&per_cu, (const void*)mk_fwd, NTHREADS, LDS_BYTES) != hipSuccess || per_cu < 1) { fprintf(stderr, "kernel_launch: occupancy query reports %d\n", per_cu); }
        (void)hipGetLastError();
        grid = cus;
    }
    if (grid < 0) return;
    (void)hipMemsetAsync((char*)d_ws + WS_CTL, 0, 1 * MiB, stream);
    Args a{};
    for (int i = 0; i < 29; ++i) a.in[i] = (const float*)d_in[i];
    a.out = (float*)d_out; a.ws = (unsigned char*)d_ws;
#if MK_PER_PHASE
    for (int p = 0; p < NPHASES; ++p) { a.ph_lo = p; a.ph_hi = p + 1; hipLaunchKernelGGL(mk_fwd, dim3(grid), dim3(NTHREADS), LDS_BYTES, stream, a); }
#else
    a.ph_lo = 0; a.ph_hi = NPHASES;
    hipLaunchKernelGGL(mk_fwd, dim3(grid), dim3(NTHREADS), LDS_BYTES, stream, a);
#endif
}
```

```cpp
#include <hip/hip_runtime.h>
#include <cstdio>
#include <cstdint>

#ifndef MK_PER_PHASE
#define MK_PER_PHASE 0
#endif

#ifndef PROBE_SEL
#define PROBE_SEL -1
#endif
#define LAS __attribute__((address_space(3)))
#define GAS __attribute__((address_space(1)))
typedef unsigned short bf16_t;
typedef short bf16x8 __attribute__((ext_vector_type(8)));
typedef float f32x4 __attribute__((ext_vector_type(4)));
typedef float f32x2 __attribute__((ext_vector_type(2)));
typedef float f32x16 __attribute__((ext_vector_type(16)));
typedef unsigned u32x4 __attribute__((ext_vector_type(4)));
typedef unsigned u32x2 __attribute__((ext_vector_type(2)));
typedef int v8i __attribute__((ext_vector_type(8)));
typedef int v4i __attribute__((ext_vector_type(4)));

namespace {
constexpr int D = 1024, NBATCH = 4, SEQ = 8192, DEPTH = 4, CTXL = 256;
constexpr int NLAT = NBATCH * SEQ;
constexpr int NCTX = NBATCH * CTXL;
constexpr int TT = NLAT + NCTX;
constexpr int PW = 1280;
constexpr int NEXP = 32, FF = 1024;
constexpr int MCH = 768;
constexpr int SUXW = 1280;
constexpr int MAXTILES = 560;
constexpr int NWAVES = 8, NTHREADS = 512;
constexpr float RMS_EPS = 1e-6f;
constexpr int P8 = 1152;

constexpr size_t MiB = 1ull << 20;
constexpr size_t WS_CTL = 0;
constexpr size_t WS_MOD = 1 * MiB;
constexpr size_t WS_ROPE = 2 * MiB;
constexpr size_t WS_LP = 3 * MiB;
constexpr size_t WS_BBAR = 8 * MiB;
constexpr size_t WS_WRT = 9 * MiB;
constexpr size_t WS_WGLUT = 10 * MiB;
constexpr size_t WS_WINT = 11 * MiB;
constexpr size_t WS_WOUTT = 27 * MiB;
constexpr size_t WS_WST = 35 * MiB;
constexpr size_t WS_KC = 67 * MiB;
constexpr size_t WS_WGUT = 227 * MiB;
constexpr size_t WS_WDT = 739 * MiB;
constexpr size_t WS_XR = 995 * MiB;
constexpr size_t WS_H = 1127 * MiB;
constexpr size_t WS_P = 1193 * MiB;
constexpr size_t WS_VT = 1276 * MiB;
constexpr size_t WS_SUX = 1309 * MiB;
constexpr size_t WS_SLOC = 1339 * MiB;
constexpr size_t WS_G = 1351 * MiB;
constexpr size_t WS_Y = 1368 * MiB;
constexpr size_t WS_ELIST = 1434 * MiB;
constexpr size_t WS_ELW = 1439 * MiB;
constexpr size_t WS_TOKINFO = 1444 * MiB;
constexpr size_t WS_ACT = 1445 * MiB;
constexpr size_t WS_EO = 1725 * MiB;
constexpr size_t WS_TOKW = 2005 * MiB;
constexpr size_t WS_DELTA = 2006 * MiB;
constexpr size_t WS_H8 = 2072 * MiB;
constexpr size_t WS_END = 2112 * MiB;
constexpr int CW_BAR = 1024;
constexpr int CW_CNT = 8192;
constexpr int CW_STAT = 12288;
constexpr int CW_XC = 12800;
constexpr int CW_QUEUE = 12544;

constexpr int LDS_STAGE = 131072;
constexpr int LDS_MISC = LDS_STAGE;
constexpr int LDS_BIAS = LDS_STAGE + 1024;
constexpr int LDS_ROPE = LDS_STAGE + 4096;
constexpr int LDS_TOK = LDS_STAGE + 4096 + 16384;
constexpr int LDS_T2E = LDS_TOK + 2048;
constexpr int LDS_BYTES = LDS_T2E + 2560;

__device__ __forceinline__ unsigned f2bf(float f) { unsigned u = __builtin_bit_cast(unsigned, f); return (u + 0x7fffu + ((u >> 16) & 1u)) >> 16; }
__device__ __forceinline__ unsigned pk2(float lo, float hi) { return f2bf(lo) | (f2bf(hi) << 16); }
__device__ __forceinline__ float bf2f(unsigned short b) { return __builtin_bit_cast(float, ((unsigned)b) << 16); }
__device__ __forceinline__ float bflo(unsigned w) { return __builtin_bit_cast(float, w << 16); }
__device__ __forceinline__ float bfhi(unsigned w) { return __builtin_bit_cast(float, w & 0xffff0000u); }
__device__ __forceinline__ f32x4 bf4_to_f32(u32x2 w) { return (f32x4){bflo(w.x), bfhi(w.x), bflo(w.y), bfhi(w.y)}; }
__device__ __forceinline__ u32x2 f32_to_bf4(f32x4 v) { u32x2 o; o.x = pk2(v.x, v.y); o.y = pk2(v.z, v.w); return o; }
__device__ __forceinline__ float wave_sum(float v) {
#pragma unroll
    for (int o = 1; o < 64; o <<= 1) v += __shfl_xor(v, o);
    return v;
}
constexpr float FP8_SW = 64.0f, FP8_SH = 16.0f, FP8_SA = 8.0f, FP8_SE = 16.0f, FP8_SY = 16.0f;
__device__ __forceinline__ unsigned pk4_fp8(float a, float b, float c, float d) {
    a = fminf(fmaxf(a, -448.f), 448.f); b = fminf(fmaxf(b, -448.f), 448.f); c = fminf(fmaxf(c, -448.f), 448.f); d = fminf(fmaxf(d, -448.f), 448.f);
    int v = 0; v = __builtin_amdgcn_cvt_pk_fp8_f32(a, b, v, false); v = __builtin_amdgcn_cvt_pk_fp8_f32(c, d, v, true); return (unsigned)v; }
__device__ __forceinline__ unsigned pk4_fp8_nc(float a, float b, float c, float d) {
    int v = 0; v = __builtin_amdgcn_cvt_pk_fp8_f32(a, b, v, false); v = __builtin_amdgcn_cvt_pk_fp8_f32(c, d, v, true); return (unsigned)v; }
__device__ __forceinline__ float fast_exp2(float x) { return __builtin_amdgcn_exp2f(x); }
__device__ __forceinline__ float sigmoidf_(float x) { return __builtin_amdgcn_rcpf(1.0f + __builtin_amdgcn_exp2f(-1.4426950408889634f * x)); }
__device__ __forceinline__ float gelu_tanh(float x) {
    const float u = 0.7978845608028654f * (x + 0.044715f * x * x * x);
    const float t = 1.0f - 2.0f * __builtin_amdgcn_rcpf(1.0f + __builtin_amdgcn_exp2f(2.8853900817779268f * u));
    return 0.5f * x * (1.0f + t);
}

#define XB_TMO      128
#define XB_XCNT(j)  (256  + 64 * (j))
#define XB_XSUB(j)  (1280 + 64 * (j))
#define XB_XGEN(j)  (2304 + 64 * (j))
#define XB_TOP      3328
#define XB_TOPGEN   3392
#define XCD_BAR_WORDS 3456
#define XB_SPIN_CAP (1u << 18)
__device__ __forceinline__ unsigned xb_ld(unsigned* p)              { return __hip_atomic_load(p, __ATOMIC_RELAXED, __HIP_MEMORY_SCOPE_AGENT); }
__device__ __forceinline__ unsigned xb_add(unsigned* p, unsigned v) { return __hip_atomic_fetch_add(p, v, __ATOMIC_RELAXED, __HIP_MEMORY_SCOPE_AGENT); }
__device__ __forceinline__ unsigned xb_xcc_id() { return (unsigned)__builtin_amdgcn_s_getreg((3 << 11) | 20) & 0xFu; }
#define XB_SPIN(cond, bar) do { unsigned _sp = 0; while (cond) { __builtin_amdgcn_s_sleep(1); \
    if ((++_sp & 255u) == 0u) { if (xb_ld(&(bar)[XB_TMO])) break; if (_sp > XB_SPIN_CAP) { atomicAdd(&(bar)[XB_TMO], 1u); break; } } } } while (0)
struct XcdBarrier { unsigned* bar; unsigned x; volatile LAS unsigned* st; };
__device__ __forceinline__ XcdBarrier xcd_barrier_post(unsigned* bar, volatile LAS unsigned* st) {
    XcdBarrier b; b.bar = bar; b.x = xb_xcc_id(); b.st = st;
    if (threadIdx.x == 0) (void)xb_add(&bar[XB_XCNT(b.x)], 1u);
    return b;
}
__device__ __forceinline__ void xcd_barrier_complete(unsigned* bar, unsigned x, unsigned& nloc, unsigned& nx) {
    const unsigned G = gridDim.x * gridDim.y * gridDim.z;
    unsigned sum, cnt, mine, sp = 0u;
    for (;;) {
        sum = 0u; cnt = 0u; mine = 0u;
#pragma unroll
        for (unsigned j = 0; j < 16; ++j) { const unsigned c = xb_ld(&bar[XB_XCNT(j)]); sum += c; cnt += (c > 0u) ? 1u : 0u; mine = (j == x) ? c : mine; }
        if (sum == G) break;
        __builtin_amdgcn_s_sleep(1);
        if ((++sp & 255u) == 0u) { if (xb_ld(&bar[XB_TMO])) break; if (sp > XB_SPIN_CAP) { atomicAdd(&bar[XB_TMO], 1u); break; } }
    }
    nloc = mine > 0u ? mine : 1u; nx = cnt > 0u ? cnt : 1u;
}
__device__ __forceinline__ void xcd_barrier(const XcdBarrier& b) {
    asm volatile("s_waitcnt vmcnt(0)" ::: "memory");
    __syncthreads();
    if (threadIdx.x == 0) {
        unsigned* bar = b.bar;
        __builtin_amdgcn_s_waitcnt(0);
        unsigned nloc = b.st[0], nx = b.st[1];
        if (nloc == 0u) { xcd_barrier_complete(bar, b.x, nloc, nx); b.st[0] = nloc; b.st[1] = nx; }
        const unsigned old = xb_add(&bar[XB_XSUB(b.x)], 1u);
        const unsigned gen = old / nloc;
        if (old + 1u == (gen + 1u) * nloc) {
            __builtin_amdgcn_fence(__ATOMIC_RELEASE, "agent");
            asm volatile("s_waitcnt vmcnt(0)" ::: "memory");
            const unsigned og = xb_add(&bar[XB_TOP], 1u);
            const unsigned tg = og / nx;
            if (og + 1u == (tg + 1u) * nx) xb_add(&bar[XB_TOPGEN], 1u);
            else XB_SPIN(xb_ld(&bar[XB_TOPGEN]) == tg, bar);
            __builtin_amdgcn_fence(__ATOMIC_ACQUIRE, "agent");
            xb_add(&bar[XB_XGEN(b.x)], 1u);
            asm volatile("s_waitcnt vmcnt(0)" ::: "memory");
        } else {
            XB_SPIN(xb_ld(&bar[XB_XGEN(b.x)]) == gen, bar);
            __builtin_amdgcn_fence(__ATOMIC_ACQUIRE, "agent");
            asm volatile("s_waitcnt vmcnt(0)" ::: "memory");
        }
    }
    __syncthreads();
}

__device__ __forceinline__ void xc_signal(unsigned* c) {
    asm volatile("s_waitcnt vmcnt(0)" ::: "memory");
    __syncthreads();
    if (threadIdx.x == 0) { __builtin_amdgcn_fence(__ATOMIC_RELEASE, "agent"); asm volatile("s_waitcnt vmcnt(0)" ::: "memory"); (void)xb_add(c, 1u); }
}
__device__ __forceinline__ void xc_wait(unsigned* c, unsigned n, unsigned* bar) {
    if (threadIdx.x == 0) { XB_SPIN(xb_ld(c) < n, bar); __builtin_amdgcn_fence(__ATOMIC_ACQUIRE, "agent"); asm volatile("s_waitcnt vmcnt(0)" ::: "memory"); }
    __syncthreads();
}

constexpr float LOG2E_ = 1.4426950408889634f;
constexpr int BM = 256, BK = 64, HALF = 128, HTB = HALF * BK * 2;
__device__ __forceinline__ int lds_byte(int r, int c) { const int st = (r >> 4) * 2 + (c >> 5), rr = r & 15, cc = c & 31, ob = rr * 64 + cc * 2; return st * 1024 + (ob ^ (((ob >> 9) & 1) << 5)); }
__device__ __forceinline__ void stage_rc(int b, int& R, int& C) { const int st = b / 1024, sb = b % 1024, swz = sb ^ (((sb >> 9) & 1) << 5); R = (st >> 1) * 16 + swz / 64; C = (st & 1) * 32 + (swz % 64) / 2; }
__device__ __forceinline__ int perm32(int rho) { const int n = rho >> 4, i = rho & 15; return 8 * (i >> 2) + 4 * n + (i & 3); }
__device__ __forceinline__ unsigned cvt_pk_bf16(float lo, float hi) { unsigned r; asm volatile("v_cvt_pk_bf16_f32 %0, %1, %2" : "=v"(r) : "v"(lo), "v"(hi)); return r; }
__device__ __forceinline__ u32x4 pack8(const float* v) { u32x4 w; w.x = cvt_pk_bf16(v[0], v[1]); w.y = cvt_pk_bf16(v[2], v[3]); w.z = cvt_pk_bf16(v[4], v[5]); w.w = cvt_pk_bf16(v[6], v[7]); return w; }

struct GUnit { const char* A; const char* B; int p0, p1, p2, p3; };
typedef f32x4 AccT[2][2][4][2];

template <bool GATHER, bool FP8, class Sched, class Epi>
__device__ __forceinline__ void gemm_phase(LAS unsigned char* lds, const int nt_  , const unsigned lda2, const unsigned ldb2  , const Sched& S, const Epi& E) {
    int tid = threadIdx.x; asm volatile("" : "+v"(tid));
    int nt = nt_; asm volatile("" : "+s"(nt));
    const int wid = __builtin_amdgcn_readfirstlane(tid >> 6), lane = tid & 63, wr = wid >> 2, wc = wid & 3, fr = lane & 15, fq = lane >> 4;
    unsigned voffA[2][2], voffB[2]; int RA[2], CA[2];
#pragma unroll
    for (int i = 0; i < 2; ++i) { int R, C;
        if (FP8) { const int g = tid + 512 * i; R = (g >> 7) * 16 + (g & 15); C = ((g >> 4) & 7) * 8; }
        else stage_rc(tid * 16 + i * 8192, R, C);
        const int Rb = (R & ~31) + perm32(R & 31);
        RA[i] = R; CA[i] = C; voffA[0][i] = S.voffA(0, R, C * 2, lda2); voffA[1][i] = S.voffA(1, R, C * 2, lda2); voffB[i] = (unsigned)Rb * ldb2 + (unsigned)C * 2u; }
    const size_t kstep = (size_t)(BK * 2);
    const size_t kstepA = S.kstepA();
    const size_t hstepB = (size_t)HALF * ldb2;
    const unsigned ldsw = (unsigned)wid * 1024u;
    const int aoff = FP8 ? ((wr * 4) * 128 + 2 * fq * 16 + fr) * 16 : lds_byte(wr * 64 + fr, fq * 8), boff = FP8 ? ((wc * 2) * 128 + 2 * fq * 16 + fr) * 16 : lds_byte(wc * 32 + fr, fq * 8);
#define PG_SA(b, h) (((b) * 2 + (h)) * HTB)
#define PG_SB(b, h) ((4 + (b) * 2 + (h)) * HTB)
#define PG_STAGE(bufoff, gbase, voff) do { _Pragma("unroll") for (int _i = 0; _i < 2; ++_i) \
        __builtin_amdgcn_global_load_lds((const unsigned*)((const char*)(gbase) + (voff)[_i]), (LAS unsigned*)(lds + (bufoff) + ldsw + _i * 8192), 16, 0, 0); } while (0)
#define PG_LD32(p) __builtin_shufflevector(*(const LAS v4i*)(p), *(const LAS v4i*)((p) + 256), 0, 1, 2, 3, 4, 5, 6, 7)
#define PG_LDA(dst, b, h) do { if (FP8) { _Pragma("unroll") for (int m = 0; m < 4; ++m) dst##8[m] = PG_LD32(lds + PG_SA(b, h) + aoff + m * 2048); } \
        else { _Pragma("unroll") for (int m = 0; m < 4; ++m) _Pragma("unroll") for (int k = 0; k < 2; ++k) dst[m][k] = *(const LAS bf16x8*)(lds + PG_SA(b, h) + aoff + m * 2048 + k * 1024); } } while (0)
#define PG_LDB(dst, b, h) do { if (FP8) { _Pragma("unroll") for (int n = 0; n < 2; ++n) dst##8[n] = PG_LD32(lds + PG_SB(b, h) + boff + n * 2048); } \
        else { _Pragma("unroll") for (int n = 0; n < 2; ++n) _Pragma("unroll") for (int k = 0; k < 2; ++k) dst[n][k] = *(const LAS bf16x8*)(lds + PG_SB(b, h) + boff + n * 2048 + k * 1024); } } while (0)
#define PG_MMA(ai, bj, At, Bt) do { __builtin_amdgcn_s_setprio(1); \
        if (FP8) { _Pragma("unroll") for (int m = 0; m < 4; ++m) _Pragma("unroll") for (int n = 0; n < 2; ++n) \
            asm volatile("v_mfma_f32_16x16x128_f8f6f4 %0, %1, %2, %0" : "+v"(acc[ai][bj][m][n]) : "v"(Bt##8[n]), "v"(At##8[m])); }   \
        else { _Pragma("unroll") for (int m = 0; m < 4; ++m) _Pragma("unroll") for (int n = 0; n < 2; ++n) _Pragma("unroll") for (int k = 0; k < 2; ++k) \
            acc[ai][bj][m][n] = __builtin_amdgcn_mfma_f32_16x16x32_bf16(Bt[n][k], At[m][k], acc[ai][bj][m][n], 0, 0, 0); } \
        __builtin_amdgcn_s_setprio(0); } while (0)
#define PG_WAIT_V(n) asm volatile("s_waitcnt vmcnt(" #n ")" ::: "memory")
#define PG_WAIT_L(n) asm volatile("s_waitcnt lgkmcnt(" #n ")" ::: "memory")
#define PG_BAR __builtin_amdgcn_s_barrier()
#define PG_SCHED __builtin_amdgcn_sched_barrier(0)
    GUnit cur, nxt; int ui = 0;
    if (!S.next(0, cur)) return;
#if PROBE_SEL >= 0
    unsigned pc_k = 0, pc_e = 0, pc_g = 0, pc_n = 0, pc_t0 = 0, pc_t1 = 0, pc_w = 0;
#define PCYC() ({ const unsigned long long c_ = __builtin_amdgcn_s_memtime(); asm volatile("s_waitcnt lgkmcnt(0)" ::: "memory"); (unsigned)c_; })
#endif
    AccT acc;
#pragma unroll
    for (int a = 0; a < 2; ++a)
#pragma unroll
        for (int b = 0; b < 2; ++b)
#pragma unroll
            for (int m = 0; m < 4; ++m)
#pragma unroll
                for (int n = 0; n < 2; ++n) acc[a][b][m][n] = (f32x4){0.f, 0.f, 0.f, 0.f};
    bf16x8 At[4][2], B0[2][2], B1[2][2]; v8i At8[4], B08[2], B18[2];
    const char* cA = cur.A; const char* cB = cur.B;
    S.pre(cur, 0, wid, lane);
    if (GATHER) {
#pragma unroll
        for (int h = 0; h < 2; ++h)
#pragma unroll
            for (int i = 0; i < 2; ++i) voffA[h][i] = (unsigned)S.row_token(cur, h * 128 + RA[i]) * lda2 + (unsigned)CA[i] * 2u;
    }
    unsigned voffAn[2][2];
#pragma unroll
    for (int h = 0; h < 2; ++h)
#pragma unroll
        for (int i = 0; i < 2; ++i) voffAn[h][i] = voffA[h][i];
    PG_STAGE(PG_SB(0, 0), cB, voffB); PG_STAGE(PG_SB(0, 1), cB + hstepB, voffB); PG_STAGE(PG_SA(0, 0), cA, voffA[0]); PG_STAGE(PG_SA(0, 1), cA, voffA[1]);
    if (wr == 1) PG_BAR;
    PG_WAIT_V(2); PG_BAR;
    PG_STAGE(PG_SB(1, 0), cB + kstep, voffB); PG_STAGE(PG_SA(1, 0), cA + kstepA, voffA[0]); PG_STAGE(PG_SB(1, 1), cB + hstepB + kstep, voffB);
    PG_WAIT_V(6); PG_BAR;
    for (;;) {
        const bool has_next = S.next(ui + 1, nxt);
        const char* nA = has_next ? nxt.A : cA; const char* nB = has_next ? nxt.B : cB;
#if PROBE_SEL >= 0
        pc_t0 = PCYC(); if (ui > 0) pc_g += (pc_t0 - pc_t1) & 0xFFFFFu;
#endif
        for (int t = 0; t < nt; t += 2) {
            const bool last = (t == nt - 2);
            const char* a1 = cA + (size_t)(t + 1) * kstepA;
            const char* a2 = last ? nA : cA + (size_t)(t + 2) * kstepA; const char* b2 = last ? nB : cB + (size_t)(t + 2) * kstep;
            const char* a3 = a2 + kstepA; const char* b3 = b2 + kstep;
            if (t == nt - 4 && has_next) S.pre(nxt, (ui + 1) & 1, wid, lane);
            if (GATHER) {
                if (last && has_next) {
                    int tq = threadIdx.x; asm volatile("" : "+v"(tq));
#pragma unroll
                    for (int i = 0; i < 2; ++i) { int R2, C2;
                        if (FP8) { const int g = tq + 512 * i; R2 = (g >> 7) * 16 + (g & 15); C2 = ((g >> 4) & 7) * 8; } else stage_rc(tq * 16 + i * 8192, R2, C2);
#pragma unroll
                        for (int h = 0; h < 2; ++h) voffAn[h][i] = (unsigned)S.row_token_lds(nxt, (ui + 1) & 1, h * 128 + R2) * lda2 + (unsigned)C2 * 2u; }
                }
            }
            unsigned vA0[2], vA1[2];
#pragma unroll
            for (int i = 0; i < 2; ++i) { vA0[i] = (GATHER && last) ? voffAn[0][i] : voffA[0][i]; vA1[i] = (GATHER && last) ? voffAn[1][i] : voffA[1][i]; }
            PG_LDB(B0, 0, 0); PG_LDB(B1, 0, 1); PG_SCHED; PG_LDA(At, 0, 0); PG_STAGE(PG_SA(1, 1), a1, voffA[1]);
            PG_WAIT_V(8); PG_WAIT_L(0); PG_BAR; PG_MMA(0, 0, At, B0); PG_MMA(0, 1, At, B1); PG_BAR; PG_SCHED;
            PG_LDA(At, 0, 1); PG_STAGE(PG_SB(0, 0), b2, voffB); PG_STAGE(PG_SB(0, 1), b2 + hstepB, voffB); PG_STAGE(PG_SA(0, 0), a2, vA0);
            PG_WAIT_V(8); PG_WAIT_L(0); PG_BAR; PG_MMA(1, 0, At, B0); PG_MMA(1, 1, At, B1); PG_BAR; PG_SCHED;
            PG_LDB(B0, 1, 0); PG_LDB(B1, 1, 1); PG_SCHED; PG_LDA(At, 1, 0); PG_STAGE(PG_SA(0, 1), a2, vA1);
            PG_WAIT_V(8); PG_WAIT_L(0); PG_BAR; PG_MMA(0, 0, At, B0); PG_MMA(0, 1, At, B1); PG_BAR; PG_SCHED;
            PG_LDA(At, 1, 1); PG_STAGE(PG_SB(1, 0), b3, voffB); PG_STAGE(PG_SB(1, 1), b3 + hstepB, voffB); PG_STAGE(PG_SA(1, 0), a3, vA0);
            PG_WAIT_V(8); PG_WAIT_L(0); PG_BAR; PG_MMA(1, 0, At, B0); PG_MMA(1, 1, At, B1); PG_BAR; PG_SCHED;
        }
#if PROBE_SEL >= 0
        pc_t1 = PCYC(); pc_k += (pc_t1 - pc_t0) & 0xFFFFFu; ++pc_n;
#endif
        if (wr == 0) PG_BAR;
        if (FP8) asm volatile("s_nop 15\n\ts_nop 15" ::: "memory");
        {
            int tz = threadIdx.x; asm volatile("" : "+v"(tz)); const int wz = __builtin_amdgcn_readfirstlane(tz >> 6), lz = tz & 63;
            E(acc, cur, ui & 1, wz >> 2, wz & 3, lz & 15, lz >> 4); }
#if PROBE_SEL >= 0
        { const unsigned te = PCYC(); pc_e += (te - pc_t1) & 0xFFFFFu; }
#endif
        if (!has_next) break;
#pragma unroll
        for (int a = 0; a < 2; ++a)
#pragma unroll
            for (int b = 0; b < 2; ++b)
#pragma unroll
                for (int m = 0; m < 4; ++m)
#pragma unroll
                    for (int n = 0; n < 2; ++n) acc[a][b][m][n] = (f32x4){0.f, 0.f, 0.f, 0.f};
        cur = nxt; cA = nA; cB = nB; ++ui;
        if (wr == 1) PG_BAR;
        if (GATHER) {
#pragma unroll
            for (int h = 0; h < 2; ++h)
#pragma unroll
                for (int i = 0; i < 2; ++i) voffA[h][i] = voffAn[h][i];
        }
    }
    PG_WAIT_V(0);
    PG_BAR;
#if PROBE_SEL >= 0
    if (S.stat != nullptr && tid == 0) { atomicAdd(S.stat + 0, pc_k); atomicAdd(S.stat + 1, pc_e); atomicAdd(S.stat + 2, pc_g); atomicAdd(S.stat + 3, pc_n); }
#undef PCYC
#endif
#undef PG_SA
#undef PG_SB
#undef PG_STAGE
#undef PG_LDA
#undef PG_LD32
#undef PG_LDB
#undef PG_MMA
#undef PG_WAIT_V
#undef PG_WAIT_L
#undef PG_BAR
#undef PG_SCHED
}

struct Args { const float* in[29]; float* out; unsigned char* ws; int ph_lo, ph_hi; };
struct Frame {
    LAS unsigned char* lds;
    int G, bid;
};
#define PH_LOCALS int tid = threadIdx.x; asm volatile("" : "+v"(tid)); const int lane = tid & 63; const int wave = __builtin_amdgcn_readfirstlane(tid >> 6); (void)lane; (void)wave
typedef const __attribute__((address_space(4))) Args* KArgs;
#define WSP(T, off) ((T*)(A->ws + (off)))
#define FIN(i) (A->in[i])

template <bool F8 = false>
__device__ __forceinline__ void transpose_item(const float* W, int K, int N, bf16_t* WT, int kb, int n0s, int drow0, LAS float* scr, int lane) {
    const int k0 = 64 * kb;
    float wv[32];
#pragma unroll
    for (int i = 0; i < 32; ++i) wv[i] = __builtin_nontemporal_load(W + (size_t)(k0 + 2 * i + (lane >> 5)) * N + n0s + (lane & 31));
#pragma unroll
    for (int i = 0; i < 32; ++i) scr[(2 * i + (lane >> 5)) * 33 + (lane & 31)] = wv[i];
    asm volatile("s_waitcnt lgkmcnt(0)" ::: "memory");
    const int c = lane & 7;
#pragma unroll
    for (int j = 0; j < 4; ++j) { const int n = (lane >> 3) + 8 * j; const LAS float* s = scr + (8 * c) * 33 + n;
        if (F8) { *(u32x2*)((unsigned char*)WT + (size_t)(drow0 + n) * P8 + k0 + 8 * c) = (u32x2){pk4_fp8_nc(s[0 * 33] * FP8_SW, s[1 * 33] * FP8_SW, s[2 * 33] * FP8_SW, s[3 * 33] * FP8_SW), pk4_fp8_nc(s[4 * 33] * FP8_SW, s[5 * 33] * FP8_SW, s[6 * 33] * FP8_SW, s[7 * 33] * FP8_SW)}; }
        else { u32x4 o; o.x = pk2(s[0 * 33], s[1 * 33]); o.y = pk2(s[2 * 33], s[3 * 33]); o.z = pk2(s[4 * 33], s[5 * 33]); o.w = pk2(s[6 * 33], s[7 * 33]);
        *(u32x4*)(WT + (size_t)(drow0 + n) * K + k0 + 8 * c) = o; } }
    asm volatile("s_waitcnt lgkmcnt(0)" ::: "memory");
}
__device__ __forceinline__ void transpose_pair_f8(const float* W, int N, unsigned char* WT, int kbp, int n0s, int drow0, LAS float* scr, int lane) {
    const int k0 = 128 * kbp;
    float wv[64];
#pragma unroll
    for (int i = 0; i < 64; ++i) wv[i] = __builtin_nontemporal_load(W + (size_t)(k0 + 2 * i + (lane >> 5)) * N + n0s + (lane & 31));
    const int c = lane & 7;
#pragma unroll
    for (int hp = 0; hp < 2; ++hp) {
#pragma unroll
        for (int i = 0; i < 32; ++i) scr[(2 * i + (lane >> 5)) * 33 + (lane & 31)] = wv[32 * hp + i];
        asm volatile("s_waitcnt lgkmcnt(0)" ::: "memory");
#pragma unroll
        for (int j = 0; j < 4; ++j) { const int n = (lane >> 3) + 8 * j; const LAS float* s = scr + (8 * c) * 33 + n;
            *(u32x2*)(WT + (size_t)(drow0 + n) * P8 + k0 + 64 * hp + 8 * c) = (u32x2){pk4_fp8_nc(s[0 * 33] * FP8_SW, s[1 * 33] * FP8_SW, s[2 * 33] * FP8_SW, s[3 * 33] * FP8_SW), pk4_fp8_nc(s[4 * 33] * FP8_SW, s[5 * 33] * FP8_SW, s[6 * 33] * FP8_SW, s[7 * 33] * FP8_SW)}; }
        asm volatile("s_waitcnt lgkmcnt(0)" ::: "memory");
    }
}
__device__ __forceinline__ int win_src_col(int d) {
    if (d < 768) return d;
    if (d < 1152) return 1408 + (d - 768);
    if (d < 1280) return 1792 + (d - 1152);
    if (d < 1536) return 1152 + (d - 1280);
    if (d < 1920) return 768 + (d - 1536);
    return d;
}
__device__ __forceinline__ int wgu_src_col(int d) { const int t = d >> 8, r = d & 255; return (r < 128) ? (128 * t + r) : (1024 + 128 * t + (r - 128)); }

constexpr int EXP_ITEMS = NEXP * 8 * 64 + NEXP * 8 * 32;
__device__ __forceinline__ void expert_item(KArgs A, int L, int r, LAS float* scr, int lane) {
    if (r < NEXP * 8 * 64) { const int le = L * NEXP + r / 512, q = r % 512, kb = q / 64, nb = q % 64;
        transpose_pair_f8(FIN(24) + (size_t)le * D * 2048, 2048, WSP(unsigned char, WS_WGUT) + (size_t)le * 2048 * P8, kb, wgu_src_col(32 * nb), 32 * nb, scr, lane); }
    else { r -= NEXP * 8 * 64; const int le = L * NEXP + r / 256, q = r % 256, kb = q / 32, nb = q % 32;
        transpose_pair_f8(FIN(26) + (size_t)le * FF * D, D, WSP(unsigned char, WS_WDT) + (size_t)le * D * P8, kb, 32 * nb, 32 * nb, scr, lane); }
}
__device__ __forceinline__ int conv_fill(KArgs A, Frame& F, int L, int nb) {
    if (L < 0 || L >= DEPTH || nb <= 0) return 0;
    PH_LOCALS;
    LAS float* scr = (LAS float*)(F.lds + wave * 16384);
    volatile LAS int* slot = (volatile LAS int*)(F.lds + LDS_MISC + 16);
    int* q = (int*)A->ws + CW_QUEUE + L;
    for (int b = 0; b < nb; ++b) {
        __syncthreads();
        if (tid == 0) *slot = atomicAdd(q, 1);
        __syncthreads();
        const int idx = *slot * NWAVES + wave;
        if (idx >= EXP_ITEMS) return b;
        expert_item(A, L, idx, scr, lane);
    }
    return nb;
}
__device__ __forceinline__ void conv_fill2(KArgs A, Frame& F, int l, int nb) { const int done = conv_fill(A, F, l, nb); conv_fill(A, F, l + 1, nb - done); }
__device__ __forceinline__ void phase_p0a(KArgs A, Frame& F) {
    PH_LOCALS;
    LAS float* scr = (LAS float*)(F.lds + wave * 16384);
    const int gw = F.bid * NWAVES + wave, NGW = F.G * NWAVES;
    constexpr int I_IN = DEPTH * 8 * 64, I_OUT = DEPTH * 8 * 32, I_GLU = DEPTH * 4 * 8, I_RT = DEPTH * 16, I_EX = 0;
    constexpr int NITEMS = I_IN + I_OUT + I_GLU + I_RT + I_EX;
    for (int it = gw; it < NITEMS; it += NGW) {
        int r = it;
        if (r < I_IN) { const int l = r / 512, q = r % 512, kb = q / 64, nb = q % 64;
            transpose_pair_f8(FIN(7) + (size_t)l * D * 2048, 2048, WSP(unsigned char, WS_WINT) + (size_t)l * 2048 * P8, kb, win_src_col(32 * nb), 32 * nb, scr, lane); continue; } r -= I_IN;
        if (r < I_OUT) { const int l = r / 256, q = r % 256, kb = q / 32, nb = q % 32;
            transpose_pair_f8(FIN(8) + (size_t)l * D * D, D, WSP(unsigned char, WS_WOUTT) + (size_t)l * D * P8, kb, 32 * nb, 32 * nb, scr, lane); continue; } r -= I_OUT;
        if (r < I_GLU) { const int l = r / 32, q = r % 32, kb = q / 8, nb = q % 8;
            transpose_item(FIN(18) + (size_t)l * 256 * 256, 256, 256, WSP(bf16_t, WS_WGLUT) + (size_t)l * 256 * 256, kb, 32 * nb, 32 * nb, scr, lane); continue; } r -= I_GLU;
        if (r < I_RT) { const int l = r / 16, kb = r % 16;
            transpose_item(FIN(22) + (size_t)l * D * NEXP, D, NEXP, WSP(bf16_t, WS_WRT) + (size_t)l * NEXP * D, kb, 0, 0, scr, lane); continue; } r -= I_RT;
        expert_item(A, 0, r, scr, lane);
    }
    __syncthreads();
    {
        LAS float* cond = (LAS float*)F.lds;
        LAS float* red = (LAS float*)(F.lds + 32768);
        for (int i = tid; i < 5 * D; i += NTHREADS) { const int bi = i / D, k = i % D; const float v = (bi < 4) ? FIN(1)[bi * D + k] : FIN(3)[k]; cond[i] = v / (1.0f + __expf(-v)); }
        __syncthreads();
        for (int u = F.bid; u < DEPTH * 96; u += F.G) {
            const int l = u / 96, j = (u % 96) * 64 + lane;
            const float* w = FIN(4) + (size_t)l * D * 6144 + j;
            float a0 = 0.f, a1 = 0.f, a2 = 0.f, a3 = 0.f, a4 = 0.f;
#pragma unroll 1
            for (int kb = 0; kb < 128; kb += 32) {
                float wv[32];
#pragma unroll
                for (int kk = 0; kk < 32; ++kk) wv[kk] = __builtin_nontemporal_load(w + (size_t)(wave * 128 + kb + kk) * 6144);
#pragma unroll
                for (int kk = 0; kk < 32; ++kk) { const int k = wave * 128 + kb + kk;
                    a0 += cond[k] * wv[kk]; a1 += cond[D + k] * wv[kk]; a2 += cond[2 * D + k] * wv[kk]; a3 += cond[3 * D + k] * wv[kk]; a4 += cond[4 * D + k] * wv[kk]; } }
            red[(wave * 5 + 0) * 64 + lane] = a0; red[(wave * 5 + 1) * 64 + lane] = a1; red[(wave * 5 + 2) * 64 + lane] = a2;
            red[(wave * 5 + 3) * 64 + lane] = a3; red[(wave * 5 + 4) * 64 + lane] = a4;
            __syncthreads();
            if (tid < 320) { const int bi = tid / 64, jj = tid % 64; float s = 0.f;
#pragma unroll
                for (int w8 = 0; w8 < 8; ++w8) s += red[(w8 * 5 + bi) * 64 + jj];
                const int col = (u % 96) * 64 + jj;
                WSP(float, WS_MOD)[((size_t)l * 5 + bi) * 6144 + col] = s + FIN(5)[l * 6144 + col]; }
            __syncthreads();
        }
    }
    const int gt = F.bid * NTHREADS + tid, NGT = F.G * NTHREADS;
    for (int i = gt; i < 128 * 16; i += NGT) { const int pos = i / 16, f = i % 16; const float inv = powf(10000.0f, -(float)f / 16.0f); const float a = (float)pos * inv;
        WSP(float, WS_ROPE)[i] = cosf(a); WSP(float, WS_ROPE)[2048 + i] = sinf(a); }
    for (int i = gt; i < DEPTH * 2 * 16 * 65 * 64; i += NGT) {
        const int p = i % 64, d = (i / 64) % 65, ldg = i / (64 * 65);
        const float are = fminf(FIN(10)[ldg * 64 + p], -1e-4f), aim = FIN(11)[ldg * 64 + p];
        const float step = expf(FIN(12)[ldg]);
        const float re = are * step * (float)d, im = aim * step * (float)d;
        const float mag = expf(re);
        WSP(f32x2, WS_LP)[i] = (f32x2){mag * cosf(im), mag * sinf(im)};
    }
    for (int i = gt; i < DEPTH * 2 * 16 * 64 * 16; i += NGT) {
        const int lp = i / 16;
        const int ldg = lp / 64;
        const float are = fminf(FIN(10)[lp], -1e-4f), aim = FIN(11)[lp];
        const float step = expf(FIN(12)[ldg]);
        const float mag = expf(are * step), lr = mag * cosf(aim * step) - 1.0f, li = mag * sinf(aim * step);
        const float den = are * are + aim * aim;
        const float qr = (lr * are + li * aim) / den, qi = (li * are - lr * aim) / den;
        const float br = FIN(13)[i], bi = FIN(14)[i];
        WSP(f32x2, WS_BBAR)[i] = (f32x2){qr * br - qi * bi, qr * bi + qi * br};
    }
}

__device__ __forceinline__ f32x2 cmul(f32x2 a, f32x2 b) { return (f32x2){a.x * b.x - a.y * b.y, a.x * b.y + a.y * b.x}; }
__device__ __forceinline__ void phase_p0b(KArgs A, Frame& F) {
    PH_LOCALS;
    const f32x2* LP = WSP(f32x2, WS_LP); const f32x2* BB = WSP(f32x2, WS_BBAR);
    LAS float* kc = (LAS float*)F.lds;
    for (int it = F.bid; it < DEPTH * 16 * 4; it += F.G) {
        const int qr = it & 3, lg = it >> 2, l = lg >> 4, g = lg & 15;
        for (int i = tid; i < 128 * 64; i += NTHREADS) kc[i] = 0.f;
        __syncthreads();
        {
            const int pq = tid & 3, hi = (tid >> 2) & 15, hol = (tid >> 6) & 3, dir = tid >> 8, ho = 4 * qr + hol;
            const int ldg = (l * 2 + dir) * 16 + g;
            const float* cre = FIN(15) + ((size_t)ldg * 16 + ho) * 64; const float* cim = FIN(16) + ((size_t)ldg * 16 + ho) * 64;
            float acc[64];
#pragma unroll
            for (int d = 0; d < 64; ++d) acc[d] = 0.f;
#pragma unroll 1
            for (int pp = 0; pp < 16; ++pp) { const int p = 16 * pq + pp;
                f32x2 z = cmul((f32x2){cre[p], cim[p]}, BB[(size_t)ldg * 1024 + p * 16 + hi]);
                const f32x2 lam = LP[((size_t)ldg * 65 + 1) * 64 + p];
#pragma unroll
                for (int d = 0; d < 64; ++d) { acc[d] += z.x; z = cmul(z, lam); }
            }
            const int R = (dir * 4 + hol) * 16 + hi;
#pragma unroll
            for (int d = 0; d < 64; ++d) (void)__hip_atomic_fetch_add(kc + R * 64 + ((d + R) & 63), acc[d], __ATOMIC_RELAXED, __HIP_MEMORY_SCOPE_WORKGROUP);
        }
        __syncthreads();
        {
            bf16_t* KC = WSP(bf16_t, WS_KC) + (size_t)lg * 1024 * SUXW;
            const int s = lane;
#pragma unroll 1
            for (int rr = 0; rr < 32; ++rr) {
                const int r = wave * 32 + rr, t = r >> 2, hol = r & 3, ho = 4 * qr + hol;
                const float dsk = FIN(17)[l * 256 + g * 16 + ho];
                float v[16];
#pragma unroll
                for (int hi = 0; hi < 16; ++hi) {
                    const int R0 = (0 * 4 + hol) * 16 + hi, R1 = (1 * 4 + hol) * 16 + hi; const int dd = (s < t) ? t - s : s - t;
                    const float a0 = kc[R0 * 64 + ((dd + R0) & 63)], a1 = kc[R1 * 64 + ((dd + R1) & 63)];
                    v[hi] = (s < t) ? a0 : (s > t) ? a1 : (a0 + a1 + ((hi == ho) ? dsk : 0.f));
                }
                bf16_t* dst = KC + (size_t)(t * 16 + ho) * SUXW + s * 16;
                *(u32x4*)dst = pack8(v); *(u32x4*)(dst + 8) = pack8(v + 8);
                const int q4 = lane >> 4, dir = q4 >> 1, ri = q4 & 1, p0 = 4 * (lane & 15);
                const int ldg = (l * 2 + dir) * 16 + g, e = dir ? 64 - t : t + 1;
                float cv[4];
#pragma unroll
                for (int j = 0; j < 4; ++j) { const int p = p0 + j; const f32x2 c = (f32x2){FIN(15)[((size_t)ldg * 16 + ho) * 64 + p], FIN(16)[((size_t)ldg * 16 + ho) * 64 + p]};
                    const f32x2 w = cmul(c, LP[((size_t)ldg * 65 + e) * 64 + p]); cv[j] = ri ? -w.y : w.x; }
                *(u32x2*)(KC + (size_t)(t * 16 + ho) * SUXW + 1024 + q4 * 64 + p0) = (u32x2){cvt_pk_bf16(cv[0], cv[1]), cvt_pk_bf16(cv[2], cv[3])};
            }
        }
        {
            bf16_t* WT = WSP(bf16_t, WS_WST) + (size_t)lg * 256 * 1024;
            const int s = lane;
#pragma unroll 1
            for (int rr = 0; rr < 8; ++rr) {
                const int n = 64 * qr + wave * 8 + rr, dir = n >> 7, ri = (n >> 6) & 1, p = n & 63;
                const int ldg = (l * 2 + dir) * 16 + g, e = dir ? s : 63 - s;
                const f32x2 lp = LP[((size_t)ldg * 65 + e) * 64 + p];
                float v[16];
#pragma unroll
                for (int hi = 0; hi < 16; ++hi) { const f32x2 w = cmul(lp, BB[(size_t)ldg * 1024 + p * 16 + hi]); v[hi] = ri ? w.y : w.x; }
                bf16_t* dst = WT + (size_t)n * 1024 + s * 16;
                *(u32x4*)dst = pack8(v); *(u32x4*)(dst + 8) = pack8(v + 8);
            }
        }
        __syncthreads();
    }
}

__device__ __forceinline__ void build_tstart(KArgs A, Frame& F, int l) {
    PH_LOCALS;
    LAS int* ts = (LAS int*)(F.lds + LDS_MISC + 64);
    if (tid == 0) { const int* cnt = (const int*)A->ws + CW_CNT + l * 32; int a = 0;
        for (int e = 0; e < 32; ++e) { ts[e] = a; ts[40 + e] = cnt[e]; a += (cnt[e] + 255) >> 8; }
        ts[32] = a; }
    __syncthreads();
    if (tid < 32) { LAS int* t2e = (LAS int*)(F.lds + LDS_T2E); for (int mt = ts[tid]; mt < ts[tid + 1]; ++mt) t2e[mt] = tid; }
    __syncthreads();
}

template <int NR>
__device__ __forceinline__ void norm1_rows(KArgs A, const LAS int* ts, const LAS float* mv, const int l, const int lane_, const int (&rows)[NR]) {
    int lane = lane_; asm volatile("" : "+v"(lane));
    const bool fin = (l == DEPTH);
    bf16_t* XR = WSP(bf16_t, WS_XR);
    f32x4 v[NR][4];
    int bi[NR];
#pragma unroll
    for (int q = 0; q < NR; ++q) bi[q] = (rows[q] < NLAT) ? (rows[q] / SEQ) : 4;
    if (l == 0) {
#pragma unroll
        for (int q = 0; q < NR; ++q) { const int r = rows[q]; const float* src = (r < NLAT) ? (FIN(0) + (size_t)r * D) : (FIN(2) + (size_t)(r - NLAT) * D);
#pragma unroll
            for (int j = 0; j < 4; ++j) v[q][j] = *(const f32x4*)(src + 4 * lane + 256 * j); }
    } else {
        int inf[NR][4]; float wk[NR][4];
#pragma unroll
        for (int q = 0; q < NR; ++q) { const v4i t4 = *(const v4i*)(WSP(int, WS_TOKINFO) + (size_t)rows[q] * 4); const f32x4 w4 = *(const f32x4*)(WSP(float, WS_TOKW) + (size_t)rows[q] * 4);
#pragma unroll
            for (int k = 0; k < 4; ++k) { inf[q][k] = t4[k]; wk[q][k] = w4[k]; } }
        unsigned ew[NR][4][4];
#pragma unroll
        for (int q = 0; q < NR; ++q) {
#pragma unroll
            for (int j = 0; j < 4; ++j) v[q][j] = bf4_to_f32(*(const u32x2*)(XR + (size_t)rows[q] * D + 4 * lane + 256 * j));
#pragma unroll
            for (int k = 0; k < 4; ++k) { const int e = (inf[q][k] >> 24) & 31, rank = inf[q][k] & 0xffffff; const unsigned char* eo = WSP(unsigned char, WS_EO) + ((size_t)ts[e] * 256 + rank) * D;
#pragma unroll
                for (int j = 0; j < 4; ++j) ew[q][k][j] = *(const unsigned*)(eo + 4 * lane + 256 * j); } }
#pragma unroll
        for (int q = 0; q < NR; ++q) {
            f32x4 a[4];
#pragma unroll
            for (int j = 0; j < 4; ++j) a[j] = (f32x4){0.f, 0.f, 0.f, 0.f};
#pragma unroll
            for (int k = 0; k < 4; ++k) { const float w1 = wk[q][k] * (1.0f / FP8_SE);
#pragma unroll
                for (int j = 0; j < 4; ++j) { const int w = (int)ew[q][k][j];
                    const f32x2 lo = __builtin_amdgcn_cvt_pk_f32_fp8(w, false), hi = __builtin_amdgcn_cvt_pk_f32_fp8(w, true);
                    a[j].x += w1 * lo.x; a[j].y += w1 * lo.y; a[j].z += w1 * hi.x; a[j].w += w1 * hi.y; } }
            const LAS float* m5 = mv + bi[q] * D + 4 * lane;
#pragma unroll
            for (int j = 0; j < 4; ++j) { const f32x4 g5 = *(const LAS f32x4*)(m5 + 256 * j); v[q][j] = v[q][j] + g5 * a[j]; }
        }
    }
    float ss[NR];
#pragma unroll
    for (int q = 0; q < NR; ++q) {
        if (!fin) {
#pragma unroll
            for (int j = 0; j < 4; ++j) *(u32x2*)(XR + (size_t)rows[q] * D + 4 * lane + 256 * j) = f32_to_bf4(v[q][j]);
        }
        ss[q] = 0.f;
#pragma unroll
        for (int j = 0; j < 4; ++j) ss[q] += (v[q][j].x * v[q][j].x + v[q][j].y * v[q][j].y) + (v[q][j].z * v[q][j].z + v[q][j].w * v[q][j].w);
    }
#pragma unroll
    for (int o = 1; o < 64; o <<= 1) {
#pragma unroll
        for (int q = 0; q < NR; ++q) ss[q] += __builtin_bit_cast(float, __builtin_amdgcn_ds_bpermute((lane ^ o) << 2, __builtin_bit_cast(int, ss[q]))); }
#pragma unroll
    for (int q = 0; q < NR; ++q) {
        const int r = rows[q];
        const float rinv = 1.0f / sqrtf(ss[q] * (1.0f / D) + RMS_EPS);
        if (fin) {
            float pscale = 1.0f;
#if PROBE_SEL >= 0
            { const unsigned* st = (const unsigned*)A->ws + CW_STAT; const float n = fmaxf((float)st[3], 1.0f);
              float val = (PROBE_SEL == 0) ? (float)st[0] / n * 5e-4f : (PROBE_SEL == 4) ? (float)st[0] / n * 4e-4f : (PROBE_SEL == 1) ? (float)st[1] / n * 1e-2f : (PROBE_SEL == 2) ? (float)st[2] / n * 1e-2f : (float)st[3];
              val = fminf(fmaxf(rintf(val), 0.0f), 300.0f); pscale = 1.0f + sqrtf(val * 1e-3f); }
#endif
#pragma unroll
            for (int j = 0; j < 4; ++j) { const f32x4 g = *(const LAS f32x4*)(mv + 5 * D + 4 * lane + 256 * j); *(f32x4*)(A->out + (size_t)r * D + 4 * lane + 256 * j) = v[q][j] * rinv * g * pscale; }
        } else {
            const LAS float* ga = mv + (5 + bi[q]) * D;
            unsigned char* hrow = WSP(unsigned char, WS_H8) + (size_t)r * P8;
#pragma unroll
            for (int j = 0; j < 4; ++j) { const int c = 4 * lane + 256 * j; const f32x4 g = *(const LAS f32x4*)(ga + c), sh = *(const LAS f32x4*)(ga + 5 * D + c);
                const f32x4 h = v[q][j] * rinv * g + sh;
                *(unsigned*)(hrow + c) = pk4_fp8(h.x * FP8_SH, h.y * FP8_SH, h.z * FP8_SH, h.w * FP8_SH); }
        }
    }
}
__device__ __forceinline__ void phase_norm1(KArgs A, Frame& F, int l, const float dsc = 1.0f) {
    PH_LOCALS;
    const int nrows = (l == DEPTH) ? NLAT : TT;
    if (l > 0) build_tstart(A, F, l - 1);
    const LAS int* ts = (const LAS int*)(F.lds + LDS_MISC + 64);
    LAS float* mv = (LAS float*)F.lds;
    {   const float* MOD = WSP(float, WS_MOD);
        for (int i = tid; i < 5 * D; i += NTHREADS) { const int b = i >> 10, c = i & (D - 1);
            mv[i] = (l > 0) ? MOD[((size_t)(l - 1) * 5 + b) * 6144 + 5 * D + c] * dsc : 0.f;
            if (l < DEPTH) { const float* m0 = MOD + ((size_t)l * 5 + b) * 6144; mv[5 * D + i] = FIN(6)[(size_t)l * D + c] * (m0[D + c] + 1.0f); mv[10 * D + i] = m0[c]; }
            else mv[5 * D + i] = FIN(28)[c]; }
        __syncthreads(); }
    const int gw = F.bid * NWAVES + wave, NGW = F.G * NWAVES;
    int r = gw;
    for (; r + NGW < nrows; r += 2 * NGW) { const int rows[2] = {r, r + NGW}; norm1_rows<2>(A, ts, mv, l, lane, rows); }
    for (; r < nrows; r += NGW) { const int rows[1] = {r}; norm1_rows<1>(A, ts, mv, l, lane, rows); }
}

__device__ __forceinline__ void phase_router(KArgs A, Frame& F, int l, const bool dry = false) {
    PH_LOCALS;
    const int nrows = (l == DEPTH - 1) ? NLAT : TT;
    LAS bf16_t* tile = (LAS bf16_t*)F.lds;
    LAS float* part = (LAS float*)(F.lds + 32 * 1032 * 2);
    LAS float* logit = part + 8 * 32 * 33;
    LAS int* lcnt = (LAS int*)(logit + 32 * 33);
    const float* MOD = WSP(float, WS_MOD);
    bf16_t* XR = WSP(bf16_t, WS_XR);
    const bf16_t* WRT = WSP(bf16_t, WS_WRT) + (size_t)l * NEXP * D;
    int* cnt = (int*)A->ws + CW_CNT + l * 32 + (dry ? 128 : 0);
    int* elist = dry ? (int*)WSP(float, WS_ELW) : WSP(int, WS_ELIST);
    const float dsc = dry ? 0.0f : 1.0f;
    LAS float* rv = (LAS float*)(F.lds + 104448);
    const int nunits = nrows / 32; const bool contig = (F.G == 256);
    int cur_b = -1;
    bf16x8 bw[8];
#pragma unroll
    for (int s = 0; s < 8; ++s) bw[s] = *(const bf16x8*)(WRT + (size_t)(lane & 31) * D + wave * 128 + 16 * s + 8 * (lane >> 5));
    for (int k = 0;; ++k) {
        int u;
        if (contig) { if (k < 4) u = 4 * F.bid + k; else if (k == 4 && F.bid < 32 && nunits > 1024) u = 1024 + F.bid; else break; }
        else { u = F.bid + k * F.G; if (u >= nunits) break; }
        const int r0 = u * 32;
        const int bi = (r0 < NLAT) ? (r0 / SEQ) : 4;
        if (bi != cur_b) {
            const float* m2 = MOD + ((size_t)l * 5 + bi) * 6144 + 2 * D; const float* gm = FIN(21) + (size_t)l * D;
            for (int i = tid; i < D; i += NTHREADS) { rv[D + i] = gm[i] * (m2[2 * D + i] + 1.0f); rv[2 * D + i] = m2[D + i]; }
            __syncthreads(); cur_b = bi; }
        {
            const int rb = r0 + wave * 4;
            f32x4 v[4][4];
#pragma unroll
            for (int q = 0; q < 4; ++q)
#pragma unroll
                for (int j = 0; j < 4; ++j) { const int c = 4 * lane + 256 * j; v[q][j] = bf4_to_f32(*(const u32x2*)(XR + (size_t)(rb + q) * D + c)); }
            float ss[4];
#pragma unroll
            for (int q = 0; q < 4; ++q) { ss[q] = 0.f;
#pragma unroll
                for (int j = 0; j < 4; ++j) {
                    ss[q] += (v[q][j].x * v[q][j].x + v[q][j].y * v[q][j].y) + (v[q][j].z * v[q][j].z + v[q][j].w * v[q][j].w); } }
#pragma unroll
            for (int o = 1; o < 64; o <<= 1) {
#pragma unroll
                for (int q = 0; q < 4; ++q) ss[q] += __builtin_bit_cast(float, __builtin_amdgcn_ds_bpermute((lane ^ o) << 2, __builtin_bit_cast(int, ss[q]))); }
#pragma unroll
            for (int q = 0; q < 4; ++q) { const float rinv = 1.0f / sqrtf(ss[q] * (1.0f / D) + RMS_EPS);
                unsigned char* hrow = WSP(unsigned char, WS_H8) + (size_t)(rb + q) * P8;
#pragma unroll
                for (int j = 0; j < 4; ++j) { const int c = 4 * lane + 256 * j; const f32x4 g = *(const LAS f32x4*)(rv + D + c), sh = *(const LAS f32x4*)(rv + 2 * D + c);
                    const f32x4 h = v[q][j] * rinv * g + sh;
                    u32x2 o; o.x = pk2(h.x, h.y); o.y = pk2(h.z, h.w); *(LAS u32x2*)(tile + (wave * 4 + q) * 1032 + c) = o;
                    *(unsigned*)(hrow + c) = pk4_fp8(h.x * FP8_SH, h.y * FP8_SH, h.z * FP8_SH, h.w * FP8_SH); } }
        }
        if (tid < 32) lcnt[tid] = 0;
        __syncthreads();
        {
            f32x16 acc;
#pragma unroll
            for (int i = 0; i < 16; ++i) acc[i] = 0.f;
            const int rr = lane & 31, hh = lane >> 5;
#pragma unroll
            for (int s = 0; s < 8; ++s) { const bf16x8 a = *(const LAS bf16x8*)(tile + rr * 1032 + wave * 128 + 16 * s + 8 * hh);
                acc = __builtin_amdgcn_mfma_f32_32x32x16_bf16(a, bw[s], acc, 0, 0, 0); }
#pragma unroll
            for (int i = 0; i < 16; ++i) { const int tok = (i & 3) + 8 * (i >> 2) + 4 * hh; part[(wave * 32 + tok) * 33 + rr] = acc[i]; }
        }
        __syncthreads();
        for (int i = tid; i < 1024; i += NTHREADS) { const int tok = i >> 5, e = i & 31; float s = FIN(23)[l * 32 + e];
#pragma unroll
            for (int w = 0; w < 8; ++w) s += part[(w * 32 + tok) * 33 + e];
            logit[tok * 33 + e] = s; }
        __syncthreads();
        if (wave == 0) {
            const int t = lane & 31, r = r0 + t; const bool act = lane < 32;
            float lg[32];
#pragma unroll
            for (int e = 0; e < 32; ++e) lg[e] = logit[t * 33 + e];
            float lv[4]; int le[4];
#pragma unroll
            for (int k = 0; k < 4; ++k) { float best = -3.0e38f; int be = 0;
#pragma unroll
                for (int e = 0; e < 32; ++e) { const bool gt = lg[e] > best; best = gt ? lg[e] : best; be = gt ? e : be; }
#pragma unroll
                for (int e = 0; e < 32; ++e) lg[e] = (e == be) ? -3.0e38f : lg[e];
                lv[k] = best; le[k] = be; }
            const float e1 = __expf(lv[1] - lv[0]), e2 = __expf(lv[2] - lv[0]), e3 = __expf(lv[3] - lv[0]); const float inv = 1.0f / (1.0f + e1 + e2 + e3);
            const float wk[4] = {inv, e1 * inv, e2 * inv, e3 * inv};
            int lr[4];
#pragma unroll
            for (int k = 0; k < 4; ++k) lr[k] = act ? __hip_atomic_fetch_add(lcnt + le[k], 1, __ATOMIC_RELAXED, __HIP_MEMORY_SCOPE_WORKGROUP) : 0;
            asm volatile("s_waitcnt lgkmcnt(0)" ::: "memory");
            if (act) { const int c = lcnt[t]; const int base = c ? atomicAdd(&cnt[t], c) : 0; lcnt[32 + t] = base; }
            asm volatile("s_waitcnt vmcnt(0) lgkmcnt(0)" ::: "memory");
            if (act) {
                int* ti = WSP(int, WS_TOKINFO) + (size_t)r * 4;
#pragma unroll
                for (int k = 0; k < 4; ++k) { const int rank = lcnt[32 + le[k]] + lr[k];
                    elist[(size_t)le[k] * TT + rank] = r; if (!dry) { WSP(float, WS_TOKW)[(size_t)r * 4 + k] = wk[k]; ti[k] = (le[k] << 24) | rank; } }
            }
        }
    }
    __syncthreads();
}

__device__ __forceinline__ void phase_s5scan(KArgs A, Frame& F, int l) {
    PH_LOCALS;
    const int gw = F.bid * NWAVES + wave, NGW = F.G * NWAVES;
    const float* SL = WSP(float, WS_SLOC);
    for (int it = gw; it < NBATCH * 16 * 2; it += NGW) {
        const int dir = it & 1, g = (it >> 1) & 15, b = it >> 5;
        const int ldg = (l * 2 + dir) * 16 + g;
        const f32x2 L64 = WSP(f32x2, WS_LP)[((size_t)ldg * 65 + 64) * 64 + lane];
        bf16_t* sux = WSP(bf16_t, WS_SUX) + (size_t)g * MCH * SUXW;
        float xr = 0.f, xi = 0.f;
#pragma unroll 4
        for (int step = 0; step < 132; ++step) {
            int ch;
            if (step < 4) ch = 512 + 4 * b + (dir ? 3 - step : step);
            else ch = 128 * b + (dir ? 127 - (step - 4) : (step - 4));
            const float sr = SL[(size_t)ch * 4096 + g * 256 + dir * 128 + lane], si = SL[(size_t)ch * 4096 + g * 256 + dir * 128 + 64 + lane];
            bf16_t* o = sux + (size_t)ch * SUXW + 1024 + dir * 128;
            o[lane] = (unsigned short)f2bf(xr); o[64 + lane] = (unsigned short)f2bf(xi);
            const float nr = L64.x * xr - L64.y * xi + sr, ni = L64.x * xi + L64.y * xr + si;
            xr = nr; xi = ni;
        }
    }
}

constexpr float LOG2E = 1.4426950408889634f;
__device__ __forceinline__ float xhalf_max(float x) { const unsigned xu = __builtin_bit_cast(unsigned, x); const auto r = __builtin_amdgcn_permlane32_swap(xu, xu, false, false);
    const unsigned a = r[0], b = r[1]; return fmaxf(__builtin_bit_cast(float, a), __builtin_bit_cast(float, b)); }
__device__ __forceinline__ float xhalf_sum(float x) { const unsigned xu = __builtin_bit_cast(unsigned, x); const auto r = __builtin_amdgcn_permlane32_swap(xu, xu, false, false);
    const unsigned a = r[0], b = r[1]; return __builtin_bit_cast(float, a) + __builtin_bit_cast(float, b); }
constexpr int AT_STEP = 32768;
constexpr int AT_RPB = LDS_ROPE;
__device__ __forceinline__ void attn_stage(const bf16_t* P, const bf16_t* VT, LAS unsigned char* lds, int slot, int ktok0, int kcol, int vrow, int lane, int wave) {
    LAS unsigned char* base = lds + slot * AT_STEP + wave * 1024;
#pragma unroll
    for (int j = 0; j < 2; ++j) {
        const int dc = 4 * j + (wave >> 1), key = (wave & 1) * 64 + lane;
        __builtin_amdgcn_global_load_lds((const unsigned*)(P + (size_t)(ktok0 + key) * PW + kcol + 8 * dc), (LAS unsigned*)(base + j * 8192), 16, 0, 0);
    }
#pragma unroll
    for (int j = 0; j < 2; ++j) {
        const int q = 8 * j + wave;
        __builtin_amdgcn_global_load_lds((const unsigned*)(VT + (size_t)(vrow + lane) * TT + ktok0 + 8 * q), (LAS unsigned*)(base + 16384 + j * 8192), 16, 0, 0);
    }
}
__device__ __forceinline__ void attn_tile(const int mm, const LAS unsigned char* kt_, const LAS unsigned char* vt_, const bf16x8 (&qf)[4], f32x16& O0, f32x16& O1, f32x16& negm, float& lsum,
                                          const LAS float* bptr, unsigned vmask, int dbase) {
    bf16x8 kf[4];
#pragma unroll
    for (int q = 0; q < 4; ++q) kf[q] = *(const LAS bf16x8*)(kt_ + q * 2048);
    bf16x8 vf[2][2];
#pragma unroll
    for (int mt = 0; mt < 2; ++mt)
#pragma unroll
        for (int s2 = 0; s2 < 2; ++s2) vf[mt][s2] = *(const LAS bf16x8*)(vt_ + s2 * 1024 + mt * 512);
    f32x16 sa = __builtin_amdgcn_mfma_f32_32x32x16_bf16(kf[0], qf[0], negm, 0, 0, 0);
#pragma unroll
    for (int q = 1; q < 4; ++q) sa = __builtin_amdgcn_mfma_f32_32x32x16_bf16(kf[q], qf[q], sa, 0, 0, 0);
    float sv[16];
#pragma unroll
    for (int i = 0; i < 16; ++i) sv[i] = sa[i];
    if (mm == 1) {
#pragma unroll
        for (int i = 0; i < 16; ++i) { const float x = sv[i] + bptr[(i & 3) + 8 * (i >> 2)]; sv[i] = ((vmask >> i) & 1u) ? x : -3.0e38f; }
    } else if (mm == 2) {
#pragma unroll
        for (int i = 0; i < 16; ++i) { const int dpos = dbase - ((i & 3) + 8 * (i >> 2)); sv[i] = (dpos <= 128 && dpos >= -128) ? sv[i] : -3.0e38f; }
    }
    float tmax = fmaxf(fmaxf(fmaxf(sv[0], sv[1]), fmaxf(sv[2], sv[3])), fmaxf(fmaxf(sv[4], sv[5]), fmaxf(sv[6], sv[7])));
    tmax = fmaxf(tmax, fmaxf(fmaxf(fmaxf(sv[8], sv[9]), fmaxf(sv[10], sv[11])), fmaxf(fmaxf(sv[12], sv[13]), fmaxf(sv[14], sv[15]))));
    tmax = xhalf_max(tmax);
    if (__any(tmax > 8.0f)) {
        const float d = (tmax > 8.0f) ? tmax : 0.f; const float alpha = fast_exp2(-d);
        lsum *= alpha;
#pragma unroll
        for (int i = 0; i < 16; ++i) { O0[i] *= alpha; O1[i] *= alpha; sv[i] -= d; negm[i] -= d; }
    }
    float psum = 0.f;
#pragma unroll
    for (int i = 0; i < 16; ++i) { const float p = fast_exp2(sv[i]); psum += p; sv[i] = p; }
    lsum += xhalf_sum(psum);
#pragma unroll
    for (int s2 = 0; s2 < 2; ++s2) {
        u32x4 pw; pw.x = cvt_pk_bf16(sv[8 * s2 + 0], sv[8 * s2 + 1]); pw.y = cvt_pk_bf16(sv[8 * s2 + 2], sv[8 * s2 + 3]); pw.z = cvt_pk_bf16(sv[8 * s2 + 4], sv[8 * s2 + 5]); pw.w = cvt_pk_bf16(sv[8 * s2 + 6], sv[8 * s2 + 7]);
        const bf16x8 pf = __builtin_bit_cast(bf16x8, pw);
        O0 = __builtin_amdgcn_mfma_f32_32x32x16_bf16(vf[0][s2], pf, O0, 0, 0, 0);
        O1 = __builtin_amdgcn_mfma_f32_32x32x16_bf16(vf[1][s2], pf, O1, 0, 0, 0);
    }
}
__device__ __forceinline__ void phase_attn(KArgs A, Frame& F, int l, const int part) {
    PH_LOCALS;
    LAS unsigned char* lds = F.lds;
    LAS float* rpb = (LAS float*)(lds + AT_RPB);
    for (int i = tid; i < 6 * 465; i += NTHREADS) rpb[i] = FIN(9)[(size_t)l * 6 * 465 + i] * LOG2E;
    __syncthreads();
    const bf16_t* P = WSP(bf16_t, WS_P); const bf16_t* VT = WSP(bf16_t, WS_VT);
    const int r = lane & 31, hh = lane >> 5;
    const int ngroups = 1536 + ((l < DEPTH - 1) ? 48 : 0);
    const bool std_grid = (F.G == 256);
    for (int k = 0;; ++k) {
        int gi;
        if (!std_grid) { gi = F.bid + k * F.G; if (part == 1 || gi >= ngroups) { if (part == 1) break; if (gi >= ngroups) break; } }
        else if (part == 0) {
            const int c = F.bid;
            if (c < 16) { if (k < 2) gi = 256 * k + c; else if (k < 5) gi = 768 + 576 + c + 16 * (k - 2); else break; }
            else if (c < 48) { if (k < 3) gi = 256 * k + c; else if (k < 6) gi = 768 + 624 + (c - 16) + 32 * (k - 3); else break; }
            else if (c < 64) { if (k < 3) gi = 256 * k + c; else if (k == 3) gi = 512 + (c - 48); else if (k < 7) gi = 768 + 720 + (c - 48) + 16 * (k - 4); else break; }
            else { if (k < 2) gi = 256 * k + c; else if (k == 2) gi = 768 + (c - 64); else break; } }
        else {
            const int c = F.bid;
            if (c < 64) break;
            if (k == 0) gi = 512 + c;
            else if (k < 3) gi = 768 + (c - 64) + 192 * k;
            else if (k == 3 && c >= 196 && c < 244 && ngroups > 1536) gi = 1536 + (c - 196);
            else break; }
        int mode, b, head, r0 = 0, qt0 = 0;
        if (gi < 768) { mode = 0; r0 = 4 * (gi & 31); const int bh = gi >> 5; head = bh % 6; b = bh / 6; }
        else if (gi < 1536) { mode = 1; const int g2 = gi - 768; qt0 = 8 * (g2 & 31); const int bh = g2 >> 5; head = bh % 6; b = bh / 6; }
        else { const int g2 = gi - 1536; mode = 2 + g2 / 24; const int bh = g2 % 24; head = bh % 6; b = bh / 6; }
        const bool na = (mode == 0 || mode == 2);
        const int qcol = na ? 64 * head : 768 + 64 * head, kcol = na ? 384 + 64 * head : 1152 + 64 * (head / 3);
        const int vrow = na ? 64 * head : 384 + 64 * (head / 3), ycol = na ? 64 * head : 640 + 64 * head;
        int qtok0, qrow = 0, mh = 0, qt = 0;
        if (mode == 0) { qrow = r0 + (wave >> 1); mh = wave & 1; qtok0 = b * SEQ + qrow * 64 + 32 * mh; }
        else if (mode == 1) { qt = qt0 + wave; qtok0 = b * SEQ + 32 * qt; }
        else qtok0 = NLAT + b * CTXL + 32 * wave;
        const int rsw = min(max(qrow - 4, 0), 120);
        const int qc = 32 * mh + r, wsn = min(max(qc - 8, 0), 48);
        const int qpos = 32 * qt + r;
        unsigned vmask0 = 0u, vmask1 = 0u;
#pragma unroll
        for (int i = 0; i < 16; ++i) { const int ki = (i & 3) + 8 * (i >> 2) + 4 * hh; vmask0 |= ((ki >= wsn && ki < wsn + 16) ? 1u : 0u) << i; vmask1 |= ((32 + ki >= wsn && 32 + ki < wsn + 16) ? 1u : 0u) << i; }
        int nlat = 0, kbase = 0, kofs = 0;
        if (mode == 0) { const int kra = min(max(r0 - 4, 0), 120), krb = min(max(r0 - 1, 0), 120) + 7; kbase = kra >> 1; kofs = (kra & 1) * 64; nlat = (krb - kra + 2) >> 1; }
        else if (mode == 1) { const int ks0 = max(qt0 - 4, 0) >> 2, ks1 = min(qt0 + 11, 255) >> 2; kbase = ks0; nlat = ks1 - ks0 + 1; }
        const int nsteps = nlat + 2;
        const int lat0 = b * SEQ + 128 * kbase + kofs, ctx0 = NLAT + b * CTXL;
        float lsum = na ? 0.f : fast_exp2(FIN(20)[l * 6 + head] * LOG2E);
        f32x16 negm;
#pragma unroll
        for (int i = 0; i < 16; ++i) negm[i] = 0.f;
        bf16x8 qf[4];
#pragma unroll
        for (int s = 0; s < 4; ++s) qf[s] = *(const bf16x8*)(P + (size_t)(qtok0 + r) * PW + qcol + 32 * hh + 8 * s);
        f32x16 O0, O1;
#pragma unroll
        for (int i = 0; i < 16; ++i) { O0[i] = 0.f; O1[i] = 0.f; }
        __builtin_amdgcn_s_barrier();
        attn_stage(P, VT, lds, 2, ctx0, kcol, vrow, lane, wave);
        attn_stage(P, VT, lds, 3, ctx0 + 128, kcol, vrow, lane, wave);
        if (nlat > 0) attn_stage(P, VT, lds, 0, lat0, kcol, vrow, lane, wave);
        else { asm volatile("s_waitcnt vmcnt(0)" ::: "memory"); __builtin_amdgcn_s_barrier(); }
        int cdone = 0;
        for (int s = 0; s < nlat || cdone < 8; ++s) {
            const bool lat = (s < nlat);
            if (lat) {
                asm volatile("s_waitcnt vmcnt(0)" ::: "memory");
                __builtin_amdgcn_s_barrier();
                if (s + 1 < nlat) attn_stage(P, VT, lds, (s + 1) & 1, lat0 + 128 * (s + 1), kcol, vrow, lane, wave);
            }
            int tl = 0;
#pragma unroll 1
            for (int it = 0; it < 4; ++it) {
                int kr = 0, ct = 0, kt = 0, dt = 0; bool have = false;
                if (lat) {
                    for (; tl < 4; ++tl) {
                        kr = 2 * (kbase + s) + (kofs >> 6) + (tl >> 1); ct = tl & 1; kt = 4 * (kbase + s) + tl; dt = kt - qt; dt = dt < 0 ? -dt : dt;
                        if (mode == 0 ? (kr >= rsw && kr <= rsw + 7) : (dt <= 4)) { have = true; break; }
                    }
                }
                int slot, tt, mm;
                if (have) { slot = s & 1; tt = tl; mm = (mode == 1 && dt < 4) ? 0 : (mode == 0 ? 1 : 2); ++tl; }
                else if (cdone < 8) { slot = 2 + (cdone >> 2); tt = cdone & 3; mm = 0; ++cdone; }
                else break;
                const LAS unsigned char* kb = lds + slot * AT_STEP; const LAS unsigned char* vb = kb + 16384;
                const LAS unsigned char* kt_ = kb + ((4 * hh) * 128 + 32 * tt + r) * 16;
                const LAS unsigned char* vt_ = vb + ((tt * 4 + hh * 2) * 64 + r) * 16;
                attn_tile(mm, kt_, vt_, qf, O0, O1, negm, lsum, rpb + head * 465 + (kr - qrow + 7) * 31 + (32 * ct + 4 * hh - qc + 15), ct ? vmask1 : vmask0, qpos - 32 * kt - 4 * hh);
            }
        }
        const float inv = FP8_SY / lsum;
        unsigned char* yrow = WSP(unsigned char, WS_Y) + (size_t)(qtok0 + r) * P8 + ycol + 4 * hh;
#pragma unroll
        for (int rg = 0; rg < 4; ++rg) {
            *(unsigned*)(yrow + 8 * rg) = pk4_fp8(O0[4 * rg + 0] * inv, O0[4 * rg + 1] * inv, O0[4 * rg + 2] * inv, O0[4 * rg + 3] * inv);
            *(unsigned*)(yrow + 32 + 8 * rg) = pk4_fp8(O1[4 * rg + 0] * inv, O1[4 * rg + 1] * inv, O1[4 * rg + 2] * inv, O1[4 * rg + 3] * inv);
        }
    }
    asm volatile("s_waitcnt vmcnt(0)" ::: "memory");
    __builtin_amdgcn_s_barrier();
}

__device__ __forceinline__ int xcd_unit(int i, int G, int c, int U) {
    if ((G & 7) != 0) { const int idx = i * G + c; return idx < U ? idx : -1; }
    const int x = c & 7, j = c >> 3, per = G >> 3, q = U >> 3, r = U & 7;
    const int start = x * q + (x < r ? x : r), size = q + (x < r ? 1 : 0);
    const int loc = i * per + j;
    return loc < size ? start + loc : -1;
}
__device__ __forceinline__ int xcd_max_units(int G, int U) {
    if ((G & 7) != 0) return (U + G - 1) / G;
    const int per = G >> 3; return ((U + 7) / 8 + per - 1) / per;
}
#define ACC8(ai, bj, m) const f32x4 a0_ = acc[ai][bj][m][0], a1_ = acc[ai][bj][m][1]; float v[8] = {a0_[0], a0_[1], a0_[2], a0_[3], a1_[0], a1_[1], a1_[2], a1_[3]}

struct SchedInproj { int G, c; const char* H; const char* W; unsigned* stat = nullptr;
    __device__ __forceinline__ bool next(int i, GUnit& u) const {
        const int idx = xcd_unit(i, G, c, 1056); if (idx < 0) return false;
        if (idx < 792) { const int pm = idx / 6, pn = idx % 6; u.A = H + (size_t)pm * 256 * P8; u.B = W + (size_t)pn * 256 * P8; u.p0 = 0; u.p1 = pm; u.p2 = pn; u.p3 = 0; }
        else { const int j = idx - 792, vm = j / 132, tn = j % 132; u.A = W + (size_t)(1536 + 256 * vm) * P8; u.B = H + (size_t)tn * 256 * P8; u.p0 = 1; u.p1 = vm; u.p2 = tn; u.p3 = 0; }
        return true; }
    __device__ __forceinline__ int row_token(const GUnit&, int) const { return 0; }
    __device__ __forceinline__ size_t kstepA() const { return 128; }
    __device__ __forceinline__ unsigned voffA(int h, int R, int cb, unsigned lda2) const { return (unsigned)(h * 128 + R) * lda2 + (unsigned)cb; }
    __device__ __forceinline__ int row_token_lds(const GUnit&, int, int) const { return 0; }
    __device__ __forceinline__ void pre(const GUnit&, int, int, int) const {}
};
struct EpiInproj { bf16_t* P; bf16_t* VT; bf16_t* SUX; const LAS float* ROPE;
    __device__ __forceinline__ void operator()(const AccT& acc, const GUnit& u, int slot, int wr, int wc, int fr, int fq) const {
        if (u.p0 == 1) {
#pragma unroll
            for (int ai = 0; ai < 2; ++ai)
#pragma unroll
                for (int m = 0; m < 4; ++m) { const int row = u.p1 * 256 + 128 * ai + 64 * wr + 16 * m + fr;
#pragma unroll
                    for (int bj = 0; bj < 2; ++bj) { ACC8(ai, bj, m);
#pragma unroll
                        for (int e = 0; e < 8; ++e) v[e] *= (1.0f / (FP8_SH * FP8_SW));
                        const u32x4 w = pack8(v);
                        bf16_t* vp = VT + (size_t)row * TT + u.p2 * 256 + 128 * bj + 32 * wc + 8 * (fq >> 1) + 4 * (fq & 1);
                        *(u32x2*)vp = (u32x2){w.x, w.y}; *(u32x2*)(vp + 16) = (u32x2){w.z, w.w}; } }
            return;
        }
        const int pm = u.p1, pn = u.p2;
#pragma unroll
        for (int bj = 0; bj < 2; ++bj) {
            const int hh = 2 * pn + bj;
            const bool rope = (hh >= 6 && hh < 10 && pm < 128), scale = (hh < 3 || (hh >= 6 && hh < 9));
            if (hh >= 10) half<4>(acc, bj, pm, hh, wr, wc, fr, fq);
            else if (rope && scale) half<3>(acc, bj, pm, hh, wr, wc, fr, fq);
            else if (rope) half<2>(acc, bj, pm, hh, wr, wc, fr, fq);
            else if (scale) half<1>(acc, bj, pm, hh, wr, wc, fr, fq);
            else half<0>(acc, bj, pm, hh, wr, wc, fr, fq);
        }
    }
    template <int KIND>
    __device__ __forceinline__ void half(const AccT& acc, const int bj, const int pm, const int hh, const int wr, const int wc, const int fr, const int fq) const {
        const bool lo32 = fq < 2;
#pragma unroll
        for (int ai = 0; ai < 2; ++ai)
#pragma unroll
            for (int m = 0; m < 4; ++m) {
                const int row = pm * 256 + 128 * ai + 64 * wr + 16 * m + fr;
                const f32x4 a0_ = bj ? acc[ai][1][m][0] : acc[ai][0][m][0], a1_ = bj ? acc[ai][1][m][1] : acc[ai][0][m][1];
                float v[8] = {a0_[0], a0_[1], a0_[2], a0_[3], a1_[0], a1_[1], a1_[2], a1_[3]};
#pragma unroll
                for (int e = 0; e < 8; ++e) v[e] *= (1.0f / (FP8_SH * FP8_SW));
                if (KIND == 4) {
                    const int g = 8 * (hh - 10) + 2 * wc + (fq >> 1);
                    *(u32x4*)(SUX + ((size_t)g * MCH + (row >> 6)) * SUXW + (row & 63) * 16 + 8 * (fq & 1)) = pack8(v);
                } else {
                    if (KIND == 2 || KIND == 3) {
                        const int t = row & (SEQ - 1); const int pos = (wc & 1) ? (t & 63) : (t >> 6);
                        const LAS float* cs = ROPE + pos * 16 + 8 * (fq & 1);
                        const f32x4 c0 = *(const LAS f32x4*)cs, c1 = *(const LAS f32x4*)(cs + 4), s0 = *(const LAS f32x4*)(cs + 2048), s1 = *(const LAS f32x4*)(cs + 2052);
                        const float sg = lo32 ? -1.0f : 1.0f;
                        const float cc[8] = {c0[0], c0[1], c0[2], c0[3], c1[0], c1[1], c1[2], c1[3]}, sn[8] = {s0[0] * sg, s0[1] * sg, s0[2] * sg, s0[3] * sg, s1[0] * sg, s1[1] * sg, s1[2] * sg, s1[3] * sg};
#pragma unroll
                        for (int e = 0; e < 8; ++e) { const unsigned xu = __builtin_bit_cast(unsigned, v[e]); const auto sw = __builtin_amdgcn_permlane32_swap(xu, xu, false, false); const unsigned lo_ = sw[0], hi_ = sw[1];
                            const unsigned pu = lo32 ? hi_ : lo_; v[e] = v[e] * cc[e] + __builtin_bit_cast(float, pu) * sn[e]; }
                    }
                    if (KIND == 1 || KIND == 3) {
#pragma unroll
                        for (int e = 0; e < 8; ++e) v[e] *= (0.125f * LOG2E_); }
                    *(u32x4*)(P + (size_t)row * PW + 128 * hh + 32 * wc + 8 * fq) = pack8(v);
                }
            }
    }
};
struct SchedS5a { int G, c; const char* SUX; const char* W; unsigned* stat = nullptr;
    __device__ __forceinline__ bool next(int i, GUnit& u) const {
        const int idx = xcd_unit(i, G, c, 48); if (idx < 0) return false;
        const int g = idx / 3, pm = idx % 3; u.A = SUX + ((size_t)g * MCH + pm * 256) * (SUXW * 2); u.B = W + (size_t)g * 256 * 2048; u.p0 = 0; u.p1 = pm; u.p2 = g; u.p3 = 0; return true; }
    __device__ __forceinline__ int row_token(const GUnit&, int) const { return 0; }
    __device__ __forceinline__ size_t kstepA() const { return 128; }
    __device__ __forceinline__ unsigned voffA(int h, int R, int cb, unsigned lda2) const { return (unsigned)(h * 128 + R) * lda2 + (unsigned)cb; }
    __device__ __forceinline__ int row_token_lds(const GUnit&, int, int) const { return 0; }
    __device__ __forceinline__ void pre(const GUnit&, int, int, int) const {}
};
struct EpiS5a { float* SL;
    __device__ __forceinline__ void operator()(const AccT& acc, const GUnit& u, int slot, int wr, int wc, int fr, int fq) const {
#pragma unroll
        for (int ai = 0; ai < 2; ++ai)
#pragma unroll
            for (int m = 0; m < 4; ++m) { float* rowp = SL + (size_t)(u.p1 * 256 + 128 * ai + 64 * wr + 16 * m + fr) * 4096 + u.p2 * 256 + 32 * wc + 8 * fq;
#pragma unroll
                for (int bj = 0; bj < 2; ++bj) { *(f32x4*)(rowp + 128 * bj) = acc[ai][bj][m][0]; *(f32x4*)(rowp + 128 * bj + 4) = acc[ai][bj][m][1]; } }
    }
};
struct SchedS5c { int G, c; const char* SUX; const char* KC; unsigned* stat = nullptr;
    __device__ __forceinline__ bool next(int i, GUnit& u) const {
        const int idx = xcd_unit(i, G, c, 192); if (idx < 0) return false;
        const int g = idx / 12, q = idx % 12, pm = q / 4, pn = q % 4;
        u.A = SUX + ((size_t)g * MCH + pm * 256) * (SUXW * 2); u.B = KC + ((size_t)g * 1024 + pn * 256) * (SUXW * 2); u.p0 = 0; u.p1 = pm; u.p2 = pn; u.p3 = g; return true; }
    __device__ __forceinline__ int row_token(const GUnit&, int) const { return 0; }
    __device__ __forceinline__ size_t kstepA() const { return 128; }
    __device__ __forceinline__ unsigned voffA(int h, int R, int cb, unsigned lda2) const { return (unsigned)(h * 128 + R) * lda2 + (unsigned)cb; }
    __device__ __forceinline__ int row_token_lds(const GUnit&, int, int) const { return 0; }
    __device__ __forceinline__ void pre(const GUnit&, int, int, int) const {}
};
struct EpiS5c { bf16_t* Gb;
    __device__ __forceinline__ void operator()(const AccT& acc, const GUnit& u, int slot, int wr, int wc, int fr, int fq) const {
#pragma unroll
        for (int ai = 0; ai < 2; ++ai)
#pragma unroll
            for (int m = 0; m < 4; ++m) { const int chunk = u.p1 * 256 + 128 * ai + 64 * wr + 16 * m + fr;
                if (chunk < TT / 64) {
#pragma unroll
                    for (int bj = 0; bj < 2; ++bj) { ACC8(ai, bj, m); const int col = u.p2 * 256 + 128 * bj + 32 * wc + 8 * fq;
#pragma unroll
                        for (int e = 0; e < 8; ++e) v[e] = gelu_tanh(v[e]);
                        *(u32x4*)(Gb + ((size_t)chunk * 64 + (col >> 4)) * 256 + u.p3 * 16 + (col & 15)) = pack8(v); } } }
    }
};
struct SchedGlu { int G, c; const char* Gb; const char* W; unsigned* stat = nullptr;
    __device__ __forceinline__ bool next(int i, GUnit& u) const {
        const int idx = xcd_unit(i, G, c, 132); if (idx < 0) return false;
        u.A = Gb + (size_t)idx * 256 * 512; u.B = W; u.p0 = 0; u.p1 = idx; u.p2 = 0; u.p3 = 0; return true; }
    __device__ __forceinline__ int row_token(const GUnit&, int) const { return 0; }
    __device__ __forceinline__ size_t kstepA() const { return 128; }
    __device__ __forceinline__ unsigned voffA(int h, int R, int cb, unsigned lda2) const { return (unsigned)(h * 128 + R) * lda2 + (unsigned)cb; }
    __device__ __forceinline__ int row_token_lds(const GUnit&, int, int) const { return 0; }
    __device__ __forceinline__ void pre(const GUnit&, int, int, int) const {}
};
struct EpiGlu { const bf16_t* Gb; unsigned char* Y; const float* bglu;
    __device__ __forceinline__ void operator()(const AccT& acc, const GUnit& u, int slot, int wr, int wc, int fr, int fq) const {
#pragma unroll
        for (int bj = 0; bj < 2; ++bj) { const int col = 128 * bj + 32 * wc + 8 * fq;
            const f32x4 b0 = *(const f32x4*)(bglu + col), b1 = *(const f32x4*)(bglu + col + 4); const float bb[8] = {b0[0], b0[1], b0[2], b0[3], b1[0], b1[1], b1[2], b1[3]};
            u32x4 gw[2][4];
#pragma unroll
            for (int ai = 0; ai < 2; ++ai)
#pragma unroll
                for (int m = 0; m < 4; ++m) gw[ai][m] = *(const u32x4*)(Gb + (size_t)(u.p1 * 256 + 128 * ai + 64 * wr + 16 * m + fr) * 256 + col);
#pragma unroll
            for (int ai = 0; ai < 2; ++ai)
#pragma unroll
                for (int m = 0; m < 4; ++m) { const int row = u.p1 * 256 + 128 * ai + 64 * wr + 16 * m + fr; ACC8(ai, bj, m);
                    const u32x4 g4 = gw[ai][m];
                    const float gv[8] = {bflo(g4.x), bfhi(g4.x), bflo(g4.y), bfhi(g4.y), bflo(g4.z), bfhi(g4.z), bflo(g4.w), bfhi(g4.w)};
#pragma unroll
                    for (int e = 0; e < 8; ++e) v[e] = (FP8_SY * gv[e]) * sigmoidf_(v[e] + bb[e]);
                    *(u32x2*)(Y + (size_t)row * P8 + 384 + col) = (u32x2){pk4_fp8(v[0], v[1], v[2], v[3]), pk4_fp8(v[4], v[5], v[6], v[7])}; } }
    }
};
struct SchedOut { int G, c, nunits; const char* Y; const char* W; unsigned* stat = nullptr;
    __device__ __forceinline__ bool next(int i, GUnit& u) const {
        const int idx = xcd_unit(i, G, c, nunits); if (idx < 0) return false;
        const int pm = idx >> 2, pn = idx & 3; u.A = Y + (size_t)pm * 256 * P8; u.B = W + (size_t)pn * 256 * P8; u.p0 = 0; u.p1 = pm; u.p2 = pn; u.p3 = 0; return true; }
    __device__ __forceinline__ int row_token(const GUnit&, int) const { return 0; }
    __device__ __forceinline__ size_t kstepA() const { return 128; }
    __device__ __forceinline__ unsigned voffA(int h, int R, int cb, unsigned lda2) const { return (unsigned)(h * 128 + R) * lda2 + (unsigned)cb; }
    __device__ __forceinline__ int row_token_lds(const GUnit&, int, int) const { return 0; }
    __device__ __forceinline__ void pre(const GUnit&, int, int, int) const {}
};
struct EpiOut { bf16_t* XR; const float* G2;
    __device__ __forceinline__ void operator()(const AccT& acc, const GUnit& u, int slot, int wr, int wc, int fr, int fq) const {
        const int bi = (u.p1 < 128) ? (u.p1 >> 5) : 4;
        const float* gp = G2 + (size_t)bi * 6144 + u.p2 * 256 + 32 * wc + 8 * fq;
        const f32x4 ga0 = *(const f32x4*)gp, ga1 = *(const f32x4*)(gp + 4), gb0 = *(const f32x4*)(gp + 128), gb1 = *(const f32x4*)(gp + 132);
        constexpr float SC = 1.0f / (FP8_SY * FP8_SW);
        const float gg[2][8] = {{ga0[0] * SC, ga0[1] * SC, ga0[2] * SC, ga0[3] * SC, ga1[0] * SC, ga1[1] * SC, ga1[2] * SC, ga1[3] * SC}, {gb0[0] * SC, gb0[1] * SC, gb0[2] * SC, gb0[3] * SC, gb1[0] * SC, gb1[1] * SC, gb1[2] * SC, gb1[3] * SC}};
#pragma unroll
        for (int ai = 0; ai < 2; ++ai) {
            u32x4 xw[4][2];
#pragma unroll
            for (int m = 0; m < 4; ++m)
#pragma unroll
                for (int bj = 0; bj < 2; ++bj) xw[m][bj] = *(const u32x4*)(XR + (size_t)(u.p1 * 256 + 128 * ai + 64 * wr + 16 * m + fr) * D + u.p2 * 256 + 32 * wc + 8 * fq + 128 * bj);
#pragma unroll
            for (int m = 0; m < 4; ++m) { bf16_t* rowp = XR + (size_t)(u.p1 * 256 + 128 * ai + 64 * wr + 16 * m + fr) * D + u.p2 * 256 + 32 * wc + 8 * fq;
#pragma unroll
                for (int bj = 0; bj < 2; ++bj) { ACC8(ai, bj, m);
                    const u32x4 x4 = xw[m][bj];
                    const float xv[8] = {bflo(x4.x), bfhi(x4.x), bflo(x4.y), bfhi(x4.y), bflo(x4.z), bfhi(x4.z), bflo(x4.w), bfhi(x4.w)};
#pragma unroll
                    for (int e = 0; e < 8; ++e) v[e] = xv[e] + gg[bj][e] * v[e];
                    *(u32x4*)(rowp + 128 * bj) = pack8(v); } } }
    }
};
struct SchedMoe { int G, c, NT; const LAS int* ts; const char* A; const char* W; size_t wstride; const int* elist; bool gather; const float* bgu; LAS unsigned char* lds; bool rev; unsigned* stat = nullptr;
    __device__ __forceinline__ bool next(int i, GUnit& u) const {
        const int idx = xcd_unit(i, G, c, ts[32] * NT); if (idx < 0) return false;
        const int mt = rev ? (ts[32] - 1 - idx / NT) : idx / NT, pn = idx % NT; const int e = ((const LAS int*)(lds + LDS_T2E))[mt];
        u.A = gather ? A : (A + (size_t)mt * 262144); u.B = W + (size_t)e * wstride + (size_t)pn * 256 * P8;   u.p0 = mt; u.p1 = pn; u.p2 = e; u.p3 = (mt - ts[e]) * 256; return true; }
    __device__ __forceinline__ int row_token(const GUnit& u, int row) const { const int j = min(u.p3 + row, ts[40 + u.p2] - 1); return elist[(size_t)u.p2 * TT + j]; }
    __device__ __forceinline__ size_t kstepA() const { return gather ? 128 : 32768; }
    __device__ __forceinline__ unsigned voffA(int h, int R, int cb, unsigned lda2) const {
        if (gather) return (unsigned)(h * 128 + R) * lda2 + (unsigned)cb;
        const int ch = cb >> 4; return (unsigned)((((h * 2 + (R >> 6)) * 4 + ((R >> 4) & 3)) * 4 + (ch >> 1)) * 512 + (R & 15) * 32 + (ch & 1) * 16); }
    __device__ __forceinline__ int row_token_lds(const GUnit& u, int slot, int row) const { const int t = ((const LAS int*)(lds + LDS_TOK + slot * 1024))[row]; return (u.p3 + row < ts[40 + u.p2]) ? t : 0; }
    __device__ __forceinline__ void pre(const GUnit& u, int slot, int wid, int lane) const {
        if (bgu != nullptr && wid == 0) { const float* src = bgu + (size_t)u.p2 * 2048 + 128 * u.p1 + ((lane & 32) ? 1024 : 0) + 4 * (lane & 31);
            __builtin_amdgcn_global_load_lds((const unsigned*)src, (LAS unsigned*)(lds + LDS_BIAS + slot * 1024), 16, 0, 0); }
        if (gather && wid == 1) __builtin_amdgcn_global_load_lds((const unsigned*)(elist + (size_t)u.p2 * TT + u.p3 + 4 * lane), (LAS unsigned*)(lds + LDS_TOK + slot * 1024), 16, 0, 0); }
};
struct EpiGateUp { unsigned char* ACT; LAS unsigned char* lds;
    __device__ __forceinline__ void operator()(const AccT& acc, const GUnit& u, int slot, int wr, int wc, int fr, int fq) const {
        const int col = 128 * u.p1 + 32 * wc + 8 * fq; const LAS float* bg = (const LAS float*)(lds + LDS_BIAS + slot * 1024) + 32 * wc + 8 * fq;
        const f32x4 g0 = *(const LAS f32x4*)bg, g1 = *(const LAS f32x4*)(bg + 4), u0 = *(const LAS f32x4*)(bg + 128), u1 = *(const LAS f32x4*)(bg + 132);
        const float bgate[8] = {g0[0], g0[1], g0[2], g0[3], g1[0], g1[1], g1[2], g1[3]}, bup[8] = {u0[0], u0[1], u0[2], u0[3], u1[0], u1[1], u1[2], u1[3]};
#pragma unroll
        for (int ai = 0; ai < 2; ++ai)
#pragma unroll
            for (int m = 0; m < 4; ++m) { const size_t row = (size_t)u.p0 * 256 + 128 * ai + 64 * wr + 16 * m + fr;
                const f32x4 ga = acc[ai][0][m][0], gb = acc[ai][0][m][1], ua = acc[ai][1][m][0], ub = acc[ai][1][m][1];
                const float gt[8] = {ga[0], ga[1], ga[2], ga[3], gb[0], gb[1], gb[2], gb[3]}, up[8] = {ua[0], ua[1], ua[2], ua[3], ub[0], ub[1], ub[2], ub[3]};
                float v[8];
#pragma unroll
                for (int e = 0; e < 8; e += 2) {
                    const f32x2 g2 = (f32x2){gt[e], gt[e + 1]} * (1.0f / (FP8_SH * FP8_SW)) + (f32x2){bgate[e], bgate[e + 1]};
                    const f32x2 u2 = (f32x2){up[e], up[e + 1]} * (FP8_SA / (FP8_SH * FP8_SW)) + (f32x2){bup[e], bup[e + 1]} * FP8_SA;
                    const f32x2 gg = (f32x2){fminf(g2.x, 7.0f), fminf(g2.y, 7.0f)};
                    const f32x2 uu = (f32x2){fminf(fmaxf(u2.x, -7.0f * FP8_SA), 7.0f * FP8_SA), fminf(fmaxf(u2.y, -7.0f * FP8_SA), 7.0f * FP8_SA)} + FP8_SA;
                    const f32x2 ex = gg * (-1.702f * 1.4426950408889634f);
                    const f32x2 den = (f32x2){__builtin_amdgcn_exp2f(ex.x), __builtin_amdgcn_exp2f(ex.y)} + 1.0f;
                    const f32x2 sg = (f32x2){__builtin_amdgcn_rcpf(den.x), __builtin_amdgcn_rcpf(den.y)};
                    const f32x2 o = gg * sg * uu; v[e] = o.x; v[e + 1] = o.y; }
                *(u32x2*)(ACT + ((size_t)u.p0 * 8 + u.p1) * 32768 + ((((ai * 2 + wr) * 4 + m) * 4 + wc) * 512 + fr * 32 + fq * 8)) = (u32x2){pk4_fp8_nc(v[0], v[1], v[2], v[3]), pk4_fp8_nc(v[4], v[5], v[6], v[7])}; }
    }
};
struct EpiDown { unsigned char* EO; const float* bd; bool dry;
    __device__ __forceinline__ void operator()(const AccT& acc, const GUnit& u, int slot, int wr, int wc, int fr, int fq) const {
        if (dry) return;
#pragma unroll
        for (int bj = 0; bj < 2; ++bj) {
            const float* bp = bd + (size_t)u.p2 * D + u.p1 * 256 + 128 * bj + 32 * wc + 8 * fq;
            const f32x4 b0 = *(const f32x4*)bp * FP8_SE, b1 = *(const f32x4*)(bp + 4) * FP8_SE; const float bb[8] = {b0[0], b0[1], b0[2], b0[3], b1[0], b1[1], b1[2], b1[3]};
#pragma unroll
            for (int ai = 0; ai < 2; ++ai)
#pragma unroll
                for (int m = 0; m < 4; ++m) { unsigned char* rowp = EO + ((size_t)u.p0 * 256 + 128 * ai + 64 * wr + 16 * m + fr) * D + u.p1 * 256 + 32 * wc + 8 * fq;
                    ACC8(ai, bj, m);
#pragma unroll
                    for (int e = 0; e < 8; ++e) v[e] = v[e] * (FP8_SE / (FP8_SA * FP8_SW)) + bb[e];
                    *(u32x2*)(rowp + 128 * bj) = (u32x2){pk4_fp8(v[0], v[1], v[2], v[3]), pk4_fp8(v[4], v[5], v[6], v[7])}; } }
    }
};

constexpr int PH_PER_LAYER = 7, NPHASES = 1 + DEPTH * PH_PER_LAYER + 1;

__global__ void __launch_bounds__(NTHREADS, 2) mk_fwd(Args args) {
    extern __shared__ __attribute__((aligned(16))) unsigned char lds_raw[];
    Frame F;
    F.lds = (LAS unsigned char*)lds_raw;
    F.G = gridDim.x; F.bid = blockIdx.x;
    KArgs A0 = (KArgs)__builtin_amdgcn_kernarg_segment_ptr();
    KArgs A = A0; asm volatile("" : "+s"(A));
    volatile LAS unsigned* misc = (volatile LAS unsigned*)(F.lds + LDS_MISC);
    if (threadIdx.x < 16) misc[threadIdx.x] = 0u;
    __syncthreads();
    const int lo = A->ph_lo, hi = A->ph_hi;
    XcdBarrier bar; bar.bar = (unsigned*)A->ws + CW_BAR; bar.x = 0; bar.st = nullptr;
    if (hi - lo > 1) bar = xcd_barrier_post((unsigned*)A->ws + CW_BAR, misc + 8);
    LAS unsigned char* L = F.lds;
    const LAS int* ts = (const LAS int*)(F.lds + LDS_MISC + 64);
    int ph = 0;
#ifdef ONLY_SITE
#define SITE_ON(s) ((s) == ONLY_SITE)
#define ONLY_SITE_BUILD true
#else
#define SITE_ON(s) true
#define ONLY_SITE_BUILD false
#endif
#ifndef DUP_MASK
#define DUP_MASK 0u
#endif
#define PH_RUN(s) (SITE_ON(s) && ph >= lo && ph < hi)
#define PH_REP(s) for (int rep_ = 0; rep_ < (((DUP_MASK >> (s)) & 1u) ? 2 : 1); ++rep_)
#define PH_END do { if (ph >= lo && ph + 1 < hi) xcd_barrier(bar); ++ph; A = A0; asm volatile("" : "+s"(A)); } while (0)

    if (PH_RUN(0)) PH_REP(0) phase_p0a(A, F);
    PH_END;
    for (int l = 0; l < DEPTH; ++l) {
        const bool lastl = (l == DEPTH - 1);
        if (PH_RUN(2)) { if (l == 0) { phase_p0b(A, F); __syncthreads(); }
            phase_norm1(A, F, l); if ((DUP_MASK >> 2) & 1u) phase_norm1(A, F, l, 0.0f); }
        PH_END;
        if (PH_RUN(3)) PH_REP(3) {
            SchedInproj S{F.G, F.bid, (const char*)WSP(unsigned char, WS_H8), (const char*)(WSP(unsigned char, WS_WINT) + (size_t)l * 2048 * P8)};
            { int t0 = threadIdx.x; asm volatile("" : "+v"(t0)); LAS float* rl = (LAS float*)(L + LDS_ROPE); const float* rg = WSP(float, WS_ROPE); for (int i = t0; i < 4096; i += NTHREADS) rl[i] = rg[i]; __syncthreads(); }
            EpiInproj E{WSP(bf16_t, WS_P), WSP(bf16_t, WS_VT), WSP(bf16_t, WS_SUX), (const LAS float*)(L + LDS_ROPE)};
            gemm_phase<false, true>(L, 8, (unsigned)P8, (unsigned)P8, S, E);
            if (xcd_unit(4, F.G, F.bid, 1056) < 0) conv_fill2(A, F, l, 5);
        }
        PH_END;
        if (PH_RUN(4)) {
            const bool std_ = (F.G == 256);
            unsigned* xc = (unsigned*)A->ws + CW_XC + l * 16;
            if (F.bid < 48) {
                SchedS5a S{48, F.bid, (const char*)WSP(bf16_t, WS_SUX), (const char*)(WSP(bf16_t, WS_WST) + (size_t)l * 16 * 256 * 1024)};
                EpiS5a E{WSP(float, WS_SLOC)};
                gemm_phase<false, false>(L, 16, (unsigned)(SUXW * 2), 2048u, S, E);
                if (std_) xc_signal(xc + 0);
            }
            if (std_ && F.bid < 16) { xc_wait(xc + 0, 48u, bar.bar); phase_s5scan(A, F, l); xc_signal(xc + 1); }
            phase_attn(A, F, l, 0);
            if (!std_) { xcd_barrier(bar); phase_s5scan(A, F, l); xcd_barrier(bar); }
            if (!std_ || F.bid >= 64) {
                if (std_) xc_wait(xc + 1, 16u, bar.bar);
                SchedS5c S{std_ ? 192 : F.G, std_ ? F.bid - 64 : F.bid, (const char*)WSP(bf16_t, WS_SUX), (const char*)(WSP(bf16_t, WS_KC) + (size_t)l * 16 * 1024 * SUXW)};
                EpiS5c E{WSP(bf16_t, WS_G)};
                gemm_phase<false, false>(L, 20, (unsigned)(SUXW * 2), (unsigned)(SUXW * 2), S, E);
                if (std_) xc_signal(xc + 2);
            }
            if (!std_) xcd_barrier(bar);
            phase_attn(A, F, l, 1);
            if (!std_ || (F.bid >= 64 && F.bid < 196)) {
                if (std_) xc_wait(xc + 2, 192u, bar.bar);
                SchedGlu S{std_ ? 132 : F.G, std_ ? F.bid - 64 : F.bid, (const char*)WSP(bf16_t, WS_G), (const char*)(WSP(bf16_t, WS_WGLUT) + (size_t)l * 256 * 256)};
                EpiGlu E{WSP(bf16_t, WS_G), WSP(unsigned char, WS_Y), FIN(19) + (size_t)l * 256};
                gemm_phase<false, false>(L, 4, 512u, 512u, S, E);
            }
            if (std_ && F.bid >= 244) conv_fill2(A, F, l, 3);
        }
        PH_END;
        if (PH_RUN(9)) PH_REP(9) {
            SchedOut S{F.G, F.bid, (lastl ? 128 : 132) * 4, (const char*)WSP(unsigned char, WS_Y), (const char*)(WSP(unsigned char, WS_WOUTT) + (size_t)l * D * P8)};
            EpiOut E{WSP(bf16_t, WS_XR), WSP(float, WS_MOD) + (size_t)l * 5 * 6144 + 2 * D};
            gemm_phase<false, true>(L, 8, (unsigned)P8, (unsigned)P8, S, E);
            if (xcd_unit(2, F.G, F.bid, (lastl ? 128 : 132) * 4) < 0) conv_fill2(A, F, l, 3);
        }
        PH_END;
        if (PH_RUN(10)) { (void)conv_fill(A, F, l, 1 << 30);
            phase_router(A, F, l); if ((DUP_MASK >> 10) & 1u) phase_router(A, F, l, true); }
        PH_END;
        if (PH_RUN(11)) PH_REP(11) {
            build_tstart(A, F, l);
            SchedMoe S{F.G, F.bid, 8, ts, (const char*)WSP(unsigned char, WS_H8), (const char*)(WSP(unsigned char, WS_WGUT) + (size_t)l * NEXP * 2048 * P8), (size_t)2048 * P8, WSP(int, WS_ELIST), true, FIN(25) + (size_t)l * NEXP * 2048, L, false};
            EpiGateUp E{WSP(unsigned char, WS_ACT), L};
            gemm_phase<true, true>(L, 8, (unsigned)P8, (unsigned)P8, S, E);
            if (xcd_unit(xcd_max_units(F.G, ts[32] * 8) - 1, F.G, F.bid, ts[32] * 8) < 0) conv_fill2(A, F, l, 4);
        }
        PH_END;
        if (PH_RUN(12)) PH_REP(12) {
            if (lo + 1 == hi || ONLY_SITE_BUILD) build_tstart(A, F, l);
            SchedMoe S{F.G, F.bid, 4, ts, (const char*)WSP(unsigned char, WS_ACT), (const char*)(WSP(unsigned char, WS_WDT) + (size_t)l * NEXP * D * P8), (size_t)D * P8, WSP(int, WS_ELIST), false, nullptr, L, true};
            EpiDown E{WSP(unsigned char, WS_EO), FIN(27) + (size_t)l * NEXP * D, (((DUP_MASK >> 20) & 1u) != 0u) && rep_ == 0};
#if PROBE_SEL >= 0
            if (l == 1) S.stat = (unsigned*)A->ws + CW_STAT;
#endif
            gemm_phase<false, true>(L, 8, (unsigned)P8, (unsigned)P8, S, E);
            if (xcd_unit(xcd_max_units(F.G, ts[32] * 4) - 1, F.G, F.bid, ts[32] * 4) < 0) conv_fill2(A, F, l, 4);
        }
        PH_END;
    }
    if (PH_RUN(13)) phase_norm1(A, F, DEPTH);
#undef PH_RUN
#undef PH_END
}
}

extern "C" void kernel_launch(void* const* d_in, const int* in_sizes, int n_in, void* d_out, int out_size, void* d_ws, size_t ws_size, hipStream_t stream) {
    static int grid = 0;
    if (grid == 0) {
        if (n_in != 29 || out_size != NLAT * D || ws_size < WS_END) { fprintf(stderr, "kernel_launch: unexpected shapes (n_in %d, out %d, ws %zu)\n", n_in, out_size, ws_size); grid = -1; return; }
        int dev = 0, cus = 0;
        if (hipGetDevice(&dev) != hipSuccess || hipDeviceGetAttribute(&cus, hipDeviceAttributeMultiprocessorCount, dev) != hipSuccess) { grid = -1; return; }
        if (hipFuncSetAttribute((const void*)mk_fwd, hipFuncAttributeMaxDynamicSharedMemorySize, LDS_BYTES) != hipSuccess) { fprintf(stderr, "kernel_launch: hipFuncSetAttribute failed\n"); grid = -1; return; }
        int per_cu = 0;
        if (hipOccupancyMaxActiveBlocksPerMultiprocessor(&per_cu, (const void*)mk_fwd, NTHREADS, LDS_BYTES) != hipSuccess || per_cu < 1) { fprintf(stderr, "kernel_launch: occupancy query reports %d\n", per_cu); }
        (void)hipGetLastError();
        grid = cus;
    }
    if (grid < 0) return;
    (void)hipMemsetAsync((char*)d_ws + WS_CTL, 0, 1 * MiB, stream);
    Args a{};
    for (int i = 0; i < 29; ++i) a.in[i] = (const float*)d_in[i];
    a.out = (float*)d_out; a.ws = (unsigned char*)d_ws;
#if MK_PER_PHASE
    for (int p = 0; p < NPHASES; ++p) { a.ph_lo = p; a.ph_hi = p + 1; hipLaunchKernelGGL(mk_fwd, dim3(grid), dim3(NTHREADS), LDS_BYTES, stream, a); }
#else
    a.ph_lo = 0; a.ph_hi = NPHASES;
    hipLaunchKernelGGL(mk_fwd, dim3(grid), dim3(NTHREADS), LDS_BYTES, stream, a);
#endif
}
```

```cpp
#include <hip/hip_runtime.h>
#include <cstdio>
#include <cstdint>

#ifndef MK_PER_PHASE
#define MK_PER_PHASE 0
#endif

#ifndef PROBE_SEL
#define PROBE_SEL -1
#endif
#define LAS __attribute__((address_space(3)))
#define GAS __attribute__((address_space(1)))
typedef unsigned short bf16_t;
typedef short bf16x8 __attribute__((ext_vector_type(8)));
typedef float f32x4 __attribute__((ext_vector_type(4)));
typedef float f32x2 __attribute__((ext_vector_type(2)));
typedef float f32x16 __attribute__((ext_vector_type(16)));
typedef unsigned u32x4 __attribute__((ext_vector_type(4)));
typedef unsigned u32x2 __attribute__((ext_vector_type(2)));
typedef int v8i __attribute__((ext_vector_type(8)));
typedef int v4i __attribute__((ext_vector_type(4)));

namespace {
constexpr int D = 1024, NBATCH = 4, SEQ = 8192, DEPTH = 4, CTXL = 256;
constexpr int NLAT = NBATCH * SEQ;
constexpr int NCTX = NBATCH * CTXL;
constexpr int TT = NLAT + NCTX;
constexpr int PW = 1280;
constexpr int NEXP = 32, FF = 1024;
constexpr int MCH = 768;
constexpr int SUXW = 1280;
constexpr int MAXTILES = 560;
constexpr int NWAVES = 8, NTHREADS = 512;
constexpr float RMS_EPS = 1e-6f;
constexpr int P8 = 1152;

constexpr size_t MiB = 1ull << 20;
constexpr size_t WS_CTL = 0;
constexpr size_t WS_MOD = 1 * MiB;
constexpr size_t WS_ROPE = 2 * MiB;
constexpr size_t WS_LP = 3 * MiB;
constexpr size_t WS_BBAR = 8 * MiB;
constexpr size_t WS_WRT = 9 * MiB;
constexpr size_t WS_WGLUT = 10 * MiB;
constexpr size_t WS_WINT = 11 * MiB;
constexpr size_t WS_WOUTT = 27 * MiB;
constexpr size_t WS_WST = 35 * MiB;
constexpr size_t WS_KC = 67 * MiB;
constexpr size_t WS_WGUT = 227 * MiB;
constexpr size_t WS_WDT = 739 * MiB;
constexpr size_t WS_XR = 995 * MiB;
constexpr size_t WS_H = 1127 * MiB;
constexpr size_t WS_P = 1193 * MiB;
constexpr size_t WS_VT = 1276 * MiB;
constexpr size_t WS_SUX = 1309 * MiB;
constexpr size_t WS_SLOC = 1339 * MiB;
constexpr size_t WS_G = 1351 * MiB;
constexpr size_t WS_Y = 1368 * MiB;
constexpr size_t WS_ELIST = 1434 * MiB;
constexpr size_t WS_ELW = 1439 * MiB;
constexpr size_t WS_TOKINFO = 1444 * MiB;
constexpr size_t WS_ACT = 1445 * MiB;
constexpr size_t WS_EO = 1725 * MiB;
constexpr size_t WS_TOKW = 2005 * MiB;
constexpr size_t WS_DELTA = 2006 * MiB;
constexpr size_t WS_H8 = 2072 * MiB;
constexpr size_t WS_END = 2112 * MiB;
constexpr int CW_BAR = 1024;
constexpr int CW_CNT = 8192;
constexpr int CW_STAT = 12288;
constexpr int CW_XC = 12800;
constexpr int CW_QUEUE = 12544;

constexpr int LDS_STAGE = 131072;
constexpr int LDS_MISC = LDS_STAGE;
constexpr int LDS_BIAS = LDS_STAGE + 1024;
constexpr int LDS_ROPE = LDS_STAGE + 4096;
constexpr int LDS_TOK = LDS_STAGE + 4096 + 16384;
constexpr int LDS_T2E = LDS_TOK + 2048;
constexpr int LDS_BYTES = LDS_T2E + 2560;

__device__ __forceinline__ unsigned f2bf(float f) { unsigned u = __builtin_bit_cast(unsigned, f); return (u + 0x7fffu + ((u >> 16) & 1u)) >> 16; }
__device__ __forceinline__ unsigned pk2(float lo, float hi) { return f2bf(lo) | (f2bf(hi) << 16); }
__device__ __forceinline__ float bf2f(unsigned short b) { return __builtin_bit_cast(float, ((unsigned)b) << 16); }
__device__ __forceinline__ float bflo(unsigned w) { return __builtin_bit_cast(float, w << 16); }
__device__ __forceinline__ float bfhi(unsigned w) { return __builtin_bit_cast(float, w & 0xffff0000u); }
__device__ __forceinline__ f32x4 bf4_to_f32(u32x2 w) { return (f32x4){bflo(w.x), bfhi(w.x), bflo(w.y), bfhi(w.y)}; }
__device__ __forceinline__ u32x2 f32_to_bf4(f32x4 v) { u32x2 o; o.x = pk2(v.x, v.y); o.y = pk2(v.z, v.w); return o; }
__device__ __forceinline__ float wave_sum(float v) {
#pragma unroll
    for (int o = 1; o < 64; o <<= 1) v += __shfl_xor(v, o);
    return v;
}
constexpr float FP8_SW = 64.0f, FP8_SH = 16.0f, FP8_SA = 8.0f, FP8_SE = 16.0f, FP8_SY = 16.0f;
__device__ __forceinline__ unsigned pk4_fp8(float a, float b, float c, float d) {
    a = fminf(fmaxf(a, -448.f), 448.f); b = fminf(fmaxf(b, -448.f), 448.f); c = fminf(fmaxf(c, -448.f), 448.f); d = fminf(fmaxf(d, -448.f), 448.f);
    int v = 0; v = __builtin_amdgcn_cvt_pk_fp8_f32(a, b, v, false); v = __builtin_amdgcn_cvt_pk_fp8_f32(c, d, v, true); return (unsigned)v; }
__device__ __forceinline__ unsigned pk4_fp8_nc(float a, float b, float c, float d) {
    int v = 0; v = __builtin_amdgcn_cvt_pk_fp8_f32(a, b, v, false); v = __builtin_amdgcn_cvt_pk_fp8_f32(c, d, v, true); return (unsigned)v; }
__device__ __forceinline__ float fast_exp2(float x) { return __builtin_amdgcn_exp2f(x); }
__device__ __forceinline__ float sigmoidf_(float x) { return __builtin_amdgcn_rcpf(1.0f + __builtin_amdgcn_exp2f(-1.4426950408889634f * x)); }
__device__ __forceinline__ float gelu_tanh(float x) {
    const float u = 0.7978845608028654f * (x + 0.044715f * x * x * x);
    const float t = 1.0f - 2.0f * __builtin_amdgcn_rcpf(1.0f + __builtin_amdgcn_exp2f(2.8853900817779268f * u));
    return 0.5f * x * (1.0f + t);
}

#define XB_TMO      128
#define XB_XCNT(j)  (256  + 64 * (j))
#define XB_XSUB(j)  (1280 + 64 * (j))
#define XB_XGEN(j)  (2304 + 64 * (j))
#define XB_TOP      3328
#define XB_TOPGEN   3392
#define XCD_BAR_WORDS 3456
#define XB_SPIN_CAP (1u << 18)
__device__ __forceinline__ unsigned xb_ld(unsigned* p)              { return __hip_atomic_load(p, __ATOMIC_RELAXED, __HIP_MEMORY_SCOPE_AGENT); }
__device__ __forceinline__ unsigned xb_add(unsigned* p, unsigned v) { return __hip_atomic_fetch_add(p, v, __ATOMIC_RELAXED, __HIP_MEMORY_SCOPE_AGENT); }
__device__ __forceinline__ unsigned xb_xcc_id() { return (unsigned)__builtin_amdgcn_s_getreg((3 << 11) | 20) & 0xFu; }
#define XB_SPIN(cond, bar) do { unsigned _sp = 0; while (cond) { __builtin_amdgcn_s_sleep(1); \
    if ((++_sp & 255u) == 0u) { if (xb_ld(&(bar)[XB_TMO])) break; if (_sp > XB_SPIN_CAP) { atomicAdd(&(bar)[XB_TMO], 1u); break; } } } } while (0)
struct XcdBarrier { unsigned* bar; unsigned x; volatile LAS unsigned* st; };
__device__ __forceinline__ XcdBarrier xcd_barrier_post(unsigned* bar, volatile LAS unsigned* st) {
    XcdBarrier b; b.bar = bar; b.x = xb_xcc_id(); b.st = st;
    if (threadIdx.x == 0) (void)xb_add(&bar[XB_XCNT(b.x)], 1u);
    return b;
}
__device__ __forceinline__ void xcd_barrier_complete(unsigned* bar, unsigned x, unsigned& nloc, unsigned& nx) {
    const unsigned G = gridDim.x * gridDim.y * gridDim.z;
    unsigned sum, cnt, mine, sp = 0u;
    for (;;) {
        sum = 0u; cnt = 0u; mine = 0u;
#pragma unroll
        for (unsigned j = 0; j < 16; ++j) { const unsigned c = xb_ld(&bar[XB_XCNT(j)]); sum += c; cnt += (c > 0u) ? 1u : 0u; mine = (j == x) ? c : mine; }
        if (sum == G) break;
        __builtin_amdgcn_s_sleep(1);
        if ((++sp & 255u) == 0u) { if (xb_ld(&bar[XB_TMO])) break; if (sp > XB_SPIN_CAP) { atomicAdd(&bar[XB_TMO], 1u); break; } }
    }
    nloc = mine > 0u ? mine : 1u; nx = cnt > 0u ? cnt : 1u;
}
__device__ __forceinline__ void xcd_barrier(const XcdBarrier& b) {
    asm volatile("s_waitcnt vmcnt(0)" ::: "memory");
    __syncthreads();
    if (threadIdx.x == 0) {
        unsigned* bar = b.bar;
        __builtin_amdgcn_s_waitcnt(0);
        unsigned nloc = b.st[0], nx = b.st[1];
        if (nloc == 0u) { xcd_barrier_complete(bar, b.x, nloc, nx); b.st[0] = nloc; b.st[1] = nx; }
        const unsigned old = xb_add(&bar[XB_XSUB(b.x)], 1u);
        const unsigned gen = old / nloc;
        if (old + 1u == (gen + 1u) * nloc) {
            __builtin_amdgcn_fence(__ATOMIC_RELEASE, "agent");
            asm volatile("s_waitcnt vmcnt(0)" ::: "memory");
            const unsigned og = xb_add(&bar[XB_TOP], 1u);
            const unsigned tg = og / nx;
            if (og + 1u == (tg + 1u) * nx) xb_add(&bar[XB_TOPGEN], 1u);
            else XB_SPIN(xb_ld(&bar[XB_TOPGEN]) == tg, bar);
            __builtin_amdgcn_fence(__ATOMIC_ACQUIRE, "agent");
            xb_add(&bar[XB_XGEN(b.x)], 1u);
            asm volatile("s_waitcnt vmcnt(0)" ::: "memory");
        } else {
            XB_SPIN(xb_ld(&bar[XB_XGEN(b.x)]) == gen, bar);
            __builtin_amdgcn_fence(__ATOMIC_ACQUIRE, "agent");
            asm volatile("s_waitcnt vmcnt(0)" ::: "memory");
        }
    }
    __syncthreads();
}

__device__ __forceinline__ void xc_signal(unsigned* c) {
    asm volatile("s_waitcnt vmcnt(0)" ::: "memory");
    __syncthreads();
    if (threadIdx.x == 0) { __builtin_amdgcn_fence(__ATOMIC_RELEASE, "agent"); asm volatile("s_waitcnt vmcnt(0)" ::: "memory"); (void)xb_add(c, 1u); }
}
__device__ __forceinline__ void xc_wait(unsigned* c, unsigned n, unsigned* bar) {
    if (threadIdx.x == 0) { XB_SPIN(xb_ld(c) < n, bar); __builtin_amdgcn_fence(__ATOMIC_ACQUIRE, "agent"); asm volatile("s_waitcnt vmcnt(0)" ::: "memory"); }
    __syncthreads();
}

constexpr float LOG2E_ = 1.4426950408889634f;
constexpr int BM = 256, BK = 64, HALF = 128, HTB = HALF * BK * 2;
__device__ __forceinline__ int lds_byte(int r, int c) { const int st = (r >> 4) * 2 + (c >> 5), rr = r & 15, cc = c & 31, ob = rr * 64 + cc * 2; return st * 1024 + (ob ^ (((ob >> 9) & 1) << 5)); }
__device__ __forceinline__ void stage_rc(int b, int& R, int& C) { const int st = b / 1024, sb = b % 1024, swz = sb ^ (((sb >> 9) & 1) << 5); R = (st >> 1) * 16 + swz / 64; C = (st & 1) * 32 + (swz % 64) / 2; }
__device__ __forceinline__ int perm32(int rho) { const int n = rho >> 4, i = rho & 15; return 8 * (i >> 2) + 4 * n + (i & 3); }
__device__ __forceinline__ unsigned cvt_pk_bf16(float lo, float hi) { unsigned r; asm volatile("v_cvt_pk_bf16_f32 %0, %1, %2" : "=v"(r) : "v"(lo), "v"(hi)); return r; }
__device__ __forceinline__ u32x4 pack8(const float* v) { u32x4 w; w.x = cvt_pk_bf16(v[0], v[1]); w.y = cvt_pk_bf16(v[2], v[3]); w.z = cvt_pk_bf16(v[4], v[5]); w.w = cvt_pk_bf16(v[6], v[7]); return w; }

struct GUnit { const char* A; const char* B; int p0, p1, p2, p3; };
typedef f32x4 AccT[2][2][4][2];

template <bool GATHER, bool FP8, class Sched, class Epi>
__device__ __forceinline__ void gemm_phase(LAS unsigned char* lds, const int nt_  , const unsigned lda2, const unsigned ldb2  , const Sched& S, const Epi& E) {
    int tid = threadIdx.x; asm volatile("" : "+v"(tid));
    int nt = nt_; asm volatile("" : "+s"(nt));
    const int wid = __builtin_amdgcn_readfirstlane(tid >> 6), lane = tid & 63, wr = wid >> 2, wc = wid & 3, fr = lane & 15, fq = lane >> 4;
    unsigned voffA[2][2], voffB[2]; int RA[2], CA[2];
#pragma unroll
    for (int i = 0; i < 2; ++i) { int R, C;
        if (FP8) { const int g = tid + 512 * i; R = (g >> 7) * 16 + (g & 15); C = ((g >> 4) & 7) * 8; }
        else stage_rc(tid * 16 + i * 8192, R, C);
        const int Rb = (R & ~31) + perm32(R & 31);
        RA[i] = R; CA[i] = C; voffA[0][i] = S.voffA(0, R, C * 2, lda2); voffA[1][i] = S.voffA(1, R, C * 2, lda2); voffB[i] = (unsigned)Rb * ldb2 + (unsigned)C * 2u; }
    const size_t kstep = (size_t)(BK * 2);
    const size_t kstepA = S.kstepA();
    const size_t hstepB = (size_t)HALF * ldb2;
    const unsigned ldsw = (unsigned)wid * 1024u;
    const int aoff = FP8 ? ((wr * 4) * 128 + 2 * fq * 16 + fr) * 16 : lds_byte(wr * 64 + fr, fq * 8), boff = FP8 ? ((wc * 2) * 128 + 2 * fq * 16 + fr) * 16 : lds_byte(wc * 32 + fr, fq * 8);
#define PG_SA(b, h) (((b) * 2 + (h)) * HTB)
#define PG_SB(b, h) ((4 + (b) * 2 + (h)) * HTB)
#define PG_STAGE(bufoff, gbase, voff) do { _Pragma("unroll") for (int _i = 0; _i < 2; ++_i) \
        __builtin_amdgcn_global_load_lds((const unsigned*)((const char*)(gbase) + (voff)[_i]), (LAS unsigned*)(lds + (bufoff) + ldsw + _i * 8192), 16, 0, 0); } while (0)
#define PG_LD32(p) __builtin_shufflevector(*(const LAS v4i*)(p), *(const LAS v4i*)((p) + 256), 0, 1, 2, 3, 4, 5, 6, 7)
#define PG_LDA(dst, b, h) do { if (FP8) { _Pragma("unroll") for (int m = 0; m < 4; ++m) dst##8[m] = PG_LD32(lds + PG_SA(b, h) + aoff + m * 2048); } \
        else { _Pragma("unroll") for (int m = 0; m < 4; ++m) _Pragma("unroll") for (int k = 0; k < 2; ++k) dst[m][k] = *(const LAS bf16x8*)(lds + PG_SA(b, h) + aoff + m * 2048 + k * 1024); } } while (0)
#define PG_LDB(dst, b, h) do { if (FP8) { _Pragma("unroll") for (int n = 0; n < 2; ++n) dst##8[n] = PG_LD32(lds + PG_SB(b, h) + boff + n * 2048); } \
        else { _Pragma("unroll") for (int n = 0; n < 2; ++n) _Pragma("unroll") for (int k = 0; k < 2; ++k) dst[n][k] = *(const LAS bf16x8*)(lds + PG_SB(b, h) + boff + n * 2048 + k * 1024); } } while (0)
#define PG_MMA(ai, bj, At, Bt, Z) do { __builtin_amdgcn_s_setprio(1); \
        if (FP8 && (Z)) { _Pragma("unroll") for (int m = 0; m < 4; ++m) _Pragma("unroll") for (int n = 0; n < 2; ++n)   \
            asm volatile("v_mfma_f32_16x16x128_f8f6f4 %0, %1, %2, 0" : "=&v"(acc[ai][bj][m][n]) : "v"(Bt##8[n]), "v"(At##8[m])); } \
        else if (FP8) { _Pragma("unroll") for (int m = 0; m < 4; ++m) _Pragma("unroll") for (int n = 0; n < 2; ++n) \
            asm volatile("v_mfma_f32_16x16x128_f8f6f4 %0, %1, %2, %0" : "+v"(acc[ai][bj][m][n]) : "v"(Bt##8[n]), "v"(At##8[m])); }   \
        else { _Pragma("unroll") for (int m = 0; m < 4; ++m) _Pragma("unroll") for (int n = 0; n < 2; ++n) _Pragma("unroll") for (int k = 0; k < 2; ++k) \
            acc[ai][bj][m][n] = __builtin_amdgcn_mfma_f32_16x16x32_bf16(Bt[n][k], At[m][k], acc[ai][bj][m][n], 0, 0, 0); } \
        __builtin_amdgcn_s_setprio(0); } while (0)
#define PG_WAIT_V(n) asm volatile("s_waitcnt vmcnt(" #n ")" ::: "memory")
#define PG_WAIT_L(n) asm volatile("s_waitcnt lgkmcnt(" #n ")" ::: "memory")
#define PG_BAR __builtin_amdgcn_s_barrier()
#define PG_SCHED __builtin_amdgcn_sched_barrier(0)
    GUnit cur, nxt; int ui = 0;
    if (!S.next(0, cur)) return;
#if PROBE_SEL >= 0
    unsigned pc_k = 0, pc_e = 0, pc_g = 0, pc_n = 0, pc_t0 = 0, pc_t1 = 0, pc_w = 0;
#define PCYC() ({ const unsigned long long c_ = __builtin_amdgcn_s_memtime(); asm volatile("s_waitcnt lgkmcnt(0)" ::: "memory"); (unsigned)c_; })
#endif
    AccT acc;
#pragma unroll
    for (int a = 0; a < 2; ++a)
#pragma unroll
        for (int b = 0; b < 2; ++b)
#pragma unroll
            for (int m = 0; m < 4; ++m)
#pragma unroll
                for (int n = 0; n < 2; ++n) { if (FP8) asm volatile("" : "=v"(acc[a][b][m][n]));   else acc[a][b][m][n] = (f32x4){0.f, 0.f, 0.f, 0.f}; }
    bf16x8 At[4][2], B0[2][2], B1[2][2]; v8i At8[4], B08[2], B18[2];
    const char* cA = cur.A; const char* cB = cur.B;
    S.pre(cur, 0, wid, lane);
    if (GATHER) {
#pragma unroll
        for (int h = 0; h < 2; ++h)
#pragma unroll
            for (int i = 0; i < 2; ++i) voffA[h][i] = (unsigned)S.row_token(cur, h * 128 + RA[i]) * lda2 + (unsigned)CA[i] * 2u;
    }
    unsigned voffAn[2][2];
#pragma unroll
    for (int h = 0; h < 2; ++h)
#pragma unroll
        for (int i = 0; i < 2; ++i) voffAn[h][i] = voffA[h][i];
    PG_STAGE(PG_SB(0, 0), cB, voffB); PG_STAGE(PG_SB(0, 1), cB + hstepB, voffB); PG_STAGE(PG_SA(0, 0), cA, voffA[0]); PG_STAGE(PG_SA(0, 1), cA, voffA[1]);
    if (wr == 1) PG_BAR;
    PG_WAIT_V(2); PG_BAR;
    PG_STAGE(PG_SB(1, 0), cB + kstep, voffB); PG_STAGE(PG_SA(1, 0), cA + kstepA, voffA[0]); PG_STAGE(PG_SB(1, 1), cB + hstepB + kstep, voffB);
    PG_WAIT_V(6); PG_BAR;
    for (;;) {
        const bool has_next = S.next(ui + 1, nxt);
        const char* nA = has_next ? nxt.A : cA; const char* nB = has_next ? nxt.B : cB;
#if PROBE_SEL >= 0
        pc_t0 = PCYC(); if (ui > 0) pc_g += (pc_t0 - pc_t1) & 0xFFFFFu;
#endif
        for (int t = 0; t < nt; t += 2) {
            const bool last = (t == nt - 2), z0 = (t == 0);
            const char* a1 = cA + (size_t)(t + 1) * kstepA;
            const char* a2 = last ? nA : cA + (size_t)(t + 2) * kstepA; const char* b2 = last ? nB : cB + (size_t)(t + 2) * kstep;
            const char* a3 = a2 + kstepA; const char* b3 = b2 + kstep;
            if (t == nt - 4 && has_next) S.pre(nxt, (ui + 1) & 1, wid, lane);
            if (GATHER) {
                if (last && has_next) {
                    int tq = threadIdx.x; asm volatile("" : "+v"(tq));
#pragma unroll
                    for (int i = 0; i < 2; ++i) { int R2, C2;
                        if (FP8) { const int g = tq + 512 * i; R2 = (g >> 7) * 16 + (g & 15); C2 = ((g >> 4) & 7) * 8; } else stage_rc(tq * 16 + i * 8192, R2, C2);
#pragma unroll
                        for (int h = 0; h < 2; ++h) voffAn[h][i] = (unsigned)S.row_token_lds(nxt, (ui + 1) & 1, h * 128 + R2) * lda2 + (unsigned)C2 * 2u; }
                }
            }
            unsigned vA0[2], vA1[2];
#pragma unroll
            for (int i = 0; i < 2; ++i) { vA0[i] = (GATHER && last) ? voffAn[0][i] : voffA[0][i]; vA1[i] = (GATHER && last) ? voffAn[1][i] : voffA[1][i]; }
            PG_LDB(B0, 0, 0); PG_LDB(B1, 0, 1); PG_SCHED; PG_LDA(At, 0, 0); PG_STAGE(PG_SA(1, 1), a1, voffA[1]);
            PG_WAIT_V(8); PG_WAIT_L(0); PG_BAR; PG_MMA(0, 0, At, B0, z0); PG_MMA(0, 1, At, B1, z0); PG_BAR; PG_SCHED;
            PG_LDA(At, 0, 1); PG_STAGE(PG_SB(0, 0), b2, voffB); PG_STAGE(PG_SB(0, 1), b2 + hstepB, voffB); PG_STAGE(PG_SA(0, 0), a2, vA0);
            PG_WAIT_V(8); PG_WAIT_L(0); PG_BAR; PG_MMA(1, 0, At, B0, z0); PG_MMA(1, 1, At, B1, z0); PG_BAR; PG_SCHED;
            PG_LDB(B0, 1, 0); PG_LDB(B1, 1, 1); PG_SCHED; PG_LDA(At, 1, 0); PG_STAGE(PG_SA(0, 1), a2, vA1);
            PG_WAIT_V(8); PG_WAIT_L(0); PG_BAR; PG_MMA(0, 0, At, B0, false); PG_MMA(0, 1, At, B1, false); PG_BAR; PG_SCHED;
            PG_LDA(At, 1, 1); PG_STAGE(PG_SB(1, 0), b3, voffB); PG_STAGE(PG_SB(1, 1), b3 + hstepB, voffB); PG_STAGE(PG_SA(1, 0), a3, vA0);
            PG_WAIT_V(8); PG_WAIT_L(0); PG_BAR; PG_MMA(1, 0, At, B0, false); PG_MMA(1, 1, At, B1, false); PG_BAR; PG_SCHED;
        }
#if PROBE_SEL >= 0
        pc_t1 = PCYC(); pc_k += (pc_t1 - pc_t0) & 0xFFFFFu; ++pc_n;
#endif
        if (wr == 0) PG_BAR;
        if (FP8) asm volatile("s_nop 15\n\ts_nop 15" ::: "memory");
        {
            int tz = threadIdx.x; asm volatile("" : "+v"(tz)); const int wz = __builtin_amdgcn_readfirstlane(tz >> 6), lz = tz & 63;
            E(acc, cur, ui & 1, wz >> 2, wz & 3, lz & 15, lz >> 4); }
#if PROBE_SEL >= 0
        { const unsigned te = PCYC(); pc_e += (te - pc_t1) & 0xFFFFFu; }
#endif
        if (!has_next) break;
#pragma unroll
        for (int a = 0; a < 2; ++a)
#pragma unroll
            for (int b = 0; b < 2; ++b)
#pragma unroll
                for (int m = 0; m < 4; ++m)
#pragma unroll
                    for (int n = 0; n < 2; ++n) { if (FP8) asm volatile("" : "=v"(acc[a][b][m][n]));   else acc[a][b][m][n] = (f32x4){0.f, 0.f, 0.f, 0.f}; }
        cur = nxt; cA = nA; cB = nB; ++ui;
        if (wr == 1) PG_BAR;
        if (GATHER) {
#pragma unroll
            for (int h = 0; h < 2; ++h)
#pragma unroll
                for (int i = 0; i < 2; ++i) voffA[h][i] = voffAn[h][i];
        }
    }
    PG_WAIT_V(0);
    PG_BAR;
#if PROBE_SEL >= 0
    if (S.stat != nullptr && tid == 0) { atomicAdd(S.stat + 0, pc_k); atomicAdd(S.stat + 1, pc_e); atomicAdd(S.stat + 2, pc_g); atomicAdd(S.stat + 3, pc_n); }
#undef PCYC
#endif
#undef PG_SA
#undef PG_SB
#undef PG_STAGE
#undef PG_LDA
#undef PG_LD32
#undef PG_LDB
#undef PG_MMA
#undef PG_WAIT_V
#undef PG_WAIT_L
#undef PG_BAR
#undef PG_SCHED
}

struct Args { const float* in[29]; float* out; unsigned char* ws; int ph_lo, ph_hi; };
struct Frame {
    LAS unsigned char* lds;
    int G, bid;
};
#define PH_LOCALS int tid = threadIdx.x; asm volatile("" : "+v"(tid)); const int lane = tid & 63; const int wave = __builtin_amdgcn_readfirstlane(tid >> 6); (void)lane; (void)wave
typedef const __attribute__((address_space(4))) Args* KArgs;
#define WSP(T, off) ((T*)(A->ws + (off)))
#define FIN(i) (A->in[i])

template <bool F8 = false>
__device__ __forceinline__ void transpose_item(const float* W, int K, int N, bf16_t* WT, int kb, int n0s, int drow0, LAS float* scr, int lane) {
    const int k0 = 64 * kb;
    float wv[32];
#pragma unroll
    for (int i = 0; i < 32; ++i) wv[i] = __builtin_nontemporal_load(W + (size_t)(k0 + 2 * i + (lane >> 5)) * N + n0s + (lane & 31));
#pragma unroll
    for (int i = 0; i < 32; ++i) scr[(2 * i + (lane >> 5)) * 33 + (lane & 31)] = wv[i];
    asm volatile("s_waitcnt lgkmcnt(0)" ::: "memory");
    const int c = lane & 7;
#pragma unroll
    for (int j = 0; j < 4; ++j) { const int n = (lane >> 3) + 8 * j; const LAS float* s = scr + (8 * c) * 33 + n;
        if (F8) { *(u32x2*)((unsigned char*)WT + (size_t)(drow0 + n) * P8 + k0 + 8 * c) = (u32x2){pk4_fp8_nc(s[0 * 33] * FP8_SW, s[1 * 33] * FP8_SW, s[2 * 33] * FP8_SW, s[3 * 33] * FP8_SW), pk4_fp8_nc(s[4 * 33] * FP8_SW, s[5 * 33] * FP8_SW, s[6 * 33] * FP8_SW, s[7 * 33] * FP8_SW)}; }
        else { u32x4 o; o.x = pk2(s[0 * 33], s[1 * 33]); o.y = pk2(s[2 * 33], s[3 * 33]); o.z = pk2(s[4 * 33], s[5 * 33]); o.w = pk2(s[6 * 33], s[7 * 33]);
        *(u32x4*)(WT + (size_t)(drow0 + n) * K + k0 + 8 * c) = o; } }
    asm volatile("s_waitcnt lgkmcnt(0)" ::: "memory");
}
__device__ __forceinline__ void transpose_pair_f8(const float* W, int N, unsigned char* WT, int kbp, int n0s, int drow0, LAS float* scr, int lane) {
    const int k0 = 128 * kbp;
    float wv[64];
#pragma unroll
    for (int i = 0; i < 64; ++i) wv[i] = __builtin_nontemporal_load(W + (size_t)(k0 + 2 * i + (lane >> 5)) * N + n0s + (lane & 31));
    const int c = lane & 7;
#pragma unroll
    for (int hp = 0; hp < 2; ++hp) {
#pragma unroll
        for (int i = 0; i < 32; ++i) scr[(2 * i + (lane >> 5)) * 33 + (lane & 31)] = wv[32 * hp + i];
        asm volatile("s_waitcnt lgkmcnt(0)" ::: "memory");
#pragma unroll
        for (int j = 0; j < 4; ++j) { const int n = (lane >> 3) + 8 * j; const LAS float* s = scr + (8 * c) * 33 + n;
            *(u32x2*)(WT + (size_t)(drow0 + n) * P8 + k0 + 64 * hp + 8 * c) = (u32x2){pk4_fp8_nc(s[0 * 33] * FP8_SW, s[1 * 33] * FP8_SW, s[2 * 33] * FP8_SW, s[3 * 33] * FP8_SW), pk4_fp8_nc(s[4 * 33] * FP8_SW, s[5 * 33] * FP8_SW, s[6 * 33] * FP8_SW, s[7 * 33] * FP8_SW)}; }
        asm volatile("s_waitcnt lgkmcnt(0)" ::: "memory");
    }
}
__device__ __forceinline__ int win_src_col(int d) {
    if (d < 768) return d;
    if (d < 1152) return 1408 + (d - 768);
    if (d < 1280) return 1792 + (d - 1152);
    if (d < 1536) return 1152 + (d - 1280);
    if (d < 1920) return 768 + (d - 1536);
    return d;
}
__device__ __forceinline__ int wgu_src_col(int d) { const int t = d >> 8, r = d & 255; return (r < 128) ? (128 * t + r) : (1024 + 128 * t + (r - 128)); }

constexpr int EXP_ITEMS = NEXP * 8 * 64 + NEXP * 8 * 32;
__device__ __forceinline__ void expert_item(KArgs A, int L, int r, LAS float* scr, int lane) {
    if (r < NEXP * 8 * 64) { const int le = L * NEXP + r / 512, q = r % 512, kb = q / 64, nb = q % 64;
        transpose_pair_f8(FIN(24) + (size_t)le * D * 2048, 2048, WSP(unsigned char, WS_WGUT) + (size_t)le * 2048 * P8, kb, wgu_src_col(32 * nb), 32 * nb, scr, lane); }
    else { r -= NEXP * 8 * 64; const int le = L * NEXP + r / 256, q = r % 256, kb = q / 32, nb = q % 32;
        transpose_pair_f8(FIN(26) + (size_t)le * FF * D, D, WSP(unsigned char, WS_WDT) + (size_t)le * D * P8, kb, 32 * nb, 32 * nb, scr, lane); }
}
__device__ __forceinline__ int conv_fill(KArgs A, Frame& F, int L, int nb) {
    if (L < 0 || L >= DEPTH || nb <= 0) return 0;
    PH_LOCALS;
    LAS float* scr = (LAS float*)(F.lds + wave * 16384);
    volatile LAS int* slot = (volatile LAS int*)(F.lds + LDS_MISC + 16);
    int* q = (int*)A->ws + CW_QUEUE + L;
    for (int b = 0; b < nb; ++b) {
        __syncthreads();
        if (tid == 0) *slot = atomicAdd(q, 1);
        __syncthreads();
        const int idx = *slot * NWAVES + wave;
        if (idx >= EXP_ITEMS) return b;
        expert_item(A, L, idx, scr, lane);
    }
    return nb;
}
__device__ __forceinline__ void conv_fill2(KArgs A, Frame& F, int l, int nb) { const int done = conv_fill(A, F, l, nb); conv_fill(A, F, l + 1, nb - done); }
__device__ __forceinline__ void phase_p0a(KArgs A, Frame& F) {
    PH_LOCALS;
    LAS float* scr = (LAS float*)(F.lds + wave * 16384);
    const int gw = F.bid * NWAVES + wave, NGW = F.G * NWAVES;
    constexpr int I_IN = DEPTH * 8 * 64, I_OUT = DEPTH * 8 * 32, I_GLU = DEPTH * 4 * 8, I_RT = DEPTH * 16, I_EX = 0;
    constexpr int NITEMS = I_IN + I_OUT + I_GLU + I_RT + I_EX;
    for (int it = gw; it < NITEMS; it += NGW) {
        int r = it;
        if (r < I_IN) { const int l = r / 512, q = r % 512, kb = q / 64, nb = q % 64;
            transpose_pair_f8(FIN(7) + (size_t)l * D * 2048, 2048, WSP(unsigned char, WS_WINT) + (size_t)l * 2048 * P8, kb, win_src_col(32 * nb), 32 * nb, scr, lane); continue; } r -= I_IN;
        if (r < I_OUT) { const int l = r / 256, q = r % 256, kb = q / 32, nb = q % 32;
            transpose_pair_f8(FIN(8) + (size_t)l * D * D, D, WSP(unsigned char, WS_WOUTT) + (size_t)l * D * P8, kb, 32 * nb, 32 * nb, scr, lane); continue; } r -= I_OUT;
        if (r < I_GLU) { const int l = r / 32, q = r % 32, kb = q / 8, nb = q % 8;
            transpose_item(FIN(18) + (size_t)l * 256 * 256, 256, 256, WSP(bf16_t, WS_WGLUT) + (size_t)l * 256 * 256, kb, 32 * nb, 32 * nb, scr, lane); continue; } r -= I_GLU;
        if (r < I_RT) { const int l = r / 16, kb = r % 16;
            transpose_item(FIN(22) + (size_t)l * D * NEXP, D, NEXP, WSP(bf16_t, WS_WRT) + (size_t)l * NEXP * D, kb, 0, 0, scr, lane); continue; } r -= I_RT;
        expert_item(A, 0, r, scr, lane);
    }
    __syncthreads();
    {
        LAS float* cond = (LAS float*)F.lds;
        LAS float* red = (LAS float*)(F.lds + 32768);
        for (int i = tid; i < 5 * D; i += NTHREADS) { const int bi = i / D, k = i % D; const float v = (bi < 4) ? FIN(1)[bi * D + k] : FIN(3)[k]; cond[i] = v / (1.0f + __expf(-v)); }
        __syncthreads();
        for (int u = F.bid; u < DEPTH * 96; u += F.G) {
            const int l = u / 96, j = (u % 96) * 64 + lane;
            const float* w = FIN(4) + (size_t)l * D * 6144 + j;
            float a0 = 0.f, a1 = 0.f, a2 = 0.f, a3 = 0.f, a4 = 0.f;
#pragma unroll 1
            for (int kb = 0; kb < 128; kb += 32) {
                float wv[32];
#pragma unroll
                for (int kk = 0; kk < 32; ++kk) wv[kk] = __builtin_nontemporal_load(w + (size_t)(wave * 128 + kb + kk) * 6144);
#pragma unroll
                for (int kk = 0; kk < 32; ++kk) { const int k = wave * 128 + kb + kk;
                    a0 += cond[k] * wv[kk]; a1 += cond[D + k] * wv[kk]; a2 += cond[2 * D + k] * wv[kk]; a3 += cond[3 * D + k] * wv[kk]; a4 += cond[4 * D + k] * wv[kk]; } }
            red[(wave * 5 + 0) * 64 + lane] = a0; red[(wave * 5 + 1) * 64 + lane] = a1; red[(wave * 5 + 2) * 64 + lane] = a2;
            red[(wave * 5 + 3) * 64 + lane] = a3; red[(wave * 5 + 4) * 64 + lane] = a4;
            __syncthreads();
            if (tid < 320) { const int bi = tid / 64, jj = tid % 64; float s = 0.f;
#pragma unroll
                for (int w8 = 0; w8 < 8; ++w8) s += red[(w8 * 5 + bi) * 64 + jj];
                const int col = (u % 96) * 64 + jj;
                WSP(float, WS_MOD)[((size_t)l * 5 + bi) * 6144 + col] = s + FIN(5)[l * 6144 + col]; }
            __syncthreads();
        }
    }
    const int gt = F.bid * NTHREADS + tid, NGT = F.G * NTHREADS;
    for (int i = gt; i < 128 * 16; i += NGT) { const int pos = i / 16, f = i % 16; const float inv = powf(10000.0f, -(float)f / 16.0f); const float a = (float)pos * inv;
        WSP(float, WS_ROPE)[i] = cosf(a); WSP(float, WS_ROPE)[2048 + i] = sinf(a); }
    for (int i = gt; i < DEPTH * 2 * 16 * 65 * 64; i += NGT) {
        const int p = i % 64, d = (i / 64) % 65, ldg = i / (64 * 65);
        const float are = fminf(FIN(10)[ldg * 64 + p], -1e-4f), aim = FIN(11)[ldg * 64 + p];
        const float step = expf(FIN(12)[ldg]);
        const float re = are * step * (float)d, im = aim * step * (float)d;
        const float mag = expf(re);
        WSP(f32x2, WS_LP)[i] = (f32x2){mag * cosf(im), mag * sinf(im)};
    }
    for (int i = gt; i < DEPTH * 2 * 16 * 64 * 16; i += NGT) {
        const int lp = i / 16;
        const int ldg = lp / 64;
        const float are = fminf(FIN(10)[lp], -1e-4f), aim = FIN(11)[lp];
        const float step = expf(FIN(12)[ldg]);
        const float mag = expf(are * step), lr = mag * cosf(aim * step) - 1.0f, li = mag * sinf(aim * step);
        const float den = are * are + aim * aim;
        const float qr = (lr * are + li * aim) / den, qi = (li * are - lr * aim) / den;
        const float br = FIN(13)[i], bi = FIN(14)[i];
        WSP(f32x2, WS_BBAR)[i] = (f32x2){qr * br - qi * bi, qr * bi + qi * br};
    }
}

__device__ __forceinline__ f32x2 cmul(f32x2 a, f32x2 b) { return (f32x2){a.x * b.x - a.y * b.y, a.x * b.y + a.y * b.x}; }
__device__ __forceinline__ void phase_p0b(KArgs A, Frame& F) {
    PH_LOCALS;
    const f32x2* LP = WSP(f32x2, WS_LP); const f32x2* BB = WSP(f32x2, WS_BBAR);
    LAS float* kc = (LAS float*)F.lds;
    for (int it = F.bid; it < DEPTH * 16 * 4; it += F.G) {
        const int qr = it & 3, lg = it >> 2, l = lg >> 4, g = lg & 15;
        for (int i = tid; i < 128 * 64; i += NTHREADS) kc[i] = 0.f;
        __syncthreads();
        {
            const int pq = tid & 3, hi = (tid >> 2) & 15, hol = (tid >> 6) & 3, dir = tid >> 8, ho = 4 * qr + hol;
            const int ldg = (l * 2 + dir) * 16 + g;
            const float* cre = FIN(15) + ((size_t)ldg * 16 + ho) * 64; const float* cim = FIN(16) + ((size_t)ldg * 16 + ho) * 64;
            float acc[64];
#pragma unroll
            for (int d = 0; d < 64; ++d) acc[d] = 0.f;
#pragma unroll 1
            for (int pp = 0; pp < 16; ++pp) { const int p = 16 * pq + pp;
                f32x2 z = cmul((f32x2){cre[p], cim[p]}, BB[(size_t)ldg * 1024 + p * 16 + hi]);
                const f32x2 lam = LP[((size_t)ldg * 65 + 1) * 64 + p];
#pragma unroll
                for (int d = 0; d < 64; ++d) { acc[d] += z.x; z = cmul(z, lam); }
            }
            const int R = (dir * 4 + hol) * 16 + hi;
#pragma unroll
            for (int d = 0; d < 64; ++d) (void)__hip_atomic_fetch_add(kc + R * 64 + ((d + R) & 63), acc[d], __ATOMIC_RELAXED, __HIP_MEMORY_SCOPE_WORKGROUP);
        }
        __syncthreads();
        {
            bf16_t* KC = WSP(bf16_t, WS_KC) + (size_t)lg * 1024 * SUXW;
            const int s = lane;
#pragma unroll 1
            for (int rr = 0; rr < 32; ++rr) {
                const int r = wave * 32 + rr, t = r >> 2, hol = r & 3, ho = 4 * qr + hol;
                const float dsk = FIN(17)[l * 256 + g * 16 + ho];
                float v[16];
#pragma unroll
                for (int hi = 0; hi < 16; ++hi) {
                    const int R0 = (0 * 4 + hol) * 16 + hi, R1 = (1 * 4 + hol) * 16 + hi; const int dd = (s < t) ? t - s : s - t;
                    const float a0 = kc[R0 * 64 + ((dd + R0) & 63)], a1 = kc[R1 * 64 + ((dd + R1) & 63)];
                    v[hi] = (s < t) ? a0 : (s > t) ? a1 : (a0 + a1 + ((hi == ho) ? dsk : 0.f));
                }
                bf16_t* dst = KC + (size_t)(t * 16 + ho) * SUXW + s * 16;
                *(u32x4*)dst = pack8(v); *(u32x4*)(dst + 8) = pack8(v + 8);
                const int q4 = lane >> 4, dir = q4 >> 1, ri = q4 & 1, p0 = 4 * (lane & 15);
                const int ldg = (l * 2 + dir) * 16 + g, e = dir ? 64 - t : t + 1;
                float cv[4];
#pragma unroll
                for (int j = 0; j < 4; ++j) { const int p = p0 + j; const f32x2 c = (f32x2){FIN(15)[((size_t)ldg * 16 + ho) * 64 + p], FIN(16)[((size_t)ldg * 16 + ho) * 64 + p]};
                    const f32x2 w = cmul(c, LP[((size_t)ldg * 65 + e) * 64 + p]); cv[j] = ri ? -w.y : w.x; }
                *(u32x2*)(KC + (size_t)(t * 16 + ho) * SUXW + 1024 + q4 * 64 + p0) = (u32x2){cvt_pk_bf16(cv[0], cv[1]), cvt_pk_bf16(cv[2], cv[3])};
            }
        }
        {
            bf16_t* WT = WSP(bf16_t, WS_WST) + (size_t)lg * 256 * 1024;
            const int s = lane;
#pragma unroll 1
            for (int rr = 0; rr < 8; ++rr) {
                const int n = 64 * qr + wave * 8 + rr, dir = n >> 7, ri = (n >> 6) & 1, p = n & 63;
                const int ldg = (l * 2 + dir) * 16 + g, e = dir ? s : 63 - s;
                const f32x2 lp = LP[((size_t)ldg * 65 + e) * 64 + p];
                float v[16];
#pragma unroll
                for (int hi = 0; hi < 16; ++hi) { const f32x2 w = cmul(lp, BB[(size_t)ldg * 1024 + p * 16 + hi]); v[hi] = ri ? w.y : w.x; }
                bf16_t* dst = WT + (size_t)n * 1024 + s * 16;
                *(u32x4*)dst = pack8(v); *(u32x4*)(dst + 8) = pack8(v + 8);
            }
        }
        __syncthreads();
    }
}

__device__ __forceinline__ void build_tstart(KArgs A, Frame& F, int l) {
    PH_LOCALS;
    LAS int* ts = (LAS int*)(F.lds + LDS_MISC + 64);
    if (tid == 0) { const int* cnt = (const int*)A->ws + CW_CNT + l * 32; int a = 0;
        for (int e = 0; e < 32; ++e) { ts[e] = a; ts[40 + e] = cnt[e]; a += (cnt[e] + 255) >> 8; }
        ts[32] = a; }
    __syncthreads();
    if (tid < 32) { LAS int* t2e = (LAS int*)(F.lds + LDS_T2E); for (int mt = ts[tid]; mt < ts[tid + 1]; ++mt) t2e[mt] = tid; }
    __syncthreads();
}

template <int NR>
__device__ __forceinline__ void norm1_rows(KArgs A, const LAS int* ts, const LAS float* mv, const int l, const int lane_, const int (&rows)[NR]) {
    int lane = lane_; asm volatile("" : "+v"(lane));
    const bool fin = (l == DEPTH);
    bf16_t* XR = WSP(bf16_t, WS_XR);
    f32x4 v[NR][4];
    int bi[NR];
#pragma unroll
    for (int q = 0; q < NR; ++q) bi[q] = (rows[q] < NLAT) ? (rows[q] / SEQ) : 4;
    if (l == 0) {
#pragma unroll
        for (int q = 0; q < NR; ++q) { const int r = rows[q]; const float* src = (r < NLAT) ? (FIN(0) + (size_t)r * D) : (FIN(2) + (size_t)(r - NLAT) * D);
#pragma unroll
            for (int j = 0; j < 4; ++j) v[q][j] = *(const f32x4*)(src + 4 * lane + 256 * j); }
    } else {
        int inf[NR][4]; float wk[NR][4];
#pragma unroll
        for (int q = 0; q < NR; ++q) { const v4i t4 = *(const v4i*)(WSP(int, WS_TOKINFO) + (size_t)rows[q] * 4); const f32x4 w4 = *(const f32x4*)(WSP(float, WS_TOKW) + (size_t)rows[q] * 4);
#pragma unroll
            for (int k = 0; k < 4; ++k) { inf[q][k] = t4[k]; wk[q][k] = w4[k]; } }
        unsigned ew[NR][4][4];
#pragma unroll
        for (int q = 0; q < NR; ++q) {
#pragma unroll
            for (int j = 0; j < 4; ++j) v[q][j] = bf4_to_f32(*(const u32x2*)(XR + (size_t)rows[q] * D + 4 * lane + 256 * j));
#pragma unroll
            for (int k = 0; k < 4; ++k) { const int e = (inf[q][k] >> 24) & 31, rank = inf[q][k] & 0xffffff; const unsigned char* eo = WSP(unsigned char, WS_EO) + ((size_t)ts[e] * 256 + rank) * D;
#pragma unroll
                for (int j = 0; j < 4; ++j) ew[q][k][j] = *(const unsigned*)(eo + 4 * lane + 256 * j); } }
#pragma unroll
        for (int q = 0; q < NR; ++q) {
            f32x4 a[4];
#pragma unroll
            for (int j = 0; j < 4; ++j) a[j] = (f32x4){0.f, 0.f, 0.f, 0.f};
#pragma unroll
            for (int k = 0; k < 4; ++k) { const float w1 = wk[q][k] * (1.0f / FP8_SE);
#pragma unroll
                for (int j = 0; j < 4; ++j) { const int w = (int)ew[q][k][j];
                    const f32x2 lo = __builtin_amdgcn_cvt_pk_f32_fp8(w, false), hi = __builtin_amdgcn_cvt_pk_f32_fp8(w, true);
                    a[j].x += w1 * lo.x; a[j].y += w1 * lo.y; a[j].z += w1 * hi.x; a[j].w += w1 * hi.y; } }
            const LAS float* m5 = mv + bi[q] * D + 4 * lane;
#pragma unroll
            for (int j = 0; j < 4; ++j) { const f32x4 g5 = *(const LAS f32x4*)(m5 + 256 * j); v[q][j] = v[q][j] + g5 * a[j]; }
        }
    }
    float ss[NR];
#pragma unroll
    for (int q = 0; q < NR; ++q) {
        if (!fin) {
#pragma unroll
            for (int j = 0; j < 4; ++j) *(u32x2*)(XR + (size_t)rows[q] * D + 4 * lane + 256 * j) = f32_to_bf4(v[q][j]);
        }
        ss[q] = 0.f;
#pragma unroll
        for (int j = 0; j < 4; ++j) ss[q] += (v[q][j].x * v[q][j].x + v[q][j].y * v[q][j].y) + (v[q][j].z * v[q][j].z + v[q][j].w * v[q][j].w);
    }
#pragma unroll
    for (int o = 1; o < 64; o <<= 1) {
#pragma unroll
        for (int q = 0; q < NR; ++q) ss[q] += __builtin_bit_cast(float, __builtin_amdgcn_ds_bpermute((lane ^ o) << 2, __builtin_bit_cast(int, ss[q]))); }
#pragma unroll
    for (int q = 0; q < NR; ++q) {
        const int r = rows[q];
        const float rinv = 1.0f / sqrtf(ss[q] * (1.0f / D) + RMS_EPS);
        if (fin) {
            float pscale = 1.0f;
#if PROBE_SEL >= 0
            { const unsigned* st = (const unsigned*)A->ws + CW_STAT; const float n = fmaxf((float)st[3], 1.0f);
              float val = (PROBE_SEL == 0) ? (float)st[0] / n * 5e-4f : (PROBE_SEL == 4) ? (float)st[0] / n * 4e-4f : (PROBE_SEL == 1) ? (float)st[1] / n * 1e-2f : (PROBE_SEL == 2) ? (float)st[2] / n * 1e-2f : (float)st[3];
              val = fminf(fmaxf(rintf(val), 0.0f), 300.0f); pscale = 1.0f + sqrtf(val * 1e-3f); }
#endif
#pragma unroll
            for (int j = 0; j < 4; ++j) { const f32x4 g = *(const LAS f32x4*)(mv + 5 * D + 4 * lane + 256 * j); *(f32x4*)(A->out + (size_t)r * D + 4 * lane + 256 * j) = v[q][j] * rinv * g * pscale; }
        } else {
            const LAS float* ga = mv + (5 + bi[q]) * D;
            unsigned char* hrow = WSP(unsigned char, WS_H8) + (size_t)r * P8;
#pragma unroll
            for (int j = 0; j < 4; ++j) { const int c = 4 * lane + 256 * j; const f32x4 g = *(const LAS f32x4*)(ga + c), sh = *(const LAS f32x4*)(ga + 5 * D + c);
                const f32x4 h = v[q][j] * rinv * g + sh;
                *(unsigned*)(hrow + c) = pk4_fp8(h.x * FP8_SH, h.y * FP8_SH, h.z * FP8_SH, h.w * FP8_SH); }
        }
    }
}
__device__ __forceinline__ void phase_norm1(KArgs A, Frame& F, int l, const float dsc = 1.0f) {
    PH_LOCALS;
    const int nrows = (l == DEPTH) ? NLAT : TT;
    if (l > 0) build_tstart(A, F, l - 1);
    const LAS int* ts = (const LAS int*)(F.lds + LDS_MISC + 64);
    LAS float* mv = (LAS float*)F.lds;
    {   const float* MOD = WSP(float, WS_MOD);
        for (int i = tid; i < 5 * D; i += NTHREADS) { const int b = i >> 10, c = i & (D - 1);
            mv[i] = (l > 0) ? MOD[((size_t)(l - 1) * 5 + b) * 6144 + 5 * D + c] * dsc : 0.f;
            if (l < DEPTH) { const float* m0 = MOD + ((size_t)l * 5 + b) * 6144; mv[5 * D + i] = FIN(6)[(size_t)l * D + c] * (m0[D + c] + 1.0f); mv[10 * D + i] = m0[c]; }
            else mv[5 * D + i] = FIN(28)[c]; }
        __syncthreads(); }
    const int gw = F.bid * NWAVES + wave, NGW = F.G * NWAVES;
    int r = gw;
    for (; r + NGW < nrows; r += 2 * NGW) { const int rows[2] = {r, r + NGW}; norm1_rows<2>(A, ts, mv, l, lane, rows); }
    for (; r < nrows; r += NGW) { const int rows[1] = {r}; norm1_rows<1>(A, ts, mv, l, lane, rows); }
}

__device__ __forceinline__ void phase_router(KArgs A, Frame& F, int l, const bool dry = false) {
    PH_LOCALS;
    const int nrows = (l == DEPTH - 1) ? NLAT : TT;
    LAS bf16_t* tile = (LAS bf16_t*)F.lds;
    LAS float* part = (LAS float*)(F.lds + 32 * 1032 * 2);
    LAS float* logit = part + 8 * 32 * 33;
    LAS int* lcnt = (LAS int*)(logit + 32 * 33);
    const float* MOD = WSP(float, WS_MOD);
    bf16_t* XR = WSP(bf16_t, WS_XR);
    const bf16_t* WRT = WSP(bf16_t, WS_WRT) + (size_t)l * NEXP * D;
    int* cnt = (int*)A->ws + CW_CNT + l * 32 + (dry ? 128 : 0);
    int* elist = dry ? (int*)WSP(float, WS_ELW) : WSP(int, WS_ELIST);
    const float dsc = dry ? 0.0f : 1.0f;
    LAS float* rv = (LAS float*)(F.lds + 104448);
    const int nunits = nrows / 32; const bool contig = (F.G == 256);
    int cur_b = -1;
    bf16x8 bw[8];
#pragma unroll
    for (int s = 0; s < 8; ++s) bw[s] = *(const bf16x8*)(WRT + (size_t)(lane & 31) * D + wave * 128 + 16 * s + 8 * (lane >> 5));
    for (int k = 0;; ++k) {
        int u;
        if (contig) { if (k < 4) u = 4 * F.bid + k; else if (k == 4 && F.bid < 32 && nunits > 1024) u = 1024 + F.bid; else break; }
        else { u = F.bid + k * F.G; if (u >= nunits) break; }
        const int r0 = u * 32;
        const int bi = (r0 < NLAT) ? (r0 / SEQ) : 4;
        if (bi != cur_b) {
            const float* m2 = MOD + ((size_t)l * 5 + bi) * 6144 + 2 * D; const float* gm = FIN(21) + (size_t)l * D;
            for (int i = tid; i < D; i += NTHREADS) { rv[D + i] = gm[i] * (m2[2 * D + i] + 1.0f); rv[2 * D + i] = m2[D + i]; }
            __syncthreads(); cur_b = bi; }
        {
            const int rb = r0 + wave * 4;
            f32x4 v[4][4];
#pragma unroll
            for (int q = 0; q < 4; ++q)
#pragma unroll
                for (int j = 0; j < 4; ++j) { const int c = 4 * lane + 256 * j; v[q][j] = bf4_to_f32(*(const u32x2*)(XR + (size_t)(rb + q) * D + c)); }
            float ss[4];
#pragma unroll
            for (int q = 0; q < 4; ++q) { ss[q] = 0.f;
#pragma unroll
                for (int j = 0; j < 4; ++j) {
                    ss[q] += (v[q][j].x * v[q][j].x + v[q][j].y * v[q][j].y) + (v[q][j].z * v[q][j].z + v[q][j].w * v[q][j].w); } }
#pragma unroll
            for (int o = 1; o < 64; o <<= 1) {
#pragma unroll
                for (int q = 0; q < 4; ++q) ss[q] += __builtin_bit_cast(float, __builtin_amdgcn_ds_bpermute((lane ^ o) << 2, __builtin_bit_cast(int, ss[q]))); }
#pragma unroll
            for (int q = 0; q < 4; ++q) { const float rinv = 1.0f / sqrtf(ss[q] * (1.0f / D) + RMS_EPS);
                unsigned char* hrow = WSP(unsigned char, WS_H8) + (size_t)(rb + q) * P8;
#pragma unroll
                for (int j = 0; j < 4; ++j) { const int c = 4 * lane + 256 * j; const f32x4 g = *(const LAS f32x4*)(rv + D + c), sh = *(const LAS f32x4*)(rv + 2 * D + c);
                    const f32x4 h = v[q][j] * rinv * g + sh;
                    u32x2 o; o.x = pk2(h.x, h.y); o.y = pk2(h.z, h.w); *(LAS u32x2*)(tile + (wave * 4 + q) * 1032 + c) = o;
                    *(unsigned*)(hrow + c) = pk4_fp8(h.x * FP8_SH, h.y * FP8_SH, h.z * FP8_SH, h.w * FP8_SH); } }
        }
        if (tid < 32) lcnt[tid] = 0;
        __syncthreads();
        {
            f32x16 acc;
#pragma unroll
            for (int i = 0; i < 16; ++i) acc[i] = 0.f;
            const int rr = lane & 31, hh = lane >> 5;
#pragma unroll
            for (int s = 0; s < 8; ++s) { const bf16x8 a = *(const LAS bf16x8*)(tile + rr * 1032 + wave * 128 + 16 * s + 8 * hh);
                acc = __builtin_amdgcn_mfma_f32_32x32x16_bf16(a, bw[s], acc, 0, 0, 0); }
#pragma unroll
            for (int i = 0; i < 16; ++i) { const int tok = (i & 3) + 8 * (i >> 2) + 4 * hh; part[(wave * 32 + tok) * 33 + rr] = acc[i]; }
        }
        __syncthreads();
        for (int i = tid; i < 1024; i += NTHREADS) { const int tok = i >> 5, e = i & 31; float s = FIN(23)[l * 32 + e];
#pragma unroll
            for (int w = 0; w < 8; ++w) s += part[(w * 32 + tok) * 33 + e];
            logit[tok * 33 + e] = s; }
        __syncthreads();
        if (wave == 0) {
            const int t = lane & 31, r = r0 + t; const bool act = lane < 32;
            float lg[32];
#pragma unroll
            for (int e = 0; e < 32; ++e) lg[e] = logit[t * 33 + e];
            float lv[4]; int le[4];
#pragma unroll
            for (int k = 0; k < 4; ++k) { float best = -3.0e38f; int be = 0;
#pragma unroll
                for (int e = 0; e < 32; ++e) { const bool gt = lg[e] > best; best = gt ? lg[e] : best; be = gt ? e : be; }
#pragma unroll
                for (int e = 0; e < 32; ++e) lg[e] = (e == be) ? -3.0e38f : lg[e];
                lv[k] = best; le[k] = be; }
            const float e1 = __expf(lv[1] - lv[0]), e2 = __expf(lv[2] - lv[0]), e3 = __expf(lv[3] - lv[0]); const float inv = 1.0f / (1.0f + e1 + e2 + e3);
            const float wk[4] = {inv, e1 * inv, e2 * inv, e3 * inv};
            int lr[4];
#pragma unroll
            for (int k = 0; k < 4; ++k) lr[k] = act ? __hip_atomic_fetch_add(lcnt + le[k], 1, __ATOMIC_RELAXED, __HIP_MEMORY_SCOPE_WORKGROUP) : 0;
            asm volatile("s_waitcnt lgkmcnt(0)" ::: "memory");
            if (act) { const int c = lcnt[t]; const int base = c ? atomicAdd(&cnt[t], c) : 0; lcnt[32 + t] = base; }
            asm volatile("s_waitcnt vmcnt(0) lgkmcnt(0)" ::: "memory");
            if (act) {
                int* ti = WSP(int, WS_TOKINFO) + (size_t)r * 4;
#pragma unroll
                for (int k = 0; k < 4; ++k) { const int rank = lcnt[32 + le[k]] + lr[k];
                    elist[(size_t)le[k] * TT + rank] = r; if (!dry) { WSP(float, WS_TOKW)[(size_t)r * 4 + k] = wk[k]; ti[k] = (le[k] << 24) | rank; } }
            }
        }
    }
    __syncthreads();
}

__device__ __forceinline__ void phase_s5scan(KArgs A, Frame& F, int l) {
    PH_LOCALS;
    const int gw = F.bid * NWAVES + wave, NGW = F.G * NWAVES;
    const float* SL = WSP(float, WS_SLOC);
    for (int it = gw; it < NBATCH * 16 * 2; it += NGW) {
        const int dir = it & 1, g = (it >> 1) & 15, b = it >> 5;
        const int ldg = (l * 2 + dir) * 16 + g;
        const f32x2 L64 = WSP(f32x2, WS_LP)[((size_t)ldg * 65 + 64) * 64 + lane];
        bf16_t* sux = WSP(bf16_t, WS_SUX) + (size_t)g * MCH * SUXW;
        float xr = 0.f, xi = 0.f;
#pragma unroll 4
        for (int step = 0; step < 132; ++step) {
            int ch;
            if (step < 4) ch = 512 + 4 * b + (dir ? 3 - step : step);
            else ch = 128 * b + (dir ? 127 - (step - 4) : (step - 4));
            const float sr = SL[(size_t)ch * 4096 + g * 256 + dir * 128 + lane], si = SL[(size_t)ch * 4096 + g * 256 + dir * 128 + 64 + lane];
            bf16_t* o = sux + (size_t)ch * SUXW + 1024 + dir * 128;
            o[lane] = (unsigned short)f2bf(xr); o[64 + lane] = (unsigned short)f2bf(xi);
            const float nr = L64.x * xr - L64.y * xi + sr, ni = L64.x * xi + L64.y * xr + si;
            xr = nr; xi = ni;
        }
    }
}

constexpr float LOG2E = 1.4426950408889634f;
__device__ __forceinline__ float xhalf_max(float x) { const unsigned xu = __builtin_bit_cast(unsigned, x); const auto r = __builtin_amdgcn_permlane32_swap(xu, xu, false, false);
    const unsigned a = r[0], b = r[1]; return fmaxf(__builtin_bit_cast(float, a), __builtin_bit_cast(float, b)); }
__device__ __forceinline__ float xhalf_sum(float x) { const unsigned xu = __builtin_bit_cast(unsigned, x); const auto r = __builtin_amdgcn_permlane32_swap(xu, xu, false, false);
    const unsigned a = r[0], b = r[1]; return __builtin_bit_cast(float, a) + __builtin_bit_cast(float, b); }
constexpr int AT_STEP = 32768;
constexpr int AT_RPB = LDS_ROPE;
__device__ __forceinline__ void attn_stage(const bf16_t* P, const bf16_t* VT, LAS unsigned char* lds, int slot, int ktok0, int kcol, int vrow, int lane, int wave) {
    LAS unsigned char* base = lds + slot * AT_STEP + wave * 1024;
#pragma unroll
    for (int j = 0; j < 2; ++j) {
        const int dc = 4 * j + (wave >> 1), key = (wave & 1) * 64 + lane;
        __builtin_amdgcn_global_load_lds((const unsigned*)(P + (size_t)(ktok0 + key) * PW + kcol + 8 * dc), (LAS unsigned*)(base + j * 8192), 16, 0, 0);
    }
#pragma unroll
    for (int j = 0; j < 2; ++j) {
        const int q = 8 * j + wave;
        __builtin_amdgcn_global_load_lds((const unsigned*)(VT + (size_t)(vrow + lane) * TT + ktok0 + 8 * q), (LAS unsigned*)(base + 16384 + j * 8192), 16, 0, 0);
    }
}
__device__ __forceinline__ void attn_tile(const int mm, const LAS unsigned char* kt_, const LAS unsigned char* vt_, const bf16x8 (&qf)[4], f32x16& O0, f32x16& O1, f32x16& negm, float& lsum,
                                          const LAS float* bptr, unsigned vmask, int dbase) {
    bf16x8 kf[4];
#pragma unroll
    for (int q = 0; q < 4; ++q) kf[q] = *(const LAS bf16x8*)(kt_ + q * 2048);
    bf16x8 vf[2][2];
#pragma unroll
    for (int mt = 0; mt < 2; ++mt)
#pragma unroll
        for (int s2 = 0; s2 < 2; ++s2) vf[mt][s2] = *(const LAS bf16x8*)(vt_ + s2 * 1024 + mt * 512);
    f32x16 sa = __builtin_amdgcn_mfma_f32_32x32x16_bf16(kf[0], qf[0], negm, 0, 0, 0);
#pragma unroll
    for (int q = 1; q < 4; ++q) sa = __builtin_amdgcn_mfma_f32_32x32x16_bf16(kf[q], qf[q], sa, 0, 0, 0);
    float sv[16];
#pragma unroll
    for (int i = 0; i < 16; ++i) sv[i] = sa[i];
    if (mm == 1) {
#pragma unroll
        for (int i = 0; i < 16; ++i) { const float x = sv[i] + bptr[(i & 3) + 8 * (i >> 2)]; sv[i] = ((vmask >> i) & 1u) ? x : -3.0e38f; }
    } else if (mm == 2) {
#pragma unroll
        for (int i = 0; i < 16; ++i) { const int dpos = dbase - ((i & 3) + 8 * (i >> 2)); sv[i] = (dpos <= 128 && dpos >= -128) ? sv[i] : -3.0e38f; }
    }
    float tmax = fmaxf(fmaxf(fmaxf(sv[0], sv[1]), fmaxf(sv[2], sv[3])), fmaxf(fmaxf(sv[4], sv[5]), fmaxf(sv[6], sv[7])));
    tmax = fmaxf(tmax, fmaxf(fmaxf(fmaxf(sv[8], sv[9]), fmaxf(sv[10], sv[11])), fmaxf(fmaxf(sv[12], sv[13]), fmaxf(sv[14], sv[15]))));
    tmax = xhalf_max(tmax);
    if (__any(tmax > 8.0f)) {
        const float d = (tmax > 8.0f) ? tmax : 0.f; const float alpha = fast_exp2(-d);
        lsum *= alpha;
#pragma unroll
        for (int i = 0; i < 16; ++i) { O0[i] *= alpha; O1[i] *= alpha; sv[i] -= d; negm[i] -= d; }
    }
    float psum = 0.f;
#pragma unroll
    for (int i = 0; i < 16; ++i) { const float p = fast_exp2(sv[i]); psum += p; sv[i] = p; }
    lsum += xhalf_sum(psum);
#pragma unroll
    for (int s2 = 0; s2 < 2; ++s2) {
        u32x4 pw; pw.x = cvt_pk_bf16(sv[8 * s2 + 0], sv[8 * s2 + 1]); pw.y = cvt_pk_bf16(sv[8 * s2 + 2], sv[8 * s2 + 3]); pw.z = cvt_pk_bf16(sv[8 * s2 + 4], sv[8 * s2 + 5]); pw.w = cvt_pk_bf16(sv[8 * s2 + 6], sv[8 * s2 + 7]);
        const bf16x8 pf = __builtin_bit_cast(bf16x8, pw);
        O0 = __builtin_amdgcn_mfma_f32_32x32x16_bf16(vf[0][s2], pf, O0, 0, 0, 0);
        O1 = __builtin_amdgcn_mfma_f32_32x32x16_bf16(vf[1][s2], pf, O1, 0, 0, 0);
    }
}
__device__ __forceinline__ void phase_attn(KArgs A, Frame& F, int l, const int part) {
    PH_LOCALS;
    LAS unsigned char* lds = F.lds;
    LAS float* rpb = (LAS float*)(lds + AT_RPB);
    for (int i = tid; i < 6 * 465; i += NTHREADS) rpb[i] = FIN(9)[(size_t)l * 6 * 465 + i] * LOG2E;
    __syncthreads();
    const bf16_t* P = WSP(bf16_t, WS_P); const bf16_t* VT = WSP(bf16_t, WS_VT);
    const int r = lane & 31, hh = lane >> 5;
    const int ngroups = 1536 + ((l < DEPTH - 1) ? 48 : 0);
    const bool std_grid = (F.G == 256);
    for (int k = 0;; ++k) {
        int gi;
        if (!std_grid) { gi = F.bid + k * F.G; if (part == 1 || gi >= ngroups) { if (part == 1) break; if (gi >= ngroups) break; } }
        else if (part == 0) {
            const int c = F.bid;
            if (c < 16) { if (k < 2) gi = 256 * k + c; else if (k < 5) gi = 768 + 576 + c + 16 * (k - 2); else break; }
            else if (c < 48) { if (k < 3) gi = 256 * k + c; else if (k < 6) gi = 768 + 624 + (c - 16) + 32 * (k - 3); else break; }
            else if (c < 64) { if (k < 3) gi = 256 * k + c; else if (k == 3) gi = 512 + (c - 48); else if (k < 7) gi = 768 + 720 + (c - 48) + 16 * (k - 4); else break; }
            else { if (k < 2) gi = 256 * k + c; else if (k == 2) gi = 768 + (c - 64); else break; } }
        else {
            const int c = F.bid;
            if (c < 64) break;
            if (k == 0) gi = 512 + c;
            else if (k < 3) gi = 768 + (c - 64) + 192 * k;
            else if (k == 3 && c >= 196 && c < 244 && ngroups > 1536) gi = 1536 + (c - 196);
            else break; }
        int mode, b, head, r0 = 0, qt0 = 0;
        if (gi < 768) { mode = 0; r0 = 4 * (gi & 31); const int bh = gi >> 5; head = bh % 6; b = bh / 6; }
        else if (gi < 1536) { mode = 1; const int g2 = gi - 768; qt0 = 8 * (g2 & 31); const int bh = g2 >> 5; head = bh % 6; b = bh / 6; }
        else { const int g2 = gi - 1536; mode = 2 + g2 / 24; const int bh = g2 % 24; head = bh % 6; b = bh / 6; }
        const bool na = (mode == 0 || mode == 2);
        const int qcol = na ? 64 * head : 768 + 64 * head, kcol = na ? 384 + 64 * head : 1152 + 64 * (head / 3);
        const int vrow = na ? 64 * head : 384 + 64 * (head / 3), ycol = na ? 64 * head : 640 + 64 * head;
        int qtok0, qrow = 0, mh = 0, qt = 0;
        if (mode == 0) { qrow = r0 + (wave >> 1); mh = wave & 1; qtok0 = b * SEQ + qrow * 64 + 32 * mh; }
        else if (mode == 1) { qt = qt0 + wave; qtok0 = b * SEQ + 32 * qt; }
        else qtok0 = NLAT + b * CTXL + 32 * wave;
        const int rsw = min(max(qrow - 4, 0), 120);
        const int qc = 32 * mh + r, wsn = min(max(qc - 8, 0), 48);
        const int qpos = 32 * qt + r;
        unsigned vmask0 = 0u, vmask1 = 0u;
#pragma unroll
        for (int i = 0; i < 16; ++i) { const int ki = (i & 3) + 8 * (i >> 2) + 4 * hh; vmask0 |= ((ki >= wsn && ki < wsn + 16) ? 1u : 0u) << i; vmask1 |= ((32 + ki >= wsn && 32 + ki < wsn + 16) ? 1u : 0u) << i; }
        int nlat = 0, kbase = 0, kofs = 0;
        if (mode == 0) { const int kra = min(max(r0 - 4, 0), 120), krb = min(max(r0 - 1, 0), 120) + 7; kbase = kra >> 1; kofs = (kra & 1) * 64; nlat = (krb - kra + 2) >> 1; }
        else if (mode == 1) { const int ks0 = max(qt0 - 4, 0) >> 2, ks1 = min(qt0 + 11, 255) >> 2; kbase = ks0; nlat = ks1 - ks0 + 1; }
        const int nsteps = nlat + 2;
        const int lat0 = b * SEQ + 128 * kbase + kofs, ctx0 = NLAT + b * CTXL;
        float lsum = na ? 0.f : fast_exp2(FIN(20)[l * 6 + head] * LOG2E);
        f32x16 negm;
#pragma unroll
        for (int i = 0; i < 16; ++i) negm[i] = 0.f;
        bf16x8 qf[4];
#pragma unroll
        for (int s = 0; s < 4; ++s) qf[s] = *(const bf16x8*)(P + (size_t)(qtok0 + r) * PW + qcol + 32 * hh + 8 * s);
        f32x16 O0, O1;
#pragma unroll
        for (int i = 0; i < 16; ++i) { O0[i] = 0.f; O1[i] = 0.f; }
        __builtin_amdgcn_s_barrier();
        attn_stage(P, VT, lds, 2, ctx0, kcol, vrow, lane, wave);
        attn_stage(P, VT, lds, 3, ctx0 + 128, kcol, vrow, lane, wave);
        if (nlat > 0) attn_stage(P, VT, lds, 0, lat0, kcol, vrow, lane, wave);
        else { asm volatile("s_waitcnt vmcnt(0)" ::: "memory"); __builtin_amdgcn_s_barrier(); }
        int cdone = 0;
        for (int s = 0; s < nlat || cdone < 8; ++s) {
            const bool lat = (s < nlat);
            if (lat) {
                asm volatile("s_waitcnt vmcnt(0)" ::: "memory");
                __builtin_amdgcn_s_barrier();
                if (s + 1 < nlat) attn_stage(P, VT, lds, (s + 1) & 1, lat0 + 128 * (s + 1), kcol, vrow, lane, wave);
            }
            int tl = 0;
#pragma unroll 1
            for (int it = 0; it < 4; ++it) {
                int kr = 0, ct = 0, kt = 0, dt = 0; bool have = false;
                if (lat) {
                    for (; tl < 4; ++tl) {
                        kr = 2 * (kbase + s) + (kofs >> 6) + (tl >> 1); ct = tl & 1; kt = 4 * (kbase + s) + tl; dt = kt - qt; dt = dt < 0 ? -dt : dt;
                        if (mode == 0 ? (kr >= rsw && kr <= rsw + 7) : (dt <= 4)) { have = true; break; }
                    }
                }
                int slot, tt, mm;
                if (have) { slot = s & 1; tt = tl; mm = (mode == 1 && dt < 4) ? 0 : (mode == 0 ? 1 : 2); ++tl; }
                else if (cdone < 8) { slot = 2 + (cdone >> 2); tt = cdone & 3; mm = 0; ++cdone; }
                else break;
                const LAS unsigned char* kb = lds + slot * AT_STEP; const LAS unsigned char* vb = kb + 16384;
                const LAS unsigned char* kt_ = kb + ((4 * hh) * 128 + 32 * tt + r) * 16;
                const LAS unsigned char* vt_ = vb + ((tt * 4 + hh * 2) * 64 + r) * 16;
                attn_tile(mm, kt_, vt_, qf, O0, O1, negm, lsum, rpb + head * 465 + (kr - qrow + 7) * 31 + (32 * ct + 4 * hh - qc + 15), ct ? vmask1 : vmask0, qpos - 32 * kt - 4 * hh);
            }
        }
        const float inv = FP8_SY / lsum;
        unsigned char* yrow = WSP(unsigned char, WS_Y) + (size_t)(qtok0 + r) * P8 + ycol + 16 * hh;
#pragma unroll
        for (int ob = 0; ob < 2; ++ob) {
            unsigned w[4];
#pragma unroll
            for (int rg = 0; rg < 4; ++rg) w[rg] = ob ? pk4_fp8(O1[4 * rg + 0] * inv, O1[4 * rg + 1] * inv, O1[4 * rg + 2] * inv, O1[4 * rg + 3] * inv)
                                                      : pk4_fp8(O0[4 * rg + 0] * inv, O0[4 * rg + 1] * inv, O0[4 * rg + 2] * inv, O0[4 * rg + 3] * inv);
            const auto r01 = __builtin_amdgcn_permlane32_swap(w[0], w[1], false, false); const unsigned p0x = r01[0], p0y = r01[1];
            const auto r23 = __builtin_amdgcn_permlane32_swap(w[2], w[3], false, false); const unsigned p1x = r23[0], p1y = r23[1];
            const auto sx = __builtin_amdgcn_permlane32_swap(p0x, p1x, false, false); const auto sy = __builtin_amdgcn_permlane32_swap(p0y, p1y, false, false);
            const unsigned q0 = sx[0], q1 = sy[0], q2 = sx[1], q3 = sy[1];
            *(u32x4*)(yrow + 32 * ob) = (u32x4){q0, q1, q2, q3};
        }
    }
    asm volatile("s_waitcnt vmcnt(0)" ::: "memory");
    __builtin_amdgcn_s_barrier();
}

__device__ __forceinline__ int xcd_unit(int i, int G, int c, int U) {
    if ((G & 7) != 0) { const int idx = i * G + c; return idx < U ? idx : -1; }
    const int x = c & 7, j = c >> 3, per = G >> 3, q = U >> 3, r = U & 7;
    const int start = x * q + (x < r ? x : r), size = q + (x < r ? 1 : 0);
    const int loc = i * per + j;
    return loc < size ? start + loc : -1;
}
__device__ __forceinline__ int xcd_max_units(int G, int U) {
    if ((G & 7) != 0) return (U + G - 1) / G;
    const int per = G >> 3; return ((U + 7) / 8 + per - 1) / per;
}
#define ACC8(ai, bj, m) const f32x4 a0_ = acc[ai][bj][m][0], a1_ = acc[ai][bj][m][1]; float v[8] = {a0_[0], a0_[1], a0_[2], a0_[3], a1_[0], a1_[1], a1_[2], a1_[3]}

struct SchedInproj { int G, c; const char* H; const char* W; unsigned* stat = nullptr;
    __device__ __forceinline__ bool next(int i, GUnit& u) const {
        const int idx = xcd_unit(i, G, c, 1056); if (idx < 0) return false;
        if (idx < 792) { const int pm = idx / 6, pn = idx % 6; u.A = H + (size_t)pm * 256 * P8; u.B = W + (size_t)pn * 256 * P8; u.p0 = 0; u.p1 = pm; u.p2 = pn; u.p3 = 0; }
        else { const int j = idx - 792, vm = j / 132, tn = j % 132; u.A = W + (size_t)(1536 + 256 * vm) * P8; u.B = H + (size_t)tn * 256 * P8; u.p0 = 1; u.p1 = vm; u.p2 = tn; u.p3 = 0; }
        return true; }
    __device__ __forceinline__ int row_token(const GUnit&, int) const { return 0; }
    __device__ __forceinline__ size_t kstepA() const { return 128; }
    __device__ __forceinline__ unsigned voffA(int h, int R, int cb, unsigned lda2) const { return (unsigned)(h * 128 + R) * lda2 + (unsigned)cb; }
    __device__ __forceinline__ int row_token_lds(const GUnit&, int, int) const { return 0; }
    __device__ __forceinline__ void pre(const GUnit&, int, int, int) const {}
};
struct EpiInproj { bf16_t* P; bf16_t* VT; bf16_t* SUX; const LAS float* ROPE;
    __device__ __forceinline__ void operator()(const AccT& acc, const GUnit& u, int slot, int wr, int wc, int fr, int fq) const {
        if (u.p0 == 1) {
#pragma unroll
            for (int ai = 0; ai < 2; ++ai)
#pragma unroll
                for (int m = 0; m < 4; ++m) { const int row = u.p1 * 256 + 128 * ai + 64 * wr + 16 * m + fr;
#pragma unroll
                    for (int bj = 0; bj < 2; ++bj) { ACC8(ai, bj, m);
#pragma unroll
                        for (int e = 0; e < 8; ++e) v[e] *= (1.0f / (FP8_SH * FP8_SW));
                        const u32x4 w = pack8(v);
                        bf16_t* vp = VT + (size_t)row * TT + u.p2 * 256 + 128 * bj + 32 * wc + 8 * (fq >> 1) + 4 * (fq & 1);
                        const auto rx = __builtin_amdgcn_permlane16_swap(w.x, w.z, false, false); const auto ry = __builtin_amdgcn_permlane16_swap(w.y, w.w, false, false);
                        const unsigned ax = rx[0], bx = rx[1], ay = ry[0], by = ry[1];
                        *(u32x4*)(vp + ((fq & 1) ? 12 : 0)) = (u32x4){ax, ay, bx, by}; } }
            return;
        }
        const int pm = u.p1, pn = u.p2;
#pragma unroll
        for (int bj = 0; bj < 2; ++bj) {
            const int hh = 2 * pn + bj;
            const bool rope = (hh >= 6 && hh < 10 && pm < 128), scale = (hh < 3 || (hh >= 6 && hh < 9));
            if (hh >= 10) half<4>(acc, bj, pm, hh, wr, wc, fr, fq);
            else if (rope && scale) half<3>(acc, bj, pm, hh, wr, wc, fr, fq);
            else if (rope) half<2>(acc, bj, pm, hh, wr, wc, fr, fq);
            else if (scale) half<1>(acc, bj, pm, hh, wr, wc, fr, fq);
            else half<0>(acc, bj, pm, hh, wr, wc, fr, fq);
        }
    }
    template <int KIND>
    __device__ __forceinline__ void half(const AccT& acc, const int bj, const int pm, const int hh, const int wr, const int wc, const int fr, const int fq) const {
        const bool lo32 = fq < 2;
#pragma unroll
        for (int ai = 0; ai < 2; ++ai)
#pragma unroll
            for (int m = 0; m < 4; ++m) {
                const int row = pm * 256 + 128 * ai + 64 * wr + 16 * m + fr;
                const f32x4 a0_ = bj ? acc[ai][1][m][0] : acc[ai][0][m][0], a1_ = bj ? acc[ai][1][m][1] : acc[ai][0][m][1];
                float v[8] = {a0_[0], a0_[1], a0_[2], a0_[3], a1_[0], a1_[1], a1_[2], a1_[3]};
#pragma unroll
                for (int e = 0; e < 8; ++e) v[e] *= (1.0f / (FP8_SH * FP8_SW));
                if (KIND == 4) {
                    const int g = 8 * (hh - 10) + 2 * wc + (fq >> 1);
                    *(u32x4*)(SUX + ((size_t)g * MCH + (row >> 6)) * SUXW + (row & 63) * 16 + 8 * (fq & 1)) = pack8(v);
                } else {
                    if (KIND == 2 || KIND == 3) {
                        const int t = row & (SEQ - 1); const int pos = (wc & 1) ? (t & 63) : (t >> 6);
                        const LAS float* cs = ROPE + pos * 16 + 8 * (fq & 1);
                        const f32x4 c0 = *(const LAS f32x4*)cs, c1 = *(const LAS f32x4*)(cs + 4), s0 = *(const LAS f32x4*)(cs + 2048), s1 = *(const LAS f32x4*)(cs + 2052);
                        const float sg = lo32 ? -1.0f : 1.0f;
                        const float cc[8] = {c0[0], c0[1], c0[2], c0[3], c1[0], c1[1], c1[2], c1[3]}, sn[8] = {s0[0] * sg, s0[1] * sg, s0[2] * sg, s0[3] * sg, s1[0] * sg, s1[1] * sg, s1[2] * sg, s1[3] * sg};
#pragma unroll
                        for (int e = 0; e < 8; ++e) { const unsigned xu = __builtin_bit_cast(unsigned, v[e]); const auto sw = __builtin_amdgcn_permlane32_swap(xu, xu, false, false); const unsigned lo_ = sw[0], hi_ = sw[1];
                            const unsigned pu = lo32 ? hi_ : lo_; v[e] = v[e] * cc[e] + __builtin_bit_cast(float, pu) * sn[e]; }
                    }
                    if (KIND == 1 || KIND == 3) {
#pragma unroll
                        for (int e = 0; e < 8; ++e) v[e] *= (0.125f * LOG2E_); }
                    *(u32x4*)(P + (size_t)row * PW + 128 * hh + 32 * wc + 8 * fq) = pack8(v);
                }
            }
    }
};
struct SchedS5a { int G, c; const char* SUX; const char* W; unsigned* stat = nullptr;
    __device__ __forceinline__ bool next(int i, GUnit& u) const {
        const int idx = xcd_unit(i, G, c, 48); if (idx < 0) return false;
        const int g = idx / 3, pm = idx % 3; u.A = SUX + ((size_t)g * MCH + pm * 256) * (SUXW * 2); u.B = W + (size_t)g * 256 * 2048; u.p0 = 0; u.p1 = pm; u.p2 = g; u.p3 = 0; return true; }
    __device__ __forceinline__ int row_token(const GUnit&, int) const { return 0; }
    __device__ __forceinline__ size_t kstepA() const { return 128; }
    __device__ __forceinline__ unsigned voffA(int h, int R, int cb, unsigned lda2) const { return (unsigned)(h * 128 + R) * lda2 + (unsigned)cb; }
    __device__ __forceinline__ int row_token_lds(const GUnit&, int, int) const { return 0; }
    __device__ __forceinline__ void pre(const GUnit&, int, int, int) const {}
};
struct EpiS5a { float* SL;
    __device__ __forceinline__ void operator()(const AccT& acc, const GUnit& u, int slot, int wr, int wc, int fr, int fq) const {
#pragma unroll
        for (int ai = 0; ai < 2; ++ai)
#pragma unroll
            for (int m = 0; m < 4; ++m) { float* rowp = SL + (size_t)(u.p1 * 256 + 128 * ai + 64 * wr + 16 * m + fr) * 4096 + u.p2 * 256 + 32 * wc + 8 * fq;
#pragma unroll
                for (int bj = 0; bj < 2; ++bj) { *(f32x4*)(rowp + 128 * bj) = acc[ai][bj][m][0]; *(f32x4*)(rowp + 128 * bj + 4) = acc[ai][bj][m][1]; } }
    }
};
struct SchedS5c { int G, c; const char* SUX; const char* KC; unsigned* stat = nullptr;
    __device__ __forceinline__ bool next(int i, GUnit& u) const {
        const int idx = xcd_unit(i, G, c, 192); if (idx < 0) return false;
        const int g = idx / 12, q = idx % 12, pm = q / 4, pn = q % 4;
        u.A = SUX + ((size_t)g * MCH + pm * 256) * (SUXW * 2); u.B = KC + ((size_t)g * 1024 + pn * 256) * (SUXW * 2); u.p0 = 0; u.p1 = pm; u.p2 = pn; u.p3 = g; return true; }
    __device__ __forceinline__ int row_token(const GUnit&, int) const { return 0; }
    __device__ __forceinline__ size_t kstepA() const { return 128; }
    __device__ __forceinline__ unsigned voffA(int h, int R, int cb, unsigned lda2) const { return (unsigned)(h * 128 + R) * lda2 + (unsigned)cb; }
    __device__ __forceinline__ int row_token_lds(const GUnit&, int, int) const { return 0; }
    __device__ __forceinline__ void pre(const GUnit&, int, int, int) const {}
};
struct EpiS5c { bf16_t* Gb;
    __device__ __forceinline__ void operator()(const AccT& acc, const GUnit& u, int slot, int wr, int wc, int fr, int fq) const {
#pragma unroll
        for (int ai = 0; ai < 2; ++ai)
#pragma unroll
            for (int m = 0; m < 4; ++m) { const int chunk = u.p1 * 256 + 128 * ai + 64 * wr + 16 * m + fr;
                if (chunk < TT / 64) {
#pragma unroll
                    for (int bj = 0; bj < 2; ++bj) { ACC8(ai, bj, m); const int col = u.p2 * 256 + 128 * bj + 32 * wc + 8 * fq;
#pragma unroll
                        for (int e = 0; e < 8; ++e) v[e] = gelu_tanh(v[e]);
                        *(u32x4*)(Gb + ((size_t)chunk * 64 + (col >> 4)) * 256 + u.p3 * 16 + (col & 15)) = pack8(v); } } }
    }
};
struct SchedGlu { int G, c; const char* Gb; const char* W; unsigned* stat = nullptr;
    __device__ __forceinline__ bool next(int i, GUnit& u) const {
        const int idx = xcd_unit(i, G, c, 132); if (idx < 0) return false;
        u.A = Gb + (size_t)idx * 256 * 512; u.B = W; u.p0 = 0; u.p1 = idx; u.p2 = 0; u.p3 = 0; return true; }
    __device__ __forceinline__ int row_token(const GUnit&, int) const { return 0; }
    __device__ __forceinline__ size_t kstepA() const { return 128; }
    __device__ __forceinline__ unsigned voffA(int h, int R, int cb, unsigned lda2) const { return (unsigned)(h * 128 + R) * lda2 + (unsigned)cb; }
    __device__ __forceinline__ int row_token_lds(const GUnit&, int, int) const { return 0; }
    __device__ __forceinline__ void pre(const GUnit&, int, int, int) const {}
};
struct EpiGlu { const bf16_t* Gb; unsigned char* Y; const float* bglu;
    __device__ __forceinline__ void operator()(const AccT& acc, const GUnit& u, int slot, int wr, int wc, int fr, int fq) const {
#pragma unroll
        for (int bj = 0; bj < 2; ++bj) { const int col = 128 * bj + 32 * wc + 8 * fq;
            const f32x4 b0 = *(const f32x4*)(bglu + col), b1 = *(const f32x4*)(bglu + col + 4); const float bb[8] = {b0[0], b0[1], b0[2], b0[3], b1[0], b1[1], b1[2], b1[3]};
            u32x4 gw[2][4];
#pragma unroll
            for (int ai = 0; ai < 2; ++ai)
#pragma unroll
                for (int m = 0; m < 4; ++m) gw[ai][m] = *(const u32x4*)(Gb + (size_t)(u.p1 * 256 + 128 * ai + 64 * wr + 16 * m + fr) * 256 + col);
#pragma unroll
            for (int ai = 0; ai < 2; ++ai)
#pragma unroll
                for (int m = 0; m < 4; ++m) { const int row = u.p1 * 256 + 128 * ai + 64 * wr + 16 * m + fr; ACC8(ai, bj, m);
                    const u32x4 g4 = gw[ai][m];
                    const float gv[8] = {bflo(g4.x), bfhi(g4.x), bflo(g4.y), bfhi(g4.y), bflo(g4.z), bfhi(g4.z), bflo(g4.w), bfhi(g4.w)};
#pragma unroll
                    for (int e = 0; e < 8; ++e) v[e] = (FP8_SY * gv[e]) * sigmoidf_(v[e] + bb[e]);
                    *(u32x2*)(Y + (size_t)row * P8 + 384 + col) = (u32x2){pk4_fp8(v[0], v[1], v[2], v[3]), pk4_fp8(v[4], v[5], v[6], v[7])}; } }
    }
};
struct SchedOut { int G, c, nunits; const char* Y; const char* W; unsigned* stat = nullptr;
    __device__ __forceinline__ bool next(int i, GUnit& u) const {
        const int idx = xcd_unit(i, G, c, nunits); if (idx < 0) return false;
        const int pm = idx >> 2, pn = idx & 3; u.A = Y + (size_t)pm * 256 * P8; u.B = W + (size_t)pn * 256 * P8; u.p0 = 0; u.p1 = pm; u.p2 = pn; u.p3 = 0; return true; }
    __device__ __forceinline__ int row_token(const GUnit&, int) const { return 0; }
    __device__ __forceinline__ size_t kstepA() const { return 128; }
    __device__ __forceinline__ unsigned voffA(int h, int R, int cb, unsigned lda2) const { return (unsigned)(h * 128 + R) * lda2 + (unsigned)cb; }
    __device__ __forceinline__ int row_token_lds(const GUnit&, int, int) const { return 0; }
    __device__ __forceinline__ void pre(const GUnit&, int, int, int) const {}
};
struct EpiOut { bf16_t* XR; const float* G2;
    __device__ __forceinline__ void operator()(const AccT& acc, const GUnit& u, int slot, int wr, int wc, int fr, int fq) const {
        const int bi = (u.p1 < 128) ? (u.p1 >> 5) : 4;
        const float* gp = G2 + (size_t)bi * 6144 + u.p2 * 256 + 32 * wc + 8 * fq;
        const f32x4 ga0 = *(const f32x4*)gp, ga1 = *(const f32x4*)(gp + 4), gb0 = *(const f32x4*)(gp + 128), gb1 = *(const f32x4*)(gp + 132);
        constexpr float SC = 1.0f / (FP8_SY * FP8_SW);
        const float gg[2][8] = {{ga0[0] * SC, ga0[1] * SC, ga0[2] * SC, ga0[3] * SC, ga1[0] * SC, ga1[1] * SC, ga1[2] * SC, ga1[3] * SC}, {gb0[0] * SC, gb0[1] * SC, gb0[2] * SC, gb0[3] * SC, gb1[0] * SC, gb1[1] * SC, gb1[2] * SC, gb1[3] * SC}};
#pragma unroll
        for (int ai = 0; ai < 2; ++ai) {
            u32x4 xw[4][2];
#pragma unroll
            for (int m = 0; m < 4; ++m)
#pragma unroll
                for (int bj = 0; bj < 2; ++bj) xw[m][bj] = *(const u32x4*)(XR + (size_t)(u.p1 * 256 + 128 * ai + 64 * wr + 16 * m + fr) * D + u.p2 * 256 + 32 * wc + 8 * fq + 128 * bj);
#pragma unroll
            for (int m = 0; m < 4; ++m) { bf16_t* rowp = XR + (size_t)(u.p1 * 256 + 128 * ai + 64 * wr + 16 * m + fr) * D + u.p2 * 256 + 32 * wc + 8 * fq;
#pragma unroll
                for (int bj = 0; bj < 2; ++bj) { ACC8(ai, bj, m);
                    const u32x4 x4 = xw[m][bj];
                    const float xv[8] = {bflo(x4.x), bfhi(x4.x), bflo(x4.y), bfhi(x4.y), bflo(x4.z), bfhi(x4.z), bflo(x4.w), bfhi(x4.w)};
#pragma unroll
                    for (int e = 0; e < 8; ++e) v[e] = xv[e] + gg[bj][e] * v[e];
                    *(u32x4*)(rowp + 128 * bj) = pack8(v); } } }
    }
};
struct SchedMoe { int G, c, NT; const LAS int* ts; const char* A; const char* W; size_t wstride; const int* elist; bool gather; const float* bgu; LAS unsigned char* lds; bool rev; unsigned* stat = nullptr;
    __device__ __forceinline__ bool next(int i, GUnit& u) const {
        const int idx = xcd_unit(i, G, c, ts[32] * NT); if (idx < 0) return false;
        const int mt = rev ? (ts[32] - 1 - idx / NT) : idx / NT, pn = idx % NT; const int e = ((const LAS int*)(lds + LDS_T2E))[mt];
        u.A = gather ? A : (A + (size_t)mt * 262144); u.B = W + (size_t)e * wstride + (size_t)pn * 256 * P8;   u.p0 = mt; u.p1 = pn; u.p2 = e; u.p3 = (mt - ts[e]) * 256; return true; }
    __device__ __forceinline__ int row_token(const GUnit& u, int row) const { const int j = min(u.p3 + row, ts[40 + u.p2] - 1); return elist[(size_t)u.p2 * TT + j]; }
    __device__ __forceinline__ size_t kstepA() const { return gather ? 128 : 32768; }
    __device__ __forceinline__ unsigned voffA(int h, int R, int cb, unsigned lda2) const {
        if (gather) return (unsigned)(h * 128 + R) * lda2 + (unsigned)cb;
        const int ch = cb >> 4; return (unsigned)((((h * 2 + (R >> 6)) * 4 + ((R >> 4) & 3)) * 4 + (ch >> 1)) * 512 + (R & 15) * 32 + (ch & 1) * 16); }
    __device__ __forceinline__ int row_token_lds(const GUnit& u, int slot, int row) const { const int t = ((const LAS int*)(lds + LDS_TOK + slot * 1024))[row]; return (u.p3 + row < ts[40 + u.p2]) ? t : 0; }
    __device__ __forceinline__ void pre(const GUnit& u, int slot, int wid, int lane) const {
        if (bgu != nullptr && wid == 0) { const float* src = bgu + (size_t)u.p2 * 2048 + 128 * u.p1 + ((lane & 32) ? 1024 : 0) + 4 * (lane & 31);
            __builtin_amdgcn_global_load_lds((const unsigned*)src, (LAS unsigned*)(lds + LDS_BIAS + slot * 1024), 16, 0, 0); }
        if (gather && wid == 1) __builtin_amdgcn_global_load_lds((const unsigned*)(elist + (size_t)u.p2 * TT + u.p3 + 4 * lane), (LAS unsigned*)(lds + LDS_TOK + slot * 1024), 16, 0, 0); }
};
struct EpiGateUp { unsigned char* ACT; LAS unsigned char* lds;
    __device__ __forceinline__ void operator()(const AccT& acc, const GUnit& u, int slot, int wr, int wc, int fr, int fq) const {
        const LAS float* bg = (const LAS float*)(lds + LDS_BIAS + slot * 1024) + 32 * wc + 8 * fq;
        const f32x4 g0 = *(const LAS f32x4*)bg, g1 = *(const LAS f32x4*)(bg + 4), u0 = *(const LAS f32x4*)(bg + 128), u1 = *(const LAS f32x4*)(bg + 132);
        constexpr float KS = -1.702f * 1.4426950408889634f;
        constexpr float CG = KS / (FP8_SH * FP8_SW), CU = (FP8_SA / (FP8_SH * FP8_SW)) / KS, TLO = 7.0f * KS, WLO = 8.0f * FP8_SA / KS, WHI = -6.0f * FP8_SA / KS;
        const f32x2 bgk[4] = {(f32x2){g0[0], g0[1]} * KS, (f32x2){g0[2], g0[3]} * KS, (f32x2){g1[0], g1[1]} * KS, (f32x2){g1[2], g1[3]} * KS};
        const f32x2 buk[4] = {((f32x2){u0[0], u0[1]} + 1.0f) * (FP8_SA / KS), ((f32x2){u0[2], u0[3]} + 1.0f) * (FP8_SA / KS), ((f32x2){u1[0], u1[1]} + 1.0f) * (FP8_SA / KS), ((f32x2){u1[2], u1[3]} + 1.0f) * (FP8_SA / KS)};
        u32x2 pend = (u32x2){0u, 0u};
#pragma unroll
        for (int ai = 0; ai < 2; ++ai)
#pragma unroll
            for (int m = 0; m < 4; ++m) {
                const f32x4 ga = acc[ai][0][m][0], gb = acc[ai][0][m][1], ua = acc[ai][1][m][0], ub = acc[ai][1][m][1];
                const f32x2 gp[4] = {__builtin_shufflevector(ga, ga, 0, 1), __builtin_shufflevector(ga, ga, 2, 3), __builtin_shufflevector(gb, gb, 0, 1), __builtin_shufflevector(gb, gb, 2, 3)};
                const f32x2 up[4] = {__builtin_shufflevector(ua, ua, 0, 1), __builtin_shufflevector(ua, ua, 2, 3), __builtin_shufflevector(ub, ub, 0, 1), __builtin_shufflevector(ub, ub, 2, 3)};
                f32x2 o[4];
#pragma unroll
                for (int q = 0; q < 4; ++q) {
                    f32x2 t = gp[q] * CG + bgk[q];
                    t = (f32x2){fmaxf(t.x, TLO), fmaxf(t.y, TLO)};
                    const f32x2 den = (f32x2){__builtin_amdgcn_exp2f(t.x), __builtin_amdgcn_exp2f(t.y)} + 1.0f;
                    const f32x2 sg = (f32x2){__builtin_amdgcn_rcpf(den.x), __builtin_amdgcn_rcpf(den.y)};
                    f32x2 w = up[q] * CU + buk[q];
                    w = (f32x2){__builtin_amdgcn_fmed3f(w.x, WLO, WHI), __builtin_amdgcn_fmed3f(w.y, WLO, WHI)};
                    o[q] = t * sg * w; }
                const u32x2 cur = (u32x2){pk4_fp8_nc(o[0].x, o[0].y, o[1].x, o[1].y), pk4_fp8_nc(o[2].x, o[2].y, o[3].x, o[3].y)};
                if ((m & 1) == 0) pend = cur;
                else {
                    const auto rx = __builtin_amdgcn_permlane16_swap(pend.x, cur.x, false, false); const auto ry = __builtin_amdgcn_permlane16_swap(pend.y, cur.y, false, false);
                    const unsigned ax = rx[0], bx = rx[1], ay = ry[0], by = ry[1];
                    unsigned char* dst = ACT + ((size_t)u.p0 * 8 + u.p1) * 32768 + ((((ai * 2 + wr) * 4 + (m - 1)) * 4 + wc) * 512 + fr * 32 + fq * 8) + ((fq & 1) ? (2048 - 8) : 0);
                    *(u32x4*)dst = (u32x4){ax, ay, bx, by}; } }
    }
};
struct EpiDown { unsigned char* EO; const float* bd; bool dry;
    __device__ __forceinline__ void operator()(const AccT& acc, const GUnit& u, int slot, int wr, int wc, int fr, int fq) const {
        if (dry) return;
        const float* bp = bd + (size_t)u.p2 * D + u.p1 * 256 + 32 * wc + 8 * fq;
        const f32x4 c0 = *(const f32x4*)bp * FP8_SE, c1 = *(const f32x4*)(bp + 4) * FP8_SE, d0 = *(const f32x4*)(bp + 128) * FP8_SE, d1 = *(const f32x4*)(bp + 132) * FP8_SE;
        const float bb0[8] = {c0[0], c0[1], c0[2], c0[3], c1[0], c1[1], c1[2], c1[3]}, bb1[8] = {d0[0], d0[1], d0[2], d0[3], d1[0], d1[1], d1[2], d1[3]};
        const int soff = (fq & 1) ? (128 - 8) : 0;
#pragma unroll
        for (int ai = 0; ai < 2; ++ai)
#pragma unroll
            for (int m = 0; m < 4; ++m) { unsigned char* rowp = EO + ((size_t)u.p0 * 256 + 128 * ai + 64 * wr + 16 * m + fr) * D + u.p1 * 256 + 32 * wc + 8 * fq;
                u32x2 a, b;
                { ACC8(ai, 0, m);
#pragma unroll
                  for (int e = 0; e < 8; ++e) v[e] = v[e] * (FP8_SE / (FP8_SA * FP8_SW)) + bb0[e];
                  a = (u32x2){pk4_fp8(v[0], v[1], v[2], v[3]), pk4_fp8(v[4], v[5], v[6], v[7])}; }
                { ACC8(ai, 1, m);
#pragma unroll
                  for (int e = 0; e < 8; ++e) v[e] = v[e] * (FP8_SE / (FP8_SA * FP8_SW)) + bb1[e];
                  b = (u32x2){pk4_fp8(v[0], v[1], v[2], v[3]), pk4_fp8(v[4], v[5], v[6], v[7])}; }
                const auto rx = __builtin_amdgcn_permlane16_swap(a.x, b.x, false, false); const auto ry = __builtin_amdgcn_permlane16_swap(a.y, b.y, false, false);
                const unsigned ax = rx[0], bx = rx[1], ay = ry[0], by = ry[1];
                *(u32x4*)(rowp + soff) = (u32x4){ax, ay, bx, by}; }
    }
};

constexpr int PH_PER_LAYER = 7, NPHASES = 1 + DEPTH * PH_PER_LAYER + 1;

__global__ void __launch_bounds__(NTHREADS, 2) mk_fwd(Args args) {
    extern __shared__ __attribute__((aligned(16))) unsigned char lds_raw[];
    Frame F;
    F.lds = (LAS unsigned char*)lds_raw;
    F.G = gridDim.x; F.bid = blockIdx.x;
    KArgs A0 = (KArgs)__builtin_amdgcn_kernarg_segment_ptr();
    KArgs A = A0; asm volatile("" : "+s"(A));
    volatile LAS unsigned* misc = (volatile LAS unsigned*)(F.lds + LDS_MISC);
    if (threadIdx.x < 16) misc[threadIdx.x] = 0u;
    __syncthreads();
    const int lo = A->ph_lo, hi = A->ph_hi;
    XcdBarrier bar; bar.bar = (unsigned*)A->ws + CW_BAR; bar.x = 0; bar.st = nullptr;
    if (hi - lo > 1) bar = xcd_barrier_post((unsigned*)A->ws + CW_BAR, misc + 8);
    LAS unsigned char* L = F.lds;
    const LAS int* ts = (const LAS int*)(F.lds + LDS_MISC + 64);
    int ph = 0;
#ifdef ONLY_SITE
#define SITE_ON(s) ((s) == ONLY_SITE)
#define ONLY_SITE_BUILD true
#else
#define SITE_ON(s) true
#define ONLY_SITE_BUILD false
#endif
#ifndef DUP_MASK
#define DUP_MASK 0u
#endif
#define PH_RUN(s) (SITE_ON(s) && ph >= lo && ph < hi)
#define PH_REP(s) for (int rep_ = 0; rep_ < (((DUP_MASK >> (s)) & 1u) ? 2 : 1); ++rep_)
#define PH_END do { if (ph >= lo && ph + 1 < hi) xcd_barrier(bar); ++ph; A = A0; asm volatile("" : "+s"(A)); } while (0)

    if (PH_RUN(0)) PH_REP(0) phase_p0a(A, F);
    PH_END;
    for (int l = 0; l < DEPTH; ++l) {
        const bool lastl = (l == DEPTH - 1);
        if (PH_RUN(2)) { if (l == 0) { phase_p0b(A, F); __syncthreads(); }
            phase_norm1(A, F, l); if ((DUP_MASK >> 2) & 1u) phase_norm1(A, F, l, 0.0f); }
        PH_END;
        if (PH_RUN(3)) PH_REP(3) {
            SchedInproj S{F.G, F.bid, (const char*)WSP(unsigned char, WS_H8), (const char*)(WSP(unsigned char, WS_WINT) + (size_t)l * 2048 * P8)};
            { int t0 = threadIdx.x; asm volatile("" : "+v"(t0)); LAS float* rl = (LAS float*)(L + LDS_ROPE); const float* rg = WSP(float, WS_ROPE); for (int i = t0; i < 4096; i += NTHREADS) rl[i] = rg[i]; __syncthreads(); }
            EpiInproj E{WSP(bf16_t, WS_P), WSP(bf16_t, WS_VT), WSP(bf16_t, WS_SUX), (const LAS float*)(L + LDS_ROPE)};
            gemm_phase<false, true>(L, 8, (unsigned)P8, (unsigned)P8, S, E);
            if (xcd_unit(4, F.G, F.bid, 1056) < 0) conv_fill2(A, F, l, 5);
        }
        PH_END;
        if (PH_RUN(4)) {
            const bool std_ = (F.G == 256);
            unsigned* xc = (unsigned*)A->ws + CW_XC + l * 16;
            if (F.bid < 48) {
                SchedS5a S{48, F.bid, (const char*)WSP(bf16_t, WS_SUX), (const char*)(WSP(bf16_t, WS_WST) + (size_t)l * 16 * 256 * 1024)};
                EpiS5a E{WSP(float, WS_SLOC)};
                gemm_phase<false, false>(L, 16, (unsigned)(SUXW * 2), 2048u, S, E);
                if (std_) xc_signal(xc + 0);
            }
            if (std_ && F.bid < 16) { xc_wait(xc + 0, 48u, bar.bar); phase_s5scan(A, F, l); xc_signal(xc + 1); }
            phase_attn(A, F, l, 0);
            if (!std_) { xcd_barrier(bar); phase_s5scan(A, F, l); xcd_barrier(bar); }
            if (!std_ || F.bid >= 64) {
                if (std_) xc_wait(xc + 1, 16u, bar.bar);
                SchedS5c S{std_ ? 192 : F.G, std_ ? F.bid - 64 : F.bid, (const char*)WSP(bf16_t, WS_SUX), (const char*)(WSP(bf16_t, WS_KC) + (size_t)l * 16 * 1024 * SUXW)};
                EpiS5c E{WSP(bf16_t, WS_G)};
                gemm_phase<false, false>(L, 20, (unsigned)(SUXW * 2), (unsigned)(SUXW * 2), S, E);
                if (std_) xc_signal(xc + 2);
            }
            if (!std_) xcd_barrier(bar);
            phase_attn(A, F, l, 1);
            if (!std_ || (F.bid >= 64 && F.bid < 196)) {
                if (std_) xc_wait(xc + 2, 192u, bar.bar);
                SchedGlu S{std_ ? 132 : F.G, std_ ? F.bid - 64 : F.bid, (const char*)WSP(bf16_t, WS_G), (const char*)(WSP(bf16_t, WS_WGLUT) + (size_t)l * 256 * 256)};
                EpiGlu E{WSP(bf16_t, WS_G), WSP(unsigned char, WS_Y), FIN(19) + (size_t)l * 256};
                gemm_phase<false, false>(L, 4, 512u, 512u, S, E);
            }
            if (std_ && F.bid >= 244) conv_fill2(A, F, l, 3);
        }
        PH_END;
        if (PH_RUN(9)) PH_REP(9) {
            SchedOut S{F.G, F.bid, (lastl ? 128 : 132) * 4, (const char*)WSP(unsigned char, WS_Y), (const char*)(WSP(unsigned char, WS_WOUTT) + (size_t)l * D * P8)};
            EpiOut E{WSP(bf16_t, WS_XR), WSP(float, WS_MOD) + (size_t)l * 5 * 6144 + 2 * D};
            gemm_phase<false, true>(L, 8, (unsigned)P8, (unsigned)P8, S, E);
            if (xcd_unit(2, F.G, F.bid, (lastl ? 128 : 132) * 4) < 0) conv_fill2(A, F, l, 3);
        }
        PH_END;
        if (PH_RUN(10)) { (void)conv_fill(A, F, l, 1 << 30);
            phase_router(A, F, l); if ((DUP_MASK >> 10) & 1u) phase_router(A, F, l, true); }
        PH_END;
        if (PH_RUN(11)) PH_REP(11) {
            build_tstart(A, F, l);
            SchedMoe S{F.G, F.bid, 8, ts, (const char*)WSP(unsigned char, WS_H8), (const char*)(WSP(unsigned char, WS_WGUT) + (size_t)l * NEXP * 2048 * P8), (size_t)2048 * P8, WSP(int, WS_ELIST), true, FIN(25) + (size_t)l * NEXP * 2048, L, false};
            EpiGateUp E{WSP(unsigned char, WS_ACT), L};
            gemm_phase<true, true>(L, 8, (unsigned)P8, (unsigned)P8, S, E);
            if (xcd_unit(xcd_max_units(F.G, ts[32] * 8) - 1, F.G, F.bid, ts[32] * 8) < 0) conv_fill2(A, F, l, 2);
        }
        PH_END;
        if (PH_RUN(12)) PH_REP(12) {
            if (lo + 1 == hi || ONLY_SITE_BUILD) build_tstart(A, F, l);
            SchedMoe S{F.G, F.bid, 4, ts, (const char*)WSP(unsigned char, WS_ACT), (const char*)(WSP(unsigned char, WS_WDT) + (size_t)l * NEXP * D * P8), (size_t)D * P8, WSP(int, WS_ELIST), false, nullptr, L, true};
            EpiDown E{WSP(unsigned char, WS_EO), FIN(27) + (size_t)l * NEXP * D, (((DUP_MASK >> 20) & 1u) != 0u) && rep_ == 0};
#if PROBE_SEL >= 0
            if (l == 1) S.stat = (unsigned*)A->ws + CW_STAT;
#endif
            gemm_phase<false, true>(L, 8, (unsigned)P8, (unsigned)P8, S, E);
            if (xcd_unit(xcd_max_units(F.G, ts[32] * 4) - 1, F.G, F.bid, ts[32] * 4) < 0) conv_fill2(A, F, l, 2);
        }
        PH_END;
    }
    if (PH_RUN(13)) phase_norm1(A, F, DEPTH);
#undef PH_RUN
#undef PH_END
}
}

extern "C" void kernel_launch(void* const* d_in, const int* in_sizes, int n_in, void* d_out, int out_size, void* d_ws, size_t ws_size, hipStream_t stream) {
    static int grid = 0;
    if (grid == 0) {
        if (n_in != 29 || out_size != NLAT * D || ws_size < WS_END) { fprintf(stderr, "kernel_launch: unexpected shapes (n_in %d, out %d, ws %zu)\n", n_in, out_size, ws_size); grid = -1; return; }
        int dev = 0, cus = 0;
        if (hipGetDevice(&dev) != hipSuccess || hipDeviceGetAttribute(&cus, hipDeviceAttributeMultiprocessorCount, dev) != hipSuccess) { grid = -1; return; }
        if (hipFuncSetAttribute((const void*)mk_fwd, hipFuncAttributeMaxDynamicSharedMemorySize, LDS_BYTES) != hipSuccess) { fprintf(stderr, "kernel_launch: hipFuncSetAttribute failed\n"); grid = -1; return; }
        int per_cu = 0;
        if (hipOccupancyMaxActiveBlocksPerMultiprocessor(&per_cu, (const void*)mk_fwd, NTHREADS, LDS_BYTES) != hipSuccess || per_cu < 1) { fprintf(stderr, "kernel_launch: occupancy query reports %d\n", per_cu); }
        (void)hipGetLastError();
        grid = cus;
    }
    if (grid < 0) return;
    (void)hipMemsetAsync((char*)d_ws + WS_CTL, 0, 1 * MiB, stream);
    Args a{};
    for (int i = 0; i < 29; ++i) a.in[i] = (const float*)d_in[i];
    a.out = (float*)d_out; a.ws = (unsigned char*)d_ws;
#if MK_PER_PHASE
    for (int p = 0; p < NPHASES; ++p) { a.ph_lo = p; a.ph_hi = p + 1; hipLaunchKernelGGL(mk_fwd, dim3(grid), dim3(NTHREADS), LDS_BYTES, stream, a); }
#else
    a.ph_lo = 0; a.ph_hi = NPHASES;
    hipLaunchKernelGGL(mk_fwd, dim3(grid), dim3(NTHREADS), LDS_BYTES, stream, a);
#endif
}
```
